# Optimizing an MI355X kernel written in HIP

```python
import math
import jax, jax.numpy as jnp
from jax import lax
import numpy as np

D_MODEL = 1024
BATCH = 1
SEQ = 16384
DEPTH = 2
DEC_BATCH = 32
DEC_SEQ = 32
PAST_LEN = 1024

CHUNK = 64
Q_BLOCK = 128
EPS = 1e-6
NEG = -1e30

DA_WIDTH = 512
DA_HEADS = 4
DA_HEAD_DIM = 64
DA_V_DIM = 2 * DA_HEAD_DIM
RW_WIDTH = 512
RW_HEADS = 8
RW_HEAD = 64
RW_DECAY_LORA = 64
RW_A_LORA = 64
RW_GN_EPS = 64e-5
RW_SHIFT_COLS = 3 * RW_WIDTH + RW_DECAY_LORA + RW_A_LORA
DA_COLS = 4 * DA_WIDTH
RW_COLS = RW_SHIFT_COLS + RW_WIDTH
EVEN_IN_COLS = DA_COLS + RW_COLS
EVEN_SPLITS = [DA_WIDTH, 2 * DA_WIDTH, 3 * DA_WIDTH, DA_COLS, DA_COLS + RW_SHIFT_COLS]
RW_SPLITS = [RW_WIDTH, 2 * RW_WIDTH, 3 * RW_WIDTH, 3 * RW_WIDTH + RW_DECAY_LORA]
SB_WIDTH = D_MODEL
SB_HEADS = 16
SB_HEAD_DIM = 64
ODD_IN_COLS = 4 * SB_WIDTH
N_BUCKETS = 32
MAX_DISTANCE = 128

kernel_name = "hybrid_diffattn_rwkv7_stickbreaking_step"


def rms_norm(x, g, eps=EPS):
    xf = x.astype(jnp.float32)
    y = xf * lax.rsqrt(jnp.mean(xf * xf, axis=-1, keepdims=True) + eps)
    return (y * g.astype(jnp.float32)).astype(x.dtype)


def lambda_init_fn(layer_idx):
    return 0.8 - 0.6 * math.exp(-0.3 * layer_idx)


def t5_bucket(rel):
    nb = N_BUCKETS // 2
    max_exact = nb // 2
    n = jnp.abs(rel)
    nf = jnp.maximum(n, 1).astype(jnp.float32)
    large = max_exact + (jnp.log(nf / max_exact) / math.log(MAX_DISTANCE / max_exact) * (nb - max_exact)).astype(jnp.int32)
    large = jnp.minimum(large, nb - 1)
    return jnp.where(rel > 0, nb, 0) + jnp.where(n < max_exact, n, large)


def blocked_queries(fn, q):
    B, T = q.shape[0], q.shape[1]
    nblk = T // Q_BLOCK
    qb = jnp.moveaxis(q.reshape((B, nblk, Q_BLOCK) + q.shape[2:]), 1, 0)
    qpos = jnp.arange(T, dtype=jnp.int32).reshape(nblk, Q_BLOCK)
    out = lax.map(lambda args: fn(args[0], args[1]), (qb, qpos))
    out = jnp.moveaxis(out, 0, 1)
    return out.reshape((B, T) + out.shape[3:])


def diff_attention(q, k, v, qpos, kpos, lam, rel_bias):
    d = DA_HEAD_DIM
    scale = d ** -0.5
    s1 = jnp.einsum('bqhd,bkhd->bhqk', q[..., :d], k[..., :d]).astype(jnp.float32) * scale
    s2 = jnp.einsum('bqhd,bkhd->bhqk', q[..., d:], k[..., d:]).astype(jnp.float32) * scale
    bias = jnp.transpose(rel_bias[t5_bucket(kpos[None, :] - qpos[:, None])], (2, 0, 1)).astype(jnp.float32)[None]
    mask = (kpos[None, :] // CHUNK) <= (qpos[:, None] // CHUNK)
    p1 = jax.nn.softmax(jnp.where(mask, s1 + bias, NEG), axis=-1)
    p2 = jax.nn.softmax(jnp.where(mask, s2 + bias, NEG), axis=-1)
    w = p1 - lam * p2
    return jnp.einsum('bhqk,bkhd->bqhd', w.astype(v.dtype), v)


def stick_breaking(q, k, v, qpos, kpos):
    z = jnp.einsum('bqhd,bkhd->bhqk', q, k).astype(jnp.float32) * (SB_HEAD_DIM ** -0.5)
    causal = kpos[None, :] < qpos[:, None]
    log1m = jnp.where(causal, -jax.nn.softplus(z), 0.0)
    suffix = lax.cumsum(log1m, axis=3, reverse=True)
    excl = jnp.concatenate([suffix[..., 1:], jnp.zeros_like(suffix[..., :1])], axis=3)
    a = jnp.where(causal, jnp.exp(jax.nn.log_sigmoid(z) + excl), 0.0)
    return jnp.einsum('bhqk,bkhd->bqhd', a.astype(v.dtype), v)


def rwkv7_scan(state, r, decay, kk, kka, k, v):
    def step(S, xs):
        r_t, w_t, kk_t, kka_t, k_t, v_t = xs
        sa = jnp.einsum('bhvk,bhk->bhv', S, kk_t)
        S = S * w_t[:, :, None, :] - sa[..., None] * kka_t[:, :, None, :] + v_t[..., None] * k_t[:, :, None, :]
        return S, jnp.einsum('bhvk,bhk->bhv', S, r_t)
    xs = tuple(jnp.moveaxis(t.astype(jnp.float32), 1, 0) for t in (r, decay, kk, kka, k, v))
    S, o = lax.scan(step, state.astype(jnp.float32), xs)
    return S.astype(state.dtype), jnp.moveaxis(o, 0, 1)


def head_group_norm(o, g, b):
    mu = jnp.mean(o, axis=-1, keepdims=True)
    var = jnp.mean(jnp.square(o - mu), axis=-1, keepdims=True)
    y = (o - mu) * lax.rsqrt(var + RW_GN_EPS)
    B, T = o.shape[0], o.shape[1]
    return y.reshape(B, T, RW_WIDTH) * g.astype(jnp.float32) + b.astype(jnp.float32)


def even_layer(x, shift_prev, wkv_prev, past_k, past_v, p, layer_idx):
    (norm_g, w_in, w_out, rel_bias, q_g, k_g, lq1, lk1, lq2, lk2, subln_g,
     mu, w0, w_up, a0, a_up, k_k, k_a, r_k, lnx_g, lnx_b) = p
    B, T, _ = x.shape
    lambda_init = lambda_init_fn(layer_idx)
    xn = rms_norm(x, norm_g)
    proj = xn @ w_in
    qa, ka, va, za, prw, zb = jnp.split(proj, EVEN_SPLITS, axis=-1)

    def qk_norm(t, g):
        return rms_norm(t.reshape(B, T, DA_HEADS, 2, DA_HEAD_DIM), g).reshape(B, T, DA_HEADS, 2 * DA_HEAD_DIM)
    q = qk_norm(qa, q_g)
    k = qk_norm(ka, k_g)
    v = va.reshape(B, T, DA_HEADS, DA_V_DIM)
    lam = (jnp.exp(jnp.sum(lq1.astype(jnp.float32) * lk1.astype(jnp.float32)))
           - jnp.exp(jnp.sum(lq2.astype(jnp.float32) * lk2.astype(jnp.float32))) + lambda_init)
    if past_k is None:
        kpos = jnp.arange(T, dtype=jnp.int32)
        attn = blocked_queries(lambda qb, qp: diff_attention(qb, k, v, qp, kpos, lam, rel_bias), q)
    else:
        P = past_k.shape[1]
        k_all = jnp.concatenate([past_k, k], axis=1)
        v_all = jnp.concatenate([past_v, v], axis=1)
        qpos = P + jnp.arange(T, dtype=jnp.int32)
        kpos = jnp.arange(P + T, dtype=jnp.int32)
        attn = diff_attention(q, k_all, v_all, qpos, kpos, lam, rel_bias)
    oa = rms_norm(attn, subln_g) * (1.0 - lambda_init)
    oa = oa.reshape(B, T, DA_WIDTH) * jax.nn.silu(za)

    prev = jnp.concatenate([shift_prev.astype(prw.dtype), prw[:, :-1]], axis=1)
    mix = prw + (prev - prw) * mu
    r, kr, vr, wl, al = jnp.split(mix, RW_SPLITS, axis=-1)
    w = -jax.nn.softplus(-(w0 + jnp.tanh(wl) @ w_up).astype(jnp.float32)) - 0.5
    decay = jnp.exp(-jnp.exp(w))
    a = jax.nn.sigmoid(a0 + al @ a_up)
    heads = lambda t: t.reshape(B, T, RW_HEADS, RW_HEAD)
    kk = heads((kr * k_k).astype(jnp.float32))
    kk = kk / jnp.maximum(jnp.sqrt(jnp.sum(kk * kk, axis=-1, keepdims=True)), 1e-12)
    kr = kr * (1.0 + (a - 1.0) * k_a)
    r_h, k_h, v_h, a_h = heads(r), heads(kr), heads(vr), heads(a)
    wkv_new, o = rwkv7_scan(wkv_prev, r_h, heads(decay), kk, kk * a_h.astype(jnp.float32), k_h, v_h)
    bonus = (jnp.sum((r_h * k_h * r_k).astype(jnp.float32), axis=-1, keepdims=True) * v_h.astype(jnp.float32)).reshape(B, T, RW_WIDTH)
    ob = (head_group_norm(o, lnx_g, lnx_b) + bonus).astype(x.dtype) * jax.nn.silu(zb)

    y = x + jnp.concatenate([oa, ob], axis=-1) @ w_out
    return y, k, v, prw[:, -1:], wkv_new


def odd_layer(x, past_k, past_v, p):
    norm_g, w_in, w_out = p
    B, T, _ = x.shape
    xn = rms_norm(x, norm_g)
    q, k, v, z = jnp.split(xn @ w_in, 4, axis=-1)
    q = q.reshape(B, T, SB_HEADS, SB_HEAD_DIM)
    k = k.reshape(B, T, SB_HEADS, SB_HEAD_DIM)
    v = v.reshape(B, T, SB_HEADS, SB_HEAD_DIM)
    if past_k is None:
        kpos = jnp.arange(T, dtype=jnp.int32)
        o = blocked_queries(lambda qb, qp: stick_breaking(qb, k, v, qp, kpos), q)
    else:
        P = past_k.shape[1]
        k_all = jnp.concatenate([past_k, k], axis=1)
        v_all = jnp.concatenate([past_v, v], axis=1)
        qpos = P + jnp.arange(T, dtype=jnp.int32)
        kpos = jnp.arange(P + T, dtype=jnp.int32)
        o = stick_breaking(q, k_all, v_all, qpos, kpos)
    o = o.reshape(B, T, SB_WIDTH) * jax.nn.silu(z)
    return x + o @ w_out, k, v


def setup_inputs(seed: int = 0) -> dict:
    key = jax.random.key(seed)
    ks = jax.random.split(key, 32)
    nrm = lambda k, shape, s: jax.random.normal(k, shape, jnp.float32) * s
    D = D_MODEL
    return {
        "x_prompt": nrm(ks[0], (BATCH, SEQ, D), 1.0),
        "x_sample": nrm(ks[1], (DEC_BATCH, DEC_SEQ, D), 1.0),
        "cache_l0_k": nrm(ks[2], (DEC_BATCH, PAST_LEN, DA_HEADS, 2 * DA_HEAD_DIM), 1.0),
        "cache_l0_v": nrm(ks[3], (DEC_BATCH, PAST_LEN, DA_HEADS, DA_V_DIM), 1.0),
        "state_l0_shift": nrm(ks[4], (DEC_BATCH, 1, RW_SHIFT_COLS), 1.0),
        "state_l0_wkv": nrm(ks[5], (DEC_BATCH, RW_HEADS, RW_HEAD, RW_HEAD), 0.5),
        "cache_l1_k": nrm(ks[6], (DEC_BATCH, PAST_LEN, SB_HEADS, SB_HEAD_DIM), 1.0),
        "cache_l1_v": nrm(ks[7], (DEC_BATCH, PAST_LEN, SB_HEADS, SB_HEAD_DIM), 1.0),
        "rel_bias": nrm(ks[8], (N_BUCKETS, DA_HEADS), 0.5),
        "norm_l0": 1.0 + nrm(ks[9], (D,), 0.05),
        "w_in_l0": nrm(ks[10], (D, EVEN_IN_COLS), D ** -0.5),
        "w_out_l0": nrm(ks[11], (DA_WIDTH + RW_WIDTH, D), (DA_WIDTH + RW_WIDTH) ** -0.5),
        "da_q_norm": 1.0 + nrm(ks[12], (DA_HEAD_DIM,), 0.05),
        "da_k_norm": 1.0 + nrm(ks[13], (DA_HEAD_DIM,), 0.05),
        "da_lambda_q1": nrm(ks[14], (DA_HEAD_DIM,), 0.1),
        "da_lambda_k1": nrm(ks[15], (DA_HEAD_DIM,), 0.1),
        "da_lambda_q2": nrm(ks[16], (DA_HEAD_DIM,), 0.1),
        "da_lambda_k2": nrm(ks[17], (DA_HEAD_DIM,), 0.1),
        "da_subln": 1.0 + nrm(ks[18], (DA_V_DIM,), 0.05),
        "rw_mu": jax.random.uniform(ks[19], (RW_SHIFT_COLS,), jnp.float32),
        "rw_w0": jax.random.uniform(ks[20], (RW_WIDTH,), jnp.float32, -6.0, 0.0),
        "rw_w_up": nrm(ks[21], (RW_DECAY_LORA, RW_WIDTH), 0.5 * RW_DECAY_LORA ** -0.5),
        "rw_a0": nrm(ks[22], (RW_WIDTH,), 0.5),
        "rw_a_up": nrm(ks[23], (RW_A_LORA, RW_WIDTH), 0.5 * RW_A_LORA ** -0.5),
        "rw_k_k": 0.85 + nrm(ks[24], (RW_WIDTH,), 0.05),
        "rw_k_a": 1.0 + nrm(ks[25], (RW_WIDTH,), 0.05),
        "rw_r_k": nrm(ks[26], (RW_HEADS, RW_HEAD), 0.1),
        "rw_lnx_g": 1.0 + nrm(ks[27], (RW_WIDTH,), 0.05),
        "rw_lnx_b": nrm(ks[28], (RW_WIDTH,), 0.02),
        "norm_l1": 1.0 + nrm(ks[29], (D,), 0.05),
        "w_in_l1": nrm(ks[30], (D, ODD_IN_COLS), D ** -0.5),
        "w_out_l1": nrm(ks[31], (SB_WIDTH, D), SB_WIDTH ** -0.5),
    }


def reference(x_prompt, x_sample, cache_l0_k, cache_l0_v, state_l0_shift, state_l0_wkv, cache_l1_k, cache_l1_v,
              rel_bias, norm_l0, w_in_l0, w_out_l0, da_q_norm, da_k_norm, da_lambda_q1, da_lambda_k1,
              da_lambda_q2, da_lambda_k2, da_subln, rw_mu, rw_w0, rw_w_up, rw_a0, rw_a_up, rw_k_k, rw_k_a,
              rw_r_k, rw_lnx_g, rw_lnx_b, norm_l1, w_in_l1, w_out_l1):
    even_params = [(norm_l0, w_in_l0, w_out_l0, rel_bias, da_q_norm, da_k_norm, da_lambda_q1, da_lambda_k1,
                    da_lambda_q2, da_lambda_k2, da_subln, rw_mu, rw_w0, rw_w_up, rw_a0, rw_a_up, rw_k_k, rw_k_a,
                    rw_r_k, rw_lnx_g, rw_lnx_b)]
    odd_params = [(norm_l1, w_in_l1, w_out_l1)]
    even_caches = [(cache_l0_k, cache_l0_v, state_l0_shift, state_l0_wkv)]
    odd_caches = [(cache_l1_k, cache_l1_v)]
    yp, ys = x_prompt, x_sample
    Bp = x_prompt.shape[0]
    for layer in range(DEPTH):
        if layer % 2 == 0:
            p = even_params[layer // 2]
            ck, cv, cs, cw = even_caches[layer // 2]
            shift0 = jnp.zeros((Bp, 1, RW_SHIFT_COLS), x_prompt.dtype)
            wkv0 = jnp.zeros((Bp, RW_HEADS, RW_HEAD, RW_HEAD), state_l0_wkv.dtype)
            yp, l0_k_p, l0_v_p, l0_shift_p, l0_wkv_p = even_layer(yp, shift0, wkv0, None, None, p, layer)
            ys, l0_k_s, l0_v_s, l0_shift_s, l0_wkv_s = even_layer(ys, cs, cw, ck, cv, p, layer)
        else:
            p = odd_params[layer // 2]
            ck, cv = odd_caches[layer // 2]
            yp, l1_k_p, l1_v_p = odd_layer(yp, None, None, p)
            ys, l1_k_s, l1_v_s = odd_layer(ys, ck, cv, p)
    return (yp, ys, l0_k_p, l0_v_p, l0_shift_p, l0_wkv_p, l1_k_p, l1_v_p,
            l0_k_s, l0_v_s, l0_shift_s, l0_wkv_s, l1_k_s, l1_v_s)
```

```cpp
#include <hip/hip_runtime.h>
#include <stdint.h>
#include <cstdio>

typedef unsigned short bf16_t;
__device__ __forceinline__ float bf2f(bf16_t b) { return __uint_as_float(((unsigned)b) << 16); }
__device__ __forceinline__ bf16_t f2bf(float f) { unsigned u = __float_as_uint(f); return (bf16_t)((u + 0x7fffu + ((u >> 16) & 1u)) >> 16); }

constexpr int D = 1024, TP = 16384, NSEQ = 32, TS = 32, MS = NSEQ * TS, M = TP + MS, PAST = 1024;
constexpr int N0 = 4224, N0P = 4352, N1 = 4096;
constexpr int C_Q = 0, C_K = 512, C_V = 1024, C_ZA = 1536, C_PRW = 2048, C_ZB = 3712;
constexpr int RWS = 1664;
constexpr float EPS = 1e-6f, GN_EPS = 64e-5f;
constexpr float LOG2E = 1.4426950408889634f;
constexpr float LAMBDA_INIT = 0.2f;
constexpr float QSCALE = 0.125f * LOG2E;

constexpr size_t O_Y = 0;
constexpr size_t O_L0K_P = (size_t)M * D;
constexpr size_t O_L0V_P = O_L0K_P + (size_t)TP * 512;
constexpr size_t O_L0SH_P = O_L0V_P + (size_t)TP * 512;
constexpr size_t O_L0WKV_P = O_L0SH_P + RWS;
constexpr size_t O_L1K_P = O_L0WKV_P + 8 * 64 * 64;
constexpr size_t O_L1V_P = O_L1K_P + (size_t)TP * 1024;
constexpr size_t O_L0K_S = O_L1V_P + (size_t)TP * 1024;
constexpr size_t O_L0V_S = O_L0K_S + (size_t)MS * 512;
constexpr size_t O_L0SH_S = O_L0V_S + (size_t)MS * 512;
constexpr size_t O_L0WKV_S = O_L0SH_S + (size_t)NSEQ * RWS;
constexpr size_t O_L1K_S = O_L0WKV_S + (size_t)NSEQ * 8 * 64 * 64;
constexpr size_t O_L1V_S = O_L1K_S + (size_t)MS * 1024;
constexpr size_t O_TOTAL = O_L1V_S + (size_t)MS * 1024;
static_assert(O_TOTAL == 72439424, "output size");

__host__ __device__ __forceinline__ size_t off_l0k(int m) { return m < TP ? O_L0K_P + (size_t)m * 512 : O_L0K_S + (size_t)(m - TP) * 512; }
__host__ __device__ __forceinline__ size_t off_l0v(int m) { return m < TP ? O_L0V_P + (size_t)m * 512 : O_L0V_S + (size_t)(m - TP) * 512; }
__host__ __device__ __forceinline__ size_t off_l1k(int m) { return m < TP ? O_L1K_P + (size_t)m * 1024 : O_L1K_S + (size_t)(m - TP) * 1024; }
__host__ __device__ __forceinline__ size_t off_l1v(int m) { return m < TP ? O_L1V_P + (size_t)m * 1024 : O_L1V_S + (size_t)(m - TP) * 1024; }

constexpr size_t MiB = 1u << 20;
constexpr size_t WS_CTL = 0;
constexpr size_t WS_TAB = 512 * 1024;
constexpr size_t WS_WT0 = 1 * MiB, WS_WO0T = 10 * MiB, WS_WT1 = 12 * MiB, WS_WO1T = 20 * MiB, WS_LORA = 22 * MiB;
constexpr size_t WS_CAT = 24 * MiB, WS_XN0 = WS_CAT;
constexpr size_t WS_PROJ0 = 58 * MiB;
constexpr size_t WS_Q0 = 203 * MiB, WS_K0 = 220 * MiB;
constexpr size_t WS_RW = 237 * MiB;
constexpr size_t WS_SST = 407 * MiB;
constexpr size_t WS_END = 441 * MiB;
constexpr size_t WS_Y0 = WS_PROJ0, WS_Y0B = 126 * MiB, WS_SSQ = 160 * MiB;
constexpr size_t WS_O1B = WS_Q0;
constexpr size_t WS_Q1 = 237 * MiB, WS_K1 = 271 * MiB, WS_V1T = 305 * MiB, WS_Z1 = 339 * MiB;
static_assert(WS_PROJ0 + (size_t)M * N0P * 2 <= WS_Q0, "proj0");
static_assert(WS_WT0 + (size_t)N0P * D * 2 <= WS_WO0T, "wt0");

struct Tab {
    float lam;
    float m0;
    float pad[2];
    float bias[4][256];
    float biasfar[4];
};

struct Ptrs {
    const float* in[32];
    float* out;
    unsigned char* ws;
};

__device__ __forceinline__ const float* xrow(const Ptrs& P, int m) { return m < TP ? P.in[0] + (size_t)m * D : P.in[1] + (size_t)(m - TP) * D; }

__device__ __forceinline__ float wave_sum(float v) {
#pragma unroll
    for (int o = 1; o < 64; o <<= 1) v += __shfl_xor(v, o);
    return v;
}
__device__ __forceinline__ float wave_max(float v) {
#pragma unroll
    for (int o = 1; o < 64; o <<= 1) v = fmaxf(v, __shfl_xor(v, o));
    return v;
}
__device__ __forceinline__ float silu(float x) { return x / (1.f + __expf(-x)); }

__device__ __forceinline__ int t5_bucket(int rel) {
    int n = rel < 0 ? -rel : rel;
    int b;
    if (n < 8) b = n;
    else { unsigned n2 = (unsigned)n * (unsigned)n; int lg = 31 - __clz((int)n2); b = 8 + (lg - 6); if (b > 15) b = 15; }
    return (rel > 0 ? 16 : 0) + b;
}
namespace nv {

__global__ void k_transpose_w(const float* W, int K, int N, int NP, bf16_t* WT, const float* g) {
    size_t i = (size_t)blockIdx.x * blockDim.x + threadIdx.x;
    if (i >= (size_t)NP * K) return;
    int n = (int)(i / K), k = (int)(i % K);
    float v = 0.f;
    if (n < N) { v = W[(size_t)k * N + n]; if (g) v *= g[k]; }
    WT[i] = f2bf(v);
}
__global__ void k_lora_t(const float* w_up, const float* a_up, float* LT) {
    int i = blockIdx.x * blockDim.x + threadIdx.x;
    if (i >= 512 * 64) return;
    int c = i / 64, l = i % 64;
    LT[i] = w_up[l * 512 + c];
    LT[512 * 64 + i] = a_up[l * 512 + c];
}
__global__ void k_tables(Ptrs P) {
    Tab* T = (Tab*)(P.ws + WS_TAB);
    int tid = threadIdx.x;
    if (tid < 64) {
        float a = P.in[14][tid] * P.in[15][tid], b = P.in[16][tid] * P.in[17][tid];
        a = wave_sum(a); b = wave_sum(b);
        float gq = fabsf(P.in[12][tid]), gk = fabsf(P.in[13][tid]);
        gq = wave_max(gq); gk = wave_max(gk);
        if (tid == 0) { T->lam = __expf(a) - __expf(b) + LAMBDA_INIT; T->m0 = 8.f * gq * gk * LOG2E * 1.0001f + 0.01f; }
    }
    if (tid < 255) { int rel = tid - 191; int b = t5_bucket(rel); for (int h = 0; h < 4; ++h) T->bias[h][tid] = P.in[8][b * 4 + h]; }
    if (tid == 255) for (int h = 0; h < 4; ++h) { T->bias[h][255] = 0.f; T->biasfar[h] = P.in[8][15 * 4 + h]; }
}
__global__ void k_rmsnorm_x(Ptrs P) {
    int w = (blockIdx.x * blockDim.x + threadIdx.x) >> 6, lane = threadIdx.x & 63;
    if (w >= M) return;
    const float* x = xrow(P, w); const float* g = P.in[9];
    bf16_t* o = (bf16_t*)(P.ws + WS_XN0) + (size_t)w * D;
    float v[16], s = 0.f;
    for (int j = 0; j < 16; ++j) { v[j] = x[lane + 64 * j]; s += v[j] * v[j]; }
    s = wave_sum(s);
    float r = rsqrtf(s * (1.f / D) + EPS);
    for (int j = 0; j < 16; ++j) o[lane + 64 * j] = f2bf(v[j] * r * g[lane + 64 * j]);
}

template <class Epi>
__global__ void __launch_bounds__(256) k_gemm(const bf16_t* A, const bf16_t* Bt, int K, Epi epi) {
    __shared__ float As[16][65], Bs[16][65];
    const int tx = threadIdx.x & 15, ty = threadIdx.x >> 4;
    const int m0 = blockIdx.y * 64, n0 = blockIdx.x * 64;
    float acc[4][4];
#pragma unroll
    for (int i = 0; i < 4; ++i)
#pragma unroll
        for (int j = 0; j < 4; ++j) acc[i][j] = 0.f;
    for (int k0 = 0; k0 < K; k0 += 16) {
#pragma unroll
        for (int i = 0; i < 4; ++i) {
            int e = threadIdx.x + 256 * i, r = e >> 4, c = e & 15;
            As[c][r] = bf2f(A[(size_t)(m0 + r) * K + k0 + c]);
            Bs[c][r] = bf2f(Bt[(size_t)(n0 + r) * K + k0 + c]);
        }
        __syncthreads();
#pragma unroll
        for (int kk = 0; kk < 16; ++kk) {
            float a[4], b[4];
#pragma unroll
            for (int i = 0; i < 4; ++i) { a[i] = As[kk][ty * 4 + i]; b[i] = Bs[kk][tx * 4 + i]; }
#pragma unroll
            for (int i = 0; i < 4; ++i)
#pragma unroll
                for (int j = 0; j < 4; ++j) acc[i][j] += a[i] * b[j];
        }
        __syncthreads();
    }
#pragma unroll
    for (int i = 0; i < 4; ++i)
#pragma unroll
        for (int j = 0; j < 4; ++j) epi(m0 + ty * 4 + i, n0 + tx * 4 + j, acc[i][j]);
}
struct EpiProj0 { bf16_t* O; __device__ void operator()(int m, int n, float v) const { O[(size_t)m * N0P + n] = f2bf(v); } };
struct EpiY0 {
    Ptrs P;
    __device__ void operator()(int m, int n, float v) const {
        float y = v + xrow(P, m)[n];
        ((float*)(P.ws + WS_Y0))[(size_t)m * D + n] = y;
        ((bf16_t*)(P.ws + WS_Y0B))[(size_t)m * D + n] = f2bf(y);
    }
};
struct EpiL1 {
    Ptrs P;
    __device__ void operator()(int m, int n, float v) const {
        const float* ss = (const float*)(P.ws + WS_SSQ) + (size_t)m * 4;
        float r = rsqrtf(((ss[0] + ss[1]) + (ss[2] + ss[3])) * (1.f / D) + EPS);
        float val = v * r;
        int c = n & 1023;
        if (n < 1024) ((bf16_t*)(P.ws + WS_Q1))[(size_t)m * D + c] = f2bf(val * QSCALE);
        else if (n < 2048) { ((bf16_t*)(P.ws + WS_K1))[(size_t)m * D + c] = f2bf(val); P.out[off_l1k(m) + c] = val; }
        else if (n < 3072) { ((bf16_t*)(P.ws + WS_V1T))[(size_t)c * M + m] = f2bf(val); P.out[off_l1v(m) + c] = val; }
        else ((bf16_t*)(P.ws + WS_Z1))[(size_t)m * D + c] = f2bf(val);
    }
};
struct EpiOut { Ptrs P; __device__ void operator()(int m, int n, float v) const { P.out[O_Y + (size_t)m * D + n] = v + ((const float*)(P.ws + WS_Y0))[(size_t)m * D + n]; } };

__global__ void k_ssq(Ptrs P) {
    int w = (blockIdx.x * blockDim.x + threadIdx.x) >> 6, lane = threadIdx.x & 63;
    if (w >= M) return;
    const float* y = (const float*)(P.ws + WS_Y0) + (size_t)w * D;
    float* ss = (float*)(P.ws + WS_SSQ) + (size_t)w * 4;
    for (int j = 0; j < 4; ++j) { float s = 0.f; for (int i = 0; i < 4; ++i) { float v = y[256 * j + 64 * i + lane]; s += v * v; } s = wave_sum(s); if (lane == 0) ss[j] = s; }
}

__global__ void k_tok0(Ptrs P) {
    int m = (blockIdx.x * blockDim.x + threadIdx.x) >> 6, lane = threadIdx.x & 63;
    if (m >= M) return;
    const bf16_t* pr = (const bf16_t*)(P.ws + WS_PROJ0) + (size_t)m * N0P;
    bf16_t* q0 = (bf16_t*)(P.ws + WS_Q0) + (size_t)m * 512;
    bf16_t* k0 = (bf16_t*)(P.ws + WS_K0) + (size_t)m * 512;
    const float gq = P.in[12][lane], gk = P.in[13][lane];
    for (int g = 0; g < 8; ++g) {
        float q = bf2f(pr[C_Q + 64 * g + lane]), k = bf2f(pr[C_K + 64 * g + lane]);
        float sq = wave_sum(q * q), sk = wave_sum(k * k);
        float qn = q * rsqrtf(sq * (1.f / 64) + EPS) * gq, kn = k * rsqrtf(sk * (1.f / 64) + EPS) * gk;
        q0[64 * g + lane] = f2bf(qn * QSCALE);
        k0[64 * g + lane] = f2bf(kn);
        P.out[off_l0k(m) + 64 * g + lane] = kn;
        P.out[off_l0v(m) + 64 * g + lane] = bf2f(pr[C_V + 64 * g + lane]);
    }
    int last = -1; size_t so = 0;
    if (m == TP - 1) { last = 1; so = O_L0SH_P; }
    else if (m >= TP && ((m - TP) & 31) == 31) { last = 1; so = O_L0SH_S + (size_t)((m - TP) >> 5) * RWS; }
    if (last > 0) for (int c = lane; c < RWS; c += 64) P.out[so + c] = bf2f(pr[C_PRW + c]);
}

__global__ void __launch_bounds__(256) k_attn0(Ptrs P) {
    __shared__ float sq[4][128], sp[4][2][64];
    const int wid = threadIdx.x >> 6, lane = threadIdx.x & 63;
    const int gw = blockIdx.x * 4 + wid;
    const int m = gw >> 2, h = gw & 3;
    if (m >= M) return;
    const Tab* T = (const Tab*)(P.ws + WS_TAB);
    const bf16_t* Q0 = (const bf16_t*)(P.ws + WS_Q0); const bf16_t* K0 = (const bf16_t*)(P.ws + WS_K0);
    const bf16_t* PR = (const bf16_t*)(P.ws + WS_PROJ0);
    int qpos, nk, b = 0; bool samp = m >= TP;
    if (!samp) { qpos = m; nk = ((m >> 6) + 1) * 64; } else { b = (m - TP) >> 5; qpos = PAST + ((m - TP) & 31); nk = PAST + TS; }
    sq[wid][lane] = bf2f(Q0[(size_t)m * 512 + 128 * h + lane]);
    sq[wid][64 + lane] = bf2f(Q0[(size_t)m * 512 + 128 * h + 64 + lane]);
    float m1 = -1e30f, m2 = -1e30f, l1 = 0.f, l2 = 0.f, o1[2] = {0.f, 0.f}, o2[2] = {0.f, 0.f};
    for (int j0 = 0; j0 < nk; j0 += 64) {
        int j = j0 + lane;
        bool valid = j < nk && ((j >> 6) <= (qpos >> 6));
        float s1 = 0.f, s2 = 0.f;
        if (valid) {
            if (samp && j < PAST) {
                const float* kr = P.in[2] + (((size_t)b * PAST + j) * 4 + h) * 128;
                for (int d = 0; d < 64; ++d) { s1 += sq[wid][d] * bf2f(f2bf(kr[d])); s2 += sq[wid][64 + d] * bf2f(f2bf(kr[64 + d])); }
            } else {
                int km = samp ? TP + 32 * b + (j - PAST) : j;
                const bf16_t* kr = K0 + (size_t)km * 512 + 128 * h;
                for (int d = 0; d < 64; ++d) { s1 += sq[wid][d] * bf2f(kr[d]); s2 += sq[wid][64 + d] * bf2f(kr[64 + d]); }
            }
            int rel = j - qpos; float bias = rel <= -128 ? T->biasfar[h] : T->bias[h][rel + 191];
            s1 += bias * LOG2E; s2 += bias * LOG2E;
        } else { s1 = -1e30f; s2 = -1e30f; }
        float bm1 = wave_max(s1), bm2 = wave_max(s2);
        float n1 = fmaxf(m1, bm1), n2 = fmaxf(m2, bm2);
        float f1 = exp2f(m1 - n1), f2 = exp2f(m2 - n2);
        float p1 = valid ? exp2f(s1 - n1) : 0.f, p2 = valid ? exp2f(s2 - n2) : 0.f;
        l1 = l1 * f1 + wave_sum(p1); l2 = l2 * f2 + wave_sum(p2);
        o1[0] *= f1; o1[1] *= f1; o2[0] *= f2; o2[1] *= f2; m1 = n1; m2 = n2;
        sp[wid][0][lane] = p1; sp[wid][1][lane] = p2;
        __builtin_amdgcn_s_waitcnt(0);
        int jn = min(64, nk - j0);
        for (int jj = 0; jj < jn; ++jj) {
            int jp = j0 + jj; float a1 = sp[wid][0][jj], a2 = sp[wid][1][jj];
            float v0, v1;
            if (samp && jp < PAST) { const float* vr = P.in[3] + (((size_t)b * PAST + jp) * 4 + h) * 128; v0 = bf2f(f2bf(vr[lane])); v1 = bf2f(f2bf(vr[64 + lane])); }
            else { int km = samp ? TP + 32 * b + (jp - PAST) : jp; const bf16_t* vr = PR + (size_t)km * N0P + C_V + 128 * h; v0 = bf2f(vr[lane]); v1 = bf2f(vr[64 + lane]); }
            o1[0] += a1 * v0; o1[1] += a1 * v1; o2[0] += a2 * v0; o2[1] += a2 * v1;
        }
    }
    const float lam = T->lam;
    float a0 = o1[0] / l1 - lam * o2[0] / l2, a1 = o1[1] / l1 - lam * o2[1] / l2;
    float ss = wave_sum(a0 * a0 + a1 * a1);
    float r = rsqrtf(ss * (1.f / 128) + EPS) * (1.f - LAMBDA_INIT);
    const float* sg = P.in[18];
    const bf16_t* za = PR + (size_t)m * N0P + C_ZA + 128 * h;
    bf16_t* cat = (bf16_t*)(P.ws + WS_CAT) + (size_t)m * D + 128 * h;
    cat[lane] = f2bf(a0 * r * sg[lane] * silu(bf2f(za[lane])));
    cat[64 + lane] = f2bf(a1 * r * sg[64 + lane] * silu(bf2f(za[64 + lane])));
}

constexpr size_t RWN = (size_t)M * 512;
__device__ __forceinline__ float prw_prev(const Ptrs& P, int m, int c) {
    if (m < TP) return m == 0 ? 0.f : bf2f(((const bf16_t*)(P.ws + WS_PROJ0))[(size_t)(m - 1) * N0P + C_PRW + c]);
    int i = (m - TP) & 31, b = (m - TP) >> 5;
    if (i == 0) return P.in[4][(size_t)b * RWS + c];
    return bf2f(((const bf16_t*)(P.ws + WS_PROJ0))[(size_t)(m - 1) * N0P + C_PRW + c]);
}
__global__ void __launch_bounds__(512) k_rw_prep(Ptrs P) {
    __shared__ float swl[64], sal[64];
    const int m = blockIdx.x, c = threadIdx.x, lane = c & 63;
    const bf16_t* pr = (const bf16_t*)(P.ws + WS_PROJ0) + (size_t)m * N0P + C_PRW;
    const float* mu = P.in[19];
    auto mix = [&](int col) { float cur = bf2f(pr[col]); float prev = prw_prev(P, m, col); return cur + (prev - cur) * mu[col]; };
    float r = mix(c), kr = mix(512 + c), vr = mix(1024 + c);
    if (c < 64) swl[c] = tanhf(mix(1536 + c)); else if (c < 128) sal[c - 64] = mix(1600 + c - 64);
    __syncthreads();
    float wa = P.in[20][c], aa = P.in[22][c];
    const float* wup = P.in[21]; const float* aup = P.in[23];
    for (int l = 0; l < 64; ++l) { wa += swl[l] * wup[l * 512 + c]; aa += sal[l] * aup[l * 512 + c]; }
    float spl = (-wa > 20.f) ? -wa : log1pf(__expf(-wa));
    float w = -spl - 0.5f;
    float dec = __expf(-__expf(w));
    float a = 1.f / (1.f + __expf(-aa));
    float kk = kr * P.in[24][c];
    float n2 = wave_sum(kk * kk);
    kk = kk / fmaxf(sqrtf(n2), 1e-12f);
    float km = kr * (1.f + (a - 1.f) * P.in[25][c]);
    float* R = (float*)(P.ws + WS_RW);
    size_t o = (size_t)m * 512 + c;
    R[o] = r; R[RWN + o] = dec; R[2 * RWN + o] = kk; R[3 * RWN + o] = kk * a; R[4 * RWN + o] = km; R[5 * RWN + o] = vr;
    (void)lane;
}
__global__ void __launch_bounds__(64) k_rw_scan(Ptrs P) {
    const int seq = blockIdx.x >> 3, h = blockIdx.x & 7, lane = threadIdx.x;
    const int m0 = seq == 0 ? 0 : TP + 32 * (seq - 1), T = seq == 0 ? TP : TS;
    float S[64];
    if (seq == 0) { for (int k = 0; k < 64; ++k) S[k] = 0.f; }
    else { const float* s0 = P.in[5] + (((size_t)(seq - 1) * 8 + h) * 64 + lane) * 64; for (int k = 0; k < 64; ++k) S[k] = s0[k]; }
    const float* R = (const float*)(P.ws + WS_RW);
    const float rk = P.in[26][h * 64 + lane], lg = P.in[27][h * 64 + lane], lb = P.in[28][h * 64 + lane];
    for (int t = 0; t < T; ++t) {
        size_t o = (size_t)(m0 + t) * 512 + h * 64 + lane;
        float r = R[o], dec = R[RWN + o], kk = R[2 * RWN + o], kka = R[3 * RWN + o], km = R[4 * RWN + o], v = R[5 * RWN + o];
        float sa = 0.f;
#pragma unroll
        for (int k = 0; k < 64; ++k) sa += S[k] * __shfl(kk, k);
        float ov = 0.f;
#pragma unroll
        for (int k = 0; k < 64; ++k) { S[k] = S[k] * __shfl(dec, k) - sa * __shfl(kka, k) + v * __shfl(km, k); ov += S[k] * __shfl(r, k); }
        float mu = wave_sum(ov) * (1.f / 64);
        float dv = ov - mu;
        float var = wave_sum(dv * dv) * (1.f / 64);
        float y = dv * rsqrtf(var + GN_EPS) * lg + lb;
        float bonus = wave_sum(r * km * rk) * v;
        int mm = m0 + t;
        float zb = bf2f(((const bf16_t*)(P.ws + WS_PROJ0))[(size_t)mm * N0P + C_ZB + h * 64 + lane]);
        ((bf16_t*)(P.ws + WS_CAT))[(size_t)mm * D + 512 + h * 64 + lane] = f2bf((y + bonus) * silu(zb));
    }
    float* so = P.out + (seq == 0 ? O_L0WKV_P + ((size_t)h * 64 + lane) * 64 : O_L0WKV_S + ((((size_t)(seq - 1)) * 8 + h) * 64 + lane) * 64);
    for (int k = 0; k < 64; ++k) so[k] = S[k];
}

__global__ void __launch_bounds__(256) k_attn1(Ptrs P) {
    __shared__ float sq[4][64], sa[4][64];
    const int wid = threadIdx.x >> 6, lane = threadIdx.x & 63;
    const int gw = blockIdx.x * 4 + wid;
    const int m = gw >> 4, h = gw & 15;
    if (m >= M) return;
    const bf16_t* Q1 = (const bf16_t*)(P.ws + WS_Q1); const bf16_t* K1 = (const bf16_t*)(P.ws + WS_K1);
    const bf16_t* V1T = (const bf16_t*)(P.ws + WS_V1T);
    bool samp = m >= TP; int b = 0, qpos;
    if (!samp) qpos = m; else { b = (m - TP) >> 5; qpos = PAST + ((m - TP) & 31); }
    sq[wid][lane] = bf2f(Q1[(size_t)m * D + 64 * h + lane]);
    float run = 0.f, o = 0.f;
    for (int s0 = qpos - 1; s0 >= 0; s0 -= 64) {
        int s = s0 - lane;
        bool valid = s >= 0;
        float z = 0.f;
        if (valid) {
            if (samp && s < PAST) { const float* kr = P.in[6] + (((size_t)b * PAST + s) * 16 + h) * 64; for (int d = 0; d < 64; ++d) z += sq[wid][d] * bf2f(f2bf(kr[d])); }
            else { int km = samp ? TP + 32 * b + (s - PAST) : s; const bf16_t* kr = K1 + (size_t)km * D + 64 * h; for (int d = 0; d < 64; ++d) z += sq[wid][d] * bf2f(kr[d]); }
        }
        float spl = valid ? log2f(1.f + exp2f(z)) : 0.f;
        float inc = spl;
#pragma unroll
        for (int off = 1; off < 64; off <<= 1) { float t = __shfl_up(inc, off); if (lane >= off) inc += t; }
        float a = valid ? exp2f(z - inc - run) : 0.f;
        sa[wid][lane] = a;
        run += __shfl(inc, 63);
        __builtin_amdgcn_s_waitcnt(0);
        int jn = min(64, s0 + 1);
        for (int jj = 0; jj < jn; ++jj) {
            int sp_ = s0 - jj; float v;
            if (samp && sp_ < PAST) v = bf2f(f2bf(P.in[7][(((size_t)b * PAST + sp_) * 16 + h) * 64 + lane]));
            else { int km = samp ? TP + 32 * b + (sp_ - PAST) : sp_; v = bf2f(V1T[(size_t)(64 * h + lane) * M + km]); }
            o += sa[wid][jj] * v;
        }
        if (run > 200.f) break;
    }
    float z1 = bf2f(((const bf16_t*)(P.ws + WS_Z1))[(size_t)m * D + 64 * h + lane]);
    ((bf16_t*)(P.ws + WS_O1B))[(size_t)m * D + 64 * h + lane] = f2bf(o * silu(z1));
}

}
static void launch_naive(const Ptrs& p, hipStream_t st) {
    unsigned char* ws = p.ws;
    auto T = [&](const float* W, int K, int N, int NP, size_t off, const float* g) {
        size_t n = (size_t)NP * K; nv::k_transpose_w<<<(unsigned)((n + 255) / 256), 256, 0, st>>>(W, K, N, NP, (bf16_t*)(ws + off), g); };
    T(p.in[10], D, N0, N0P, WS_WT0, nullptr);
    T(p.in[11], D, D, D, WS_WO0T, nullptr);
    T(p.in[30], D, N1, N1, WS_WT1, p.in[29]);
    T(p.in[31], D, D, D, WS_WO1T, nullptr);
    nv::k_tables<<<1, 256, 0, st>>>(p);
    nv::k_rmsnorm_x<<<M / 4, 256, 0, st>>>(p);
    nv::k_gemm<nv::EpiProj0><<<dim3(N0P / 64, M / 64), 256, 0, st>>>((const bf16_t*)(ws + WS_XN0), (const bf16_t*)(ws + WS_WT0), D, nv::EpiProj0{(bf16_t*)(ws + WS_PROJ0)});
    nv::k_tok0<<<M / 4, 256, 0, st>>>(p);
    nv::k_attn0<<<M, 256, 0, st>>>(p);
    nv::k_rw_prep<<<M, 512, 0, st>>>(p);
    nv::k_rw_scan<<<33 * 8, 64, 0, st>>>(p);
    nv::k_gemm<nv::EpiY0><<<dim3(D / 64, M / 64), 256, 0, st>>>((const bf16_t*)(ws + WS_CAT), (const bf16_t*)(ws + WS_WO0T), D, nv::EpiY0{p});
    nv::k_ssq<<<M / 4, 256, 0, st>>>(p);
    nv::k_gemm<nv::EpiL1><<<dim3(N1 / 64, M / 64), 256, 0, st>>>((const bf16_t*)(ws + WS_Y0B), (const bf16_t*)(ws + WS_WT1), D, nv::EpiL1{p});
    nv::k_attn1<<<M * 4, 256, 0, st>>>(p);
    nv::k_gemm<nv::EpiOut><<<dim3(D / 64, M / 64), 256, 0, st>>>((const bf16_t*)(ws + WS_O1B), (const bf16_t*)(ws + WS_WO1T), D, nv::EpiOut{p});
}
extern "C" void kernel_launch(void* const* d_in, const int* in_sizes, int n_in, void* d_out, int out_size, void* d_ws, size_t ws_size, hipStream_t stream) {
    if (n_in != 32 || (size_t)out_size != O_TOTAL || ws_size < WS_END) { fprintf(stderr, "kernel_launch: unexpected shapes n_in=%d out=%d ws=%zu\n", n_in, out_size, ws_size); return; }
    Ptrs p{};
    for (int i = 0; i < 32; ++i) p.in[i] = (const float*)d_in[i];
    p.out = (float*)d_out; p.ws = (unsigned char*)d_ws;
    launch_naive(p, stream);
}
```

```cpp
#include <hip/hip_runtime.h>
#include <stdint.h>
#include <cstdio>

typedef unsigned short bf16_t;
__device__ __forceinline__ float bf2f(bf16_t b) { return __uint_as_float(((unsigned)b) << 16); }
__device__ __forceinline__ bf16_t f2bf(float f) { unsigned u = __float_as_uint(f); return (bf16_t)((u + 0x7fffu + ((u >> 16) & 1u)) >> 16); }

constexpr int D = 1024, TP = 16384, NSEQ = 32, TS = 32, MS = NSEQ * TS, M = TP + MS, PAST = 1024;
constexpr int N0 = 4224, N0P = 4352, N1 = 4096;
constexpr int C_Q = 0, C_K = 512, C_V = 1024, C_ZA = 1536, C_PRW = 2048, C_ZB = 3712;
constexpr int RWS = 1664;
constexpr float EPS = 1e-6f, GN_EPS = 64e-5f;
constexpr float LOG2E = 1.4426950408889634f;
constexpr float LAMBDA_INIT = 0.2f;
constexpr float QSCALE = 0.125f * LOG2E;

constexpr size_t O_Y = 0;
constexpr size_t O_L0K_P = (size_t)M * D;
constexpr size_t O_L0V_P = O_L0K_P + (size_t)TP * 512;
constexpr size_t O_L0SH_P = O_L0V_P + (size_t)TP * 512;
constexpr size_t O_L0WKV_P = O_L0SH_P + RWS;
constexpr size_t O_L1K_P = O_L0WKV_P + 8 * 64 * 64;
constexpr size_t O_L1V_P = O_L1K_P + (size_t)TP * 1024;
constexpr size_t O_L0K_S = O_L1V_P + (size_t)TP * 1024;
constexpr size_t O_L0V_S = O_L0K_S + (size_t)MS * 512;
constexpr size_t O_L0SH_S = O_L0V_S + (size_t)MS * 512;
constexpr size_t O_L0WKV_S = O_L0SH_S + (size_t)NSEQ * RWS;
constexpr size_t O_L1K_S = O_L0WKV_S + (size_t)NSEQ * 8 * 64 * 64;
constexpr size_t O_L1V_S = O_L1K_S + (size_t)MS * 1024;
constexpr size_t O_TOTAL = O_L1V_S + (size_t)MS * 1024;
static_assert(O_TOTAL == 72439424, "output size");

__host__ __device__ __forceinline__ size_t off_l0k(int m) { return m < TP ? O_L0K_P + (size_t)m * 512 : O_L0K_S + (size_t)(m - TP) * 512; }
__host__ __device__ __forceinline__ size_t off_l0v(int m) { return m < TP ? O_L0V_P + (size_t)m * 512 : O_L0V_S + (size_t)(m - TP) * 512; }
__host__ __device__ __forceinline__ size_t off_l1k(int m) { return m < TP ? O_L1K_P + (size_t)m * 1024 : O_L1K_S + (size_t)(m - TP) * 1024; }
__host__ __device__ __forceinline__ size_t off_l1v(int m) { return m < TP ? O_L1V_P + (size_t)m * 1024 : O_L1V_S + (size_t)(m - TP) * 1024; }

constexpr size_t MiB = 1u << 20;
constexpr size_t WS_CTL = 0;
constexpr size_t WS_TAB = 512 * 1024;
constexpr size_t WS_WT0 = 1 * MiB, WS_WO0T = 10 * MiB, WS_WT1 = 12 * MiB, WS_WO1T = 20 * MiB, WS_LORA = 22 * MiB;
constexpr size_t WS_CAT = 24 * MiB, WS_XN0 = WS_CAT;
constexpr size_t WS_PROJ0 = 58 * MiB;
constexpr size_t WS_Q0 = 203 * MiB, WS_K0 = 220 * MiB;
constexpr size_t WS_RW = 237 * MiB;
constexpr size_t WS_SST = 407 * MiB;
constexpr size_t WS_END = 441 * MiB;
constexpr size_t WS_Y0 = WS_PROJ0, WS_Y0B = 126 * MiB, WS_SSQ = 160 * MiB;
constexpr size_t WS_O1B = WS_Q0;
constexpr size_t WS_Q1 = 237 * MiB, WS_K1 = 271 * MiB, WS_V1T = 305 * MiB, WS_Z1 = 339 * MiB;
static_assert(WS_PROJ0 + (size_t)M * N0P * 2 <= WS_Q0, "proj0");
static_assert(WS_WT0 + (size_t)N0P * D * 2 <= WS_WO0T, "wt0");

struct Tab {
    float lam;
    float m0;
    float pad[2];
    float bias[4][256];
    float biasfar[4];
};

struct Ptrs {
    const float* in[32];
    float* out;
    unsigned char* ws;
};

__device__ __forceinline__ const float* xrow(const Ptrs& P, int m) { return m < TP ? P.in[0] + (size_t)m * D : P.in[1] + (size_t)(m - TP) * D; }

__device__ __forceinline__ float wave_sum(float v) {
#pragma unroll
    for (int o = 1; o < 64; o <<= 1) v += __shfl_xor(v, o);
    return v;
}
__device__ __forceinline__ float wave_max(float v) {
#pragma unroll
    for (int o = 1; o < 64; o <<= 1) v = fmaxf(v, __shfl_xor(v, o));
    return v;
}
__device__ __forceinline__ float silu(float x) { return x / (1.f + __expf(-x)); }

__device__ __forceinline__ int t5_bucket(int rel) {
    int n = rel < 0 ? -rel : rel;
    int b;
    if (n < 8) b = n;
    else { unsigned n2 = (unsigned)n * (unsigned)n; int lg = 31 - __clz((int)n2); b = 8 + (lg - 6); if (b > 15) b = 15; }
    return (rel > 0 ? 16 : 0) + b;
}
namespace nv {

__global__ void k_transpose_w(const float* W, int K, int N, int NP, bf16_t* WT, const float* g) {
    size_t i = (size_t)blockIdx.x * blockDim.x + threadIdx.x;
    if (i >= (size_t)NP * K) return;
    int n = (int)(i / K), k = (int)(i % K);
    float v = 0.f;
    if (n < N) { v = W[(size_t)k * N + n]; if (g) v *= g[k]; }
    WT[i] = f2bf(v);
}
__global__ void k_lora_t(const float* w_up, const float* a_up, float* LT) {
    int i = blockIdx.x * blockDim.x + threadIdx.x;
    if (i >= 512 * 64) return;
    int c = i / 64, l = i % 64;
    LT[i] = w_up[l * 512 + c];
    LT[512 * 64 + i] = a_up[l * 512 + c];
}
__global__ void k_tables(Ptrs P) {
    Tab* T = (Tab*)(P.ws + WS_TAB);
    int tid = threadIdx.x;
    if (tid < 64) {
        float a = P.in[14][tid] * P.in[15][tid], b = P.in[16][tid] * P.in[17][tid];
        a = wave_sum(a); b = wave_sum(b);
        float gq = fabsf(P.in[12][tid]), gk = fabsf(P.in[13][tid]);
        gq = wave_max(gq); gk = wave_max(gk);
        if (tid == 0) { T->lam = __expf(a) - __expf(b) + LAMBDA_INIT; T->m0 = 8.f * gq * gk * LOG2E * 1.0001f + 0.01f; }
    }
    if (tid < 255) { int rel = tid - 191; int b = t5_bucket(rel); for (int h = 0; h < 4; ++h) T->bias[h][tid] = P.in[8][b * 4 + h]; }
    if (tid == 255) for (int h = 0; h < 4; ++h) { T->bias[h][255] = 0.f; T->biasfar[h] = P.in[8][15 * 4 + h]; }
}
__global__ void k_rmsnorm_x(Ptrs P) {
    int w = (blockIdx.x * blockDim.x + threadIdx.x) >> 6, lane = threadIdx.x & 63;
    if (w >= M) return;
    const float* x = xrow(P, w); const float* g = P.in[9];
    bf16_t* o = (bf16_t*)(P.ws + WS_XN0) + (size_t)w * D;
    float v[16], s = 0.f;
    for (int j = 0; j < 16; ++j) { v[j] = x[lane + 64 * j]; s += v[j] * v[j]; }
    s = wave_sum(s);
    float r = rsqrtf(s * (1.f / D) + EPS);
    for (int j = 0; j < 16; ++j) o[lane + 64 * j] = f2bf(v[j] * r * g[lane + 64 * j]);
}

template <class Epi>
__global__ void __launch_bounds__(256) k_gemm(const bf16_t* A, const bf16_t* Bt, int K, Epi epi) {
    __shared__ float As[16][65], Bs[16][65];
    const int tx = threadIdx.x & 15, ty = threadIdx.x >> 4;
    const int m0 = blockIdx.y * 64, n0 = blockIdx.x * 64;
    float acc[4][4];
#pragma unroll
    for (int i = 0; i < 4; ++i)
#pragma unroll
        for (int j = 0; j < 4; ++j) acc[i][j] = 0.f;
    for (int k0 = 0; k0 < K; k0 += 16) {
#pragma unroll
        for (int i = 0; i < 4; ++i) {
            int e = threadIdx.x + 256 * i, r = e >> 4, c = e & 15;
            As[c][r] = bf2f(A[(size_t)(m0 + r) * K + k0 + c]);
            Bs[c][r] = bf2f(Bt[(size_t)(n0 + r) * K + k0 + c]);
        }
        __syncthreads();
#pragma unroll
        for (int kk = 0; kk < 16; ++kk) {
            float a[4], b[4];
#pragma unroll
            for (int i = 0; i < 4; ++i) { a[i] = As[kk][ty * 4 + i]; b[i] = Bs[kk][tx * 4 + i]; }
#pragma unroll
            for (int i = 0; i < 4; ++i)
#pragma unroll
                for (int j = 0; j < 4; ++j) acc[i][j] += a[i] * b[j];
        }
        __syncthreads();
    }
#pragma unroll
    for (int i = 0; i < 4; ++i)
#pragma unroll
        for (int j = 0; j < 4; ++j) epi(m0 + ty * 4 + i, n0 + tx * 4 + j, acc[i][j]);
}
struct EpiProj0 { bf16_t* O; __device__ void operator()(int m, int n, float v) const { O[(size_t)m * N0P + n] = f2bf(v); } };
struct EpiY0 {
    Ptrs P;
    __device__ void operator()(int m, int n, float v) const {
        float y = v + xrow(P, m)[n];
        ((float*)(P.ws + WS_Y0))[(size_t)m * D + n] = y;
        ((bf16_t*)(P.ws + WS_Y0B))[(size_t)m * D + n] = f2bf(y);
    }
};
struct EpiL1 {
    Ptrs P;
    __device__ void operator()(int m, int n, float v) const {
        const float* ss = (const float*)(P.ws + WS_SSQ) + (size_t)m * 16;
        float t = 0.f; for (int j = 0; j < 16; ++j) t += ss[j];
        float r = rsqrtf(t * (1.f / D) + EPS);
        float val = v * r;
        int c = n & 1023;
        if (n < 1024) ((bf16_t*)(P.ws + WS_Q1))[(size_t)m * D + c] = f2bf(val * QSCALE);
        else if (n < 2048) { ((bf16_t*)(P.ws + WS_K1))[(size_t)m * D + c] = f2bf(val); P.out[off_l1k(m) + c] = val; }
        else if (n < 3072) { ((bf16_t*)(P.ws + WS_V1T))[(size_t)c * M + m] = f2bf(val); P.out[off_l1v(m) + c] = val; }
        else ((bf16_t*)(P.ws + WS_Z1))[(size_t)m * D + c] = f2bf(val);
    }
};
struct EpiOut { Ptrs P; __device__ void operator()(int m, int n, float v) const { P.out[O_Y + (size_t)m * D + n] = v + ((const float*)(P.ws + WS_Y0))[(size_t)m * D + n]; } };

__global__ void k_ssq(Ptrs P) {
    int w = (blockIdx.x * blockDim.x + threadIdx.x) >> 6, lane = threadIdx.x & 63;
    if (w >= M) return;
    const float* y = (const float*)(P.ws + WS_Y0) + (size_t)w * D;
    float* ss = (float*)(P.ws + WS_SSQ) + (size_t)w * 16;
    for (int j = 0; j < 16; ++j) { float v = y[64 * j + lane]; float s = wave_sum(v * v); if (lane == 0) ss[j] = s; }
}

__global__ void k_tok0(Ptrs P) {
    int m = (blockIdx.x * blockDim.x + threadIdx.x) >> 6, lane = threadIdx.x & 63;
    if (m >= M) return;
    const bf16_t* pr = (const bf16_t*)(P.ws + WS_PROJ0) + (size_t)m * N0P;
    bf16_t* q0 = (bf16_t*)(P.ws + WS_Q0) + (size_t)m * 512;
    bf16_t* k0 = (bf16_t*)(P.ws + WS_K0) + (size_t)m * 512;
    const float gq = P.in[12][lane], gk = P.in[13][lane];
    for (int g = 0; g < 8; ++g) {
        float q = bf2f(pr[C_Q + 64 * g + lane]), k = bf2f(pr[C_K + 64 * g + lane]);
        float sq = wave_sum(q * q), sk = wave_sum(k * k);
        float qn = q * rsqrtf(sq * (1.f / 64) + EPS) * gq, kn = k * rsqrtf(sk * (1.f / 64) + EPS) * gk;
        q0[64 * g + lane] = f2bf(qn * QSCALE);
        k0[64 * g + lane] = f2bf(kn);
        P.out[off_l0k(m) + 64 * g + lane] = kn;
        P.out[off_l0v(m) + 64 * g + lane] = bf2f(pr[C_V + 64 * g + lane]);
    }
    int last = -1; size_t so = 0;
    if (m == TP - 1) { last = 1; so = O_L0SH_P; }
    else if (m >= TP && ((m - TP) & 31) == 31) { last = 1; so = O_L0SH_S + (size_t)((m - TP) >> 5) * RWS; }
    if (last > 0) for (int c = lane; c < RWS; c += 64) P.out[so + c] = bf2f(pr[C_PRW + c]);
}

__global__ void __launch_bounds__(256) k_attn0(Ptrs P) {
    __shared__ float sq[4][128], sp[4][2][64];
    const int wid = threadIdx.x >> 6, lane = threadIdx.x & 63;
    const int gw = blockIdx.x * 4 + wid;
    const int m = gw >> 2, h = gw & 3;
    if (m >= M) return;
    const Tab* T = (const Tab*)(P.ws + WS_TAB);
    const bf16_t* Q0 = (const bf16_t*)(P.ws + WS_Q0); const bf16_t* K0 = (const bf16_t*)(P.ws + WS_K0);
    const bf16_t* PR = (const bf16_t*)(P.ws + WS_PROJ0);
    int qpos, nk, b = 0; bool samp = m >= TP;
    if (!samp) { qpos = m; nk = ((m >> 6) + 1) * 64; } else { b = (m - TP) >> 5; qpos = PAST + ((m - TP) & 31); nk = PAST + TS; }
    sq[wid][lane] = bf2f(Q0[(size_t)m * 512 + 128 * h + lane]);
    sq[wid][64 + lane] = bf2f(Q0[(size_t)m * 512 + 128 * h + 64 + lane]);
    float m1 = -1e30f, m2 = -1e30f, l1 = 0.f, l2 = 0.f, o1[2] = {0.f, 0.f}, o2[2] = {0.f, 0.f};
    for (int j0 = 0; j0 < nk; j0 += 64) {
        int j = j0 + lane;
        bool valid = j < nk && ((j >> 6) <= (qpos >> 6));
        float s1 = 0.f, s2 = 0.f;
        if (valid) {
            if (samp && j < PAST) {
                const float* kr = P.in[2] + (((size_t)b * PAST + j) * 4 + h) * 128;
                for (int d = 0; d < 64; ++d) { s1 += sq[wid][d] * bf2f(f2bf(kr[d])); s2 += sq[wid][64 + d] * bf2f(f2bf(kr[64 + d])); }
            } else {
                int km = samp ? TP + 32 * b + (j - PAST) : j;
                const bf16_t* kr = K0 + (size_t)km * 512 + 128 * h;
                for (int d = 0; d < 64; ++d) { s1 += sq[wid][d] * bf2f(kr[d]); s2 += sq[wid][64 + d] * bf2f(kr[64 + d]); }
            }
            int rel = j - qpos; float bias = rel <= -128 ? T->biasfar[h] : T->bias[h][rel + 191];
            s1 += bias * LOG2E; s2 += bias * LOG2E;
        } else { s1 = -1e30f; s2 = -1e30f; }
        float bm1 = wave_max(s1), bm2 = wave_max(s2);
        float n1 = fmaxf(m1, bm1), n2 = fmaxf(m2, bm2);
        float f1 = exp2f(m1 - n1), f2 = exp2f(m2 - n2);
        float p1 = valid ? exp2f(s1 - n1) : 0.f, p2 = valid ? exp2f(s2 - n2) : 0.f;
        l1 = l1 * f1 + wave_sum(p1); l2 = l2 * f2 + wave_sum(p2);
        o1[0] *= f1; o1[1] *= f1; o2[0] *= f2; o2[1] *= f2; m1 = n1; m2 = n2;
        sp[wid][0][lane] = p1; sp[wid][1][lane] = p2;
        __builtin_amdgcn_s_waitcnt(0);
        int jn = min(64, nk - j0);
        for (int jj = 0; jj < jn; ++jj) {
            int jp = j0 + jj; float a1 = sp[wid][0][jj], a2 = sp[wid][1][jj];
            float v0, v1;
            if (samp && jp < PAST) { const float* vr = P.in[3] + (((size_t)b * PAST + jp) * 4 + h) * 128; v0 = bf2f(f2bf(vr[lane])); v1 = bf2f(f2bf(vr[64 + lane])); }
            else { int km = samp ? TP + 32 * b + (jp - PAST) : jp; const bf16_t* vr = PR + (size_t)km * N0P + C_V + 128 * h; v0 = bf2f(vr[lane]); v1 = bf2f(vr[64 + lane]); }
            o1[0] += a1 * v0; o1[1] += a1 * v1; o2[0] += a2 * v0; o2[1] += a2 * v1;
        }
    }
    const float lam = T->lam;
    float a0 = o1[0] / l1 - lam * o2[0] / l2, a1 = o1[1] / l1 - lam * o2[1] / l2;
    float ss = wave_sum(a0 * a0 + a1 * a1);
    float r = rsqrtf(ss * (1.f / 128) + EPS) * (1.f - LAMBDA_INIT);
    const float* sg = P.in[18];
    const bf16_t* za = PR + (size_t)m * N0P + C_ZA + 128 * h;
    bf16_t* cat = (bf16_t*)(P.ws + WS_CAT) + (size_t)m * D + 128 * h;
    cat[lane] = f2bf(a0 * r * sg[lane] * silu(bf2f(za[lane])));
    cat[64 + lane] = f2bf(a1 * r * sg[64 + lane] * silu(bf2f(za[64 + lane])));
}

constexpr size_t RWN = (size_t)M * 512;
__device__ __forceinline__ float prw_prev(const Ptrs& P, int m, int c) {
    if (m < TP) return m == 0 ? 0.f : bf2f(((const bf16_t*)(P.ws + WS_PROJ0))[(size_t)(m - 1) * N0P + C_PRW + c]);
    int i = (m - TP) & 31, b = (m - TP) >> 5;
    if (i == 0) return P.in[4][(size_t)b * RWS + c];
    return bf2f(((const bf16_t*)(P.ws + WS_PROJ0))[(size_t)(m - 1) * N0P + C_PRW + c]);
}
__global__ void __launch_bounds__(512) k_rw_prep(Ptrs P) {
    __shared__ float swl[64], sal[64];
    const int m = blockIdx.x, c = threadIdx.x, lane = c & 63;
    const bf16_t* pr = (const bf16_t*)(P.ws + WS_PROJ0) + (size_t)m * N0P + C_PRW;
    const float* mu = P.in[19];
    auto mix = [&](int col) { float cur = bf2f(pr[col]); float prev = prw_prev(P, m, col); return cur + (prev - cur) * mu[col]; };
    float r = mix(c), kr = mix(512 + c), vr = mix(1024 + c);
    if (c < 64) swl[c] = tanhf(mix(1536 + c)); else if (c < 128) sal[c - 64] = mix(1600 + c - 64);
    __syncthreads();
    float wa = P.in[20][c], aa = P.in[22][c];
    const float* wup = P.in[21]; const float* aup = P.in[23];
    for (int l = 0; l < 64; ++l) { wa += swl[l] * wup[l * 512 + c]; aa += sal[l] * aup[l * 512 + c]; }
    float spl = (-wa > 20.f) ? -wa : log1pf(__expf(-wa));
    float w = -spl - 0.5f;
    float dec = __expf(-__expf(w));
    float a = 1.f / (1.f + __expf(-aa));
    float kk = kr * P.in[24][c];
    float n2 = wave_sum(kk * kk);
    kk = kk / fmaxf(sqrtf(n2), 1e-12f);
    float km = kr * (1.f + (a - 1.f) * P.in[25][c]);
    float* R = (float*)(P.ws + WS_RW);
    size_t o = (size_t)m * 512 + c;
    R[o] = r; R[RWN + o] = dec; R[2 * RWN + o] = kk; R[3 * RWN + o] = kk * a; R[4 * RWN + o] = km; R[5 * RWN + o] = vr;
    (void)lane;
}
__global__ void __launch_bounds__(64) k_rw_scan(Ptrs P) {
    const int seq = blockIdx.x >> 3, h = blockIdx.x & 7, lane = threadIdx.x;
    const int m0 = seq == 0 ? 0 : TP + 32 * (seq - 1), T = seq == 0 ? TP : TS;
    float S[64];
    if (seq == 0) { for (int k = 0; k < 64; ++k) S[k] = 0.f; }
    else { const float* s0 = P.in[5] + (((size_t)(seq - 1) * 8 + h) * 64 + lane) * 64; for (int k = 0; k < 64; ++k) S[k] = s0[k]; }
    const float* R = (const float*)(P.ws + WS_RW);
    const float rk = P.in[26][h * 64 + lane], lg = P.in[27][h * 64 + lane], lb = P.in[28][h * 64 + lane];
    for (int t = 0; t < T; ++t) {
        size_t o = (size_t)(m0 + t) * 512 + h * 64 + lane;
        float r = R[o], dec = R[RWN + o], kk = R[2 * RWN + o], kka = R[3 * RWN + o], km = R[4 * RWN + o], v = R[5 * RWN + o];
        float sa = 0.f;
#pragma unroll
        for (int k = 0; k < 64; ++k) sa += S[k] * __shfl(kk, k);
        float ov = 0.f;
#pragma unroll
        for (int k = 0; k < 64; ++k) { S[k] = S[k] * __shfl(dec, k) - sa * __shfl(kka, k) + v * __shfl(km, k); ov += S[k] * __shfl(r, k); }
        float mu = wave_sum(ov) * (1.f / 64);
        float dv = ov - mu;
        float var = wave_sum(dv * dv) * (1.f / 64);
        float y = dv * rsqrtf(var + GN_EPS) * lg + lb;
        float bonus = wave_sum(r * km * rk) * v;
        int mm = m0 + t;
        float zb = bf2f(((const bf16_t*)(P.ws + WS_PROJ0))[(size_t)mm * N0P + C_ZB + h * 64 + lane]);
        ((bf16_t*)(P.ws + WS_CAT))[(size_t)mm * D + 512 + h * 64 + lane] = f2bf((y + bonus) * silu(zb));
    }
    float* so = P.out + (seq == 0 ? O_L0WKV_P + ((size_t)h * 64 + lane) * 64 : O_L0WKV_S + ((((size_t)(seq - 1)) * 8 + h) * 64 + lane) * 64);
    for (int k = 0; k < 64; ++k) so[k] = S[k];
}

__global__ void __launch_bounds__(256) k_attn1(Ptrs P) {
    __shared__ float sq[4][64], sa[4][64];
    const int wid = threadIdx.x >> 6, lane = threadIdx.x & 63;
    const int gw = blockIdx.x * 4 + wid;
    const int m = gw >> 4, h = gw & 15;
    if (m >= M) return;
    const bf16_t* Q1 = (const bf16_t*)(P.ws + WS_Q1); const bf16_t* K1 = (const bf16_t*)(P.ws + WS_K1);
    const bf16_t* V1T = (const bf16_t*)(P.ws + WS_V1T);
    bool samp = m >= TP; int b = 0, qpos;
    if (!samp) qpos = m; else { b = (m - TP) >> 5; qpos = PAST + ((m - TP) & 31); }
    sq[wid][lane] = bf2f(Q1[(size_t)m * D + 64 * h + lane]);
    float run = 0.f, o = 0.f;
    for (int s0 = qpos - 1; s0 >= 0; s0 -= 64) {
        int s = s0 - lane;
        bool valid = s >= 0;
        float z = 0.f;
        if (valid) {
            if (samp && s < PAST) { const float* kr = P.in[6] + (((size_t)b * PAST + s) * 16 + h) * 64; for (int d = 0; d < 64; ++d) z += sq[wid][d] * bf2f(f2bf(kr[d])); }
            else { int km = samp ? TP + 32 * b + (s - PAST) : s; const bf16_t* kr = K1 + (size_t)km * D + 64 * h; for (int d = 0; d < 64; ++d) z += sq[wid][d] * bf2f(kr[d]); }
        }
        float spl = valid ? log2f(1.f + exp2f(z)) : 0.f;
        float inc = spl;
#pragma unroll
        for (int off = 1; off < 64; off <<= 1) { float t = __shfl_up(inc, off); if (lane >= off) inc += t; }
        float a = valid ? exp2f(z - inc - run) : 0.f;
        sa[wid][lane] = a;
        run += __shfl(inc, 63);
        __builtin_amdgcn_s_waitcnt(0);
        int jn = min(64, s0 + 1);
        for (int jj = 0; jj < jn; ++jj) {
            int sp_ = s0 - jj; float v;
            if (samp && sp_ < PAST) v = bf2f(f2bf(P.in[7][(((size_t)b * PAST + sp_) * 16 + h) * 64 + lane]));
            else { int km = samp ? TP + 32 * b + (sp_ - PAST) : sp_; v = bf2f(V1T[(size_t)(64 * h + lane) * M + km]); }
            o += sa[wid][jj] * v;
        }
        if (run > 200.f) break;
    }
    float z1 = bf2f(((const bf16_t*)(P.ws + WS_Z1))[(size_t)m * D + 64 * h + lane]);
    ((bf16_t*)(P.ws + WS_O1B))[(size_t)m * D + 64 * h + lane] = f2bf(o * silu(z1));
}

}
namespace pg8 {
#define PG8_LAS __attribute__((address_space(3)))
typedef unsigned short bf16_t;
typedef short bf16x8 __attribute__((ext_vector_type(8)));
typedef float f32x4 __attribute__((ext_vector_type(4)));
typedef unsigned u32x4 __attribute__((ext_vector_type(4)));
constexpr int BM = 256, BK = 64, HALF = 128, HTB = HALF * BK * 2  , STAGE_BYTES = 8 * HTB, NXCD = 8, WGM = 8;

__host__ __device__ __forceinline__ int lds_byte(int r, int c) { const int st = (r >> 4) * 2 + (c >> 5), rr = r & 15, cc = c & 31, ob = rr * 64 + cc * 2; return st * 1024 + (ob ^ (((ob >> 9) & 1) << 5)); }
__host__ __device__ __forceinline__ void stage_rc(int b, int& R, int& C) { const int st = b / 1024, sb = b % 1024, swz = sb ^ (((sb >> 9) & 1) << 5); R = (st >> 1) * 16 + swz / 64; C = (st & 1) * 32 + (swz % 64) / 2; }
__host__ __device__ __forceinline__ int perm32(int rho) { const int n = rho >> 4, i = rho & 15; return 8 * (i >> 2) + 4 * n + (i & 3); }

struct Unit { int pm, pn; };
struct Gemm { const bf16_t* A; const bf16_t* Bt; int M, N, K; };

struct StaticOrder {
    int nM, nN, nwg, G, c;
    __host__ __device__ void init(int M, int N, int G_, int c_) { nM = M / BM; nN = N / BM; nwg = nM * nN; G = G_; c = c_; }
    __host__ __device__ bool next(int i, Unit& u) const {
        const long L = (long)i * G + c; if (L >= nwg) return false;
        int wgid = (int)L; { const int q = nwg / NXCD, r = nwg % NXCD, xcd = wgid % NXCD, off = wgid / NXCD; wgid = (xcd < r ? xcd * (q + 1) : r * (q + 1) + (xcd - r) * q) + off; }
        const int nig = WGM * nN, gid = wgid / nig, fm = gid * WGM, gsz = (nM - fm) < WGM ? (nM - fm) : WGM;
        u.pm = fm + ((wgid % nig) % gsz); u.pn = (wgid % nig) / gsz; return true;
    }
    __device__ __forceinline__ void a_ready(const Unit&) const {}
    __device__ __forceinline__ void done(const Unit&) const {}
};


__device__ __forceinline__ unsigned cvt_pk_bf16(float lo, float hi) { unsigned r; asm volatile("v_cvt_pk_bf16_f32 %0, %1, %2" : "=v"(r) : "v"(lo), "v"(hi)); return r; }
__device__ __forceinline__ u32x4 pack8(const f32x4& v0, const f32x4& v1) { u32x4 w; w.x = cvt_pk_bf16(v0[0], v0[1]); w.y = cvt_pk_bf16(v0[2], v0[3]); w.z = cvt_pk_bf16(v1[0], v1[1]); w.w = cvt_pk_bf16(v1[2], v1[3]); return w; }

struct EpiProj0F {
    static constexpr bool PERM = true, AFTER_DRAIN = false;
    bf16_t* O;
    __device__ __forceinline__ void operator()(const f32x4 (&acc)[2][2][4][2], const Unit& u, int wr, int wc, int fr, int fq) const {
        const int row0 = u.pm * BM + wr * 64 + fr, col0 = u.pn * BM + wc * 32 + 8 * fq;
#pragma unroll
        for (int ai = 0; ai < 2; ++ai)
#pragma unroll
            for (int m = 0; m < 4; ++m) { bf16_t* rowp = O + (size_t)(row0 + ai * HALF + m * 16) * N0P + col0;
#pragma unroll
                for (int bj = 0; bj < 2; ++bj) *(u32x4*)(rowp + bj * HALF) = pack8(acc[ai][bj][m][0], acc[ai][bj][m][1]); }
    }
};
struct EpiY0F {
    static constexpr bool PERM = true, AFTER_DRAIN = false;
    Ptrs P;
    __device__ __forceinline__ void operator()(const f32x4 (&acc)[2][2][4][2], const Unit& u, int wr, int wc, int fr, int fq) const {
        const int row0 = u.pm * BM + wr * 64 + fr, col0 = u.pn * BM + wc * 32 + 8 * fq;
        float* Y0 = (float*)(P.ws + WS_Y0); bf16_t* YB = (bf16_t*)(P.ws + WS_Y0B); float* SSQ = (float*)(P.ws + WS_SSQ);
#pragma unroll
        for (int ai = 0; ai < 2; ++ai)
#pragma unroll
            for (int m = 0; m < 4; ++m) { const int row = row0 + ai * HALF + m * 16; const float* xr = xrow(P, row) + col0; float ss = 0.f;
#pragma unroll
                for (int bj = 0; bj < 2; ++bj) {
                    const f32x4 y0 = acc[ai][bj][m][0] + *(const f32x4*)(xr + bj * HALF), y1 = acc[ai][bj][m][1] + *(const f32x4*)(xr + bj * HALF + 4);
                    *(f32x4*)(Y0 + (size_t)row * D + col0 + bj * HALF) = y0; *(f32x4*)(Y0 + (size_t)row * D + col0 + bj * HALF + 4) = y1;
                    *(u32x4*)(YB + (size_t)row * D + col0 + bj * HALF) = pack8(y0, y1);
                    ss += (y0[0] * y0[0] + y0[1] * y0[1]) + (y0[2] * y0[2] + y0[3] * y0[3]) + (y1[0] * y1[0] + y1[1] * y1[1]) + (y1[2] * y1[2] + y1[3] * y1[3]); }
                ss += __shfl_xor(ss, 16); ss += __shfl_xor(ss, 32);
                if (fq == 0) SSQ[(size_t)row * 16 + u.pn * 4 + wc] = ss; }
    }
};
struct EpiL1F {
    static constexpr bool PERM = true, AFTER_DRAIN = false;
    Ptrs P;
    __device__ __forceinline__ void operator()(const f32x4 (&acc)[2][2][4][2], const Unit& u, int wr, int wc, int fr, int fq) const {
        const int row0 = u.pm * BM + wr * 64 + fr, colt = u.pn * BM, reg = colt >> 10, c0 = (colt & 1023) + wc * 32 + 8 * fq;
        const float* SSQ = (const float*)(P.ws + WS_SSQ);
#pragma unroll
        for (int ai = 0; ai < 2; ++ai)
#pragma unroll
            for (int m = 0; m < 4; ++m) { const int row = row0 + ai * HALF + m * 16;
                const f32x4* sp = (const f32x4*)(SSQ + (size_t)row * 16); const f32x4 s0 = sp[0], s1 = sp[1], s2 = sp[2], s3 = sp[3];
                const f32x4 st = (s0 + s1) + (s2 + s3); const float rs = rsqrtf(((st[0] + st[1]) + (st[2] + st[3])) * (1.f / D) + EPS);
#pragma unroll
                for (int bj = 0; bj < 2; ++bj) { const int c = c0 + bj * HALF; f32x4 v0 = acc[ai][bj][m][0] * rs, v1 = acc[ai][bj][m][1] * rs;
                    if (reg == 0) { *(u32x4*)((bf16_t*)(P.ws + WS_Q1) + (size_t)row * D + c) = pack8(v0 * QSCALE, v1 * QSCALE); }
                    else if (reg == 1) { *(u32x4*)((bf16_t*)(P.ws + WS_K1) + (size_t)row * D + c) = pack8(v0, v1); float* o = P.out + off_l1k(row) + c; *(f32x4*)o = v0; *(f32x4*)(o + 4) = v1; }
                    else if (reg == 2) { bf16_t* vt = (bf16_t*)(P.ws + WS_V1T) + (size_t)c * M + row;
#pragma unroll
                        for (int j = 0; j < 4; ++j) { vt[(size_t)j * M] = f2bf(v0[j]); vt[(size_t)(4 + j) * M] = f2bf(v1[j]); }
                        float* o = P.out + off_l1v(row) + c; *(f32x4*)o = v0; *(f32x4*)(o + 4) = v1; }
                    else { *(u32x4*)((bf16_t*)(P.ws + WS_Z1) + (size_t)row * D + c) = pack8(v0, v1); } } }
    }
};
struct EpiOutF {
    static constexpr bool PERM = true, AFTER_DRAIN = false;
    Ptrs P;
    __device__ __forceinline__ void operator()(const f32x4 (&acc)[2][2][4][2], const Unit& u, int wr, int wc, int fr, int fq) const {
        const int row0 = u.pm * BM + wr * 64 + fr, col0 = u.pn * BM + wc * 32 + 8 * fq;
        const float* Y0 = (const float*)(P.ws + WS_Y0);
#pragma unroll
        for (int ai = 0; ai < 2; ++ai)
#pragma unroll
            for (int m = 0; m < 4; ++m) { const size_t ro = (size_t)(row0 + ai * HALF + m * 16) * D + col0;
#pragma unroll
                for (int bj = 0; bj < 2; ++bj) {
                    *(f32x4*)(P.out + O_Y + ro + bj * HALF) = acc[ai][bj][m][0] + *(const f32x4*)(Y0 + ro + bj * HALF);
                    *(f32x4*)(P.out + O_Y + ro + bj * HALF + 4) = acc[ai][bj][m][1] + *(const f32x4*)(Y0 + ro + bj * HALF + 4); } }
    }
};
template <class Epi, class Sched, bool ALIGN_EPI = false, bool SP2 = false>
__device__ __forceinline__ void gemm_phase(PG8_LAS unsigned char* lds, const Gemm g, const Sched& S, const Epi& E) {
    const int tid = threadIdx.x, wid = __builtin_amdgcn_readfirstlane(tid >> 6), lane = tid & 63, wr = wid >> 2, wc = wid & 3, fr = lane & 15, fq = lane >> 4;
    const int K = g.K, nt = K / BK;
    unsigned voffA[2], voffB[2];
#pragma unroll
    for (int i = 0; i < 2; ++i) { int R, C; stage_rc(tid * 16 + i * 8192, R, C); const int Rb = Epi::PERM ? ((R & ~31) + perm32(R & 31)) : R;
        voffA[i] = (unsigned)(R * K + C) * 2u; voffB[i] = (unsigned)(Rb * K + C) * 2u; }
    const size_t kstep = (size_t)(BK * 2);
    const size_t hstep = (size_t)HALF * K * 2;
    const size_t tstep = 2 * hstep;
    const unsigned ldsw = (unsigned)wid * 1024u;
    const int aoff = lds_byte(wr * 64 + fr, fq * 8), boff = lds_byte(wc * 32 + fr, fq * 8);
#define PG8_SA(b, h) (((b) * 2 + (h)) * HTB)
#define PG8_SB(b, h) ((4 + (b) * 2 + (h)) * HTB)
#define PG8_STAGE(bufoff, gbase, voff) do { _Pragma("unroll") for (int _i = 0; _i < 2; ++_i) \
        __builtin_amdgcn_global_load_lds((const unsigned*)((const char*)(gbase) + (voff)[_i]), (PG8_LAS unsigned*)(lds + (bufoff) + ldsw + _i * 8192), 16, 0, 0); } while (0)
#define PG8_LDA(dst, b, h) do { _Pragma("unroll") for (int m = 0; m < 4; ++m) _Pragma("unroll") for (int k = 0; k < 2; ++k) dst[m][k] = *(const PG8_LAS bf16x8*)(lds + PG8_SA(b, h) + aoff + m * 2048 + k * 1024); } while (0)
#define PG8_LDB(dst, b, h) do { _Pragma("unroll") for (int n = 0; n < 2; ++n) _Pragma("unroll") for (int k = 0; k < 2; ++k) dst[n][k] = *(const PG8_LAS bf16x8*)(lds + PG8_SB(b, h) + boff + n * 2048 + k * 1024); } while (0)
#define PG8_MMA(ai, bj, At, Bt) do { __builtin_amdgcn_s_setprio(1); _Pragma("unroll") for (int m = 0; m < 4; ++m) _Pragma("unroll") for (int n = 0; n < 2; ++n) _Pragma("unroll") for (int k = 0; k < 2; ++k) \
        acc[ai][bj][m][n] = __builtin_amdgcn_mfma_f32_16x16x32_bf16(Bt[n][k], At[m][k], acc[ai][bj][m][n], 0, 0, 0); __builtin_amdgcn_s_setprio(0); } while (0)
#define PG8_WAIT_V(n) asm volatile("s_waitcnt vmcnt(" #n ")" ::: "memory")
#define PG8_WAIT_L(n) asm volatile("s_waitcnt lgkmcnt(" #n ")" ::: "memory")
#define PG8_BAR __builtin_amdgcn_s_barrier()
#define PG8_SCHED __builtin_amdgcn_sched_barrier(0)
    Unit cur, nxt; int ui = 0;
    if (!S.next(0, cur)) return;
    f32x4 acc[2][2][4][2];
#pragma unroll
    for (int a = 0; a < 2; ++a)
#pragma unroll
        for (int b = 0; b < 2; ++b)
#pragma unroll
            for (int m = 0; m < 4; ++m)
#pragma unroll
                for (int n = 0; n < 2; ++n) acc[a][b][m][n] = (f32x4){0.f, 0.f, 0.f, 0.f};
    bf16x8 At[4][2], B0[2][2], B1[2][2];
    const char* cA = (const char*)g.A + (size_t)cur.pm * tstep; const char* cB = (const char*)g.Bt + (size_t)cur.pn * tstep;
    S.a_ready(cur);
    if constexpr (SP2) {
        PG8_STAGE(PG8_SB(0, 0), cB, voffB); PG8_STAGE(PG8_SB(0, 1), cB + hstep, voffB); PG8_STAGE(PG8_SA(0, 0), cA, voffA); PG8_STAGE(PG8_SA(0, 1), cA + hstep, voffA);
        if (wr == 1) PG8_BAR;
        PG8_WAIT_V(2); PG8_BAR;
        PG8_STAGE(PG8_SB(1, 0), cB + kstep, voffB); PG8_STAGE(PG8_SA(1, 0), cA + kstep, voffA); PG8_STAGE(PG8_SB(1, 1), cB + hstep + kstep, voffB);
        PG8_WAIT_V(6); PG8_BAR;
    } else {
        PG8_STAGE(PG8_SB(0, 0), cB, voffB); PG8_STAGE(PG8_SA(0, 0), cA, voffA); PG8_STAGE(PG8_SB(0, 1), cB + hstep, voffB); PG8_STAGE(PG8_SA(0, 1), cA + hstep, voffA);
        if (wr == 1) PG8_BAR;
        PG8_WAIT_V(4); PG8_BAR;
        PG8_STAGE(PG8_SB(1, 0), cB + kstep, voffB); PG8_STAGE(PG8_SA(1, 0), cA + kstep, voffA); PG8_STAGE(PG8_SB(1, 1), cB + hstep + kstep, voffB);
        PG8_WAIT_V(6); PG8_BAR;
    }
    for (;;) {
        const bool has_next = S.next(ui + 1, nxt);
        const char* nA = has_next ? (const char*)g.A + (size_t)nxt.pm * tstep : cA; const char* nB = has_next ? (const char*)g.Bt + (size_t)nxt.pn * tstep : cB;
        for (int t = 0; t < nt; t += 2) {
            const bool last = (t == nt - 2);
            const char* a1 = cA + (size_t)(t + 1) * kstep;
            const char* a2 = last ? nA : cA + (size_t)(t + 2) * kstep; const char* b2 = last ? nB : cB + (size_t)(t + 2) * kstep;
            const char* a3 = a2 + kstep; const char* b3 = b2 + kstep;
            if (last && has_next) S.a_ready(nxt);
            if constexpr (SP2) {
            PG8_LDB(B0, 0, 0); PG8_LDB(B1, 0, 1); PG8_SCHED; PG8_LDA(At, 0, 0); PG8_STAGE(PG8_SA(1, 1), a1 + hstep, voffA);
            PG8_WAIT_V(8); PG8_WAIT_L(0); PG8_BAR; PG8_MMA(0, 0, At, B0); PG8_MMA(0, 1, At, B1); PG8_BAR; PG8_SCHED;
            PG8_LDA(At, 0, 1); PG8_STAGE(PG8_SB(0, 0), b2, voffB); PG8_STAGE(PG8_SB(0, 1), b2 + hstep, voffB); PG8_STAGE(PG8_SA(0, 0), a2, voffA);
            PG8_WAIT_V(8); PG8_WAIT_L(0); PG8_BAR; PG8_MMA(1, 0, At, B0); PG8_MMA(1, 1, At, B1); PG8_BAR; PG8_SCHED;
            PG8_LDB(B0, 1, 0); PG8_LDB(B1, 1, 1); PG8_SCHED; PG8_LDA(At, 1, 0); PG8_STAGE(PG8_SA(0, 1), a2 + hstep, voffA);
            PG8_WAIT_V(8); PG8_WAIT_L(0); PG8_BAR; PG8_MMA(0, 0, At, B0); PG8_MMA(0, 1, At, B1); PG8_BAR; PG8_SCHED;
            PG8_LDA(At, 1, 1); PG8_STAGE(PG8_SB(1, 0), b3, voffB); PG8_STAGE(PG8_SB(1, 1), b3 + hstep, voffB); PG8_STAGE(PG8_SA(1, 0), a3, voffA);
            PG8_WAIT_V(8); PG8_WAIT_L(0); PG8_BAR; PG8_MMA(1, 0, At, B0); PG8_MMA(1, 1, At, B1); PG8_BAR; PG8_SCHED;
            } else {
            PG8_LDB(B0, 0, 0); PG8_SCHED; PG8_LDA(At, 0, 0); PG8_STAGE(PG8_SA(1, 1), a1 + hstep, voffA);
            PG8_WAIT_L(8); PG8_BAR; PG8_WAIT_L(0); PG8_MMA(0, 0, At, B0); PG8_BAR; PG8_SCHED;
            PG8_LDB(B1, 0, 1); PG8_STAGE(PG8_SB(0, 0), b2, voffB);
            PG8_BAR; PG8_WAIT_L(0); PG8_MMA(0, 1, At, B1); PG8_BAR;
            PG8_LDA(At, 0, 1); PG8_STAGE(PG8_SA(0, 0), a2, voffA);
            PG8_BAR; PG8_WAIT_L(0); PG8_MMA(1, 0, At, B0); PG8_BAR; PG8_SCHED;
            PG8_STAGE(PG8_SB(0, 1), b2 + hstep, voffB);
            PG8_WAIT_V(6); PG8_BAR; PG8_MMA(1, 1, At, B1); PG8_BAR;
            PG8_LDB(B0, 1, 0); PG8_SCHED; PG8_LDA(At, 1, 0); PG8_STAGE(PG8_SA(0, 1), a2 + hstep, voffA);
            PG8_WAIT_L(8); PG8_BAR; PG8_WAIT_L(0); PG8_MMA(0, 0, At, B0); PG8_BAR; PG8_SCHED;
            PG8_LDB(B1, 1, 1); PG8_STAGE(PG8_SB(1, 0), b3, voffB);
            PG8_BAR; PG8_WAIT_L(0); PG8_MMA(0, 1, At, B1); PG8_BAR;
            PG8_LDA(At, 1, 1); PG8_STAGE(PG8_SA(1, 0), a3, voffA);
            PG8_BAR; PG8_WAIT_L(0); PG8_MMA(1, 0, At, B0); PG8_BAR; PG8_SCHED;
            PG8_STAGE(PG8_SB(1, 1), b3 + hstep, voffB);
            PG8_WAIT_V(6); PG8_BAR; PG8_MMA(1, 1, At, B1); PG8_BAR;
            }
        }
        if constexpr (ALIGN_EPI) { if (wr == 0) PG8_BAR; }
        if constexpr (!Epi::AFTER_DRAIN) { E(acc, cur, wr, wc, fr, fq); S.done(cur); }
        if (!has_next) break;
#pragma unroll
        for (int a = 0; a < 2; ++a)
#pragma unroll
            for (int b = 0; b < 2; ++b)
#pragma unroll
                for (int m = 0; m < 4; ++m)
#pragma unroll
                    for (int n = 0; n < 2; ++n) acc[a][b][m][n] = (f32x4){0.f, 0.f, 0.f, 0.f};
        cur = nxt; cA = nA; cB = nB; ++ui;
        if constexpr (ALIGN_EPI) { if (wr == 1) PG8_BAR; }
    }
    PG8_WAIT_V(0);
    if constexpr (!ALIGN_EPI) { if (wr == 0) PG8_BAR; }
    PG8_BAR;
    if constexpr (Epi::AFTER_DRAIN) { E.fused(acc, cur, wr, wc, fr, fq, lds, wid, lane); S.done(cur); }
#undef PG8_SA
#undef PG8_SB
#undef PG8_STAGE
#undef PG8_LDA
#undef PG8_LDB
#undef PG8_MMA
#undef PG8_WAIT_V
#undef PG8_WAIT_L
#undef PG8_BAR
#undef PG8_SCHED
}
}
constexpr int NWAVES = 8, NTHREADS = 512;
constexpr int LDS_BYTES = 147456;
enum Phase { PH_PRO = 0, PH_GEMM1 = 1, PH_TOK = 2, PH_MIX = 3, PH_RWC = 4, PH_GEMM2 = 5, PH_GEMM3 = 6, PH_ATTN1 = 7, PH_GEMM4 = 8, PH_END = 9 };
#define LAS __attribute__((address_space(3)))
struct Args { Ptrs p; int ph_lo, ph_hi; int pad0, pad1; };

__global__ void __launch_bounds__(NTHREADS, 2) mk_fwd(Args a) {
    extern __shared__ __attribute__((aligned(16))) unsigned char lds[];
    const Ptrs& P = a.p;
    unsigned char* ws = P.ws;
    const int lo = a.ph_lo, hi = a.ph_hi;
#define IN(k) (lo <= (k) && (k) < hi)
    if (IN(PH_GEMM1)) {
        pg8::Gemm g{(const bf16_t*)(ws + WS_XN0), (const bf16_t*)(ws + WS_WT0), M, N0P, D}; pg8::StaticOrder S; S.init(M, N0P, (int)gridDim.x, (int)blockIdx.x);
        pg8::EpiProj0F E{(bf16_t*)(ws + WS_PROJ0)};
        pg8::gemm_phase<pg8::EpiProj0F, pg8::StaticOrder, true, true>((LAS unsigned char*)lds, g, S, E);
    }
    if (IN(PH_GEMM2)) {
        pg8::Gemm g{(const bf16_t*)(ws + WS_CAT), (const bf16_t*)(ws + WS_WO0T), M, D, D}; pg8::StaticOrder S; S.init(M, D, (int)gridDim.x, (int)blockIdx.x);
        pg8::EpiY0F E{P};
        pg8::gemm_phase<pg8::EpiY0F, pg8::StaticOrder, true, true>((LAS unsigned char*)lds, g, S, E);
    }
    if (IN(PH_GEMM3)) {
        pg8::Gemm g{(const bf16_t*)(ws + WS_Y0B), (const bf16_t*)(ws + WS_WT1), M, N1, D}; pg8::StaticOrder S; S.init(M, N1, (int)gridDim.x, (int)blockIdx.x);
        pg8::EpiL1F E{P};
        pg8::gemm_phase<pg8::EpiL1F, pg8::StaticOrder, true, true>((LAS unsigned char*)lds, g, S, E);
    }
    if (IN(PH_GEMM4)) {
        pg8::Gemm g{(const bf16_t*)(ws + WS_O1B), (const bf16_t*)(ws + WS_WO1T), M, D, D}; pg8::StaticOrder S; S.init(M, D, (int)gridDim.x, (int)blockIdx.x);
        pg8::EpiOutF E{P};
        pg8::gemm_phase<pg8::EpiOutF, pg8::StaticOrder, true, true>((LAS unsigned char*)lds, g, S, E);
    }
#undef IN
}
static int g_grid = 0;
static void mk_phase(const Ptrs& p, int lo, int hi, hipStream_t st) {
    Args a{}; a.p = p; a.ph_lo = lo; a.ph_hi = hi;
    hipLaunchKernelGGL(mk_fwd, dim3(g_grid), dim3(NTHREADS), LDS_BYTES, st, a);
}
static void launch_mixed(const Ptrs& p, hipStream_t st) {
    unsigned char* ws = p.ws;
    auto T = [&](const float* W, int K, int N, int NP, size_t off, const float* g) {
        size_t n = (size_t)NP * K; nv::k_transpose_w<<<(unsigned)((n + 255) / 256), 256, 0, st>>>(W, K, N, NP, (bf16_t*)(ws + off), g); };
    T(p.in[10], D, N0, N0P, WS_WT0, nullptr);
    T(p.in[11], D, D, D, WS_WO0T, nullptr);
    T(p.in[30], D, N1, N1, WS_WT1, p.in[29]);
    T(p.in[31], D, D, D, WS_WO1T, nullptr);
    nv::k_tables<<<1, 256, 0, st>>>(p);
    nv::k_rmsnorm_x<<<M / 4, 256, 0, st>>>(p);
    mk_phase(p, PH_GEMM1, PH_GEMM1 + 1, st);
    nv::k_tok0<<<M / 4, 256, 0, st>>>(p);
    nv::k_attn0<<<M, 256, 0, st>>>(p);
    nv::k_rw_prep<<<M, 512, 0, st>>>(p);
    nv::k_rw_scan<<<33 * 8, 64, 0, st>>>(p);
    mk_phase(p, PH_GEMM2, PH_GEMM2 + 1, st);
    mk_phase(p, PH_GEMM3, PH_GEMM3 + 1, st);
    nv::k_attn1<<<M * 4, 256, 0, st>>>(p);
    mk_phase(p, PH_GEMM4, PH_GEMM4 + 1, st);
}
extern "C" void kernel_launch(void* const* d_in, const int* in_sizes, int n_in, void* d_out, int out_size, void* d_ws, size_t ws_size, hipStream_t stream) {
    if (n_in != 32 || (size_t)out_size != O_TOTAL || ws_size < WS_END) { fprintf(stderr, "kernel_launch: unexpected shapes n_in=%d out=%d ws=%zu\n", n_in, out_size, ws_size); return; }
    if (g_grid == 0) {
        int dev = 0, cus = 0;
        hipGetDevice(&dev); hipDeviceGetAttribute(&cus, hipDeviceAttributeMultiprocessorCount, dev);
        hipFuncSetAttribute((const void*)mk_fwd, hipFuncAttributeMaxDynamicSharedMemorySize, LDS_BYTES);
        g_grid = cus > 0 ? cus : 256;
    }
    Ptrs p{};
    for (int i = 0; i < 32; ++i) p.in[i] = (const float*)d_in[i];
    p.out = (float*)d_out; p.ws = (unsigned char*)d_ws;
    launch_mixed(p, stream);
}
```

```cpp
#include <hip/hip_runtime.h>
#include <stdint.h>
#include <cstdio>

typedef unsigned short bf16_t;
__device__ __forceinline__ float bf2f(bf16_t b) { return __uint_as_float(((unsigned)b) << 16); }
__device__ __forceinline__ bf16_t f2bf(float f) { unsigned u = __float_as_uint(f); return (bf16_t)((u + 0x7fffu + ((u >> 16) & 1u)) >> 16); }

constexpr int D = 1024, TP = 16384, NSEQ = 32, TS = 32, MS = NSEQ * TS, M = TP + MS, PAST = 1024;
constexpr int N0 = 4224, N0P = 4352, N1 = 4096;
constexpr int C_Q = 0, C_K = 512, C_V = 1024, C_ZA = 1536, C_PRW = 2048, C_ZB = 3712;
constexpr int RWS = 1664;
constexpr float EPS = 1e-6f, GN_EPS = 64e-5f;
constexpr float LOG2E = 1.4426950408889634f;
constexpr float LAMBDA_INIT = 0.2f;
constexpr float QSCALE = 0.125f * LOG2E;

constexpr size_t O_Y = 0;
constexpr size_t O_L0K_P = (size_t)M * D;
constexpr size_t O_L0V_P = O_L0K_P + (size_t)TP * 512;
constexpr size_t O_L0SH_P = O_L0V_P + (size_t)TP * 512;
constexpr size_t O_L0WKV_P = O_L0SH_P + RWS;
constexpr size_t O_L1K_P = O_L0WKV_P + 8 * 64 * 64;
constexpr size_t O_L1V_P = O_L1K_P + (size_t)TP * 1024;
constexpr size_t O_L0K_S = O_L1V_P + (size_t)TP * 1024;
constexpr size_t O_L0V_S = O_L0K_S + (size_t)MS * 512;
constexpr size_t O_L0SH_S = O_L0V_S + (size_t)MS * 512;
constexpr size_t O_L0WKV_S = O_L0SH_S + (size_t)NSEQ * RWS;
constexpr size_t O_L1K_S = O_L0WKV_S + (size_t)NSEQ * 8 * 64 * 64;
constexpr size_t O_L1V_S = O_L1K_S + (size_t)MS * 1024;
constexpr size_t O_TOTAL = O_L1V_S + (size_t)MS * 1024;
static_assert(O_TOTAL == 72439424, "output size");

__host__ __device__ __forceinline__ size_t off_l0k(int m) { return m < TP ? O_L0K_P + (size_t)m * 512 : O_L0K_S + (size_t)(m - TP) * 512; }
__host__ __device__ __forceinline__ size_t off_l0v(int m) { return m < TP ? O_L0V_P + (size_t)m * 512 : O_L0V_S + (size_t)(m - TP) * 512; }
__host__ __device__ __forceinline__ size_t off_l1k(int m) { return m < TP ? O_L1K_P + (size_t)m * 1024 : O_L1K_S + (size_t)(m - TP) * 1024; }
__host__ __device__ __forceinline__ size_t off_l1v(int m) { return m < TP ? O_L1V_P + (size_t)m * 1024 : O_L1V_S + (size_t)(m - TP) * 1024; }

constexpr size_t MiB = 1u << 20;
constexpr size_t WS_CTL = 0;
constexpr size_t WS_TAB = 512 * 1024;
constexpr size_t WS_WT0 = 1 * MiB, WS_WO0T = 10 * MiB, WS_WT1 = 12 * MiB, WS_WO1T = 20 * MiB, WS_LORA = 22 * MiB;
constexpr size_t WS_CAT = 24 * MiB, WS_XN0 = WS_CAT;
constexpr size_t WS_PROJ0 = 58 * MiB;
constexpr size_t WS_Q0 = 203 * MiB, WS_K0 = 220 * MiB;
constexpr size_t WS_RW = 237 * MiB;
constexpr size_t WS_SST = 407 * MiB;
constexpr size_t WS_END = 441 * MiB;
constexpr size_t WS_Y0 = WS_PROJ0, WS_Y0B = 126 * MiB, WS_SSQ = 160 * MiB;
constexpr size_t WS_O1B = WS_Q0;
constexpr size_t WS_Q1 = 237 * MiB, WS_K1 = 271 * MiB, WS_V1T = 305 * MiB, WS_Z1 = 339 * MiB;
static_assert(WS_PROJ0 + (size_t)M * N0P * 2 <= WS_Q0, "proj0");
static_assert(WS_WT0 + (size_t)N0P * D * 2 <= WS_WO0T, "wt0");

struct Tab {
    float lam;
    float m0;
    float pad[2];
    float bias[4][256];
    float biasfar[4];
};

struct Ptrs {
    const float* in[32];
    float* out;
    unsigned char* ws;
};

__device__ __forceinline__ const float* xrow(const Ptrs& P, int m) { return m < TP ? P.in[0] + (size_t)m * D : P.in[1] + (size_t)(m - TP) * D; }

__device__ __forceinline__ float wave_sum(float v) {
#pragma unroll
    for (int o = 1; o < 64; o <<= 1) v += __shfl_xor(v, o);
    return v;
}
__device__ __forceinline__ float wave_max(float v) {
#pragma unroll
    for (int o = 1; o < 64; o <<= 1) v = fmaxf(v, __shfl_xor(v, o));
    return v;
}
__device__ __forceinline__ float silu(float x) { return x / (1.f + __expf(-x)); }

__device__ __forceinline__ int t5_bucket(int rel) {
    int n = rel < 0 ? -rel : rel;
    int b;
    if (n < 8) b = n;
    else { unsigned n2 = (unsigned)n * (unsigned)n; int lg = 31 - __clz((int)n2); b = 8 + (lg - 6); if (b > 15) b = 15; }
    return (rel > 0 ? 16 : 0) + b;
}
namespace nv {

__device__ __forceinline__ void d_transpose_w(const float* W, int K, int N, int NP, bf16_t* WT, const float* g, size_t i) {
    int n = (int)(i / K), k = (int)(i % K);
    float v = 0.f;
    if (n < N) { v = W[(size_t)k * N + n]; if (g) v *= g[k]; }
    WT[i] = f2bf(v);
}
__global__ void k_transpose_w(const float* W, int K, int N, int NP, bf16_t* WT, const float* g) {
    size_t i = (size_t)blockIdx.x * blockDim.x + threadIdx.x; if (i < (size_t)NP * K) d_transpose_w(W, K, N, NP, WT, g, i); }
__global__ void k_lora_t(const float* w_up, const float* a_up, float* LT) {
    int i = blockIdx.x * blockDim.x + threadIdx.x;
    if (i >= 512 * 64) return;
    int c = i / 64, l = i % 64;
    LT[i] = w_up[l * 512 + c];
    LT[512 * 64 + i] = a_up[l * 512 + c];
}
__device__ __forceinline__ void d_tables(const Ptrs& P, int tid) {
    Tab* T = (Tab*)(P.ws + WS_TAB);
    if (tid < 64) {
        float a = P.in[14][tid] * P.in[15][tid], b = P.in[16][tid] * P.in[17][tid];
        a = wave_sum(a); b = wave_sum(b);
        float gq = fabsf(P.in[12][tid]), gk = fabsf(P.in[13][tid]);
        gq = wave_max(gq); gk = wave_max(gk);
        if (tid == 0) { T->lam = __expf(a) - __expf(b) + LAMBDA_INIT; T->m0 = 8.f * gq * gk * LOG2E * 1.0001f + 0.01f; }
    }
    if (tid < 255) { int rel = tid - 191; int b = t5_bucket(rel); for (int h = 0; h < 4; ++h) T->bias[h][tid] = P.in[8][b * 4 + h]; }
    if (tid == 255) for (int h = 0; h < 4; ++h) { T->bias[h][255] = 0.f; T->biasfar[h] = P.in[8][15 * 4 + h]; }
}
__global__ void k_tables(Ptrs P) { d_tables(P, threadIdx.x); }
__device__ __forceinline__ void d_rmsnorm_x(const Ptrs& P, int w, int lane) {
    const float* x = xrow(P, w); const float* g = P.in[9];
    bf16_t* o = (bf16_t*)(P.ws + WS_XN0) + (size_t)w * D;
    float v[16], s = 0.f;
#pragma unroll
    for (int j = 0; j < 16; ++j) { v[j] = x[lane + 64 * j]; s += v[j] * v[j]; }
    s = wave_sum(s);
    float r = rsqrtf(s * (1.f / D) + EPS);
#pragma unroll
    for (int j = 0; j < 16; ++j) o[lane + 64 * j] = f2bf(v[j] * r * g[lane + 64 * j]);
}
__global__ void k_rmsnorm_x(Ptrs P) { int w = (blockIdx.x * blockDim.x + threadIdx.x) >> 6; if (w < M) d_rmsnorm_x(P, w, threadIdx.x & 63); }

template <class Epi>
__global__ void __launch_bounds__(256) k_gemm(const bf16_t* A, const bf16_t* Bt, int K, Epi epi) {
    __shared__ float As[16][65], Bs[16][65];
    const int tx = threadIdx.x & 15, ty = threadIdx.x >> 4;
    const int m0 = blockIdx.y * 64, n0 = blockIdx.x * 64;
    float acc[4][4];
#pragma unroll
    for (int i = 0; i < 4; ++i)
#pragma unroll
        for (int j = 0; j < 4; ++j) acc[i][j] = 0.f;
    for (int k0 = 0; k0 < K; k0 += 16) {
#pragma unroll
        for (int i = 0; i < 4; ++i) {
            int e = threadIdx.x + 256 * i, r = e >> 4, c = e & 15;
            As[c][r] = bf2f(A[(size_t)(m0 + r) * K + k0 + c]);
            Bs[c][r] = bf2f(Bt[(size_t)(n0 + r) * K + k0 + c]);
        }
        __syncthreads();
#pragma unroll
        for (int kk = 0; kk < 16; ++kk) {
            float a[4], b[4];
#pragma unroll
            for (int i = 0; i < 4; ++i) { a[i] = As[kk][ty * 4 + i]; b[i] = Bs[kk][tx * 4 + i]; }
#pragma unroll
            for (int i = 0; i < 4; ++i)
#pragma unroll
                for (int j = 0; j < 4; ++j) acc[i][j] += a[i] * b[j];
        }
        __syncthreads();
    }
#pragma unroll
    for (int i = 0; i < 4; ++i)
#pragma unroll
        for (int j = 0; j < 4; ++j) epi(m0 + ty * 4 + i, n0 + tx * 4 + j, acc[i][j]);
}
struct EpiProj0 { bf16_t* O; __device__ void operator()(int m, int n, float v) const { O[(size_t)m * N0P + n] = f2bf(v); } };
struct EpiY0 {
    Ptrs P;
    __device__ void operator()(int m, int n, float v) const {
        float y = v + xrow(P, m)[n];
        ((float*)(P.ws + WS_Y0))[(size_t)m * D + n] = y;
        ((bf16_t*)(P.ws + WS_Y0B))[(size_t)m * D + n] = f2bf(y);
    }
};
struct EpiL1 {
    Ptrs P;
    __device__ void operator()(int m, int n, float v) const {
        const float* ss = (const float*)(P.ws + WS_SSQ) + (size_t)m * 16;
        float t = 0.f; for (int j = 0; j < 16; ++j) t += ss[j];
        float r = rsqrtf(t * (1.f / D) + EPS);
        float val = v * r;
        int c = n & 1023;
        if (n < 1024) ((bf16_t*)(P.ws + WS_Q1))[(size_t)m * D + c] = f2bf(val * QSCALE);
        else if (n < 2048) { ((bf16_t*)(P.ws + WS_K1))[(size_t)m * D + c] = f2bf(val); P.out[off_l1k(m) + c] = val; }
        else if (n < 3072) { ((bf16_t*)(P.ws + WS_V1T))[(size_t)c * M + m] = f2bf(val); P.out[off_l1v(m) + c] = val; }
        else ((bf16_t*)(P.ws + WS_Z1))[(size_t)m * D + c] = f2bf(val);
    }
};
struct EpiOut { Ptrs P; __device__ void operator()(int m, int n, float v) const { P.out[O_Y + (size_t)m * D + n] = v + ((const float*)(P.ws + WS_Y0))[(size_t)m * D + n]; } };

__device__ __forceinline__ void d_ssq(const Ptrs& P, int w, int lane) {
    const float* y = (const float*)(P.ws + WS_Y0) + (size_t)w * D;
    float* ss = (float*)(P.ws + WS_SSQ) + (size_t)w * 16;
    for (int j = 0; j < 16; ++j) { float v = y[64 * j + lane]; float s = wave_sum(v * v); if (lane == 0) ss[j] = s; }
}
__global__ void k_ssq(Ptrs P) { int w = (blockIdx.x * blockDim.x + threadIdx.x) >> 6; if (w < M) d_ssq(P, w, threadIdx.x & 63); }

__device__ __forceinline__ void d_tok0(const Ptrs& P, int m, int lane) {
    const bf16_t* pr = (const bf16_t*)(P.ws + WS_PROJ0) + (size_t)m * N0P;
    bf16_t* q0 = (bf16_t*)(P.ws + WS_Q0) + (size_t)m * 512;
    bf16_t* k0 = (bf16_t*)(P.ws + WS_K0) + (size_t)m * 512;
    const float gq = P.in[12][lane], gk = P.in[13][lane];
#pragma unroll 1
    for (int g = 0; g < 8; ++g) {
        float q = bf2f(pr[C_Q + 64 * g + lane]), k = bf2f(pr[C_K + 64 * g + lane]);
        float sq = wave_sum(q * q), sk = wave_sum(k * k);
        float qn = q * rsqrtf(sq * (1.f / 64) + EPS) * gq, kn = k * rsqrtf(sk * (1.f / 64) + EPS) * gk;
        q0[64 * g + lane] = f2bf(qn * QSCALE);
        k0[64 * g + lane] = f2bf(kn);
        P.out[off_l0k(m) + 64 * g + lane] = kn;
        P.out[off_l0v(m) + 64 * g + lane] = bf2f(pr[C_V + 64 * g + lane]);
    }
    int last = -1; size_t so = 0;
    if (m == TP - 1) { last = 1; so = O_L0SH_P; }
    else if (m >= TP && ((m - TP) & 31) == 31) { last = 1; so = O_L0SH_S + (size_t)((m - TP) >> 5) * RWS; }
    if (last > 0) for (int c = lane; c < RWS; c += 64) P.out[so + c] = bf2f(pr[C_PRW + c]);
}
__global__ void k_tok0(Ptrs P) { int m = (blockIdx.x * blockDim.x + threadIdx.x) >> 6; if (m < M) d_tok0(P, m, threadIdx.x & 63); }

template <class SP> __device__ __forceinline__ void d_attn0(const Ptrs& P, int m, int h, int lane, SP sqw, SP spw) {
    const Tab* T = (const Tab*)(P.ws + WS_TAB);
    const bf16_t* Q0 = (const bf16_t*)(P.ws + WS_Q0); const bf16_t* K0 = (const bf16_t*)(P.ws + WS_K0);
    const bf16_t* PR = (const bf16_t*)(P.ws + WS_PROJ0);
    int qpos, nk, b = 0; bool samp = m >= TP;
    if (!samp) { qpos = m; nk = ((m >> 6) + 1) * 64; } else { b = (m - TP) >> 5; qpos = PAST + ((m - TP) & 31); nk = PAST + TS; }
    sqw[lane] = bf2f(Q0[(size_t)m * 512 + 128 * h + lane]);
    sqw[64 + lane] = bf2f(Q0[(size_t)m * 512 + 128 * h + 64 + lane]);
    float m1 = -1e30f, m2 = -1e30f, l1 = 0.f, l2 = 0.f, o1[2] = {0.f, 0.f}, o2[2] = {0.f, 0.f};
    for (int j0 = 0; j0 < nk; j0 += 64) {
        int j = j0 + lane;
        bool valid = j < nk && ((j >> 6) <= (qpos >> 6));
        float s1 = 0.f, s2 = 0.f;
        if (valid) {
            if (samp && j < PAST) {
                const float* kr = P.in[2] + (((size_t)b * PAST + j) * 4 + h) * 128;
                for (int d = 0; d < 64; ++d) { s1 += sqw[d] * bf2f(f2bf(kr[d])); s2 += sqw[64 + d] * bf2f(f2bf(kr[64 + d])); }
            } else {
                int km = samp ? TP + 32 * b + (j - PAST) : j;
                const bf16_t* kr = K0 + (size_t)km * 512 + 128 * h;
                for (int d = 0; d < 64; ++d) { s1 += sqw[d] * bf2f(kr[d]); s2 += sqw[64 + d] * bf2f(kr[64 + d]); }
            }
            int rel = j - qpos; float bias = rel <= -128 ? T->biasfar[h] : T->bias[h][rel + 191];
            s1 += bias * LOG2E; s2 += bias * LOG2E;
        } else { s1 = -1e30f; s2 = -1e30f; }
        float bm1 = wave_max(s1), bm2 = wave_max(s2);
        float n1 = fmaxf(m1, bm1), n2 = fmaxf(m2, bm2);
        float f1 = exp2f(m1 - n1), f2 = exp2f(m2 - n2);
        float p1 = valid ? exp2f(s1 - n1) : 0.f, p2 = valid ? exp2f(s2 - n2) : 0.f;
        l1 = l1 * f1 + wave_sum(p1); l2 = l2 * f2 + wave_sum(p2);
        o1[0] *= f1; o1[1] *= f1; o2[0] *= f2; o2[1] *= f2; m1 = n1; m2 = n2;
        spw[lane] = p1; spw[64 + lane] = p2;
        __builtin_amdgcn_s_waitcnt(0);
        int jn = min(64, nk - j0);
        for (int jj = 0; jj < jn; ++jj) {
            int jp = j0 + jj; float a1 = spw[jj], a2 = spw[64 + jj];
            float v0, v1;
            if (samp && jp < PAST) { const float* vr = P.in[3] + (((size_t)b * PAST + jp) * 4 + h) * 128; v0 = bf2f(f2bf(vr[lane])); v1 = bf2f(f2bf(vr[64 + lane])); }
            else { int km = samp ? TP + 32 * b + (jp - PAST) : jp; const bf16_t* vr = PR + (size_t)km * N0P + C_V + 128 * h; v0 = bf2f(vr[lane]); v1 = bf2f(vr[64 + lane]); }
            o1[0] += a1 * v0; o1[1] += a1 * v1; o2[0] += a2 * v0; o2[1] += a2 * v1;
        }
    }
    const float lam = T->lam;
    float a0 = o1[0] / l1 - lam * o2[0] / l2, a1 = o1[1] / l1 - lam * o2[1] / l2;
    float ss = wave_sum(a0 * a0 + a1 * a1);
    float r = rsqrtf(ss * (1.f / 128) + EPS) * (1.f - LAMBDA_INIT);
    const float* sg = P.in[18];
    const bf16_t* za = PR + (size_t)m * N0P + C_ZA + 128 * h;
    bf16_t* cat = (bf16_t*)(P.ws + WS_CAT) + (size_t)m * D + 128 * h;
    cat[lane] = f2bf(a0 * r * sg[lane] * silu(bf2f(za[lane])));
    cat[64 + lane] = f2bf(a1 * r * sg[64 + lane] * silu(bf2f(za[64 + lane])));
}
__global__ void __launch_bounds__(256) k_attn0(Ptrs P) {
    __shared__ float sq[4][128], sp[4][128];
    const int wid = threadIdx.x >> 6, lane = threadIdx.x & 63, gw = blockIdx.x * 4 + wid;
    if ((gw >> 2) < M) d_attn0(P, gw >> 2, gw & 3, lane, &sq[wid][0], &sp[wid][0]);
}

constexpr size_t RWN = (size_t)M * 512;
__device__ __forceinline__ float prw_prev(const Ptrs& P, int m, int c) {
    if (m < TP) return m == 0 ? 0.f : bf2f(((const bf16_t*)(P.ws + WS_PROJ0))[(size_t)(m - 1) * N0P + C_PRW + c]);
    int i = (m - TP) & 31, b = (m - TP) >> 5;
    if (i == 0) return P.in[4][(size_t)b * RWS + c];
    return bf2f(((const bf16_t*)(P.ws + WS_PROJ0))[(size_t)(m - 1) * N0P + C_PRW + c]);
}
template <class SP> __device__ __forceinline__ void d_rw_prep(const Ptrs& P, int m, int c, SP swl, SP sal) {
    const bf16_t* pr = (const bf16_t*)(P.ws + WS_PROJ0) + (size_t)m * N0P + C_PRW;
    const float* mu = P.in[19];
#define NV_MIX(col) (bf2f(pr[col]) + (prw_prev(P, m, (col)) - bf2f(pr[col])) * mu[col])
    float r = NV_MIX(c), kr = NV_MIX(512 + c), vr = NV_MIX(1024 + c);
    if (c < 64) swl[c] = tanhf(NV_MIX(1536 + c)); else if (c < 128) sal[c - 64] = NV_MIX(1600 + c - 64);
#undef NV_MIX
    __syncthreads();
    float wa = P.in[20][c], aa = P.in[22][c];
    const float* wup = P.in[21]; const float* aup = P.in[23];
#pragma unroll 4
    for (int l = 0; l < 64; ++l) { wa += swl[l] * wup[l * 512 + c]; aa += sal[l] * aup[l * 512 + c]; }
    float spl = (-wa > 20.f) ? -wa : log1pf(__expf(-wa));
    float w = -spl - 0.5f;
    float dec = __expf(-__expf(w));
    float a = 1.f / (1.f + __expf(-aa));
    float kk = kr * P.in[24][c];
    float n2 = wave_sum(kk * kk);
    kk = kk / fmaxf(sqrtf(n2), 1e-12f);
    float km = kr * (1.f + (a - 1.f) * P.in[25][c]);
    float* R = (float*)(P.ws + WS_RW);
    size_t o = (size_t)m * 512 + c;
    R[o] = r; R[RWN + o] = dec; R[2 * RWN + o] = kk; R[3 * RWN + o] = kk * a; R[4 * RWN + o] = km; R[5 * RWN + o] = vr;
}
__global__ void __launch_bounds__(512) k_rw_prep(Ptrs P) { __shared__ float swl[64], sal[64]; d_rw_prep(P, blockIdx.x, threadIdx.x, &swl[0], &sal[0]); }
__device__ __forceinline__ void d_rw_scan(const Ptrs& P, int seq, int h, int lane) {
    const int m0 = seq == 0 ? 0 : TP + 32 * (seq - 1), T = seq == 0 ? TP : TS;
    float S[64];
    const float* s0 = P.in[5] + (((size_t)(seq > 0 ? seq - 1 : 0) * 8 + h) * 64 + lane) * 64;
#pragma unroll
    for (int k = 0; k < 64; ++k) S[k] = seq == 0 ? 0.f : s0[k];
    const float* R = (const float*)(P.ws + WS_RW);
    const float rk = P.in[26][h * 64 + lane], lg = P.in[27][h * 64 + lane], lb = P.in[28][h * 64 + lane];
    for (int t = 0; t < T; ++t) {
        size_t o = (size_t)(m0 + t) * 512 + h * 64 + lane;
        float r = R[o], dec = R[RWN + o], kk = R[2 * RWN + o], kka = R[3 * RWN + o], km = R[4 * RWN + o], v = R[5 * RWN + o];
        float sa = 0.f;
#pragma unroll
        for (int k = 0; k < 64; ++k) sa += S[k] * __shfl(kk, k);
        float ov = 0.f;
#pragma unroll
        for (int k = 0; k < 64; ++k) { S[k] = S[k] * __shfl(dec, k) - sa * __shfl(kka, k) + v * __shfl(km, k); ov += S[k] * __shfl(r, k); }
        float mu = wave_sum(ov) * (1.f / 64);
        float dv = ov - mu;
        float var = wave_sum(dv * dv) * (1.f / 64);
        float y = dv * rsqrtf(var + GN_EPS) * lg + lb;
        float bonus = wave_sum(r * km * rk) * v;
        int mm = m0 + t;
        float zb = bf2f(((const bf16_t*)(P.ws + WS_PROJ0))[(size_t)mm * N0P + C_ZB + h * 64 + lane]);
        ((bf16_t*)(P.ws + WS_CAT))[(size_t)mm * D + 512 + h * 64 + lane] = f2bf((y + bonus) * silu(zb));
    }
    float* so = P.out + (seq == 0 ? O_L0WKV_P + ((size_t)h * 64 + lane) * 64 : O_L0WKV_S + ((((size_t)(seq - 1)) * 8 + h) * 64 + lane) * 64);
#pragma unroll
    for (int k = 0; k < 64; ++k) so[k] = S[k];
}
__global__ void __launch_bounds__(64) k_rw_scan(Ptrs P) { d_rw_scan(P, blockIdx.x >> 3, blockIdx.x & 7, threadIdx.x); }

template <class SP> __device__ __forceinline__ void d_attn1(const Ptrs& P, int m, int h, int lane, SP sqw, SP saw) {
    const bf16_t* Q1 = (const bf16_t*)(P.ws + WS_Q1); const bf16_t* K1 = (const bf16_t*)(P.ws + WS_K1);
    const bf16_t* V1T = (const bf16_t*)(P.ws + WS_V1T);
    bool samp = m >= TP; int b = 0, qpos;
    if (!samp) qpos = m; else { b = (m - TP) >> 5; qpos = PAST + ((m - TP) & 31); }
    sqw[lane] = bf2f(Q1[(size_t)m * D + 64 * h + lane]);
    float run = 0.f, o = 0.f;
    for (int s0 = qpos - 1; s0 >= 0; s0 -= 64) {
        int s = s0 - lane;
        bool valid = s >= 0;
        float z = 0.f;
        if (valid) {
            if (samp && s < PAST) { const float* kr = P.in[6] + (((size_t)b * PAST + s) * 16 + h) * 64; for (int d = 0; d < 64; ++d) z += sqw[d] * bf2f(f2bf(kr[d])); }
            else { int km = samp ? TP + 32 * b + (s - PAST) : s; const bf16_t* kr = K1 + (size_t)km * D + 64 * h; for (int d = 0; d < 64; ++d) z += sqw[d] * bf2f(kr[d]); }
        }
        float spl = valid ? log2f(1.f + exp2f(z)) : 0.f;
        float inc = spl;
#pragma unroll
        for (int off = 1; off < 64; off <<= 1) { float t = __shfl_up(inc, off); if (lane >= off) inc += t; }
        float a = valid ? exp2f(z - inc - run) : 0.f;
        saw[lane] = a;
        run += __shfl(inc, 63);
        __builtin_amdgcn_s_waitcnt(0);
        int jn = min(64, s0 + 1);
        for (int jj = 0; jj < jn; ++jj) {
            int sp_ = s0 - jj; float v;
            if (samp && sp_ < PAST) v = bf2f(f2bf(P.in[7][(((size_t)b * PAST + sp_) * 16 + h) * 64 + lane]));
            else { int km = samp ? TP + 32 * b + (sp_ - PAST) : sp_; v = bf2f(V1T[(size_t)(64 * h + lane) * M + km]); }
            o += saw[jj] * v;
        }
        if (run > 200.f) break;
    }
    float z1 = bf2f(((const bf16_t*)(P.ws + WS_Z1))[(size_t)m * D + 64 * h + lane]);
    ((bf16_t*)(P.ws + WS_O1B))[(size_t)m * D + 64 * h + lane] = f2bf(o * silu(z1));
}
__global__ void __launch_bounds__(256) k_attn1(Ptrs P) {
    __shared__ float sq[4][64], sa[4][64];
    const int wid = threadIdx.x >> 6, lane = threadIdx.x & 63, gw = blockIdx.x * 4 + wid;
    if ((gw >> 4) < M) d_attn1(P, gw >> 4, gw & 15, lane, &sq[wid][0], &sa[wid][0]);
}

}
namespace pg8 {
#define PG8_LAS __attribute__((address_space(3)))
typedef unsigned short bf16_t;
typedef short bf16x8 __attribute__((ext_vector_type(8)));
typedef float f32x4 __attribute__((ext_vector_type(4)));
typedef unsigned u32x4 __attribute__((ext_vector_type(4)));
constexpr int BM = 256, BK = 64, HALF = 128, HTB = HALF * BK * 2  , STAGE_BYTES = 8 * HTB, NXCD = 8, WGM = 8;

__host__ __device__ __forceinline__ int lds_byte(int r, int c) { const int st = (r >> 4) * 2 + (c >> 5), rr = r & 15, cc = c & 31, ob = rr * 64 + cc * 2; return st * 1024 + (ob ^ (((ob >> 9) & 1) << 5)); }
__host__ __device__ __forceinline__ void stage_rc(int b, int& R, int& C) { const int st = b / 1024, sb = b % 1024, swz = sb ^ (((sb >> 9) & 1) << 5); R = (st >> 1) * 16 + swz / 64; C = (st & 1) * 32 + (swz % 64) / 2; }
__host__ __device__ __forceinline__ int perm32(int rho) { const int n = rho >> 4, i = rho & 15; return 8 * (i >> 2) + 4 * n + (i & 3); }

struct Unit { int pm, pn; };
struct Gemm { const bf16_t* A; const bf16_t* Bt; int M, N, K; };

struct StaticOrder {
    int nM, nN, nwg, G, c;
    __host__ __device__ void init(int M, int N, int G_, int c_) { nM = M / BM; nN = N / BM; nwg = nM * nN; G = G_; c = c_; }
    __host__ __device__ bool next(int i, Unit& u) const {
        const long L = (long)i * G + c; if (L >= nwg) return false;
        int wgid = (int)L; { const int q = nwg / NXCD, r = nwg % NXCD, xcd = wgid % NXCD, off = wgid / NXCD; wgid = (xcd < r ? xcd * (q + 1) : r * (q + 1) + (xcd - r) * q) + off; }
        const int nig = WGM * nN, gid = wgid / nig, fm = gid * WGM, gsz = (nM - fm) < WGM ? (nM - fm) : WGM;
        u.pm = fm + ((wgid % nig) % gsz); u.pn = (wgid % nig) / gsz; return true;
    }
    __device__ __forceinline__ void a_ready(const Unit&) const {}
    __device__ __forceinline__ void done(const Unit&) const {}
};


__device__ __forceinline__ unsigned cvt_pk_bf16(float lo, float hi) { unsigned r; asm volatile("v_cvt_pk_bf16_f32 %0, %1, %2" : "=v"(r) : "v"(lo), "v"(hi)); return r; }
__device__ __forceinline__ u32x4 pack8(const f32x4& v0, const f32x4& v1) { u32x4 w; w.x = cvt_pk_bf16(v0[0], v0[1]); w.y = cvt_pk_bf16(v0[2], v0[3]); w.z = cvt_pk_bf16(v1[0], v1[1]); w.w = cvt_pk_bf16(v1[2], v1[3]); return w; }

struct EpiProj0F {
    static constexpr bool PERM = true, AFTER_DRAIN = false;
    bf16_t* O;
    __device__ __forceinline__ void operator()(const f32x4 (&acc)[2][2][4][2], const Unit& u, int wr, int wc, int fr, int fq) const {
        const int row0 = u.pm * BM + wr * 64 + fr, col0 = u.pn * BM + wc * 32 + 8 * fq;
#pragma unroll
        for (int ai = 0; ai < 2; ++ai)
#pragma unroll
            for (int m = 0; m < 4; ++m) { bf16_t* rowp = O + (size_t)(row0 + ai * HALF + m * 16) * N0P + col0;
#pragma unroll
                for (int bj = 0; bj < 2; ++bj) *(u32x4*)(rowp + bj * HALF) = pack8(acc[ai][bj][m][0], acc[ai][bj][m][1]); }
    }
};
struct EpiY0F {
    static constexpr bool PERM = true, AFTER_DRAIN = false;
    Ptrs P;
    __device__ __forceinline__ void operator()(const f32x4 (&acc)[2][2][4][2], const Unit& u, int wr, int wc, int fr, int fq) const {
        const int row0 = u.pm * BM + wr * 64 + fr, col0 = u.pn * BM + wc * 32 + 8 * fq;
        float* Y0 = (float*)(P.ws + WS_Y0); bf16_t* YB = (bf16_t*)(P.ws + WS_Y0B); float* SSQ = (float*)(P.ws + WS_SSQ);
#pragma unroll
        for (int ai = 0; ai < 2; ++ai)
#pragma unroll
            for (int m = 0; m < 4; ++m) { const int row = row0 + ai * HALF + m * 16; const float* xr = xrow(P, row) + col0; float ss = 0.f;
#pragma unroll
                for (int bj = 0; bj < 2; ++bj) {
                    const f32x4 y0 = acc[ai][bj][m][0] + *(const f32x4*)(xr + bj * HALF), y1 = acc[ai][bj][m][1] + *(const f32x4*)(xr + bj * HALF + 4);
                    *(f32x4*)(Y0 + (size_t)row * D + col0 + bj * HALF) = y0; *(f32x4*)(Y0 + (size_t)row * D + col0 + bj * HALF + 4) = y1;
                    *(u32x4*)(YB + (size_t)row * D + col0 + bj * HALF) = pack8(y0, y1);
                    ss += (y0[0] * y0[0] + y0[1] * y0[1]) + (y0[2] * y0[2] + y0[3] * y0[3]) + (y1[0] * y1[0] + y1[1] * y1[1]) + (y1[2] * y1[2] + y1[3] * y1[3]); }
                ss += __shfl_xor(ss, 16); ss += __shfl_xor(ss, 32);
                if (fq == 0) SSQ[(size_t)row * 16 + u.pn * 4 + wc] = ss; }
    }
};
struct EpiL1F {
    static constexpr bool PERM = true, AFTER_DRAIN = false;
    Ptrs P;
    __device__ __forceinline__ void operator()(const f32x4 (&acc)[2][2][4][2], const Unit& u, int wr, int wc, int fr, int fq) const {
        const int row0 = u.pm * BM + wr * 64 + fr, colt = u.pn * BM, reg = colt >> 10, c0 = (colt & 1023) + wc * 32 + 8 * fq;
        const float* SSQ = (const float*)(P.ws + WS_SSQ);
#pragma unroll
        for (int ai = 0; ai < 2; ++ai)
#pragma unroll
            for (int m = 0; m < 4; ++m) { const int row = row0 + ai * HALF + m * 16;
                const f32x4* sp = (const f32x4*)(SSQ + (size_t)row * 16); const f32x4 s0 = sp[0], s1 = sp[1], s2 = sp[2], s3 = sp[3];
                const f32x4 st = (s0 + s1) + (s2 + s3); const float rs = rsqrtf(((st[0] + st[1]) + (st[2] + st[3])) * (1.f / D) + EPS);
#pragma unroll
                for (int bj = 0; bj < 2; ++bj) { const int c = c0 + bj * HALF; f32x4 v0 = acc[ai][bj][m][0] * rs, v1 = acc[ai][bj][m][1] * rs;
                    if (reg == 0) { *(u32x4*)((bf16_t*)(P.ws + WS_Q1) + (size_t)row * D + c) = pack8(v0 * QSCALE, v1 * QSCALE); }
                    else if (reg == 1) { *(u32x4*)((bf16_t*)(P.ws + WS_K1) + (size_t)row * D + c) = pack8(v0, v1); float* o = P.out + off_l1k(row) + c; *(f32x4*)o = v0; *(f32x4*)(o + 4) = v1; }
                    else if (reg == 2) { bf16_t* vt = (bf16_t*)(P.ws + WS_V1T) + (size_t)c * M + row;
#pragma unroll
                        for (int j = 0; j < 4; ++j) { vt[(size_t)j * M] = f2bf(v0[j]); vt[(size_t)(4 + j) * M] = f2bf(v1[j]); }
                        float* o = P.out + off_l1v(row) + c; *(f32x4*)o = v0; *(f32x4*)(o + 4) = v1; }
                    else { *(u32x4*)((bf16_t*)(P.ws + WS_Z1) + (size_t)row * D + c) = pack8(v0, v1); } } }
    }
};
struct EpiOutF {
    static constexpr bool PERM = true, AFTER_DRAIN = false;
    Ptrs P;
    __device__ __forceinline__ void operator()(const f32x4 (&acc)[2][2][4][2], const Unit& u, int wr, int wc, int fr, int fq) const {
        const int row0 = u.pm * BM + wr * 64 + fr, col0 = u.pn * BM + wc * 32 + 8 * fq;
        const float* Y0 = (const float*)(P.ws + WS_Y0);
#pragma unroll
        for (int ai = 0; ai < 2; ++ai)
#pragma unroll
            for (int m = 0; m < 4; ++m) { const size_t ro = (size_t)(row0 + ai * HALF + m * 16) * D + col0;
#pragma unroll
                for (int bj = 0; bj < 2; ++bj) {
                    *(f32x4*)(P.out + O_Y + ro + bj * HALF) = acc[ai][bj][m][0] + *(const f32x4*)(Y0 + ro + bj * HALF);
                    *(f32x4*)(P.out + O_Y + ro + bj * HALF + 4) = acc[ai][bj][m][1] + *(const f32x4*)(Y0 + ro + bj * HALF + 4); } }
    }
};
template <class Epi, class Sched, bool ALIGN_EPI = false, bool SP2 = false>
__device__ __forceinline__ void gemm_phase(PG8_LAS unsigned char* lds, const Gemm g, const Sched& S, const Epi& E) {
    const int tid = threadIdx.x, wid = __builtin_amdgcn_readfirstlane(tid >> 6), lane = tid & 63, wr = wid >> 2, wc = wid & 3, fr = lane & 15, fq = lane >> 4;
    const int K = g.K, nt = K / BK;
    unsigned voffA[2], voffB[2];
#pragma unroll
    for (int i = 0; i < 2; ++i) { int R, C; stage_rc(tid * 16 + i * 8192, R, C); const int Rb = Epi::PERM ? ((R & ~31) + perm32(R & 31)) : R;
        voffA[i] = (unsigned)(R * K + C) * 2u; voffB[i] = (unsigned)(Rb * K + C) * 2u; }
    const size_t kstep = (size_t)(BK * 2);
    const size_t hstep = (size_t)HALF * K * 2;
    const size_t tstep = 2 * hstep;
    const unsigned ldsw = (unsigned)wid * 1024u;
    const int aoff = lds_byte(wr * 64 + fr, fq * 8), boff = lds_byte(wc * 32 + fr, fq * 8);
#define PG8_SA(b, h) (((b) * 2 + (h)) * HTB)
#define PG8_SB(b, h) ((4 + (b) * 2 + (h)) * HTB)
#define PG8_STAGE(bufoff, gbase, voff) do { _Pragma("unroll") for (int _i = 0; _i < 2; ++_i) \
        __builtin_amdgcn_global_load_lds((const unsigned*)((const char*)(gbase) + (voff)[_i]), (PG8_LAS unsigned*)(lds + (bufoff) + ldsw + _i * 8192), 16, 0, 0); } while (0)
#define PG8_LDA(dst, b, h) do { _Pragma("unroll") for (int m = 0; m < 4; ++m) _Pragma("unroll") for (int k = 0; k < 2; ++k) dst[m][k] = *(const PG8_LAS bf16x8*)(lds + PG8_SA(b, h) + aoff + m * 2048 + k * 1024); } while (0)
#define PG8_LDB(dst, b, h) do { _Pragma("unroll") for (int n = 0; n < 2; ++n) _Pragma("unroll") for (int k = 0; k < 2; ++k) dst[n][k] = *(const PG8_LAS bf16x8*)(lds + PG8_SB(b, h) + boff + n * 2048 + k * 1024); } while (0)
#define PG8_MMA(ai, bj, At, Bt) do { __builtin_amdgcn_s_setprio(1); _Pragma("unroll") for (int m = 0; m < 4; ++m) _Pragma("unroll") for (int n = 0; n < 2; ++n) _Pragma("unroll") for (int k = 0; k < 2; ++k) \
        acc[ai][bj][m][n] = __builtin_amdgcn_mfma_f32_16x16x32_bf16(Bt[n][k], At[m][k], acc[ai][bj][m][n], 0, 0, 0); __builtin_amdgcn_s_setprio(0); } while (0)
#define PG8_WAIT_V(n) asm volatile("s_waitcnt vmcnt(" #n ")" ::: "memory")
#define PG8_WAIT_L(n) asm volatile("s_waitcnt lgkmcnt(" #n ")" ::: "memory")
#define PG8_BAR __builtin_amdgcn_s_barrier()
#define PG8_SCHED __builtin_amdgcn_sched_barrier(0)
    Unit cur, nxt; int ui = 0;
    if (!S.next(0, cur)) return;
    f32x4 acc[2][2][4][2];
#pragma unroll
    for (int a = 0; a < 2; ++a)
#pragma unroll
        for (int b = 0; b < 2; ++b)
#pragma unroll
            for (int m = 0; m < 4; ++m)
#pragma unroll
                for (int n = 0; n < 2; ++n) acc[a][b][m][n] = (f32x4){0.f, 0.f, 0.f, 0.f};
    bf16x8 At[4][2], B0[2][2], B1[2][2];
    const char* cA = (const char*)g.A + (size_t)cur.pm * tstep; const char* cB = (const char*)g.Bt + (size_t)cur.pn * tstep;
    S.a_ready(cur);
    if constexpr (SP2) {
        PG8_STAGE(PG8_SB(0, 0), cB, voffB); PG8_STAGE(PG8_SB(0, 1), cB + hstep, voffB); PG8_STAGE(PG8_SA(0, 0), cA, voffA); PG8_STAGE(PG8_SA(0, 1), cA + hstep, voffA);
        if (wr == 1) PG8_BAR;
        PG8_WAIT_V(2); PG8_BAR;
        PG8_STAGE(PG8_SB(1, 0), cB + kstep, voffB); PG8_STAGE(PG8_SA(1, 0), cA + kstep, voffA); PG8_STAGE(PG8_SB(1, 1), cB + hstep + kstep, voffB);
        PG8_WAIT_V(6); PG8_BAR;
    } else {
        PG8_STAGE(PG8_SB(0, 0), cB, voffB); PG8_STAGE(PG8_SA(0, 0), cA, voffA); PG8_STAGE(PG8_SB(0, 1), cB + hstep, voffB); PG8_STAGE(PG8_SA(0, 1), cA + hstep, voffA);
        if (wr == 1) PG8_BAR;
        PG8_WAIT_V(4); PG8_BAR;
        PG8_STAGE(PG8_SB(1, 0), cB + kstep, voffB); PG8_STAGE(PG8_SA(1, 0), cA + kstep, voffA); PG8_STAGE(PG8_SB(1, 1), cB + hstep + kstep, voffB);
        PG8_WAIT_V(6); PG8_BAR;
    }
    for (;;) {
        const bool has_next = S.next(ui + 1, nxt);
        const char* nA = has_next ? (const char*)g.A + (size_t)nxt.pm * tstep : cA; const char* nB = has_next ? (const char*)g.Bt + (size_t)nxt.pn * tstep : cB;
        for (int t = 0; t < nt; t += 2) {
            const bool last = (t == nt - 2);
            const char* a1 = cA + (size_t)(t + 1) * kstep;
            const char* a2 = last ? nA : cA + (size_t)(t + 2) * kstep; const char* b2 = last ? nB : cB + (size_t)(t + 2) * kstep;
            const char* a3 = a2 + kstep; const char* b3 = b2 + kstep;
            if (last && has_next) S.a_ready(nxt);
            if constexpr (SP2) {
            PG8_LDB(B0, 0, 0); PG8_LDB(B1, 0, 1); PG8_SCHED; PG8_LDA(At, 0, 0); PG8_STAGE(PG8_SA(1, 1), a1 + hstep, voffA);
            PG8_WAIT_V(8); PG8_WAIT_L(0); PG8_BAR; PG8_MMA(0, 0, At, B0); PG8_MMA(0, 1, At, B1); PG8_BAR; PG8_SCHED;
            PG8_LDA(At, 0, 1); PG8_STAGE(PG8_SB(0, 0), b2, voffB); PG8_STAGE(PG8_SB(0, 1), b2 + hstep, voffB); PG8_STAGE(PG8_SA(0, 0), a2, voffA);
            PG8_WAIT_V(8); PG8_WAIT_L(0); PG8_BAR; PG8_MMA(1, 0, At, B0); PG8_MMA(1, 1, At, B1); PG8_BAR; PG8_SCHED;
            PG8_LDB(B0, 1, 0); PG8_LDB(B1, 1, 1); PG8_SCHED; PG8_LDA(At, 1, 0); PG8_STAGE(PG8_SA(0, 1), a2 + hstep, voffA);
            PG8_WAIT_V(8); PG8_WAIT_L(0); PG8_BAR; PG8_MMA(0, 0, At, B0); PG8_MMA(0, 1, At, B1); PG8_BAR; PG8_SCHED;
            PG8_LDA(At, 1, 1); PG8_STAGE(PG8_SB(1, 0), b3, voffB); PG8_STAGE(PG8_SB(1, 1), b3 + hstep, voffB); PG8_STAGE(PG8_SA(1, 0), a3, voffA);
            PG8_WAIT_V(8); PG8_WAIT_L(0); PG8_BAR; PG8_MMA(1, 0, At, B0); PG8_MMA(1, 1, At, B1); PG8_BAR; PG8_SCHED;
            } else {
            PG8_LDB(B0, 0, 0); PG8_SCHED; PG8_LDA(At, 0, 0); PG8_STAGE(PG8_SA(1, 1), a1 + hstep, voffA);
            PG8_WAIT_L(8); PG8_BAR; PG8_WAIT_L(0); PG8_MMA(0, 0, At, B0); PG8_BAR; PG8_SCHED;
            PG8_LDB(B1, 0, 1); PG8_STAGE(PG8_SB(0, 0), b2, voffB);
            PG8_BAR; PG8_WAIT_L(0); PG8_MMA(0, 1, At, B1); PG8_BAR;
            PG8_LDA(At, 0, 1); PG8_STAGE(PG8_SA(0, 0), a2, voffA);
            PG8_BAR; PG8_WAIT_L(0); PG8_MMA(1, 0, At, B0); PG8_BAR; PG8_SCHED;
            PG8_STAGE(PG8_SB(0, 1), b2 + hstep, voffB);
            PG8_WAIT_V(6); PG8_BAR; PG8_MMA(1, 1, At, B1); PG8_BAR;
            PG8_LDB(B0, 1, 0); PG8_SCHED; PG8_LDA(At, 1, 0); PG8_STAGE(PG8_SA(0, 1), a2 + hstep, voffA);
            PG8_WAIT_L(8); PG8_BAR; PG8_WAIT_L(0); PG8_MMA(0, 0, At, B0); PG8_BAR; PG8_SCHED;
            PG8_LDB(B1, 1, 1); PG8_STAGE(PG8_SB(1, 0), b3, voffB);
            PG8_BAR; PG8_WAIT_L(0); PG8_MMA(0, 1, At, B1); PG8_BAR;
            PG8_LDA(At, 1, 1); PG8_STAGE(PG8_SA(1, 0), a3, voffA);
            PG8_BAR; PG8_WAIT_L(0); PG8_MMA(1, 0, At, B0); PG8_BAR; PG8_SCHED;
            PG8_STAGE(PG8_SB(1, 1), b3 + hstep, voffB);
            PG8_WAIT_V(6); PG8_BAR; PG8_MMA(1, 1, At, B1); PG8_BAR;
            }
        }
        if constexpr (ALIGN_EPI) { if (wr == 0) PG8_BAR; }
        if constexpr (!Epi::AFTER_DRAIN) { E(acc, cur, wr, wc, fr, fq); S.done(cur); }
        if (!has_next) break;
#pragma unroll
        for (int a = 0; a < 2; ++a)
#pragma unroll
            for (int b = 0; b < 2; ++b)
#pragma unroll
                for (int m = 0; m < 4; ++m)
#pragma unroll
                    for (int n = 0; n < 2; ++n) acc[a][b][m][n] = (f32x4){0.f, 0.f, 0.f, 0.f};
        cur = nxt; cA = nA; cB = nB; ++ui;
        if constexpr (ALIGN_EPI) { if (wr == 1) PG8_BAR; }
    }
    PG8_WAIT_V(0);
    if constexpr (!ALIGN_EPI) { if (wr == 0) PG8_BAR; }
    PG8_BAR;
    if constexpr (Epi::AFTER_DRAIN) { E.fused(acc, cur, wr, wc, fr, fq, lds, wid, lane); S.done(cur); }
#undef PG8_SA
#undef PG8_SB
#undef PG8_STAGE
#undef PG8_LDA
#undef PG8_LDB
#undef PG8_MMA
#undef PG8_WAIT_V
#undef PG8_WAIT_L
#undef PG8_BAR
#undef PG8_SCHED
}
}
#include <hip/hip_cooperative_groups.h>
namespace cg = cooperative_groups;
constexpr int NWAVES = 8, NTHREADS = 512;
constexpr int LDS_BYTES = 147456;
enum Phase { PH_PRO = 0, PH_GEMM1 = 1, PH_TOK = 2, PH_MIX = 3, PH_RWC = 4, PH_GEMM2 = 5, PH_GEMM3 = 6, PH_ATTN1 = 7, PH_GEMM4 = 8, PH_END = 9 };
#define LAS __attribute__((address_space(3)))
struct Args { Ptrs p; int ph_lo, ph_hi; int pad0, pad1; };

__global__ void __launch_bounds__(NTHREADS, 2) mk_fwd(Args a) {
    extern __shared__ __attribute__((aligned(16))) unsigned char lds[];
    const Ptrs& P = a.p;
    unsigned char* ws = P.ws;
    const int lo = a.ph_lo, hi = a.ph_hi;
    const int tid = threadIdx.x, lane = tid & 63, wave = tid >> 6;
    const int G = gridDim.x, gw = blockIdx.x * NWAVES + wave, NGW = G * NWAVES;
    float* wscr = (float*)lds + wave * 256;
#define IN(k) (lo <= (k) && (k) < hi)
#define SEAM(k) do { if (IN(k) && IN((k) + 1)) cg::this_grid().sync(); } while (0)
    if (IN(PH_PRO)) {
        const size_t gt = (size_t)blockIdx.x * NTHREADS + tid, NT = (size_t)G * NTHREADS;
        for (size_t i = gt; i < (size_t)N0P * D; i += NT) nv::d_transpose_w(P.in[10], D, N0, N0P, (bf16_t*)(ws + WS_WT0), nullptr, i);
        for (size_t i = gt; i < (size_t)D * D; i += NT) nv::d_transpose_w(P.in[11], D, D, D, (bf16_t*)(ws + WS_WO0T), nullptr, i);
        for (size_t i = gt; i < (size_t)N1 * D; i += NT) nv::d_transpose_w(P.in[30], D, N1, N1, (bf16_t*)(ws + WS_WT1), P.in[29], i);
        for (size_t i = gt; i < (size_t)D * D; i += NT) nv::d_transpose_w(P.in[31], D, D, D, (bf16_t*)(ws + WS_WO1T), nullptr, i);
        if (blockIdx.x == 0 && tid < 256) nv::d_tables(P, tid);
        for (int m = gw; m < M; m += NGW) nv::d_rmsnorm_x(P, m, lane);
    }
    SEAM(PH_PRO);
    if (IN(PH_GEMM1)) {
        pg8::Gemm g{(const bf16_t*)(ws + WS_XN0), (const bf16_t*)(ws + WS_WT0), M, N0P, D}; pg8::StaticOrder S; S.init(M, N0P, G, (int)blockIdx.x);
        pg8::EpiProj0F E{(bf16_t*)(ws + WS_PROJ0)};
        pg8::gemm_phase<pg8::EpiProj0F, pg8::StaticOrder, true, true>((LAS unsigned char*)lds, g, S, E);
    }
    SEAM(PH_GEMM1);
    if (IN(PH_TOK)) {
        for (int m = gw; m < M; m += NGW) nv::d_tok0(P, m, lane);
        __syncthreads();
        for (int m = blockIdx.x; m < M; m += G) { nv::d_rw_prep(P, m, tid, (float*)lds, (float*)lds + 64); __syncthreads(); }
    }
    SEAM(PH_TOK);
    if (IN(PH_MIX)) {
        if (gw < 33 * 8) nv::d_rw_scan(P, gw >> 3, gw & 7, lane);
        for (int i = gw; i < M * 4; i += NGW) nv::d_attn0(P, i >> 2, i & 3, lane, wscr, wscr + 128);
    }
    SEAM(PH_MIX);
    SEAM(PH_RWC);
    if (IN(PH_GEMM2)) {
        pg8::Gemm g{(const bf16_t*)(ws + WS_CAT), (const bf16_t*)(ws + WS_WO0T), M, D, D}; pg8::StaticOrder S; S.init(M, D, G, (int)blockIdx.x);
        pg8::EpiY0F E{P};
        pg8::gemm_phase<pg8::EpiY0F, pg8::StaticOrder, true, true>((LAS unsigned char*)lds, g, S, E);
    }
    SEAM(PH_GEMM2);
    if (IN(PH_GEMM3)) {
        pg8::Gemm g{(const bf16_t*)(ws + WS_Y0B), (const bf16_t*)(ws + WS_WT1), M, N1, D}; pg8::StaticOrder S; S.init(M, N1, G, (int)blockIdx.x);
        pg8::EpiL1F E{P};
        pg8::gemm_phase<pg8::EpiL1F, pg8::StaticOrder, true, true>((LAS unsigned char*)lds, g, S, E);
    }
    SEAM(PH_GEMM3);
    if (IN(PH_ATTN1)) {
        for (int i = gw; i < M * 16; i += NGW) nv::d_attn1(P, i >> 4, i & 15, lane, wscr, wscr + 64);
    }
    SEAM(PH_ATTN1);
    if (IN(PH_GEMM4)) {
        pg8::Gemm g{(const bf16_t*)(ws + WS_O1B), (const bf16_t*)(ws + WS_WO1T), M, D, D}; pg8::StaticOrder S; S.init(M, D, G, (int)blockIdx.x);
        pg8::EpiOutF E{P};
        pg8::gemm_phase<pg8::EpiOutF, pg8::StaticOrder, true, true>((LAS unsigned char*)lds, g, S, E);
    }
#undef IN
#undef SEAM
}
extern "C" void kernel_launch(void* const* d_in, const int* in_sizes, int n_in, void* d_out, int out_size, void* d_ws, size_t ws_size, hipStream_t stream) {
    static int grid = 0;
    if (n_in != 32 || (size_t)out_size != O_TOTAL || ws_size < WS_END) { fprintf(stderr, "kernel_launch: unexpected shapes n_in=%d out=%d ws=%zu\n", n_in, out_size, ws_size); return; }
    if (grid == 0) {
        int dev = 0, cus = 0, per_cu = 0;
        (void)hipGetDevice(&dev); (void)hipDeviceGetAttribute(&cus, hipDeviceAttributeMultiprocessorCount, dev);
        (void)hipFuncSetAttribute((const void*)mk_fwd, hipFuncAttributeMaxDynamicSharedMemorySize, LDS_BYTES);
        (void)hipOccupancyMaxActiveBlocksPerMultiprocessor(&per_cu, (const void*)mk_fwd, NTHREADS, LDS_BYTES);
        if (per_cu < 1) { fprintf(stderr, "kernel_launch: occupancy query says %d blocks/CU\n", per_cu); per_cu = 1; }
        grid = (cus > 0 ? cus : 256);
    }
    Args a{};
    for (int i = 0; i < 32; ++i) a.p.in[i] = (const float*)d_in[i];
    a.p.out = (float*)d_out; a.p.ws = (unsigned char*)d_ws; a.ph_lo = 0; a.ph_hi = PH_END;
    void* args[] = {&a};
    hipError_t e = hipLaunchCooperativeKernel((const void*)mk_fwd, dim3(grid), dim3(NTHREADS), args, LDS_BYTES, stream);
    if (e != hipSuccess) fprintf(stderr, "cooperative launch failed: %s (grid %d)\n", hipGetErrorString(e), grid);
}
```

```cpp
#include <hip/hip_runtime.h>
#include <stdint.h>
#include <cstdio>

typedef unsigned short bf16_t;
__device__ __forceinline__ float bf2f(bf16_t b) { return __uint_as_float(((unsigned)b) << 16); }
__device__ __forceinline__ bf16_t f2bf(float f) { unsigned u = __float_as_uint(f); return (bf16_t)((u + 0x7fffu + ((u >> 16) & 1u)) >> 16); }

constexpr int D = 1024, TP = 16384, NSEQ = 32, TS = 32, MS = NSEQ * TS, M = TP + MS, PAST = 1024;
constexpr int N0 = 4224, N0P = 4352, N1 = 4096;
constexpr int C_Q = 0, C_K = 512, C_V = 1024, C_ZA = 1536, C_PRW = 2048, C_ZB = 3712;
constexpr int RWS = 1664;
constexpr float EPS = 1e-6f, GN_EPS = 64e-5f;
constexpr float LOG2E = 1.4426950408889634f;
constexpr float LAMBDA_INIT = 0.2f;
constexpr float QSCALE = 0.125f * LOG2E;

constexpr size_t O_Y = 0;
constexpr size_t O_L0K_P = (size_t)M * D;
constexpr size_t O_L0V_P = O_L0K_P + (size_t)TP * 512;
constexpr size_t O_L0SH_P = O_L0V_P + (size_t)TP * 512;
constexpr size_t O_L0WKV_P = O_L0SH_P + RWS;
constexpr size_t O_L1K_P = O_L0WKV_P + 8 * 64 * 64;
constexpr size_t O_L1V_P = O_L1K_P + (size_t)TP * 1024;
constexpr size_t O_L0K_S = O_L1V_P + (size_t)TP * 1024;
constexpr size_t O_L0V_S = O_L0K_S + (size_t)MS * 512;
constexpr size_t O_L0SH_S = O_L0V_S + (size_t)MS * 512;
constexpr size_t O_L0WKV_S = O_L0SH_S + (size_t)NSEQ * RWS;
constexpr size_t O_L1K_S = O_L0WKV_S + (size_t)NSEQ * 8 * 64 * 64;
constexpr size_t O_L1V_S = O_L1K_S + (size_t)MS * 1024;
constexpr size_t O_TOTAL = O_L1V_S + (size_t)MS * 1024;
static_assert(O_TOTAL == 72439424, "output size");

__host__ __device__ __forceinline__ size_t off_l0k(int m) { return m < TP ? O_L0K_P + (size_t)m * 512 : O_L0K_S + (size_t)(m - TP) * 512; }
__host__ __device__ __forceinline__ size_t off_l0v(int m) { return m < TP ? O_L0V_P + (size_t)m * 512 : O_L0V_S + (size_t)(m - TP) * 512; }
__host__ __device__ __forceinline__ size_t off_l1k(int m) { return m < TP ? O_L1K_P + (size_t)m * 1024 : O_L1K_S + (size_t)(m - TP) * 1024; }
__host__ __device__ __forceinline__ size_t off_l1v(int m) { return m < TP ? O_L1V_P + (size_t)m * 1024 : O_L1V_S + (size_t)(m - TP) * 1024; }

constexpr size_t MiB = 1u << 20;
constexpr size_t WS_CTL = 0;
constexpr size_t WS_TAB = 512 * 1024;
constexpr size_t WS_WT0 = 1 * MiB, WS_WO0T = 10 * MiB, WS_WT1 = 12 * MiB, WS_WO1T = 20 * MiB, WS_LORA = 22 * MiB;
constexpr size_t WS_CAT = 24 * MiB, WS_XN0 = WS_CAT;
constexpr size_t WS_PROJ0 = 58 * MiB;
constexpr size_t WS_Q0 = 203 * MiB, WS_K0 = 220 * MiB;
constexpr size_t WS_RW = 237 * MiB;
constexpr size_t WS_SST = 407 * MiB;
constexpr size_t WS_END = 441 * MiB;
constexpr size_t WS_Y0 = WS_PROJ0, WS_Y0B = 126 * MiB, WS_SSQ = 160 * MiB;
constexpr size_t WS_O1B = WS_Q0;
constexpr size_t WS_Q1 = 237 * MiB, WS_K1 = 271 * MiB, WS_V1T = 305 * MiB, WS_Z1 = 339 * MiB;
static_assert(WS_PROJ0 + (size_t)M * N0P * 2 <= WS_Q0, "proj0");
static_assert(WS_WT0 + (size_t)N0P * D * 2 <= WS_WO0T, "wt0");

struct Tab {
    float lam;
    float m0;
    float pad[2];
    float bias[4][256];
    float biasfar[4];
};

struct Ptrs {
    const float* in[32];
    float* out;
    unsigned char* ws;
};

__device__ __forceinline__ const float* xrow(const Ptrs& P, int m) { return m < TP ? P.in[0] + (size_t)m * D : P.in[1] + (size_t)(m - TP) * D; }

__device__ __forceinline__ float wave_sum(float v) {
#pragma unroll
    for (int o = 1; o < 64; o <<= 1) v += __shfl_xor(v, o);
    return v;
}
__device__ __forceinline__ float wave_max(float v) {
#pragma unroll
    for (int o = 1; o < 64; o <<= 1) v = fmaxf(v, __shfl_xor(v, o));
    return v;
}
__device__ __forceinline__ float silu(float x) { return x / (1.f + __expf(-x)); }

__device__ __forceinline__ int t5_bucket(int rel) {
    int n = rel < 0 ? -rel : rel;
    int b;
    if (n < 8) b = n;
    else { unsigned n2 = (unsigned)n * (unsigned)n; int lg = 31 - __clz((int)n2); b = 8 + (lg - 6); if (b > 15) b = 15; }
    return (rel > 0 ? 16 : 0) + b;
}
namespace nv {

__device__ __forceinline__ void d_transpose_w(const float* W, int K, int N, int NP, bf16_t* WT, const float* g, size_t i) {
    int n = (int)(i / K), k = (int)(i % K);
    float v = 0.f;
    if (n < N) { v = W[(size_t)k * N + n]; if (g) v *= g[k]; }
    WT[i] = f2bf(v);
}
__global__ void k_transpose_w(const float* W, int K, int N, int NP, bf16_t* WT, const float* g) {
    size_t i = (size_t)blockIdx.x * blockDim.x + threadIdx.x; if (i < (size_t)NP * K) d_transpose_w(W, K, N, NP, WT, g, i); }
__global__ void k_lora_t(const float* w_up, const float* a_up, float* LT) {
    int i = blockIdx.x * blockDim.x + threadIdx.x;
    if (i >= 512 * 64) return;
    int c = i / 64, l = i % 64;
    LT[i] = w_up[l * 512 + c];
    LT[512 * 64 + i] = a_up[l * 512 + c];
}
__device__ __forceinline__ void d_tables(const Ptrs& P, int tid) {
    Tab* T = (Tab*)(P.ws + WS_TAB);
    if (tid < 64) {
        float a = P.in[14][tid] * P.in[15][tid], b = P.in[16][tid] * P.in[17][tid];
        a = wave_sum(a); b = wave_sum(b);
        float gq = fabsf(P.in[12][tid]), gk = fabsf(P.in[13][tid]);
        gq = wave_max(gq); gk = wave_max(gk);
        if (tid == 0) { T->lam = __expf(a) - __expf(b) + LAMBDA_INIT; T->m0 = 8.f * gq * gk * LOG2E * 1.0001f + 0.01f; }
    }
    if (tid < 255) { int rel = tid - 191; int b = t5_bucket(rel); for (int h = 0; h < 4; ++h) T->bias[h][tid] = P.in[8][b * 4 + h]; }
    if (tid == 255) for (int h = 0; h < 4; ++h) { T->bias[h][255] = 0.f; T->biasfar[h] = P.in[8][15 * 4 + h]; }
}
__global__ void k_tables(Ptrs P) { d_tables(P, threadIdx.x); }
__device__ __forceinline__ void d_rmsnorm_x(const Ptrs& P, int w, int lane) {
    const float* x = xrow(P, w); const float* g = P.in[9];
    bf16_t* o = (bf16_t*)(P.ws + WS_XN0) + (size_t)w * D;
    float v[16], s = 0.f;
#pragma unroll
    for (int j = 0; j < 16; ++j) { v[j] = x[lane + 64 * j]; s += v[j] * v[j]; }
    s = wave_sum(s);
    float r = rsqrtf(s * (1.f / D) + EPS);
#pragma unroll
    for (int j = 0; j < 16; ++j) o[lane + 64 * j] = f2bf(v[j] * r * g[lane + 64 * j]);
}
__global__ void k_rmsnorm_x(Ptrs P) { int w = (blockIdx.x * blockDim.x + threadIdx.x) >> 6; if (w < M) d_rmsnorm_x(P, w, threadIdx.x & 63); }

template <class Epi>
__global__ void __launch_bounds__(256) k_gemm(const bf16_t* A, const bf16_t* Bt, int K, Epi epi) {
    __shared__ float As[16][65], Bs[16][65];
    const int tx = threadIdx.x & 15, ty = threadIdx.x >> 4;
    const int m0 = blockIdx.y * 64, n0 = blockIdx.x * 64;
    float acc[4][4];
#pragma unroll
    for (int i = 0; i < 4; ++i)
#pragma unroll
        for (int j = 0; j < 4; ++j) acc[i][j] = 0.f;
    for (int k0 = 0; k0 < K; k0 += 16) {
#pragma unroll
        for (int i = 0; i < 4; ++i) {
            int e = threadIdx.x + 256 * i, r = e >> 4, c = e & 15;
            As[c][r] = bf2f(A[(size_t)(m0 + r) * K + k0 + c]);
            Bs[c][r] = bf2f(Bt[(size_t)(n0 + r) * K + k0 + c]);
        }
        __syncthreads();
#pragma unroll
        for (int kk = 0; kk < 16; ++kk) {
            float a[4], b[4];
#pragma unroll
            for (int i = 0; i < 4; ++i) { a[i] = As[kk][ty * 4 + i]; b[i] = Bs[kk][tx * 4 + i]; }
#pragma unroll
            for (int i = 0; i < 4; ++i)
#pragma unroll
                for (int j = 0; j < 4; ++j) acc[i][j] += a[i] * b[j];
        }
        __syncthreads();
    }
#pragma unroll
    for (int i = 0; i < 4; ++i)
#pragma unroll
        for (int j = 0; j < 4; ++j) epi(m0 + ty * 4 + i, n0 + tx * 4 + j, acc[i][j]);
}
struct EpiProj0 { bf16_t* O; __device__ void operator()(int m, int n, float v) const { O[(size_t)m * N0P + n] = f2bf(v); } };
struct EpiY0 {
    Ptrs P;
    __device__ void operator()(int m, int n, float v) const {
        float y = v + xrow(P, m)[n];
        ((float*)(P.ws + WS_Y0))[(size_t)m * D + n] = y;
        ((bf16_t*)(P.ws + WS_Y0B))[(size_t)m * D + n] = f2bf(y);
    }
};
struct EpiL1 {
    Ptrs P;
    __device__ void operator()(int m, int n, float v) const {
        const float* ss = (const float*)(P.ws + WS_SSQ) + (size_t)m * 16;
        float t = 0.f; for (int j = 0; j < 16; ++j) t += ss[j];
        float r = rsqrtf(t * (1.f / D) + EPS);
        float val = v * r;
        int c = n & 1023;
        if (n < 1024) ((bf16_t*)(P.ws + WS_Q1))[(size_t)m * D + c] = f2bf(val * QSCALE);
        else if (n < 2048) { ((bf16_t*)(P.ws + WS_K1))[(size_t)m * D + c] = f2bf(val); P.out[off_l1k(m) + c] = val; }
        else if (n < 3072) { ((bf16_t*)(P.ws + WS_V1T))[(size_t)c * M + m] = f2bf(val); P.out[off_l1v(m) + c] = val; }
        else ((bf16_t*)(P.ws + WS_Z1))[(size_t)m * D + c] = f2bf(val);
    }
};
struct EpiOut { Ptrs P; __device__ void operator()(int m, int n, float v) const { P.out[O_Y + (size_t)m * D + n] = v + ((const float*)(P.ws + WS_Y0))[(size_t)m * D + n]; } };

__device__ __forceinline__ void d_ssq(const Ptrs& P, int w, int lane) {
    const float* y = (const float*)(P.ws + WS_Y0) + (size_t)w * D;
    float* ss = (float*)(P.ws + WS_SSQ) + (size_t)w * 16;
    for (int j = 0; j < 16; ++j) { float v = y[64 * j + lane]; float s = wave_sum(v * v); if (lane == 0) ss[j] = s; }
}
__global__ void k_ssq(Ptrs P) { int w = (blockIdx.x * blockDim.x + threadIdx.x) >> 6; if (w < M) d_ssq(P, w, threadIdx.x & 63); }

__device__ __forceinline__ void d_tok0(const Ptrs& P, int m, int lane) {
    const bf16_t* pr = (const bf16_t*)(P.ws + WS_PROJ0) + (size_t)m * N0P;
    bf16_t* q0 = (bf16_t*)(P.ws + WS_Q0) + (size_t)m * 512;
    bf16_t* k0 = (bf16_t*)(P.ws + WS_K0) + (size_t)m * 512;
    const float gq = P.in[12][lane], gk = P.in[13][lane];
#pragma unroll 1
    for (int g = 0; g < 8; ++g) {
        float q = bf2f(pr[C_Q + 64 * g + lane]), k = bf2f(pr[C_K + 64 * g + lane]);
        float sq = wave_sum(q * q), sk = wave_sum(k * k);
        float qn = q * rsqrtf(sq * (1.f / 64) + EPS) * gq, kn = k * rsqrtf(sk * (1.f / 64) + EPS) * gk;
        q0[64 * g + lane] = f2bf(qn * QSCALE);
        k0[64 * g + lane] = f2bf(kn);
        P.out[off_l0k(m) + 64 * g + lane] = kn;
        P.out[off_l0v(m) + 64 * g + lane] = bf2f(pr[C_V + 64 * g + lane]);
    }
    int last = -1; size_t so = 0;
    if (m == TP - 1) { last = 1; so = O_L0SH_P; }
    else if (m >= TP && ((m - TP) & 31) == 31) { last = 1; so = O_L0SH_S + (size_t)((m - TP) >> 5) * RWS; }
    if (last > 0) for (int c = lane; c < RWS; c += 64) P.out[so + c] = bf2f(pr[C_PRW + c]);
}
__global__ void k_tok0(Ptrs P) { int m = (blockIdx.x * blockDim.x + threadIdx.x) >> 6; if (m < M) d_tok0(P, m, threadIdx.x & 63); }

template <class SP> __device__ __forceinline__ void d_attn0(const Ptrs& P, int m, int h, int lane, SP sqw, SP spw) {
    const Tab* T = (const Tab*)(P.ws + WS_TAB);
    const bf16_t* Q0 = (const bf16_t*)(P.ws + WS_Q0); const bf16_t* K0 = (const bf16_t*)(P.ws + WS_K0);
    const bf16_t* PR = (const bf16_t*)(P.ws + WS_PROJ0);
    int qpos, nk, b = 0; bool samp = m >= TP;
    if (!samp) { qpos = m; nk = ((m >> 6) + 1) * 64; } else { b = (m - TP) >> 5; qpos = PAST + ((m - TP) & 31); nk = PAST + TS; }
    sqw[lane] = bf2f(Q0[(size_t)m * 512 + 128 * h + lane]);
    sqw[64 + lane] = bf2f(Q0[(size_t)m * 512 + 128 * h + 64 + lane]);
    float m1 = -1e30f, m2 = -1e30f, l1 = 0.f, l2 = 0.f, o1[2] = {0.f, 0.f}, o2[2] = {0.f, 0.f};
    for (int j0 = 0; j0 < nk; j0 += 64) {
        int j = j0 + lane;
        bool valid = j < nk && ((j >> 6) <= (qpos >> 6));
        float s1 = 0.f, s2 = 0.f;
        if (valid) {
            if (samp && j < PAST) {
                const float* kr = P.in[2] + (((size_t)b * PAST + j) * 4 + h) * 128;
                for (int d = 0; d < 64; ++d) { s1 += sqw[d] * bf2f(f2bf(kr[d])); s2 += sqw[64 + d] * bf2f(f2bf(kr[64 + d])); }
            } else {
                int km = samp ? TP + 32 * b + (j - PAST) : j;
                const bf16_t* kr = K0 + (size_t)km * 512 + 128 * h;
                for (int d = 0; d < 64; ++d) { s1 += sqw[d] * bf2f(kr[d]); s2 += sqw[64 + d] * bf2f(kr[64 + d]); }
            }
            int rel = j - qpos; float bias = rel <= -128 ? T->biasfar[h] : T->bias[h][rel + 191];
            s1 += bias * LOG2E; s2 += bias * LOG2E;
        } else { s1 = -1e30f; s2 = -1e30f; }
        float bm1 = wave_max(s1), bm2 = wave_max(s2);
        float n1 = fmaxf(m1, bm1), n2 = fmaxf(m2, bm2);
        float f1 = exp2f(m1 - n1), f2 = exp2f(m2 - n2);
        float p1 = valid ? exp2f(s1 - n1) : 0.f, p2 = valid ? exp2f(s2 - n2) : 0.f;
        l1 = l1 * f1 + wave_sum(p1); l2 = l2 * f2 + wave_sum(p2);
        o1[0] *= f1; o1[1] *= f1; o2[0] *= f2; o2[1] *= f2; m1 = n1; m2 = n2;
        spw[lane] = p1; spw[64 + lane] = p2;
        __builtin_amdgcn_s_waitcnt(0);
        int jn = min(64, nk - j0);
        for (int jj = 0; jj < jn; ++jj) {
            int jp = j0 + jj; float a1 = spw[jj], a2 = spw[64 + jj];
            float v0, v1;
            if (samp && jp < PAST) { const float* vr = P.in[3] + (((size_t)b * PAST + jp) * 4 + h) * 128; v0 = bf2f(f2bf(vr[lane])); v1 = bf2f(f2bf(vr[64 + lane])); }
            else { int km = samp ? TP + 32 * b + (jp - PAST) : jp; const bf16_t* vr = PR + (size_t)km * N0P + C_V + 128 * h; v0 = bf2f(vr[lane]); v1 = bf2f(vr[64 + lane]); }
            o1[0] += a1 * v0; o1[1] += a1 * v1; o2[0] += a2 * v0; o2[1] += a2 * v1;
        }
    }
    const float lam = T->lam;
    float a0 = o1[0] / l1 - lam * o2[0] / l2, a1 = o1[1] / l1 - lam * o2[1] / l2;
    float ss = wave_sum(a0 * a0 + a1 * a1);
    float r = rsqrtf(ss * (1.f / 128) + EPS) * (1.f - LAMBDA_INIT);
    const float* sg = P.in[18];
    const bf16_t* za = PR + (size_t)m * N0P + C_ZA + 128 * h;
    bf16_t* cat = (bf16_t*)(P.ws + WS_CAT) + (size_t)m * D + 128 * h;
    cat[lane] = f2bf(a0 * r * sg[lane] * silu(bf2f(za[lane])));
    cat[64 + lane] = f2bf(a1 * r * sg[64 + lane] * silu(bf2f(za[64 + lane])));
}
__global__ void __launch_bounds__(256) k_attn0(Ptrs P) {
    __shared__ float sq[4][128], sp[4][128];
    const int wid = threadIdx.x >> 6, lane = threadIdx.x & 63, gw = blockIdx.x * 4 + wid;
    if ((gw >> 2) < M) d_attn0(P, gw >> 2, gw & 3, lane, &sq[wid][0], &sp[wid][0]);
}

constexpr size_t RWN = (size_t)M * 512;
__device__ __forceinline__ float prw_prev(const Ptrs& P, int m, int c) {
    if (m < TP) return m == 0 ? 0.f : bf2f(((const bf16_t*)(P.ws + WS_PROJ0))[(size_t)(m - 1) * N0P + C_PRW + c]);
    int i = (m - TP) & 31, b = (m - TP) >> 5;
    if (i == 0) return P.in[4][(size_t)b * RWS + c];
    return bf2f(((const bf16_t*)(P.ws + WS_PROJ0))[(size_t)(m - 1) * N0P + C_PRW + c]);
}
template <class SP> __device__ __forceinline__ void d_rw_prep(const Ptrs& P, int m, int c, SP swl, SP sal) {
    const bf16_t* pr = (const bf16_t*)(P.ws + WS_PROJ0) + (size_t)m * N0P + C_PRW;
    const float* mu = P.in[19];
#define NV_MIX(col) (bf2f(pr[col]) + (prw_prev(P, m, (col)) - bf2f(pr[col])) * mu[col])
    float r = NV_MIX(c), kr = NV_MIX(512 + c), vr = NV_MIX(1024 + c);
    if (c < 64) swl[c] = tanhf(NV_MIX(1536 + c)); else if (c < 128) sal[c - 64] = NV_MIX(1600 + c - 64);
#undef NV_MIX
    __syncthreads();
    float wa = P.in[20][c], aa = P.in[22][c];
    const float* wup = P.in[21]; const float* aup = P.in[23];
#pragma unroll 4
    for (int l = 0; l < 64; ++l) { wa += swl[l] * wup[l * 512 + c]; aa += sal[l] * aup[l * 512 + c]; }
    float spl = (-wa > 20.f) ? -wa : log1pf(__expf(-wa));
    float w = -spl - 0.5f;
    float dec = __expf(-__expf(w));
    float a = 1.f / (1.f + __expf(-aa));
    float kk = kr * P.in[24][c];
    float n2 = wave_sum(kk * kk);
    kk = kk / fmaxf(sqrtf(n2), 1e-12f);
    float km = kr * (1.f + (a - 1.f) * P.in[25][c]);
    float* R = (float*)(P.ws + WS_RW);
    size_t o = (size_t)m * 512 + c;
    R[o] = r; R[RWN + o] = dec; R[2 * RWN + o] = kk; R[3 * RWN + o] = kk * a; R[4 * RWN + o] = km; R[5 * RWN + o] = vr;
}
__global__ void __launch_bounds__(512) k_rw_prep(Ptrs P) { __shared__ float swl[64], sal[64]; d_rw_prep(P, blockIdx.x, threadIdx.x, &swl[0], &sal[0]); }
__device__ __forceinline__ void d_rw_scan(const Ptrs& P, int seq, int h, int lane) {
    const int m0 = seq == 0 ? 0 : TP + 32 * (seq - 1), T = seq == 0 ? TP : TS;
    float S[64];
    const float* s0 = P.in[5] + (((size_t)(seq > 0 ? seq - 1 : 0) * 8 + h) * 64 + lane) * 64;
#pragma unroll
    for (int k = 0; k < 64; ++k) S[k] = seq == 0 ? 0.f : s0[k];
    const float* R = (const float*)(P.ws + WS_RW);
    const float rk = P.in[26][h * 64 + lane], lg = P.in[27][h * 64 + lane], lb = P.in[28][h * 64 + lane];
    for (int t = 0; t < T; ++t) {
        size_t o = (size_t)(m0 + t) * 512 + h * 64 + lane;
        float r = R[o], dec = R[RWN + o], kk = R[2 * RWN + o], kka = R[3 * RWN + o], km = R[4 * RWN + o], v = R[5 * RWN + o];
        float sa = 0.f;
#pragma unroll
        for (int k = 0; k < 64; ++k) sa += S[k] * __shfl(kk, k);
        float ov = 0.f;
#pragma unroll
        for (int k = 0; k < 64; ++k) { S[k] = S[k] * __shfl(dec, k) - sa * __shfl(kka, k) + v * __shfl(km, k); ov += S[k] * __shfl(r, k); }
        float mu = wave_sum(ov) * (1.f / 64);
        float dv = ov - mu;
        float var = wave_sum(dv * dv) * (1.f / 64);
        float y = dv * rsqrtf(var + GN_EPS) * lg + lb;
        float bonus = wave_sum(r * km * rk) * v;
        int mm = m0 + t;
        float zb = bf2f(((const bf16_t*)(P.ws + WS_PROJ0))[(size_t)mm * N0P + C_ZB + h * 64 + lane]);
        ((bf16_t*)(P.ws + WS_CAT))[(size_t)mm * D + 512 + h * 64 + lane] = f2bf((y + bonus) * silu(zb));
    }
    float* so = P.out + (seq == 0 ? O_L0WKV_P + ((size_t)h * 64 + lane) * 64 : O_L0WKV_S + ((((size_t)(seq - 1)) * 8 + h) * 64 + lane) * 64);
#pragma unroll
    for (int k = 0; k < 64; ++k) so[k] = S[k];
}
__global__ void __launch_bounds__(64) k_rw_scan(Ptrs P) { d_rw_scan(P, blockIdx.x >> 3, blockIdx.x & 7, threadIdx.x); }

template <class SP> __device__ __forceinline__ void d_attn1(const Ptrs& P, int m, int h, int lane, SP sqw, SP saw) {
    const bf16_t* Q1 = (const bf16_t*)(P.ws + WS_Q1); const bf16_t* K1 = (const bf16_t*)(P.ws + WS_K1);
    const bf16_t* V1T = (const bf16_t*)(P.ws + WS_V1T);
    bool samp = m >= TP; int b = 0, qpos;
    if (!samp) qpos = m; else { b = (m - TP) >> 5; qpos = PAST + ((m - TP) & 31); }
    sqw[lane] = bf2f(Q1[(size_t)m * D + 64 * h + lane]);
    float run = 0.f, o = 0.f;
    for (int s0 = qpos - 1; s0 >= 0; s0 -= 64) {
        int s = s0 - lane;
        bool valid = s >= 0;
        float z = 0.f;
        if (valid) {
            if (samp && s < PAST) { const float* kr = P.in[6] + (((size_t)b * PAST + s) * 16 + h) * 64; for (int d = 0; d < 64; ++d) z += sqw[d] * bf2f(f2bf(kr[d])); }
            else { int km = samp ? TP + 32 * b + (s - PAST) : s; const bf16_t* kr = K1 + (size_t)km * D + 64 * h; for (int d = 0; d < 64; ++d) z += sqw[d] * bf2f(kr[d]); }
        }
        float spl = valid ? log2f(1.f + exp2f(z)) : 0.f;
        float inc = spl;
#pragma unroll
        for (int off = 1; off < 64; off <<= 1) { float t = __shfl_up(inc, off); if (lane >= off) inc += t; }
        float a = valid ? exp2f(z - inc - run) : 0.f;
        saw[lane] = a;
        run += __shfl(inc, 63);
        __builtin_amdgcn_s_waitcnt(0);
        int jn = min(64, s0 + 1);
        for (int jj = 0; jj < jn; ++jj) {
            int sp_ = s0 - jj; float v;
            if (samp && sp_ < PAST) v = bf2f(f2bf(P.in[7][(((size_t)b * PAST + sp_) * 16 + h) * 64 + lane]));
            else { int km = samp ? TP + 32 * b + (sp_ - PAST) : sp_; v = bf2f(V1T[(size_t)(64 * h + lane) * M + km]); }
            o += saw[jj] * v;
        }
        if (run > 200.f) break;
    }
    float z1 = bf2f(((const bf16_t*)(P.ws + WS_Z1))[(size_t)m * D + 64 * h + lane]);
    ((bf16_t*)(P.ws + WS_O1B))[(size_t)m * D + 64 * h + lane] = f2bf(o * silu(z1));
}
__global__ void __launch_bounds__(256) k_attn1(Ptrs P) {
    __shared__ float sq[4][64], sa[4][64];
    const int wid = threadIdx.x >> 6, lane = threadIdx.x & 63, gw = blockIdx.x * 4 + wid;
    if ((gw >> 4) < M) d_attn1(P, gw >> 4, gw & 15, lane, &sq[wid][0], &sa[wid][0]);
}

}
namespace pg8 {
#define PG8_LAS __attribute__((address_space(3)))
typedef unsigned short bf16_t;
typedef short bf16x8 __attribute__((ext_vector_type(8)));
typedef float f32x4 __attribute__((ext_vector_type(4)));
typedef unsigned u32x4 __attribute__((ext_vector_type(4)));
constexpr int BM = 256, BK = 64, HALF = 128, HTB = HALF * BK * 2  , STAGE_BYTES = 8 * HTB, NXCD = 8, WGM = 8;

__host__ __device__ __forceinline__ int lds_byte(int r, int c) { const int st = (r >> 4) * 2 + (c >> 5), rr = r & 15, cc = c & 31, ob = rr * 64 + cc * 2; return st * 1024 + (ob ^ (((ob >> 9) & 1) << 5)); }
__host__ __device__ __forceinline__ void stage_rc(int b, int& R, int& C) { const int st = b / 1024, sb = b % 1024, swz = sb ^ (((sb >> 9) & 1) << 5); R = (st >> 1) * 16 + swz / 64; C = (st & 1) * 32 + (swz % 64) / 2; }
__host__ __device__ __forceinline__ int perm32(int rho) { const int n = rho >> 4, i = rho & 15; return 8 * (i >> 2) + 4 * n + (i & 3); }

struct Unit { int pm, pn; };
struct Gemm { const bf16_t* A; const bf16_t* Bt; int M, N, K; };

struct StaticOrder {
    int nM, nN, nwg, G, c;
    __host__ __device__ void init(int M, int N, int G_, int c_) { nM = M / BM; nN = N / BM; nwg = nM * nN; G = G_; c = c_; }
    __host__ __device__ bool next(int i, Unit& u) const {
        const long L = (long)i * G + c; if (L >= nwg) return false;
        int wgid = (int)L; { const int q = nwg / NXCD, r = nwg % NXCD, xcd = wgid % NXCD, off = wgid / NXCD; wgid = (xcd < r ? xcd * (q + 1) : r * (q + 1) + (xcd - r) * q) + off; }
        const int nig = WGM * nN, gid = wgid / nig, fm = gid * WGM, gsz = (nM - fm) < WGM ? (nM - fm) : WGM;
        u.pm = fm + ((wgid % nig) % gsz); u.pn = (wgid % nig) / gsz; return true;
    }
    __device__ __forceinline__ void a_ready(const Unit&) const {}
    __device__ __forceinline__ void done(const Unit&) const {}
};


__device__ __forceinline__ unsigned cvt_pk_bf16(float lo, float hi) { unsigned r; asm volatile("v_cvt_pk_bf16_f32 %0, %1, %2" : "=v"(r) : "v"(lo), "v"(hi)); return r; }
__device__ __forceinline__ u32x4 pack8(const f32x4& v0, const f32x4& v1) { u32x4 w; w.x = cvt_pk_bf16(v0[0], v0[1]); w.y = cvt_pk_bf16(v0[2], v0[3]); w.z = cvt_pk_bf16(v1[0], v1[1]); w.w = cvt_pk_bf16(v1[2], v1[3]); return w; }

struct EpiProj0F {
    static constexpr bool PERM = true, AFTER_DRAIN = false;
    bf16_t* O;
    __device__ __forceinline__ void operator()(const f32x4 (&acc)[2][2][4][2], const Unit& u, int wr, int wc, int fr, int fq) const {
        const int row0 = u.pm * BM + wr * 64 + fr, col0 = u.pn * BM + wc * 32 + 8 * fq;
#pragma unroll
        for (int ai = 0; ai < 2; ++ai)
#pragma unroll
            for (int m = 0; m < 4; ++m) { bf16_t* rowp = O + (size_t)(row0 + ai * HALF + m * 16) * N0P + col0;
#pragma unroll
                for (int bj = 0; bj < 2; ++bj) *(u32x4*)(rowp + bj * HALF) = pack8(acc[ai][bj][m][0], acc[ai][bj][m][1]); }
    }
};
struct EpiY0F {
    static constexpr bool PERM = true, AFTER_DRAIN = false;
    Ptrs P;
    __device__ __forceinline__ void operator()(const f32x4 (&acc)[2][2][4][2], const Unit& u, int wr, int wc, int fr, int fq) const {
        const int row0 = u.pm * BM + wr * 64 + fr, col0 = u.pn * BM + wc * 32 + 8 * fq;
        float* Y0 = (float*)(P.ws + WS_Y0); bf16_t* YB = (bf16_t*)(P.ws + WS_Y0B); float* SSQ = (float*)(P.ws + WS_SSQ);
#pragma unroll
        for (int ai = 0; ai < 2; ++ai)
#pragma unroll
            for (int m = 0; m < 4; ++m) { const int row = row0 + ai * HALF + m * 16; const float* xr = xrow(P, row) + col0; float ss = 0.f;
#pragma unroll
                for (int bj = 0; bj < 2; ++bj) {
                    const f32x4 y0 = acc[ai][bj][m][0] + *(const f32x4*)(xr + bj * HALF), y1 = acc[ai][bj][m][1] + *(const f32x4*)(xr + bj * HALF + 4);
                    *(f32x4*)(Y0 + (size_t)row * D + col0 + bj * HALF) = y0; *(f32x4*)(Y0 + (size_t)row * D + col0 + bj * HALF + 4) = y1;
                    *(u32x4*)(YB + (size_t)row * D + col0 + bj * HALF) = pack8(y0, y1);
                    ss += (y0[0] * y0[0] + y0[1] * y0[1]) + (y0[2] * y0[2] + y0[3] * y0[3]) + (y1[0] * y1[0] + y1[1] * y1[1]) + (y1[2] * y1[2] + y1[3] * y1[3]); }
                ss += __shfl_xor(ss, 16); ss += __shfl_xor(ss, 32);
                if (fq == 0) SSQ[(size_t)row * 16 + u.pn * 4 + wc] = ss; }
    }
};
struct EpiL1F {
    static constexpr bool PERM = true, AFTER_DRAIN = false;
    Ptrs P;
    __device__ __forceinline__ void operator()(const f32x4 (&acc)[2][2][4][2], const Unit& u, int wr, int wc, int fr, int fq) const {
        const int row0 = u.pm * BM + wr * 64 + fr, colt = u.pn * BM, reg = colt >> 10, c0 = (colt & 1023) + wc * 32 + 8 * fq;
        const float* SSQ = (const float*)(P.ws + WS_SSQ);
#pragma unroll
        for (int ai = 0; ai < 2; ++ai)
#pragma unroll
            for (int m = 0; m < 4; ++m) { const int row = row0 + ai * HALF + m * 16;
                const f32x4* sp = (const f32x4*)(SSQ + (size_t)row * 16); const f32x4 s0 = sp[0], s1 = sp[1], s2 = sp[2], s3 = sp[3];
                const f32x4 st = (s0 + s1) + (s2 + s3); const float rs = rsqrtf(((st[0] + st[1]) + (st[2] + st[3])) * (1.f / D) + EPS);
#pragma unroll
                for (int bj = 0; bj < 2; ++bj) { const int c = c0 + bj * HALF; f32x4 v0 = acc[ai][bj][m][0] * rs, v1 = acc[ai][bj][m][1] * rs;
                    if (reg == 0) { *(u32x4*)((bf16_t*)(P.ws + WS_Q1) + (size_t)row * D + c) = pack8(v0 * QSCALE, v1 * QSCALE); }
                    else if (reg == 1) { *(u32x4*)((bf16_t*)(P.ws + WS_K1) + (size_t)row * D + c) = pack8(v0, v1); float* o = P.out + off_l1k(row) + c; *(f32x4*)o = v0; *(f32x4*)(o + 4) = v1; }
                    else if (reg == 2) { bf16_t* vt = (bf16_t*)(P.ws + WS_V1T) + (size_t)c * M + row;
#pragma unroll
                        for (int j = 0; j < 4; ++j) { vt[(size_t)j * M] = f2bf(v0[j]); vt[(size_t)(4 + j) * M] = f2bf(v1[j]); }
                        float* o = P.out + off_l1v(row) + c; *(f32x4*)o = v0; *(f32x4*)(o + 4) = v1; }
                    else { *(u32x4*)((bf16_t*)(P.ws + WS_Z1) + (size_t)row * D + c) = pack8(v0, v1); } } }
    }
};
struct EpiOutF {
    static constexpr bool PERM = true, AFTER_DRAIN = false;
    Ptrs P;
    __device__ __forceinline__ void operator()(const f32x4 (&acc)[2][2][4][2], const Unit& u, int wr, int wc, int fr, int fq) const {
        const int row0 = u.pm * BM + wr * 64 + fr, col0 = u.pn * BM + wc * 32 + 8 * fq;
        const float* Y0 = (const float*)(P.ws + WS_Y0);
#pragma unroll
        for (int ai = 0; ai < 2; ++ai)
#pragma unroll
            for (int m = 0; m < 4; ++m) { const size_t ro = (size_t)(row0 + ai * HALF + m * 16) * D + col0;
#pragma unroll
                for (int bj = 0; bj < 2; ++bj) {
                    *(f32x4*)(P.out + O_Y + ro + bj * HALF) = acc[ai][bj][m][0] + *(const f32x4*)(Y0 + ro + bj * HALF);
                    *(f32x4*)(P.out + O_Y + ro + bj * HALF + 4) = acc[ai][bj][m][1] + *(const f32x4*)(Y0 + ro + bj * HALF + 4); } }
    }
};
template <class Epi, class Sched, bool ALIGN_EPI = false, bool SP2 = false>
__device__ __forceinline__ void gemm_phase(PG8_LAS unsigned char* lds, const Gemm g, const Sched& S, const Epi& E) {
    const int tid = threadIdx.x, wid = __builtin_amdgcn_readfirstlane(tid >> 6), lane = tid & 63, wr = wid >> 2, wc = wid & 3, fr = lane & 15, fq = lane >> 4;
    const int K = g.K, nt = K / BK;
    unsigned voffA[2], voffB[2];
#pragma unroll
    for (int i = 0; i < 2; ++i) { int R, C; stage_rc(tid * 16 + i * 8192, R, C); const int Rb = Epi::PERM ? ((R & ~31) + perm32(R & 31)) : R;
        voffA[i] = (unsigned)(R * K + C) * 2u; voffB[i] = (unsigned)(Rb * K + C) * 2u; }
    const size_t kstep = (size_t)(BK * 2);
    const size_t hstep = (size_t)HALF * K * 2;
    const size_t tstep = 2 * hstep;
    const unsigned ldsw = (unsigned)wid * 1024u;
    const int aoff = lds_byte(wr * 64 + fr, fq * 8), boff = lds_byte(wc * 32 + fr, fq * 8);
#define PG8_SA(b, h) (((b) * 2 + (h)) * HTB)
#define PG8_SB(b, h) ((4 + (b) * 2 + (h)) * HTB)
#define PG8_STAGE(bufoff, gbase, voff) do { _Pragma("unroll") for (int _i = 0; _i < 2; ++_i) \
        __builtin_amdgcn_global_load_lds((const unsigned*)((const char*)(gbase) + (voff)[_i]), (PG8_LAS unsigned*)(lds + (bufoff) + ldsw + _i * 8192), 16, 0, 0); } while (0)
#define PG8_LDA(dst, b, h) do { _Pragma("unroll") for (int m = 0; m < 4; ++m) _Pragma("unroll") for (int k = 0; k < 2; ++k) dst[m][k] = *(const PG8_LAS bf16x8*)(lds + PG8_SA(b, h) + aoff + m * 2048 + k * 1024); } while (0)
#define PG8_LDB(dst, b, h) do { _Pragma("unroll") for (int n = 0; n < 2; ++n) _Pragma("unroll") for (int k = 0; k < 2; ++k) dst[n][k] = *(const PG8_LAS bf16x8*)(lds + PG8_SB(b, h) + boff + n * 2048 + k * 1024); } while (0)
#define PG8_MMA(ai, bj, At, Bt) do { __builtin_amdgcn_s_setprio(1); _Pragma("unroll") for (int m = 0; m < 4; ++m) _Pragma("unroll") for (int n = 0; n < 2; ++n) _Pragma("unroll") for (int k = 0; k < 2; ++k) \
        acc[ai][bj][m][n] = __builtin_amdgcn_mfma_f32_16x16x32_bf16(Bt[n][k], At[m][k], acc[ai][bj][m][n], 0, 0, 0); __builtin_amdgcn_s_setprio(0); } while (0)
#define PG8_WAIT_V(n) asm volatile("s_waitcnt vmcnt(" #n ")" ::: "memory")
#define PG8_WAIT_L(n) asm volatile("s_waitcnt lgkmcnt(" #n ")" ::: "memory")
#define PG8_BAR __builtin_amdgcn_s_barrier()
#define PG8_SCHED __builtin_amdgcn_sched_barrier(0)
    Unit cur, nxt; int ui = 0;
    if (!S.next(0, cur)) return;
    f32x4 acc[2][2][4][2];
#pragma unroll
    for (int a = 0; a < 2; ++a)
#pragma unroll
        for (int b = 0; b < 2; ++b)
#pragma unroll
            for (int m = 0; m < 4; ++m)
#pragma unroll
                for (int n = 0; n < 2; ++n) acc[a][b][m][n] = (f32x4){0.f, 0.f, 0.f, 0.f};
    bf16x8 At[4][2], B0[2][2], B1[2][2];
    const char* cA = (const char*)g.A + (size_t)cur.pm * tstep; const char* cB = (const char*)g.Bt + (size_t)cur.pn * tstep;
    S.a_ready(cur);
    if constexpr (SP2) {
        PG8_STAGE(PG8_SB(0, 0), cB, voffB); PG8_STAGE(PG8_SB(0, 1), cB + hstep, voffB); PG8_STAGE(PG8_SA(0, 0), cA, voffA); PG8_STAGE(PG8_SA(0, 1), cA + hstep, voffA);
        if (wr == 1) PG8_BAR;
        PG8_WAIT_V(2); PG8_BAR;
        PG8_STAGE(PG8_SB(1, 0), cB + kstep, voffB); PG8_STAGE(PG8_SA(1, 0), cA + kstep, voffA); PG8_STAGE(PG8_SB(1, 1), cB + hstep + kstep, voffB);
        PG8_WAIT_V(6); PG8_BAR;
    } else {
        PG8_STAGE(PG8_SB(0, 0), cB, voffB); PG8_STAGE(PG8_SA(0, 0), cA, voffA); PG8_STAGE(PG8_SB(0, 1), cB + hstep, voffB); PG8_STAGE(PG8_SA(0, 1), cA + hstep, voffA);
        if (wr == 1) PG8_BAR;
        PG8_WAIT_V(4); PG8_BAR;
        PG8_STAGE(PG8_SB(1, 0), cB + kstep, voffB); PG8_STAGE(PG8_SA(1, 0), cA + kstep, voffA); PG8_STAGE(PG8_SB(1, 1), cB + hstep + kstep, voffB);
        PG8_WAIT_V(6); PG8_BAR;
    }
    for (;;) {
        const bool has_next = S.next(ui + 1, nxt);
        const char* nA = has_next ? (const char*)g.A + (size_t)nxt.pm * tstep : cA; const char* nB = has_next ? (const char*)g.Bt + (size_t)nxt.pn * tstep : cB;
        for (int t = 0; t < nt; t += 2) {
            const bool last = (t == nt - 2);
            const char* a1 = cA + (size_t)(t + 1) * kstep;
            const char* a2 = last ? nA : cA + (size_t)(t + 2) * kstep; const char* b2 = last ? nB : cB + (size_t)(t + 2) * kstep;
            const char* a3 = a2 + kstep; const char* b3 = b2 + kstep;
            if (last && has_next) S.a_ready(nxt);
            if constexpr (SP2) {
            PG8_LDB(B0, 0, 0); PG8_LDB(B1, 0, 1); PG8_SCHED; PG8_LDA(At, 0, 0); PG8_STAGE(PG8_SA(1, 1), a1 + hstep, voffA);
            PG8_WAIT_V(8); PG8_WAIT_L(0); PG8_BAR; PG8_MMA(0, 0, At, B0); PG8_MMA(0, 1, At, B1); PG8_BAR; PG8_SCHED;
            PG8_LDA(At, 0, 1); PG8_STAGE(PG8_SB(0, 0), b2, voffB); PG8_STAGE(PG8_SB(0, 1), b2 + hstep, voffB); PG8_STAGE(PG8_SA(0, 0), a2, voffA);
            PG8_WAIT_V(8); PG8_WAIT_L(0); PG8_BAR; PG8_MMA(1, 0, At, B0); PG8_MMA(1, 1, At, B1); PG8_BAR; PG8_SCHED;
            PG8_LDB(B0, 1, 0); PG8_LDB(B1, 1, 1); PG8_SCHED; PG8_LDA(At, 1, 0); PG8_STAGE(PG8_SA(0, 1), a2 + hstep, voffA);
            PG8_WAIT_V(8); PG8_WAIT_L(0); PG8_BAR; PG8_MMA(0, 0, At, B0); PG8_MMA(0, 1, At, B1); PG8_BAR; PG8_SCHED;
            PG8_LDA(At, 1, 1); PG8_STAGE(PG8_SB(1, 0), b3, voffB); PG8_STAGE(PG8_SB(1, 1), b3 + hstep, voffB); PG8_STAGE(PG8_SA(1, 0), a3, voffA);
            PG8_WAIT_V(8); PG8_WAIT_L(0); PG8_BAR; PG8_MMA(1, 0, At, B0); PG8_MMA(1, 1, At, B1); PG8_BAR; PG8_SCHED;
            } else {
            PG8_LDB(B0, 0, 0); PG8_SCHED; PG8_LDA(At, 0, 0); PG8_STAGE(PG8_SA(1, 1), a1 + hstep, voffA);
            PG8_WAIT_L(8); PG8_BAR; PG8_WAIT_L(0); PG8_MMA(0, 0, At, B0); PG8_BAR; PG8_SCHED;
            PG8_LDB(B1, 0, 1); PG8_STAGE(PG8_SB(0, 0), b2, voffB);
            PG8_BAR; PG8_WAIT_L(0); PG8_MMA(0, 1, At, B1); PG8_BAR;
            PG8_LDA(At, 0, 1); PG8_STAGE(PG8_SA(0, 0), a2, voffA);
            PG8_BAR; PG8_WAIT_L(0); PG8_MMA(1, 0, At, B0); PG8_BAR; PG8_SCHED;
            PG8_STAGE(PG8_SB(0, 1), b2 + hstep, voffB);
            PG8_WAIT_V(6); PG8_BAR; PG8_MMA(1, 1, At, B1); PG8_BAR;
            PG8_LDB(B0, 1, 0); PG8_SCHED; PG8_LDA(At, 1, 0); PG8_STAGE(PG8_SA(0, 1), a2 + hstep, voffA);
            PG8_WAIT_L(8); PG8_BAR; PG8_WAIT_L(0); PG8_MMA(0, 0, At, B0); PG8_BAR; PG8_SCHED;
            PG8_LDB(B1, 1, 1); PG8_STAGE(PG8_SB(1, 0), b3, voffB);
            PG8_BAR; PG8_WAIT_L(0); PG8_MMA(0, 1, At, B1); PG8_BAR;
            PG8_LDA(At, 1, 1); PG8_STAGE(PG8_SA(1, 0), a3, voffA);
            PG8_BAR; PG8_WAIT_L(0); PG8_MMA(1, 0, At, B0); PG8_BAR; PG8_SCHED;
            PG8_STAGE(PG8_SB(1, 1), b3 + hstep, voffB);
            PG8_WAIT_V(6); PG8_BAR; PG8_MMA(1, 1, At, B1); PG8_BAR;
            }
        }
        if constexpr (ALIGN_EPI) { if (wr == 0) PG8_BAR; }
        if constexpr (!Epi::AFTER_DRAIN) { E(acc, cur, wr, wc, fr, fq); S.done(cur); }
        if (!has_next) break;
#pragma unroll
        for (int a = 0; a < 2; ++a)
#pragma unroll
            for (int b = 0; b < 2; ++b)
#pragma unroll
                for (int m = 0; m < 4; ++m)
#pragma unroll
                    for (int n = 0; n < 2; ++n) acc[a][b][m][n] = (f32x4){0.f, 0.f, 0.f, 0.f};
        cur = nxt; cA = nA; cB = nB; ++ui;
        if constexpr (ALIGN_EPI) { if (wr == 1) PG8_BAR; }
    }
    PG8_WAIT_V(0);
    if constexpr (!ALIGN_EPI) { if (wr == 0) PG8_BAR; }
    PG8_BAR;
    if constexpr (Epi::AFTER_DRAIN) { E.fused(acc, cur, wr, wc, fr, fq, lds, wid, lane); S.done(cur); }
#undef PG8_SA
#undef PG8_SB
#undef PG8_STAGE
#undef PG8_LDA
#undef PG8_LDB
#undef PG8_MMA
#undef PG8_WAIT_V
#undef PG8_WAIT_L
#undef PG8_BAR
#undef PG8_SCHED
}
}
namespace da {
#define DLAS __attribute__((address_space(3)))
typedef short bf16x8 __attribute__((ext_vector_type(8)));
typedef short s16x4 __attribute__((ext_vector_type(4)));
typedef float f32x16 __attribute__((ext_vector_type(16)));
typedef float f32x4 __attribute__((ext_vector_type(4)));
typedef unsigned u32x4 __attribute__((ext_vector_type(4)));

constexpr int KROW = 272, KBUF = 64 * KROW, VBUF = 16384;
constexpr int OFF_K = 0, OFF_V = 2 * KBUF;
constexpr int OFF_STAGE = 0;
constexpr int OFF_LST = 131072;
constexpr int OFF_BIAS = OFF_LST + 1024;
constexpr int DA_LDS_END = OFF_BIAS + 1024;

struct Unit { int kind, h, idx; };

__device__ __forceinline__ unsigned cvtpk(float lo, float hi) { unsigned r; asm volatile("v_cvt_pk_bf16_f32 %0, %1, %2" : "=v"(r) : "v"(lo), "v"(hi)); return r; }
__device__ __forceinline__ u32x4 pack8(const f32x4& a, const f32x4& b) { u32x4 w; w.x = cvtpk(a[0], a[1]); w.y = cvtpk(a[2], a[3]); w.z = cvtpk(b[0], b[1]); w.w = cvtpk(b[2], b[3]); return w; }

struct Stage { f32x4 kA0, kA1, vA0, vA1, kB0, kB1, vB0, vB1; };
template <int KIND> __device__ __forceinline__ void chunk_issue(const Ptrs& P, const Unit& u, int t, int c, f32x4& k0, f32x4& k1, f32x4& v0, f32x4& v1) {
    const int row = c >> 4, ch = c & 15;
    if (KIND == 0 || t == 16) {
        const int m = (KIND == 0) ? 64 * t + row : TP + 32 * u.idx + (row & 31);
        const bf16_t* kp = (const bf16_t*)(P.ws + WS_K0) + (size_t)m * 512 + 128 * u.h + ch * 8;
        const bf16_t* vp = (const bf16_t*)(P.ws + WS_PROJ0) + (size_t)m * N0P + C_V + 128 * u.h + ch * 8;
        f32x4 kv = *(const f32x4*)kp, vv = *(const f32x4*)vp;
        if (KIND != 0 && row >= 32) { kv = (f32x4){0.f, 0.f, 0.f, 0.f}; vv = kv; }
        k0 = kv; v0 = vv;
    } else {
        const size_t ro = (((size_t)u.idx * PAST + 64 * t + row) * 4 + u.h) * 128 + ch * 8;
        const float* kp = P.in[2] + ro; const float* vp = P.in[3] + ro;
        k0 = *(const f32x4*)kp; k1 = *(const f32x4*)(kp + 4); v0 = *(const f32x4*)vp; v1 = *(const f32x4*)(vp + 4);
    }
}
template <int KIND> __device__ __forceinline__ void chunk_write(int t, int c, DLAS unsigned char* lds, int buf, const f32x4& k0, const f32x4& k1, const f32x4& v0, const f32x4& v1) {
    const int row = c >> 4, ch = c & 15;
    DLAS unsigned char* kd = lds + OFF_K + buf * KBUF + row * KROW + ch * 16;
    DLAS unsigned char* vd = lds + OFF_V + buf * VBUF + (ch >> 2) * 4096 + row * 64 + (ch & 3) * 16;
    if (KIND == 0 || t == 16) { *(DLAS f32x4*)kd = k0; *(DLAS f32x4*)vd = v0; }
    else { *(DLAS u32x4*)kd = pack8(k0, k1); *(DLAS u32x4*)vd = pack8(v0, v1); }
}
#define TILE_ISSUE(t_) do { chunk_issue<KIND>(P, u, (t_), tid, S.kA0, S.kA1, S.vA0, S.vA1); chunk_issue<KIND>(P, u, (t_), tid + 512, S.kB0, S.kB1, S.vB0, S.vB1); } while (0)
#define TILE_WRITE(t_, buf_) do { chunk_write<KIND>((t_), tid, lds, (buf_), S.kA0, S.kA1, S.vA0, S.vA1); chunk_write<KIND>((t_), tid + 512, lds, (buf_), S.kB0, S.kB1, S.vB0, S.vB1); } while (0)

template <int KIND> __device__ __forceinline__ void unit_run(const Ptrs& P, const Unit& u0, DLAS unsigned char* lds, int tid) {
    const Unit u{KIND, u0.h, u0.idx};
    const int lane = tid & 63, wave = __builtin_amdgcn_readfirstlane(tid >> 6), r32 = lane & 31, hi = lane >> 5, mp = wave >> 2, w4 = wave & 3;
    constexpr bool is_s = KIND != 0;
    int m0row, qpos0, NT, cq;
    if (!is_s) { m0row = 128 * u.idx + 32 * w4; qpos0 = m0row; NT = 2 * u.idx + 2; cq = m0row >> 6; }
    else { m0row = TP + 32 * u.idx; qpos0 = PAST; NT = 17; cq = 16; }
    const Tab* T = (const Tab*)(P.ws + WS_TAB);
    DLAS float* lst = (DLAS float*)(lds + OFF_LST);
    DLAS float* bl = (DLAS float*)(lds + OFF_BIAS);
    if (tid < 256) { bl[tid] = (T->bias[u.h][tid] - T->biasfar[u.h]) * LOG2E; lst[tid] = 0.f; }
    bf16x8 qf[4];
    { const bf16_t* qp = (const bf16_t*)(P.ws + WS_Q0) + (size_t)(m0row + r32) * 512 + 128 * u.h + 64 * mp + 8 * hi;
#pragma unroll
      for (int s = 0; s < 4; ++s) qf[s] = *(const bf16x8*)(qp + 16 * s); }
    f32x16 o[4];
#pragma unroll
    for (int d = 0; d < 4; ++d)
#pragma unroll
        for (int r = 0; r < 16; ++r) o[d][r] = 0.f;
    float lsum = 0.f;
    Stage S;
    { const f32x4 z = (f32x4){0.f, 0.f, 0.f, 0.f}; S.kA0 = z; S.kA1 = z; S.vA0 = z; S.vA1 = z; S.kB0 = z; S.kB1 = z; S.vB0 = z; S.vB1 = z; }
    TILE_ISSUE(0);
    TILE_WRITE(0, 0);
    __syncthreads();
    const int vaddr = (4 * hi + ((lane & 15) >> 2)) * 64 + (16 * ((lane >> 4) & 1) + 4 * (lane & 3)) * 2;
    for (int t = 0; t < NT; ++t) {
        const int buf = t & 1;
        const bool has_next = t + 1 < NT;
        if (has_next) TILE_ISSUE(t + 1);
        const bool active = is_s ? ((t & 3) == w4) : (t <= cq);
        if (active) {
            const DLAS unsigned char* kb = lds + OFF_K + buf * KBUF + r32 * KROW + mp * 128 + hi * 16;
            f32x16 p0, p1;
#pragma unroll
            for (int r = 0; r < 16; ++r) { p0[r] = 0.f; p1[r] = 0.f; }
#pragma unroll
            for (int s = 0; s < 4; ++s) {
                const bf16x8 a0 = *(const DLAS bf16x8*)(kb + s * 32), a1 = *(const DLAS bf16x8*)(kb + 32 * KROW + s * 32);
                p0 = __builtin_amdgcn_mfma_f32_32x32x16_bf16(a0, qf[s], p0, 0, 0, 0);
                p1 = __builtin_amdgcn_mfma_f32_32x32x16_bf16(a1, qf[s], p1, 0, 0, 0);
            }
            if (t >= cq - 2) {
                const int rb = 64 * t - qpos0 - r32 + 191 + 4 * hi;
#pragma unroll
                for (int r = 0; r < 16; ++r) { const int kk = (r & 3) + 8 * (r >> 2); p0[r] += bl[rb + kk]; p1[r] += bl[rb + 32 + kk]; }
            }
#pragma unroll
            for (int r = 0; r < 16; ++r) { p0[r] = __builtin_amdgcn_exp2f(p0[r]); p1[r] = __builtin_amdgcn_exp2f(p1[r]); }
            if (is_s && t == 16) {
#pragma unroll
                for (int r = 0; r < 16; ++r) p1[r] = 0.f;
            }
            float sa = 0.f, sb = 0.f;
#pragma unroll
            for (int r = 0; r < 16; ++r) { sa += p0[r]; sb += p1[r]; }
            lsum += sa + sb;
            bf16x8 pa[4];
            pa[0] = __builtin_bit_cast(bf16x8, pack8((f32x4){p0[0], p0[1], p0[2], p0[3]}, (f32x4){p0[4], p0[5], p0[6], p0[7]}));
            pa[1] = __builtin_bit_cast(bf16x8, pack8((f32x4){p0[8], p0[9], p0[10], p0[11]}, (f32x4){p0[12], p0[13], p0[14], p0[15]}));
            pa[2] = __builtin_bit_cast(bf16x8, pack8((f32x4){p1[0], p1[1], p1[2], p1[3]}, (f32x4){p1[4], p1[5], p1[6], p1[7]}));
            pa[3] = __builtin_bit_cast(bf16x8, pack8((f32x4){p1[8], p1[9], p1[10], p1[11]}, (f32x4){p1[12], p1[13], p1[14], p1[15]}));
            const DLAS unsigned char* vb = lds + OFF_V + buf * VBUF + vaddr;
#pragma unroll
            for (int d = 0; d < 4; ++d)
#pragma unroll
                for (int k = 0; k < 4; ++k) {
                    const s16x4 lo = __builtin_bit_cast(s16x4, __builtin_amdgcn_ds_read_tr16_b64_v4i16((DLAS s16x4*)(vb + d * 4096 + k * 1024)));
                    const s16x4 hh = __builtin_bit_cast(s16x4, __builtin_amdgcn_ds_read_tr16_b64_v4i16((DLAS s16x4*)(vb + d * 4096 + k * 1024 + 512)));
                    const bf16x8 bf = (bf16x8){lo[0], lo[1], lo[2], lo[3], hh[0], hh[1], hh[2], hh[3]};
                    o[d] = __builtin_amdgcn_mfma_f32_32x32x16_bf16(pa[k], bf, o[d], 0, 0, 0);
                    if (k == 3) __builtin_amdgcn_sched_barrier(0);
                }
        }
        if (has_next) TILE_WRITE(t + 1, buf ^ 1);
        __syncthreads();
    }
    lsum += __shfl_xor(lsum, 32);
    DLAS float* stage = (DLAS float*)(lds + OFF_STAGE);
    {
        const int rowb = is_s ? 0 : 32 * w4;
        DLAS float* st0 = stage + (mp * 128 + rowb + 4 * hi) * 128 + r32;
#pragma unroll 1
        for (int round = 0; round < (is_s ? 4 : 1); ++round) {
            if (!is_s || round == w4) {
                const bool first = !is_s || round == 0;
#pragma unroll
                for (int d = 0; d < 4; ++d)
#pragma unroll
                    for (int r = 0; r < 16; ++r) {
                        DLAS float* st = st0 + ((r & 3) + 8 * (r >> 2)) * 128 + d * 32;
                        *st = first ? o[d][r] : *st + o[d][r];
                    }
                if (hi == 0) { DLAS float* lp = &lst[mp * 128 + rowb + r32]; *lp = first ? lsum : *lp + lsum; }
            }
            __syncthreads();
        }
    }
    {
        const int nrow = is_s ? 4 : 16;
        const float lam = T->lam;
        const float* sg = P.in[18];
        for (int i = 0; i < nrow; ++i) {
            const int row = wave * nrow + i;
            const float l1 = lst[row], l2 = lst[128 + row];
            const float il1 = 1.f / l1, il2 = lam / l2;
            const float a0 = stage[row * 128 + lane] * il1 - stage[(128 + row) * 128 + lane] * il2;
            const float a1 = stage[row * 128 + 64 + lane] * il1 - stage[(128 + row) * 128 + 64 + lane] * il2;
            const float ss = wave_sum(a0 * a0 + a1 * a1);
            const float rr = rsqrtf(ss * (1.f / 128) + EPS) * (1.f - LAMBDA_INIT);
            const int m = is_s ? TP + 32 * u.idx + row : 128 * u.idx + row;
            const bf16_t* za = (const bf16_t*)(P.ws + WS_PROJ0) + (size_t)m * N0P + C_ZA + 128 * u.h;
            bf16_t* cat = (bf16_t*)(P.ws + WS_CAT) + (size_t)m * D + 128 * u.h;
            cat[lane] = f2bf(a0 * rr * sg[lane] * silu(bf2f(za[lane])));
            cat[64 + lane] = f2bf(a1 * rr * sg[64 + lane] * silu(bf2f(za[64 + lane])));
        }
    }
    __syncthreads();
}

__device__ __forceinline__ void phase(const Ptrs& P, DLAS unsigned char* lds, int vcu, int nvcu, int tid) {
    if (nvcu == 256) {
        const int v = vcu, h = v >> 6, s = v & 63;
        unit_run<0>(P, Unit{0, h, 127 - s}, lds, tid);
        unit_run<0>(P, Unit{0, h, s}, lds, tid);
        if (v < 128) unit_run<1>(P, Unit{1, v & 3, v >> 2}, lds, tid);
    } else {
#pragma unroll 1
        for (int i = vcu; i < 512; i += nvcu) unit_run<0>(P, Unit{0, i >> 7, 127 - (i & 127)}, lds, tid);
#pragma unroll 1
        for (int i = vcu; i < 128; i += nvcu) unit_run<1>(P, Unit{1, i & 3, i >> 2}, lds, tid);
    }
}
#undef DLAS
}
#ifndef FAST_ATTN0
#define FAST_ATTN0 1
#endif
#include <hip/hip_cooperative_groups.h>
namespace cg = cooperative_groups;
constexpr int NWAVES = 8, NTHREADS = 512;
constexpr int LDS_BYTES = 147456;
enum Phase { PH_PRO = 0, PH_GEMM1 = 1, PH_TOK = 2, PH_MIX = 3, PH_RWC = 4, PH_GEMM2 = 5, PH_GEMM3 = 6, PH_ATTN1 = 7, PH_GEMM4 = 8, PH_END = 9 };
#define LAS __attribute__((address_space(3)))
struct Args { Ptrs p; int ph_lo, ph_hi; int pad0, pad1; };

__global__ void __launch_bounds__(NTHREADS, 2) mk_fwd(Args a) {
    extern __shared__ __attribute__((aligned(16))) unsigned char lds[];
    const Ptrs& P = a.p;
    unsigned char* ws = P.ws;
    const int lo = a.ph_lo, hi = a.ph_hi;
    const int tid = threadIdx.x, lane = tid & 63, wave = tid >> 6;
    const int G = gridDim.x, gw = blockIdx.x * NWAVES + wave, NGW = G * NWAVES;
    float* wscr = (float*)lds + wave * 256;
#define IN(k) (lo <= (k) && (k) < hi)
#define SEAM(k) do { if (IN(k) && IN((k) + 1)) cg::this_grid().sync(); } while (0)
    if (IN(PH_PRO)) {
        const size_t gt = (size_t)blockIdx.x * NTHREADS + tid, NT = (size_t)G * NTHREADS;
        for (size_t i = gt; i < (size_t)N0P * D; i += NT) nv::d_transpose_w(P.in[10], D, N0, N0P, (bf16_t*)(ws + WS_WT0), nullptr, i);
        for (size_t i = gt; i < (size_t)D * D; i += NT) nv::d_transpose_w(P.in[11], D, D, D, (bf16_t*)(ws + WS_WO0T), nullptr, i);
        for (size_t i = gt; i < (size_t)N1 * D; i += NT) nv::d_transpose_w(P.in[30], D, N1, N1, (bf16_t*)(ws + WS_WT1), P.in[29], i);
        for (size_t i = gt; i < (size_t)D * D; i += NT) nv::d_transpose_w(P.in[31], D, D, D, (bf16_t*)(ws + WS_WO1T), nullptr, i);
        if (blockIdx.x == 0 && tid < 256) nv::d_tables(P, tid);
        for (int m = gw; m < M; m += NGW) nv::d_rmsnorm_x(P, m, lane);
    }
    SEAM(PH_PRO);
    if (IN(PH_GEMM1)) {
        pg8::Gemm g{(const bf16_t*)(ws + WS_XN0), (const bf16_t*)(ws + WS_WT0), M, N0P, D}; pg8::StaticOrder S; S.init(M, N0P, G, (int)blockIdx.x);
        pg8::EpiProj0F E{(bf16_t*)(ws + WS_PROJ0)};
        pg8::gemm_phase<pg8::EpiProj0F, pg8::StaticOrder, true, true>((LAS unsigned char*)lds, g, S, E);
    }
    SEAM(PH_GEMM1);
    if (IN(PH_TOK)) {
        for (int m = gw; m < M; m += NGW) nv::d_tok0(P, m, lane);
        __syncthreads();
        for (int m = blockIdx.x; m < M; m += G) { nv::d_rw_prep(P, m, tid, (float*)lds, (float*)lds + 64); __syncthreads(); }
    }
    SEAM(PH_TOK);
    if (IN(PH_MIX)) {
        if (gw < 33 * 8) nv::d_rw_scan(P, gw >> 3, gw & 7, lane);
#if FAST_ATTN0
        { const int vcu = (G % 8 == 0) ? ((int)blockIdx.x % 8) * (G / 8) + (int)blockIdx.x / 8 : (int)blockIdx.x;
          __syncthreads();
          da::phase(P, (LAS unsigned char*)lds, vcu, G, tid); }
#else
        for (int i = gw; i < M * 4; i += NGW) nv::d_attn0(P, i >> 2, i & 3, lane, wscr, wscr + 128);
#endif
    }
    SEAM(PH_MIX);
    SEAM(PH_RWC);
    if (IN(PH_GEMM2)) {
        pg8::Gemm g{(const bf16_t*)(ws + WS_CAT), (const bf16_t*)(ws + WS_WO0T), M, D, D}; pg8::StaticOrder S; S.init(M, D, G, (int)blockIdx.x);
        pg8::EpiY0F E{P};
        pg8::gemm_phase<pg8::EpiY0F, pg8::StaticOrder, true, true>((LAS unsigned char*)lds, g, S, E);
    }
    SEAM(PH_GEMM2);
    if (IN(PH_GEMM3)) {
        pg8::Gemm g{(const bf16_t*)(ws + WS_Y0B), (const bf16_t*)(ws + WS_WT1), M, N1, D}; pg8::StaticOrder S; S.init(M, N1, G, (int)blockIdx.x);
        pg8::EpiL1F E{P};
        pg8::gemm_phase<pg8::EpiL1F, pg8::StaticOrder, true, true>((LAS unsigned char*)lds, g, S, E);
    }
    SEAM(PH_GEMM3);
    if (IN(PH_ATTN1)) {
        for (int i = gw; i < M * 16; i += NGW) nv::d_attn1(P, i >> 4, i & 15, lane, wscr, wscr + 64);
    }
    SEAM(PH_ATTN1);
    if (IN(PH_GEMM4)) {
        pg8::Gemm g{(const bf16_t*)(ws + WS_O1B), (const bf16_t*)(ws + WS_WO1T), M, D, D}; pg8::StaticOrder S; S.init(M, D, G, (int)blockIdx.x);
        pg8::EpiOutF E{P};
        pg8::gemm_phase<pg8::EpiOutF, pg8::StaticOrder, true, true>((LAS unsigned char*)lds, g, S, E);
    }
#undef IN
#undef SEAM
}
extern "C" void kernel_launch(void* const* d_in, const int* in_sizes, int n_in, void* d_out, int out_size, void* d_ws, size_t ws_size, hipStream_t stream) {
    static int grid = 0;
    if (n_in != 32 || (size_t)out_size != O_TOTAL || ws_size < WS_END) { fprintf(stderr, "kernel_launch: unexpected shapes n_in=%d out=%d ws=%zu\n", n_in, out_size, ws_size); return; }
    if (grid == 0) {
        int dev = 0, cus = 0, per_cu = 0;
        (void)hipGetDevice(&dev); (void)hipDeviceGetAttribute(&cus, hipDeviceAttributeMultiprocessorCount, dev);
        (void)hipFuncSetAttribute((const void*)mk_fwd, hipFuncAttributeMaxDynamicSharedMemorySize, LDS_BYTES);
        (void)hipOccupancyMaxActiveBlocksPerMultiprocessor(&per_cu, (const void*)mk_fwd, NTHREADS, LDS_BYTES);
        if (per_cu < 1) { fprintf(stderr, "kernel_launch: occupancy query says %d blocks/CU\n", per_cu); per_cu = 1; }
        grid = (cus > 0 ? cus : 256);
    }
    Args a{};
    for (int i = 0; i < 32; ++i) a.p.in[i] = (const float*)d_in[i];
    a.p.out = (float*)d_out; a.p.ws = (unsigned char*)d_ws; a.ph_lo = 0; a.ph_hi = PH_END;
    void* args[] = {&a};
    hipError_t e = hipLaunchCooperativeKernel((const void*)mk_fwd, dim3(grid), dim3(NTHREADS), args, LDS_BYTES, stream);
    if (e != hipSuccess) fprintf(stderr, "cooperative launch failed: %s (grid %d)\n", hipGetErrorString(e), grid);
}
```

```cpp
#include <hip/hip_runtime.h>
#include <stdint.h>
#include <cstdio>

typedef unsigned short bf16_t;
__device__ __forceinline__ float bf2f(bf16_t b) { return __uint_as_float(((unsigned)b) << 16); }
__device__ __forceinline__ bf16_t f2bf(float f) { unsigned u = __float_as_uint(f); return (bf16_t)((u + 0x7fffu + ((u >> 16) & 1u)) >> 16); }

constexpr int D = 1024, TP = 16384, NSEQ = 32, TS = 32, MS = NSEQ * TS, M = TP + MS, PAST = 1024;
constexpr int N0 = 4224, N0P = 4352, N1 = 4096;
constexpr int C_Q = 0, C_K = 512, C_V = 1024, C_ZA = 1536, C_PRW = 2048, C_ZB = 3712;
constexpr int RWS = 1664;
constexpr float EPS = 1e-6f, GN_EPS = 64e-5f;
constexpr float LOG2E = 1.4426950408889634f;
constexpr float LAMBDA_INIT = 0.2f;
constexpr float QSCALE = 0.125f * LOG2E;

constexpr size_t O_Y = 0;
constexpr size_t O_L0K_P = (size_t)M * D;
constexpr size_t O_L0V_P = O_L0K_P + (size_t)TP * 512;
constexpr size_t O_L0SH_P = O_L0V_P + (size_t)TP * 512;
constexpr size_t O_L0WKV_P = O_L0SH_P + RWS;
constexpr size_t O_L1K_P = O_L0WKV_P + 8 * 64 * 64;
constexpr size_t O_L1V_P = O_L1K_P + (size_t)TP * 1024;
constexpr size_t O_L0K_S = O_L1V_P + (size_t)TP * 1024;
constexpr size_t O_L0V_S = O_L0K_S + (size_t)MS * 512;
constexpr size_t O_L0SH_S = O_L0V_S + (size_t)MS * 512;
constexpr size_t O_L0WKV_S = O_L0SH_S + (size_t)NSEQ * RWS;
constexpr size_t O_L1K_S = O_L0WKV_S + (size_t)NSEQ * 8 * 64 * 64;
constexpr size_t O_L1V_S = O_L1K_S + (size_t)MS * 1024;
constexpr size_t O_TOTAL = O_L1V_S + (size_t)MS * 1024;
static_assert(O_TOTAL == 72439424, "output size");

__host__ __device__ __forceinline__ size_t off_l0k(int m) { return m < TP ? O_L0K_P + (size_t)m * 512 : O_L0K_S + (size_t)(m - TP) * 512; }
__host__ __device__ __forceinline__ size_t off_l0v(int m) { return m < TP ? O_L0V_P + (size_t)m * 512 : O_L0V_S + (size_t)(m - TP) * 512; }
__host__ __device__ __forceinline__ size_t off_l1k(int m) { return m < TP ? O_L1K_P + (size_t)m * 1024 : O_L1K_S + (size_t)(m - TP) * 1024; }
__host__ __device__ __forceinline__ size_t off_l1v(int m) { return m < TP ? O_L1V_P + (size_t)m * 1024 : O_L1V_S + (size_t)(m - TP) * 1024; }

constexpr size_t MiB = 1u << 20;
constexpr size_t WS_CTL = 0;
constexpr size_t WS_TAB = 512 * 1024;
constexpr size_t WS_WT0 = 1 * MiB, WS_WO0T = 10 * MiB, WS_WT1 = 12 * MiB, WS_WO1T = 20 * MiB, WS_LORA = 22 * MiB;
constexpr size_t WS_CAT = 24 * MiB, WS_XN0 = WS_CAT;
constexpr size_t WS_PROJ0 = 58 * MiB;
constexpr size_t WS_Q0 = 203 * MiB, WS_K0 = 220 * MiB;
constexpr size_t WS_RW = 237 * MiB;
constexpr size_t WS_SST = 407 * MiB;
constexpr size_t WS_END = 441 * MiB;
constexpr size_t WS_Y0 = WS_PROJ0, WS_Y0B = 126 * MiB, WS_SSQ = 160 * MiB;
constexpr size_t WS_O1B = WS_Q0;
constexpr size_t WS_Q1 = 237 * MiB, WS_K1 = 271 * MiB, WS_V1T = 305 * MiB, WS_Z1 = 339 * MiB;
static_assert(WS_PROJ0 + (size_t)M * N0P * 2 <= WS_Q0, "proj0");
static_assert(WS_WT0 + (size_t)N0P * D * 2 <= WS_WO0T, "wt0");

struct Tab {
    float lam;
    float m0;
    float pad[2];
    float bias[4][256];
    float biasfar[4];
};

struct Ptrs {
    const float* in[32];
    float* out;
    unsigned char* ws;
};

__device__ __forceinline__ const float* xrow(const Ptrs& P, int m) { return m < TP ? P.in[0] + (size_t)m * D : P.in[1] + (size_t)(m - TP) * D; }

__device__ __forceinline__ float wave_sum(float v) {
#pragma unroll
    for (int o = 1; o < 64; o <<= 1) v += __shfl_xor(v, o);
    return v;
}
__device__ __forceinline__ float wave_max(float v) {
#pragma unroll
    for (int o = 1; o < 64; o <<= 1) v = fmaxf(v, __shfl_xor(v, o));
    return v;
}
__device__ __forceinline__ float silu(float x) { return x / (1.f + __expf(-x)); }

__device__ __forceinline__ int t5_bucket(int rel) {
    int n = rel < 0 ? -rel : rel;
    int b;
    if (n < 8) b = n;
    else { unsigned n2 = (unsigned)n * (unsigned)n; int lg = 31 - __clz((int)n2); b = 8 + (lg - 6); if (b > 15) b = 15; }
    return (rel > 0 ? 16 : 0) + b;
}
namespace nv {

__device__ __forceinline__ void d_transpose_w(const float* W, int K, int N, int NP, bf16_t* WT, const float* g, size_t i) {
    int n = (int)(i / K), k = (int)(i % K);
    float v = 0.f;
    if (n < N) { v = W[(size_t)k * N + n]; if (g) v *= g[k]; }
    WT[i] = f2bf(v);
}
__global__ void k_transpose_w(const float* W, int K, int N, int NP, bf16_t* WT, const float* g) {
    size_t i = (size_t)blockIdx.x * blockDim.x + threadIdx.x; if (i < (size_t)NP * K) d_transpose_w(W, K, N, NP, WT, g, i); }
__global__ void k_lora_t(const float* w_up, const float* a_up, float* LT) {
    int i = blockIdx.x * blockDim.x + threadIdx.x;
    if (i >= 512 * 64) return;
    int c = i / 64, l = i % 64;
    LT[i] = w_up[l * 512 + c];
    LT[512 * 64 + i] = a_up[l * 512 + c];
}
__device__ __forceinline__ void d_tables(const Ptrs& P, int tid) {
    Tab* T = (Tab*)(P.ws + WS_TAB);
    if (tid < 64) {
        float a = P.in[14][tid] * P.in[15][tid], b = P.in[16][tid] * P.in[17][tid];
        a = wave_sum(a); b = wave_sum(b);
        float gq = fabsf(P.in[12][tid]), gk = fabsf(P.in[13][tid]);
        gq = wave_max(gq); gk = wave_max(gk);
        if (tid == 0) { T->lam = __expf(a) - __expf(b) + LAMBDA_INIT; T->m0 = 8.f * gq * gk * LOG2E * 1.0001f + 0.01f; }
    }
    if (tid < 255) { int rel = tid - 191; int b = t5_bucket(rel); for (int h = 0; h < 4; ++h) T->bias[h][tid] = P.in[8][b * 4 + h]; }
    if (tid == 255) for (int h = 0; h < 4; ++h) { T->bias[h][255] = 0.f; T->biasfar[h] = P.in[8][15 * 4 + h]; }
}
__global__ void k_tables(Ptrs P) { d_tables(P, threadIdx.x); }
__device__ __forceinline__ void d_rmsnorm_x(const Ptrs& P, int w, int lane) {
    const float* x = xrow(P, w); const float* g = P.in[9];
    bf16_t* o = (bf16_t*)(P.ws + WS_XN0) + (size_t)w * D;
    float v[16], s = 0.f;
#pragma unroll
    for (int j = 0; j < 16; ++j) { v[j] = x[lane + 64 * j]; s += v[j] * v[j]; }
    s = wave_sum(s);
    float r = rsqrtf(s * (1.f / D) + EPS);
#pragma unroll
    for (int j = 0; j < 16; ++j) o[lane + 64 * j] = f2bf(v[j] * r * g[lane + 64 * j]);
}
__global__ void k_rmsnorm_x(Ptrs P) { int w = (blockIdx.x * blockDim.x + threadIdx.x) >> 6; if (w < M) d_rmsnorm_x(P, w, threadIdx.x & 63); }

template <class Epi>
__global__ void __launch_bounds__(256) k_gemm(const bf16_t* A, const bf16_t* Bt, int K, Epi epi) {
    __shared__ float As[16][65], Bs[16][65];
    const int tx = threadIdx.x & 15, ty = threadIdx.x >> 4;
    const int m0 = blockIdx.y * 64, n0 = blockIdx.x * 64;
    float acc[4][4];
#pragma unroll
    for (int i = 0; i < 4; ++i)
#pragma unroll
        for (int j = 0; j < 4; ++j) acc[i][j] = 0.f;
    for (int k0 = 0; k0 < K; k0 += 16) {
#pragma unroll
        for (int i = 0; i < 4; ++i) {
            int e = threadIdx.x + 256 * i, r = e >> 4, c = e & 15;
            As[c][r] = bf2f(A[(size_t)(m0 + r) * K + k0 + c]);
            Bs[c][r] = bf2f(Bt[(size_t)(n0 + r) * K + k0 + c]);
        }
        __syncthreads();
#pragma unroll
        for (int kk = 0; kk < 16; ++kk) {
            float a[4], b[4];
#pragma unroll
            for (int i = 0; i < 4; ++i) { a[i] = As[kk][ty * 4 + i]; b[i] = Bs[kk][tx * 4 + i]; }
#pragma unroll
            for (int i = 0; i < 4; ++i)
#pragma unroll
                for (int j = 0; j < 4; ++j) acc[i][j] += a[i] * b[j];
        }
        __syncthreads();
    }
#pragma unroll
    for (int i = 0; i < 4; ++i)
#pragma unroll
        for (int j = 0; j < 4; ++j) epi(m0 + ty * 4 + i, n0 + tx * 4 + j, acc[i][j]);
}
struct EpiProj0 { bf16_t* O; __device__ void operator()(int m, int n, float v) const { O[(size_t)m * N0P + n] = f2bf(v); } };
struct EpiY0 {
    Ptrs P;
    __device__ void operator()(int m, int n, float v) const {
        float y = v + xrow(P, m)[n];
        ((float*)(P.ws + WS_Y0))[(size_t)m * D + n] = y;
        ((bf16_t*)(P.ws + WS_Y0B))[(size_t)m * D + n] = f2bf(y);
    }
};
struct EpiL1 {
    Ptrs P;
    __device__ void operator()(int m, int n, float v) const {
        const float* ss = (const float*)(P.ws + WS_SSQ) + (size_t)m * 16;
        float t = 0.f; for (int j = 0; j < 16; ++j) t += ss[j];
        float r = rsqrtf(t * (1.f / D) + EPS);
        float val = v * r;
        int c = n & 1023;
        if (n < 1024) ((bf16_t*)(P.ws + WS_Q1))[(size_t)m * D + c] = f2bf(val * QSCALE);
        else if (n < 2048) { ((bf16_t*)(P.ws + WS_K1))[(size_t)m * D + c] = f2bf(val); P.out[off_l1k(m) + c] = val; }
        else if (n < 3072) { ((bf16_t*)(P.ws + WS_V1T))[(size_t)c * M + m] = f2bf(val); P.out[off_l1v(m) + c] = val; }
        else ((bf16_t*)(P.ws + WS_Z1))[(size_t)m * D + c] = f2bf(val);
    }
};
struct EpiOut { Ptrs P; __device__ void operator()(int m, int n, float v) const { P.out[O_Y + (size_t)m * D + n] = v + ((const float*)(P.ws + WS_Y0))[(size_t)m * D + n]; } };

__device__ __forceinline__ void d_ssq(const Ptrs& P, int w, int lane) {
    const float* y = (const float*)(P.ws + WS_Y0) + (size_t)w * D;
    float* ss = (float*)(P.ws + WS_SSQ) + (size_t)w * 16;
    for (int j = 0; j < 16; ++j) { float v = y[64 * j + lane]; float s = wave_sum(v * v); if (lane == 0) ss[j] = s; }
}
__global__ void k_ssq(Ptrs P) { int w = (blockIdx.x * blockDim.x + threadIdx.x) >> 6; if (w < M) d_ssq(P, w, threadIdx.x & 63); }

__device__ __forceinline__ void d_tok0(const Ptrs& P, int m, int lane) {
    const bf16_t* pr = (const bf16_t*)(P.ws + WS_PROJ0) + (size_t)m * N0P;
    bf16_t* q0 = (bf16_t*)(P.ws + WS_Q0) + (size_t)m * 512;
    bf16_t* k0 = (bf16_t*)(P.ws + WS_K0) + (size_t)m * 512;
    const float gq = P.in[12][lane], gk = P.in[13][lane];
#pragma unroll 1
    for (int g = 0; g < 8; ++g) {
        float q = bf2f(pr[C_Q + 64 * g + lane]), k = bf2f(pr[C_K + 64 * g + lane]);
        float sq = wave_sum(q * q), sk = wave_sum(k * k);
        float qn = q * rsqrtf(sq * (1.f / 64) + EPS) * gq, kn = k * rsqrtf(sk * (1.f / 64) + EPS) * gk;
        q0[64 * g + lane] = f2bf(qn * QSCALE);
        k0[64 * g + lane] = f2bf(kn);
        P.out[off_l0k(m) + 64 * g + lane] = kn;
        P.out[off_l0v(m) + 64 * g + lane] = bf2f(pr[C_V + 64 * g + lane]);
    }
    int last = -1; size_t so = 0;
    if (m == TP - 1) { last = 1; so = O_L0SH_P; }
    else if (m >= TP && ((m - TP) & 31) == 31) { last = 1; so = O_L0SH_S + (size_t)((m - TP) >> 5) * RWS; }
    if (last > 0) for (int c = lane; c < RWS; c += 64) P.out[so + c] = bf2f(pr[C_PRW + c]);
}
__global__ void k_tok0(Ptrs P) { int m = (blockIdx.x * blockDim.x + threadIdx.x) >> 6; if (m < M) d_tok0(P, m, threadIdx.x & 63); }

template <class SP> __device__ __forceinline__ void d_attn0(const Ptrs& P, int m, int h, int lane, SP sqw, SP spw) {
    const Tab* T = (const Tab*)(P.ws + WS_TAB);
    const bf16_t* Q0 = (const bf16_t*)(P.ws + WS_Q0); const bf16_t* K0 = (const bf16_t*)(P.ws + WS_K0);
    const bf16_t* PR = (const bf16_t*)(P.ws + WS_PROJ0);
    int qpos, nk, b = 0; bool samp = m >= TP;
    if (!samp) { qpos = m; nk = ((m >> 6) + 1) * 64; } else { b = (m - TP) >> 5; qpos = PAST + ((m - TP) & 31); nk = PAST + TS; }
    sqw[lane] = bf2f(Q0[(size_t)m * 512 + 128 * h + lane]);
    sqw[64 + lane] = bf2f(Q0[(size_t)m * 512 + 128 * h + 64 + lane]);
    float m1 = -1e30f, m2 = -1e30f, l1 = 0.f, l2 = 0.f, o1[2] = {0.f, 0.f}, o2[2] = {0.f, 0.f};
    for (int j0 = 0; j0 < nk; j0 += 64) {
        int j = j0 + lane;
        bool valid = j < nk && ((j >> 6) <= (qpos >> 6));
        float s1 = 0.f, s2 = 0.f;
        if (valid) {
            if (samp && j < PAST) {
                const float* kr = P.in[2] + (((size_t)b * PAST + j) * 4 + h) * 128;
                for (int d = 0; d < 64; ++d) { s1 += sqw[d] * bf2f(f2bf(kr[d])); s2 += sqw[64 + d] * bf2f(f2bf(kr[64 + d])); }
            } else {
                int km = samp ? TP + 32 * b + (j - PAST) : j;
                const bf16_t* kr = K0 + (size_t)km * 512 + 128 * h;
                for (int d = 0; d < 64; ++d) { s1 += sqw[d] * bf2f(kr[d]); s2 += sqw[64 + d] * bf2f(kr[64 + d]); }
            }
            int rel = j - qpos; float bias = rel <= -128 ? T->biasfar[h] : T->bias[h][rel + 191];
            s1 += bias * LOG2E; s2 += bias * LOG2E;
        } else { s1 = -1e30f; s2 = -1e30f; }
        float bm1 = wave_max(s1), bm2 = wave_max(s2);
        float n1 = fmaxf(m1, bm1), n2 = fmaxf(m2, bm2);
        float f1 = exp2f(m1 - n1), f2 = exp2f(m2 - n2);
        float p1 = valid ? exp2f(s1 - n1) : 0.f, p2 = valid ? exp2f(s2 - n2) : 0.f;
        l1 = l1 * f1 + wave_sum(p1); l2 = l2 * f2 + wave_sum(p2);
        o1[0] *= f1; o1[1] *= f1; o2[0] *= f2; o2[1] *= f2; m1 = n1; m2 = n2;
        spw[lane] = p1; spw[64 + lane] = p2;
        __builtin_amdgcn_s_waitcnt(0);
        int jn = min(64, nk - j0);
        for (int jj = 0; jj < jn; ++jj) {
            int jp = j0 + jj; float a1 = spw[jj], a2 = spw[64 + jj];
            float v0, v1;
            if (samp && jp < PAST) { const float* vr = P.in[3] + (((size_t)b * PAST + jp) * 4 + h) * 128; v0 = bf2f(f2bf(vr[lane])); v1 = bf2f(f2bf(vr[64 + lane])); }
            else { int km = samp ? TP + 32 * b + (jp - PAST) : jp; const bf16_t* vr = PR + (size_t)km * N0P + C_V + 128 * h; v0 = bf2f(vr[lane]); v1 = bf2f(vr[64 + lane]); }
            o1[0] += a1 * v0; o1[1] += a1 * v1; o2[0] += a2 * v0; o2[1] += a2 * v1;
        }
    }
    const float lam = T->lam;
    float a0 = o1[0] / l1 - lam * o2[0] / l2, a1 = o1[1] / l1 - lam * o2[1] / l2;
    float ss = wave_sum(a0 * a0 + a1 * a1);
    float r = rsqrtf(ss * (1.f / 128) + EPS) * (1.f - LAMBDA_INIT);
    const float* sg = P.in[18];
    const bf16_t* za = PR + (size_t)m * N0P + C_ZA + 128 * h;
    bf16_t* cat = (bf16_t*)(P.ws + WS_CAT) + (size_t)m * D + 128 * h;
    cat[lane] = f2bf(a0 * r * sg[lane] * silu(bf2f(za[lane])));
    cat[64 + lane] = f2bf(a1 * r * sg[64 + lane] * silu(bf2f(za[64 + lane])));
}
__global__ void __launch_bounds__(256) k_attn0(Ptrs P) {
    __shared__ float sq[4][128], sp[4][128];
    const int wid = threadIdx.x >> 6, lane = threadIdx.x & 63, gw = blockIdx.x * 4 + wid;
    if ((gw >> 2) < M) d_attn0(P, gw >> 2, gw & 3, lane, &sq[wid][0], &sp[wid][0]);
}

constexpr size_t RWN = (size_t)M * 512;
__device__ __forceinline__ float prw_prev(const Ptrs& P, int m, int c) {
    if (m < TP) return m == 0 ? 0.f : bf2f(((const bf16_t*)(P.ws + WS_PROJ0))[(size_t)(m - 1) * N0P + C_PRW + c]);
    int i = (m - TP) & 31, b = (m - TP) >> 5;
    if (i == 0) return P.in[4][(size_t)b * RWS + c];
    return bf2f(((const bf16_t*)(P.ws + WS_PROJ0))[(size_t)(m - 1) * N0P + C_PRW + c]);
}
template <class SP> __device__ __forceinline__ void d_rw_prep(const Ptrs& P, int m, int c, SP swl, SP sal) {
    const bf16_t* pr = (const bf16_t*)(P.ws + WS_PROJ0) + (size_t)m * N0P + C_PRW;
    const float* mu = P.in[19];
#define NV_MIX(col) (bf2f(pr[col]) + (prw_prev(P, m, (col)) - bf2f(pr[col])) * mu[col])
    float r = NV_MIX(c), kr = NV_MIX(512 + c), vr = NV_MIX(1024 + c);
    if (c < 64) swl[c] = tanhf(NV_MIX(1536 + c)); else if (c < 128) sal[c - 64] = NV_MIX(1600 + c - 64);
#undef NV_MIX
    __syncthreads();
    float wa = P.in[20][c], aa = P.in[22][c];
    const float* wup = P.in[21]; const float* aup = P.in[23];
#pragma unroll 4
    for (int l = 0; l < 64; ++l) { wa += swl[l] * wup[l * 512 + c]; aa += sal[l] * aup[l * 512 + c]; }
    float spl = (-wa > 20.f) ? -wa : log1pf(__expf(-wa));
    float w = -spl - 0.5f;
    float dec = __expf(-__expf(w));
    float a = 1.f / (1.f + __expf(-aa));
    float kk = kr * P.in[24][c];
    float n2 = wave_sum(kk * kk);
    kk = kk / fmaxf(sqrtf(n2), 1e-12f);
    float km = kr * (1.f + (a - 1.f) * P.in[25][c]);
    float* R = (float*)(P.ws + WS_RW);
    size_t o = (size_t)m * 512 + c;
    R[o] = r; R[RWN + o] = dec; R[2 * RWN + o] = kk; R[3 * RWN + o] = kk * a; R[4 * RWN + o] = km; R[5 * RWN + o] = vr;
}
__global__ void __launch_bounds__(512) k_rw_prep(Ptrs P) { __shared__ float swl[64], sal[64]; d_rw_prep(P, blockIdx.x, threadIdx.x, &swl[0], &sal[0]); }
__device__ __forceinline__ void d_rw_scan(const Ptrs& P, int seq, int h, int lane) {
    const int m0 = seq == 0 ? 0 : TP + 32 * (seq - 1), T = seq == 0 ? TP : TS;
    float S[64];
    const float* s0 = P.in[5] + (((size_t)(seq > 0 ? seq - 1 : 0) * 8 + h) * 64 + lane) * 64;
#pragma unroll
    for (int k = 0; k < 64; ++k) S[k] = seq == 0 ? 0.f : s0[k];
    const float* R = (const float*)(P.ws + WS_RW);
    const float rk = P.in[26][h * 64 + lane], lg = P.in[27][h * 64 + lane], lb = P.in[28][h * 64 + lane];
    for (int t = 0; t < T; ++t) {
        size_t o = (size_t)(m0 + t) * 512 + h * 64 + lane;
        float r = R[o], dec = R[RWN + o], kk = R[2 * RWN + o], kka = R[3 * RWN + o], km = R[4 * RWN + o], v = R[5 * RWN + o];
        float sa = 0.f;
#pragma unroll
        for (int k = 0; k < 64; ++k) sa += S[k] * __shfl(kk, k);
        float ov = 0.f;
#pragma unroll
        for (int k = 0; k < 64; ++k) { S[k] = S[k] * __shfl(dec, k) - sa * __shfl(kka, k) + v * __shfl(km, k); ov += S[k] * __shfl(r, k); }
        float mu = wave_sum(ov) * (1.f / 64);
        float dv = ov - mu;
        float var = wave_sum(dv * dv) * (1.f / 64);
        float y = dv * rsqrtf(var + GN_EPS) * lg + lb;
        float bonus = wave_sum(r * km * rk) * v;
        int mm = m0 + t;
        float zb = bf2f(((const bf16_t*)(P.ws + WS_PROJ0))[(size_t)mm * N0P + C_ZB + h * 64 + lane]);
        ((bf16_t*)(P.ws + WS_CAT))[(size_t)mm * D + 512 + h * 64 + lane] = f2bf((y + bonus) * silu(zb));
    }
    float* so = P.out + (seq == 0 ? O_L0WKV_P + ((size_t)h * 64 + lane) * 64 : O_L0WKV_S + ((((size_t)(seq - 1)) * 8 + h) * 64 + lane) * 64);
#pragma unroll
    for (int k = 0; k < 64; ++k) so[k] = S[k];
}
__global__ void __launch_bounds__(64) k_rw_scan(Ptrs P) { d_rw_scan(P, blockIdx.x >> 3, blockIdx.x & 7, threadIdx.x); }

template <class SP> __device__ __forceinline__ void d_attn1(const Ptrs& P, int m, int h, int lane, SP sqw, SP saw) {
    const bf16_t* Q1 = (const bf16_t*)(P.ws + WS_Q1); const bf16_t* K1 = (const bf16_t*)(P.ws + WS_K1);
    const bf16_t* V1T = (const bf16_t*)(P.ws + WS_V1T);
    bool samp = m >= TP; int b = 0, qpos;
    if (!samp) qpos = m; else { b = (m - TP) >> 5; qpos = PAST + ((m - TP) & 31); }
    sqw[lane] = bf2f(Q1[(size_t)m * D + 64 * h + lane]);
    float run = 0.f, o = 0.f;
    for (int s0 = qpos - 1; s0 >= 0; s0 -= 64) {
        int s = s0 - lane;
        bool valid = s >= 0;
        float z = 0.f;
        if (valid) {
            if (samp && s < PAST) { const float* kr = P.in[6] + (((size_t)b * PAST + s) * 16 + h) * 64; for (int d = 0; d < 64; ++d) z += sqw[d] * bf2f(f2bf(kr[d])); }
            else { int km = samp ? TP + 32 * b + (s - PAST) : s; const bf16_t* kr = K1 + (size_t)km * D + 64 * h; for (int d = 0; d < 64; ++d) z += sqw[d] * bf2f(kr[d]); }
        }
        float spl = valid ? log2f(1.f + exp2f(z)) : 0.f;
        float inc = spl;
#pragma unroll
        for (int off = 1; off < 64; off <<= 1) { float t = __shfl_up(inc, off); if (lane >= off) inc += t; }
        float a = valid ? exp2f(z - inc - run) : 0.f;
        saw[lane] = a;
        run += __shfl(inc, 63);
        __builtin_amdgcn_s_waitcnt(0);
        int jn = min(64, s0 + 1);
        for (int jj = 0; jj < jn; ++jj) {
            int sp_ = s0 - jj; float v;
            if (samp && sp_ < PAST) v = bf2f(f2bf(P.in[7][(((size_t)b * PAST + sp_) * 16 + h) * 64 + lane]));
            else { int km = samp ? TP + 32 * b + (sp_ - PAST) : sp_; v = bf2f(V1T[(size_t)(64 * h + lane) * M + km]); }
            o += saw[jj] * v;
        }
        if (run > 200.f) break;
    }
    float z1 = bf2f(((const bf16_t*)(P.ws + WS_Z1))[(size_t)m * D + 64 * h + lane]);
    ((bf16_t*)(P.ws + WS_O1B))[(size_t)m * D + 64 * h + lane] = f2bf(o * silu(z1));
}
__global__ void __launch_bounds__(256) k_attn1(Ptrs P) {
    __shared__ float sq[4][64], sa[4][64];
    const int wid = threadIdx.x >> 6, lane = threadIdx.x & 63, gw = blockIdx.x * 4 + wid;
    if ((gw >> 4) < M) d_attn1(P, gw >> 4, gw & 15, lane, &sq[wid][0], &sa[wid][0]);
}

}
namespace pg8 {
#define PG8_LAS __attribute__((address_space(3)))
typedef unsigned short bf16_t;
typedef short bf16x8 __attribute__((ext_vector_type(8)));
typedef float f32x4 __attribute__((ext_vector_type(4)));
typedef unsigned u32x4 __attribute__((ext_vector_type(4)));
constexpr int BM = 256, BK = 64, HALF = 128, HTB = HALF * BK * 2  , STAGE_BYTES = 8 * HTB, NXCD = 8, WGM = 8;

__host__ __device__ __forceinline__ int lds_byte(int r, int c) { const int st = (r >> 4) * 2 + (c >> 5), rr = r & 15, cc = c & 31, ob = rr * 64 + cc * 2; return st * 1024 + (ob ^ (((ob >> 9) & 1) << 5)); }
__host__ __device__ __forceinline__ void stage_rc(int b, int& R, int& C) { const int st = b / 1024, sb = b % 1024, swz = sb ^ (((sb >> 9) & 1) << 5); R = (st >> 1) * 16 + swz / 64; C = (st & 1) * 32 + (swz % 64) / 2; }
__host__ __device__ __forceinline__ int perm32(int rho) { const int n = rho >> 4, i = rho & 15; return 8 * (i >> 2) + 4 * n + (i & 3); }

struct Unit { int pm, pn; };
struct Gemm { const bf16_t* A; const bf16_t* Bt; int M, N, K; };

struct StaticOrder {
    int nM, nN, nwg, G, c;
    __host__ __device__ void init(int M, int N, int G_, int c_) { nM = M / BM; nN = N / BM; nwg = nM * nN; G = G_; c = c_; }
    __host__ __device__ bool next(int i, Unit& u) const {
        const long L = (long)i * G + c; if (L >= nwg) return false;
        int wgid = (int)L; { const int q = nwg / NXCD, r = nwg % NXCD, xcd = wgid % NXCD, off = wgid / NXCD; wgid = (xcd < r ? xcd * (q + 1) : r * (q + 1) + (xcd - r) * q) + off; }
        const int nig = WGM * nN, gid = wgid / nig, fm = gid * WGM, gsz = (nM - fm) < WGM ? (nM - fm) : WGM;
        u.pm = fm + ((wgid % nig) % gsz); u.pn = (wgid % nig) / gsz; return true;
    }
    __device__ __forceinline__ void a_ready(const Unit&) const {}
    __device__ __forceinline__ void done(const Unit&) const {}
};


__device__ __forceinline__ unsigned cvt_pk_bf16(float lo, float hi) { unsigned r; asm volatile("v_cvt_pk_bf16_f32 %0, %1, %2" : "=v"(r) : "v"(lo), "v"(hi)); return r; }
__device__ __forceinline__ u32x4 pack8(const f32x4& v0, const f32x4& v1) { u32x4 w; w.x = cvt_pk_bf16(v0[0], v0[1]); w.y = cvt_pk_bf16(v0[2], v0[3]); w.z = cvt_pk_bf16(v1[0], v1[1]); w.w = cvt_pk_bf16(v1[2], v1[3]); return w; }

struct EpiProj0F {
    static constexpr bool PERM = true, AFTER_DRAIN = false;
    bf16_t* O;
    __device__ __forceinline__ void operator()(const f32x4 (&acc)[2][2][4][2], const Unit& u, int wr, int wc, int fr, int fq) const {
        const int row0 = u.pm * BM + wr * 64 + fr, col0 = u.pn * BM + wc * 32 + 8 * fq;
#pragma unroll
        for (int ai = 0; ai < 2; ++ai)
#pragma unroll
            for (int m = 0; m < 4; ++m) { bf16_t* rowp = O + (size_t)(row0 + ai * HALF + m * 16) * N0P + col0;
#pragma unroll
                for (int bj = 0; bj < 2; ++bj) *(u32x4*)(rowp + bj * HALF) = pack8(acc[ai][bj][m][0], acc[ai][bj][m][1]); }
    }
};
struct EpiY0F {
    static constexpr bool PERM = true, AFTER_DRAIN = false;
    Ptrs P;
    __device__ __forceinline__ void operator()(const f32x4 (&acc)[2][2][4][2], const Unit& u, int wr, int wc, int fr, int fq) const {
        const int row0 = u.pm * BM + wr * 64 + fr, col0 = u.pn * BM + wc * 32 + 8 * fq;
        float* Y0 = (float*)(P.ws + WS_Y0); bf16_t* YB = (bf16_t*)(P.ws + WS_Y0B); float* SSQ = (float*)(P.ws + WS_SSQ);
#pragma unroll
        for (int ai = 0; ai < 2; ++ai)
#pragma unroll
            for (int m = 0; m < 4; ++m) { const int row = row0 + ai * HALF + m * 16; const float* xr = xrow(P, row) + col0; float ss = 0.f;
#pragma unroll
                for (int bj = 0; bj < 2; ++bj) {
                    const f32x4 y0 = acc[ai][bj][m][0] + *(const f32x4*)(xr + bj * HALF), y1 = acc[ai][bj][m][1] + *(const f32x4*)(xr + bj * HALF + 4);
                    *(f32x4*)(Y0 + (size_t)row * D + col0 + bj * HALF) = y0; *(f32x4*)(Y0 + (size_t)row * D + col0 + bj * HALF + 4) = y1;
                    *(u32x4*)(YB + (size_t)row * D + col0 + bj * HALF) = pack8(y0, y1);
                    ss += (y0[0] * y0[0] + y0[1] * y0[1]) + (y0[2] * y0[2] + y0[3] * y0[3]) + (y1[0] * y1[0] + y1[1] * y1[1]) + (y1[2] * y1[2] + y1[3] * y1[3]); }
                ss += __shfl_xor(ss, 16); ss += __shfl_xor(ss, 32);
                if (fq == 0) SSQ[(size_t)row * 16 + u.pn * 4 + wc] = ss; }
    }
};
struct EpiL1F {
    static constexpr bool PERM = true, AFTER_DRAIN = false;
    Ptrs P;
    __device__ __forceinline__ void operator()(const f32x4 (&acc)[2][2][4][2], const Unit& u, int wr, int wc, int fr, int fq) const {
        const int row0 = u.pm * BM + wr * 64 + fr, colt = u.pn * BM, reg = colt >> 10, c0 = (colt & 1023) + wc * 32 + 8 * fq;
        const float* SSQ = (const float*)(P.ws + WS_SSQ);
#pragma unroll
        for (int ai = 0; ai < 2; ++ai)
#pragma unroll
            for (int m = 0; m < 4; ++m) { const int row = row0 + ai * HALF + m * 16;
                const f32x4* sp = (const f32x4*)(SSQ + (size_t)row * 16); const f32x4 s0 = sp[0], s1 = sp[1], s2 = sp[2], s3 = sp[3];
                const f32x4 st = (s0 + s1) + (s2 + s3); const float rs = rsqrtf(((st[0] + st[1]) + (st[2] + st[3])) * (1.f / D) + EPS);
#pragma unroll
                for (int bj = 0; bj < 2; ++bj) { const int c = c0 + bj * HALF; f32x4 v0 = acc[ai][bj][m][0] * rs, v1 = acc[ai][bj][m][1] * rs;
                    if (reg == 0) { *(u32x4*)((bf16_t*)(P.ws + WS_Q1) + (size_t)row * D + c) = pack8(v0 * QSCALE, v1 * QSCALE); }
                    else if (reg == 1) { *(u32x4*)((bf16_t*)(P.ws + WS_K1) + (size_t)row * D + c) = pack8(v0, v1); float* o = P.out + off_l1k(row) + c; *(f32x4*)o = v0; *(f32x4*)(o + 4) = v1; }
                    else if (reg == 2) { bf16_t* vt = (bf16_t*)(P.ws + WS_V1T) + (size_t)c * M + row;
#pragma unroll
                        for (int j = 0; j < 4; ++j) { vt[(size_t)j * M] = f2bf(v0[j]); vt[(size_t)(4 + j) * M] = f2bf(v1[j]); }
                        float* o = P.out + off_l1v(row) + c; *(f32x4*)o = v0; *(f32x4*)(o + 4) = v1; }
                    else { *(u32x4*)((bf16_t*)(P.ws + WS_Z1) + (size_t)row * D + c) = pack8(v0, v1); } } }
    }
};
struct EpiOutF {
    static constexpr bool PERM = true, AFTER_DRAIN = false;
    Ptrs P;
    __device__ __forceinline__ void operator()(const f32x4 (&acc)[2][2][4][2], const Unit& u, int wr, int wc, int fr, int fq) const {
        const int row0 = u.pm * BM + wr * 64 + fr, col0 = u.pn * BM + wc * 32 + 8 * fq;
        const float* Y0 = (const float*)(P.ws + WS_Y0);
#pragma unroll
        for (int ai = 0; ai < 2; ++ai)
#pragma unroll
            for (int m = 0; m < 4; ++m) { const size_t ro = (size_t)(row0 + ai * HALF + m * 16) * D + col0;
#pragma unroll
                for (int bj = 0; bj < 2; ++bj) {
                    *(f32x4*)(P.out + O_Y + ro + bj * HALF) = acc[ai][bj][m][0] + *(const f32x4*)(Y0 + ro + bj * HALF);
                    *(f32x4*)(P.out + O_Y + ro + bj * HALF + 4) = acc[ai][bj][m][1] + *(const f32x4*)(Y0 + ro + bj * HALF + 4); } }
    }
};
template <class Epi, class Sched, bool ALIGN_EPI = false, bool SP2 = false>
__device__ __forceinline__ void gemm_phase(PG8_LAS unsigned char* lds, const Gemm g, const Sched& S, const Epi& E) {
    const int tid = threadIdx.x, wid = __builtin_amdgcn_readfirstlane(tid >> 6), lane = tid & 63, wr = wid >> 2, wc = wid & 3, fr = lane & 15, fq = lane >> 4;
    const int K = g.K, nt = K / BK;
    unsigned voffA[2], voffB[2];
#pragma unroll
    for (int i = 0; i < 2; ++i) { int R, C; stage_rc(tid * 16 + i * 8192, R, C); const int Rb = Epi::PERM ? ((R & ~31) + perm32(R & 31)) : R;
        voffA[i] = (unsigned)(R * K + C) * 2u; voffB[i] = (unsigned)(Rb * K + C) * 2u; }
    const size_t kstep = (size_t)(BK * 2);
    const size_t hstep = (size_t)HALF * K * 2;
    const size_t tstep = 2 * hstep;
    const unsigned ldsw = (unsigned)wid * 1024u;
    const int aoff = lds_byte(wr * 64 + fr, fq * 8), boff = lds_byte(wc * 32 + fr, fq * 8);
#define PG8_SA(b, h) (((b) * 2 + (h)) * HTB)
#define PG8_SB(b, h) ((4 + (b) * 2 + (h)) * HTB)
#define PG8_STAGE(bufoff, gbase, voff) do { _Pragma("unroll") for (int _i = 0; _i < 2; ++_i) \
        __builtin_amdgcn_global_load_lds((const unsigned*)((const char*)(gbase) + (voff)[_i]), (PG8_LAS unsigned*)(lds + (bufoff) + ldsw + _i * 8192), 16, 0, 0); } while (0)
#define PG8_LDA(dst, b, h) do { _Pragma("unroll") for (int m = 0; m < 4; ++m) _Pragma("unroll") for (int k = 0; k < 2; ++k) dst[m][k] = *(const PG8_LAS bf16x8*)(lds + PG8_SA(b, h) + aoff + m * 2048 + k * 1024); } while (0)
#define PG8_LDB(dst, b, h) do { _Pragma("unroll") for (int n = 0; n < 2; ++n) _Pragma("unroll") for (int k = 0; k < 2; ++k) dst[n][k] = *(const PG8_LAS bf16x8*)(lds + PG8_SB(b, h) + boff + n * 2048 + k * 1024); } while (0)
#define PG8_MMA(ai, bj, At, Bt) do { __builtin_amdgcn_s_setprio(1); _Pragma("unroll") for (int m = 0; m < 4; ++m) _Pragma("unroll") for (int n = 0; n < 2; ++n) _Pragma("unroll") for (int k = 0; k < 2; ++k) \
        acc[ai][bj][m][n] = __builtin_amdgcn_mfma_f32_16x16x32_bf16(Bt[n][k], At[m][k], acc[ai][bj][m][n], 0, 0, 0); __builtin_amdgcn_s_setprio(0); } while (0)
#define PG8_WAIT_V(n) asm volatile("s_waitcnt vmcnt(" #n ")" ::: "memory")
#define PG8_WAIT_L(n) asm volatile("s_waitcnt lgkmcnt(" #n ")" ::: "memory")
#define PG8_BAR __builtin_amdgcn_s_barrier()
#define PG8_SCHED __builtin_amdgcn_sched_barrier(0)
    Unit cur, nxt; int ui = 0;
    if (!S.next(0, cur)) return;
    f32x4 acc[2][2][4][2];
#pragma unroll
    for (int a = 0; a < 2; ++a)
#pragma unroll
        for (int b = 0; b < 2; ++b)
#pragma unroll
            for (int m = 0; m < 4; ++m)
#pragma unroll
                for (int n = 0; n < 2; ++n) acc[a][b][m][n] = (f32x4){0.f, 0.f, 0.f, 0.f};
    bf16x8 At[4][2], B0[2][2], B1[2][2];
    const char* cA = (const char*)g.A + (size_t)cur.pm * tstep; const char* cB = (const char*)g.Bt + (size_t)cur.pn * tstep;
    S.a_ready(cur);
    if constexpr (SP2) {
        PG8_STAGE(PG8_SB(0, 0), cB, voffB); PG8_STAGE(PG8_SB(0, 1), cB + hstep, voffB); PG8_STAGE(PG8_SA(0, 0), cA, voffA); PG8_STAGE(PG8_SA(0, 1), cA + hstep, voffA);
        if (wr == 1) PG8_BAR;
        PG8_WAIT_V(2); PG8_BAR;
        PG8_STAGE(PG8_SB(1, 0), cB + kstep, voffB); PG8_STAGE(PG8_SA(1, 0), cA + kstep, voffA); PG8_STAGE(PG8_SB(1, 1), cB + hstep + kstep, voffB);
        PG8_WAIT_V(6); PG8_BAR;
    } else {
        PG8_STAGE(PG8_SB(0, 0), cB, voffB); PG8_STAGE(PG8_SA(0, 0), cA, voffA); PG8_STAGE(PG8_SB(0, 1), cB + hstep, voffB); PG8_STAGE(PG8_SA(0, 1), cA + hstep, voffA);
        if (wr == 1) PG8_BAR;
        PG8_WAIT_V(4); PG8_BAR;
        PG8_STAGE(PG8_SB(1, 0), cB + kstep, voffB); PG8_STAGE(PG8_SA(1, 0), cA + kstep, voffA); PG8_STAGE(PG8_SB(1, 1), cB + hstep + kstep, voffB);
        PG8_WAIT_V(6); PG8_BAR;
    }
    for (;;) {
        const bool has_next = S.next(ui + 1, nxt);
        const char* nA = has_next ? (const char*)g.A + (size_t)nxt.pm * tstep : cA; const char* nB = has_next ? (const char*)g.Bt + (size_t)nxt.pn * tstep : cB;
        for (int t = 0; t < nt; t += 2) {
            const bool last = (t == nt - 2);
            const char* a1 = cA + (size_t)(t + 1) * kstep;
            const char* a2 = last ? nA : cA + (size_t)(t + 2) * kstep; const char* b2 = last ? nB : cB + (size_t)(t + 2) * kstep;
            const char* a3 = a2 + kstep; const char* b3 = b2 + kstep;
            if (last && has_next) S.a_ready(nxt);
            if constexpr (SP2) {
            PG8_LDB(B0, 0, 0); PG8_LDB(B1, 0, 1); PG8_SCHED; PG8_LDA(At, 0, 0); PG8_STAGE(PG8_SA(1, 1), a1 + hstep, voffA);
            PG8_WAIT_V(8); PG8_WAIT_L(0); PG8_BAR; PG8_MMA(0, 0, At, B0); PG8_MMA(0, 1, At, B1); PG8_BAR; PG8_SCHED;
            PG8_LDA(At, 0, 1); PG8_STAGE(PG8_SB(0, 0), b2, voffB); PG8_STAGE(PG8_SB(0, 1), b2 + hstep, voffB); PG8_STAGE(PG8_SA(0, 0), a2, voffA);
            PG8_WAIT_V(8); PG8_WAIT_L(0); PG8_BAR; PG8_MMA(1, 0, At, B0); PG8_MMA(1, 1, At, B1); PG8_BAR; PG8_SCHED;
            PG8_LDB(B0, 1, 0); PG8_LDB(B1, 1, 1); PG8_SCHED; PG8_LDA(At, 1, 0); PG8_STAGE(PG8_SA(0, 1), a2 + hstep, voffA);
            PG8_WAIT_V(8); PG8_WAIT_L(0); PG8_BAR; PG8_MMA(0, 0, At, B0); PG8_MMA(0, 1, At, B1); PG8_BAR; PG8_SCHED;
            PG8_LDA(At, 1, 1); PG8_STAGE(PG8_SB(1, 0), b3, voffB); PG8_STAGE(PG8_SB(1, 1), b3 + hstep, voffB); PG8_STAGE(PG8_SA(1, 0), a3, voffA);
            PG8_WAIT_V(8); PG8_WAIT_L(0); PG8_BAR; PG8_MMA(1, 0, At, B0); PG8_MMA(1, 1, At, B1); PG8_BAR; PG8_SCHED;
            } else {
            PG8_LDB(B0, 0, 0); PG8_SCHED; PG8_LDA(At, 0, 0); PG8_STAGE(PG8_SA(1, 1), a1 + hstep, voffA);
            PG8_WAIT_L(8); PG8_BAR; PG8_WAIT_L(0); PG8_MMA(0, 0, At, B0); PG8_BAR; PG8_SCHED;
            PG8_LDB(B1, 0, 1); PG8_STAGE(PG8_SB(0, 0), b2, voffB);
            PG8_BAR; PG8_WAIT_L(0); PG8_MMA(0, 1, At, B1); PG8_BAR;
            PG8_LDA(At, 0, 1); PG8_STAGE(PG8_SA(0, 0), a2, voffA);
            PG8_BAR; PG8_WAIT_L(0); PG8_MMA(1, 0, At, B0); PG8_BAR; PG8_SCHED;
            PG8_STAGE(PG8_SB(0, 1), b2 + hstep, voffB);
            PG8_WAIT_V(6); PG8_BAR; PG8_MMA(1, 1, At, B1); PG8_BAR;
            PG8_LDB(B0, 1, 0); PG8_SCHED; PG8_LDA(At, 1, 0); PG8_STAGE(PG8_SA(0, 1), a2 + hstep, voffA);
            PG8_WAIT_L(8); PG8_BAR; PG8_WAIT_L(0); PG8_MMA(0, 0, At, B0); PG8_BAR; PG8_SCHED;
            PG8_LDB(B1, 1, 1); PG8_STAGE(PG8_SB(1, 0), b3, voffB);
            PG8_BAR; PG8_WAIT_L(0); PG8_MMA(0, 1, At, B1); PG8_BAR;
            PG8_LDA(At, 1, 1); PG8_STAGE(PG8_SA(1, 0), a3, voffA);
            PG8_BAR; PG8_WAIT_L(0); PG8_MMA(1, 0, At, B0); PG8_BAR; PG8_SCHED;
            PG8_STAGE(PG8_SB(1, 1), b3 + hstep, voffB);
            PG8_WAIT_V(6); PG8_BAR; PG8_MMA(1, 1, At, B1); PG8_BAR;
            }
        }
        if constexpr (ALIGN_EPI) { if (wr == 0) PG8_BAR; }
        if constexpr (!Epi::AFTER_DRAIN) { E(acc, cur, wr, wc, fr, fq); S.done(cur); }
        if (!has_next) break;
#pragma unroll
        for (int a = 0; a < 2; ++a)
#pragma unroll
            for (int b = 0; b < 2; ++b)
#pragma unroll
                for (int m = 0; m < 4; ++m)
#pragma unroll
                    for (int n = 0; n < 2; ++n) acc[a][b][m][n] = (f32x4){0.f, 0.f, 0.f, 0.f};
        cur = nxt; cA = nA; cB = nB; ++ui;
        if constexpr (ALIGN_EPI) { if (wr == 1) PG8_BAR; }
    }
    PG8_WAIT_V(0);
    if constexpr (!ALIGN_EPI) { if (wr == 0) PG8_BAR; }
    PG8_BAR;
    if constexpr (Epi::AFTER_DRAIN) { E.fused(acc, cur, wr, wc, fr, fq, lds, wid, lane); S.done(cur); }
#undef PG8_SA
#undef PG8_SB
#undef PG8_STAGE
#undef PG8_LDA
#undef PG8_LDB
#undef PG8_MMA
#undef PG8_WAIT_V
#undef PG8_WAIT_L
#undef PG8_BAR
#undef PG8_SCHED
}
}
namespace da {
#define DLAS __attribute__((address_space(3)))
typedef short bf16x8 __attribute__((ext_vector_type(8)));
typedef short s16x4 __attribute__((ext_vector_type(4)));
typedef float f32x16 __attribute__((ext_vector_type(16)));
typedef float f32x4 __attribute__((ext_vector_type(4)));
typedef unsigned u32x4 __attribute__((ext_vector_type(4)));

constexpr int KROW = 272, KBUF = 64 * KROW, VBUF = 16384;
constexpr int OFF_K = 0, OFF_V = 2 * KBUF;
constexpr int OFF_STAGE = 0;
constexpr int OFF_LST = 131072;
constexpr int OFF_BIAS = OFF_LST + 1024;
constexpr int DA_LDS_END = OFF_BIAS + 1024;

struct Unit { int kind, h, idx; };

__device__ __forceinline__ unsigned cvtpk(float lo, float hi) { unsigned r; asm volatile("v_cvt_pk_bf16_f32 %0, %1, %2" : "=v"(r) : "v"(lo), "v"(hi)); return r; }
__device__ __forceinline__ u32x4 pack8(const f32x4& a, const f32x4& b) { u32x4 w; w.x = cvtpk(a[0], a[1]); w.y = cvtpk(a[2], a[3]); w.z = cvtpk(b[0], b[1]); w.w = cvtpk(b[2], b[3]); return w; }

struct Stage { f32x4 kA0, kA1, vA0, vA1, kB0, kB1, vB0, vB1; };
template <int KIND> __device__ __forceinline__ void chunk_issue(const Ptrs& P, const Unit& u, int t, int c, f32x4& k0, f32x4& k1, f32x4& v0, f32x4& v1) {
    const int row = c >> 4, ch = c & 15;
    if (KIND == 0 || t == 16) {
        const int m = (KIND == 0) ? 64 * t + row : TP + 32 * u.idx + (row & 31);
        const bf16_t* kp = (const bf16_t*)(P.ws + WS_K0) + (size_t)m * 512 + 128 * u.h + ch * 8;
        const bf16_t* vp = (const bf16_t*)(P.ws + WS_PROJ0) + (size_t)m * N0P + C_V + 128 * u.h + ch * 8;
        f32x4 kv = *(const f32x4*)kp, vv = *(const f32x4*)vp;
        if (KIND != 0 && row >= 32) { kv = (f32x4){0.f, 0.f, 0.f, 0.f}; vv = kv; }
        k0 = kv; v0 = vv;
    } else {
        const size_t ro = (((size_t)u.idx * PAST + 64 * t + row) * 4 + u.h) * 128 + ch * 8;
        const float* kp = P.in[2] + ro; const float* vp = P.in[3] + ro;
        k0 = *(const f32x4*)kp; k1 = *(const f32x4*)(kp + 4); v0 = *(const f32x4*)vp; v1 = *(const f32x4*)(vp + 4);
    }
}
template <int KIND> __device__ __forceinline__ void chunk_write(int t, int c, DLAS unsigned char* lds, int buf, const f32x4& k0, const f32x4& k1, const f32x4& v0, const f32x4& v1) {
    const int row = c >> 4, ch = c & 15;
    DLAS unsigned char* kd = lds + OFF_K + buf * KBUF + row * KROW + ch * 16;
    DLAS unsigned char* vd = lds + OFF_V + buf * VBUF + (ch >> 2) * 4096 + row * 64 + (ch & 3) * 16;
    if (KIND == 0 || t == 16) { *(DLAS f32x4*)kd = k0; *(DLAS f32x4*)vd = v0; }
    else { *(DLAS u32x4*)kd = pack8(k0, k1); *(DLAS u32x4*)vd = pack8(v0, v1); }
}
#define TILE_ISSUE(t_) do { chunk_issue<KIND>(P, u, (t_), tid, S.kA0, S.kA1, S.vA0, S.vA1); chunk_issue<KIND>(P, u, (t_), tid + 512, S.kB0, S.kB1, S.vB0, S.vB1); } while (0)
#define TILE_WRITE(t_, buf_) do { chunk_write<KIND>((t_), tid, lds, (buf_), S.kA0, S.kA1, S.vA0, S.vA1); chunk_write<KIND>((t_), tid + 512, lds, (buf_), S.kB0, S.kB1, S.vB0, S.vB1); } while (0)

template <int KIND> __device__ __forceinline__ void unit_run(const Ptrs& P, const Unit& u0, DLAS unsigned char* lds, int tid) {
    const Unit u{KIND, u0.h, u0.idx};
    const int lane = tid & 63, wave = __builtin_amdgcn_readfirstlane(tid >> 6), r32 = lane & 31, hi = lane >> 5, mp = wave >> 2, w4 = wave & 3;
    constexpr bool is_s = KIND != 0;
    int m0row, qpos0, NT, cq;
    if (!is_s) { m0row = 128 * u.idx + 32 * w4; qpos0 = m0row; NT = 2 * u.idx + 2; cq = m0row >> 6; }
    else { m0row = TP + 32 * u.idx; qpos0 = PAST; NT = 17; cq = 16; }
    const Tab* T = (const Tab*)(P.ws + WS_TAB);
    DLAS float* lst = (DLAS float*)(lds + OFF_LST);
    DLAS float* bl = (DLAS float*)(lds + OFF_BIAS);
    if (tid < 256) { bl[tid] = (T->bias[u.h][tid] - T->biasfar[u.h]) * LOG2E; lst[tid] = 0.f; }
    bf16x8 qf[4];
    { const bf16_t* qp = (const bf16_t*)(P.ws + WS_Q0) + (size_t)(m0row + r32) * 512 + 128 * u.h + 64 * mp + 8 * hi;
#pragma unroll
      for (int s = 0; s < 4; ++s) qf[s] = *(const bf16x8*)(qp + 16 * s); }
    f32x16 o[4];
#pragma unroll
    for (int d = 0; d < 4; ++d)
#pragma unroll
        for (int r = 0; r < 16; ++r) o[d][r] = 0.f;
    float lsum = 0.f;
    Stage S;
    { const f32x4 z = (f32x4){0.f, 0.f, 0.f, 0.f}; S.kA0 = z; S.kA1 = z; S.vA0 = z; S.vA1 = z; S.kB0 = z; S.kB1 = z; S.vB0 = z; S.vB1 = z; }
    TILE_ISSUE(0);
    TILE_WRITE(0, 0);
    __syncthreads();
    const int vaddr = (4 * hi + ((lane & 15) >> 2)) * 64 + (16 * ((lane >> 4) & 1) + 4 * (lane & 3)) * 2;
    for (int t = 0; t < NT; ++t) {
        const int buf = t & 1;
        const bool has_next = t + 1 < NT;
        if (has_next) TILE_ISSUE(t + 1);
        const bool active = is_s ? ((t & 3) == w4) : (t <= cq);
        if (active) {
            const DLAS unsigned char* kb = lds + OFF_K + buf * KBUF + r32 * KROW + mp * 128 + hi * 16;
            f32x16 p0, p1;
#pragma unroll
            for (int r = 0; r < 16; ++r) { p0[r] = 0.f; p1[r] = 0.f; }
#pragma unroll
            for (int s = 0; s < 4; ++s) {
                const bf16x8 a0 = *(const DLAS bf16x8*)(kb + s * 32), a1 = *(const DLAS bf16x8*)(kb + 32 * KROW + s * 32);
                p0 = __builtin_amdgcn_mfma_f32_32x32x16_bf16(a0, qf[s], p0, 0, 0, 0);
                p1 = __builtin_amdgcn_mfma_f32_32x32x16_bf16(a1, qf[s], p1, 0, 0, 0);
            }
            if (t >= cq - 2) {
                const int rb = 64 * t - qpos0 - r32 + 191 + 4 * hi;
#pragma unroll
                for (int r = 0; r < 16; ++r) { const int kk = (r & 3) + 8 * (r >> 2); p0[r] += bl[rb + kk]; p1[r] += bl[rb + 32 + kk]; }
            }
#pragma unroll
            for (int r = 0; r < 16; ++r) { p0[r] = __builtin_amdgcn_exp2f(p0[r]); p1[r] = __builtin_amdgcn_exp2f(p1[r]); }
            if (is_s && t == 16) {
#pragma unroll
                for (int r = 0; r < 16; ++r) p1[r] = 0.f;
            }
            float sa = 0.f, sb = 0.f;
#pragma unroll
            for (int r = 0; r < 16; ++r) { sa += p0[r]; sb += p1[r]; }
            lsum += sa + sb;
            bf16x8 pa[4];
            pa[0] = __builtin_bit_cast(bf16x8, pack8((f32x4){p0[0], p0[1], p0[2], p0[3]}, (f32x4){p0[4], p0[5], p0[6], p0[7]}));
            pa[1] = __builtin_bit_cast(bf16x8, pack8((f32x4){p0[8], p0[9], p0[10], p0[11]}, (f32x4){p0[12], p0[13], p0[14], p0[15]}));
            pa[2] = __builtin_bit_cast(bf16x8, pack8((f32x4){p1[0], p1[1], p1[2], p1[3]}, (f32x4){p1[4], p1[5], p1[6], p1[7]}));
            pa[3] = __builtin_bit_cast(bf16x8, pack8((f32x4){p1[8], p1[9], p1[10], p1[11]}, (f32x4){p1[12], p1[13], p1[14], p1[15]}));
            const DLAS unsigned char* vb = lds + OFF_V + buf * VBUF + vaddr;
#pragma unroll
            for (int d = 0; d < 4; ++d)
#pragma unroll
                for (int k = 0; k < 4; ++k) {
                    const s16x4 lo = __builtin_bit_cast(s16x4, __builtin_amdgcn_ds_read_tr16_b64_v4i16((DLAS s16x4*)(vb + d * 4096 + k * 1024)));
                    const s16x4 hh = __builtin_bit_cast(s16x4, __builtin_amdgcn_ds_read_tr16_b64_v4i16((DLAS s16x4*)(vb + d * 4096 + k * 1024 + 512)));
                    const bf16x8 bf = (bf16x8){lo[0], lo[1], lo[2], lo[3], hh[0], hh[1], hh[2], hh[3]};
                    o[d] = __builtin_amdgcn_mfma_f32_32x32x16_bf16(pa[k], bf, o[d], 0, 0, 0);
                    if (k == 3) __builtin_amdgcn_sched_barrier(0);
                }
        }
        if (has_next) TILE_WRITE(t + 1, buf ^ 1);
        __syncthreads();
    }
    lsum += __shfl_xor(lsum, 32);
    DLAS float* stage = (DLAS float*)(lds + OFF_STAGE);
    {
        const int rowb = is_s ? 0 : 32 * w4;
        DLAS float* st0 = stage + (mp * 128 + rowb + 4 * hi) * 128 + r32;
#pragma unroll 1
        for (int round = 0; round < (is_s ? 4 : 1); ++round) {
            if (!is_s || round == w4) {
                const bool first = !is_s || round == 0;
#pragma unroll
                for (int d = 0; d < 4; ++d)
#pragma unroll
                    for (int r = 0; r < 16; ++r) {
                        DLAS float* st = st0 + ((r & 3) + 8 * (r >> 2)) * 128 + d * 32;
                        *st = first ? o[d][r] : *st + o[d][r];
                    }
                if (hi == 0) { DLAS float* lp = &lst[mp * 128 + rowb + r32]; *lp = first ? lsum : *lp + lsum; }
            }
            __syncthreads();
        }
    }
    {
        const int nrow = is_s ? 4 : 16;
        const float lam = T->lam;
        const float* sg = P.in[18];
        for (int i = 0; i < nrow; ++i) {
            const int row = wave * nrow + i;
            const float l1 = lst[row], l2 = lst[128 + row];
            const float il1 = 1.f / l1, il2 = lam / l2;
            const float a0 = stage[row * 128 + lane] * il1 - stage[(128 + row) * 128 + lane] * il2;
            const float a1 = stage[row * 128 + 64 + lane] * il1 - stage[(128 + row) * 128 + 64 + lane] * il2;
            const float ss = wave_sum(a0 * a0 + a1 * a1);
            const float rr = rsqrtf(ss * (1.f / 128) + EPS) * (1.f - LAMBDA_INIT);
            const int m = is_s ? TP + 32 * u.idx + row : 128 * u.idx + row;
            const bf16_t* za = (const bf16_t*)(P.ws + WS_PROJ0) + (size_t)m * N0P + C_ZA + 128 * u.h;
            bf16_t* cat = (bf16_t*)(P.ws + WS_CAT) + (size_t)m * D + 128 * u.h;
            cat[lane] = f2bf(a0 * rr * sg[lane] * silu(bf2f(za[lane])));
            cat[64 + lane] = f2bf(a1 * rr * sg[64 + lane] * silu(bf2f(za[64 + lane])));
        }
    }
    __syncthreads();
}

__device__ __forceinline__ void phase(const Ptrs& P, DLAS unsigned char* lds, int vcu, int nvcu, int tid) {
    if (nvcu == 256) {
        const int v = vcu, h = v >> 6, s = v & 63;
        unit_run<0>(P, Unit{0, h, 127 - s}, lds, tid);
        unit_run<0>(P, Unit{0, h, s}, lds, tid);
        if (v < 128) unit_run<1>(P, Unit{1, v & 3, v >> 2}, lds, tid);
    } else {
#pragma unroll 1
        for (int i = vcu; i < 512; i += nvcu) unit_run<0>(P, Unit{0, i >> 7, 127 - (i & 127)}, lds, tid);
#pragma unroll 1
        for (int i = vcu; i < 128; i += nvcu) unit_run<1>(P, Unit{1, i & 3, i >> 2}, lds, tid);
    }
}
#undef DLAS
}
namespace sb {
typedef short bf16x8 __attribute__((ext_vector_type(8)));
typedef short s16x4 __attribute__((ext_vector_type(4)));
typedef float f32x16 __attribute__((ext_vector_type(16)));
typedef float f32x4 __attribute__((ext_vector_type(4)));
typedef unsigned u32x4 __attribute__((ext_vector_type(4)));
typedef unsigned u32x2 __attribute__((ext_vector_type(2)));

__device__ __forceinline__ unsigned cvtpk(float lo, float hi) { unsigned r; asm volatile("v_cvt_pk_bf16_f32 %0, %1, %2" : "=v"(r) : "v"(lo), "v"(hi)); return r; }
constexpr float RUN_EXIT = 160.f;

template <int SAMPLE> __device__ __forceinline__ void unit_run(const Ptrs& P, int b, int h, int qt, int lane) {
    const int r32 = lane & 31, hi = lane >> 5;
    const bf16_t* Q1 = (const bf16_t*)(P.ws + WS_Q1); const bf16_t* K1 = (const bf16_t*)(P.ws + WS_K1); const bf16_t* V1T = (const bf16_t*)(P.ws + WS_V1T);
    const int m0 = SAMPLE ? TP + 32 * b : 32 * qt;
    const int q0 = SAMPLE ? PAST : 32 * qt;
    bf16x8 qf[4];
    { const bf16_t* qp = Q1 + (size_t)(m0 + r32) * D + 64 * h + 8 * hi;
#pragma unroll
      for (int s = 0; s < 4; ++s) qf[s] = *(const bf16x8*)(qp + 16 * s); }
    f32x16 o0, o1;
#pragma unroll
    for (int r = 0; r < 16; ++r) { o0[r] = 0.f; o1[r] = 0.f; }
    float run = 0.f;
#pragma unroll 1
    for (int k0 = q0; k0 >= 0; k0 -= 32) {
        const bool diag = (k0 == q0);
        const bool cache = SAMPLE && !diag;
        f32x16 p;
#pragma unroll
        for (int r = 0; r < 16; ++r) p[r] = 0.f;
        if (!cache) {
            const int mk = SAMPLE ? TP + 32 * b : k0;
            const bf16_t* kp = K1 + (size_t)(mk + r32) * D + 64 * h + 8 * hi;
#pragma unroll
            for (int s = 0; s < 4; ++s) { const bf16x8 a = *(const bf16x8*)(kp + 16 * s); p = __builtin_amdgcn_mfma_f32_32x32x16_bf16(a, qf[s], p, 0, 0, 0); }
        } else {
            const float* kp = P.in[6] + (((size_t)b * PAST + k0 + r32) * 16 + h) * 64 + 8 * hi;
#pragma unroll
            for (int s = 0; s < 4; ++s) { const f32x4 x0 = *(const f32x4*)(kp + 16 * s), x1 = *(const f32x4*)(kp + 16 * s + 4);
                u32x4 w; w.x = cvtpk(x0[0], x0[1]); w.y = cvtpk(x0[2], x0[3]); w.z = cvtpk(x1[0], x1[1]); w.w = cvtpk(x1[2], x1[3]);
                p = __builtin_amdgcn_mfma_f32_32x32x16_bf16(__builtin_bit_cast(bf16x8, w), qf[s], p, 0, 0, 0); }
        }
        float sp[16];
#pragma unroll
        for (int r = 0; r < 16; ++r) {
            const int kk = (r & 3) + 8 * (r >> 2) + 4 * hi;
            const float e = __builtin_amdgcn_exp2f(p[r]);
            float s = __builtin_amdgcn_logf(1.f + e);
            if (diag && !(kk < r32)) s = 0.f;
            sp[r] = s;
        }
        float a[4], bsum[4];
#pragma unroll
        for (int g = 0; g < 4; ++g) { a[g] = (sp[4 * g] + sp[4 * g + 1]) + (sp[4 * g + 2] + sp[4 * g + 3]); bsum[g] = __shfl_xor(a[g], 32); }
        float Tg[4];
        { float accA = 0.f, accB = 0.f;
#pragma unroll
          for (int g = 3; g >= 0; --g) {
              const float pb = hi ? accB : accB + bsum[g];
              Tg[g] = accA + pb;
              accA += a[g]; accB += bsum[g];
          }
          const float tot = accA + accB;
#pragma unroll
          for (int g = 0; g < 4; ++g) {
              float c = Tg[g] + run;
#pragma unroll
              for (int i = 3; i >= 0; --i) {
                  const int r = 4 * g + i, kk = i + 8 * g + 4 * hi;
                  c += sp[r];
                  float w = __builtin_amdgcn_exp2f(p[r] - c);
                  if (diag && !(kk < r32)) w = 0.f;
                  p[r] = w;
              }
          }
          run += tot;
        }
        u32x4 w0, w1;
        w0.x = cvtpk(p[0], p[1]); w0.y = cvtpk(p[2], p[3]); w0.z = cvtpk(p[4], p[5]); w0.w = cvtpk(p[6], p[7]);
        w1.x = cvtpk(p[8], p[9]); w1.y = cvtpk(p[10], p[11]); w1.z = cvtpk(p[12], p[13]); w1.w = cvtpk(p[14], p[15]);
        const bf16x8 pa0 = __builtin_bit_cast(bf16x8, w0), pa1 = __builtin_bit_cast(bf16x8, w1);
        if (!cache) {
            const int mk = SAMPLE ? TP + 32 * b : k0;
            const bf16_t* vp = V1T + (size_t)(64 * h + r32) * M + mk + 4 * hi;
#pragma unroll
            for (int d = 0; d < 2; ++d)
#pragma unroll
                for (int s = 0; s < 2; ++s) {
                    const u32x2 lo = *(const u32x2*)(vp + (size_t)(32 * d) * M + 16 * s), hh = *(const u32x2*)(vp + (size_t)(32 * d) * M + 16 * s + 8);
                    const u32x4 w = (u32x4){lo.x, lo.y, hh.x, hh.y};
                    if (d == 0) o0 = __builtin_amdgcn_mfma_f32_32x32x16_bf16(s == 0 ? pa0 : pa1, __builtin_bit_cast(bf16x8, w), o0, 0, 0, 0);
                    else o1 = __builtin_amdgcn_mfma_f32_32x32x16_bf16(s == 0 ? pa0 : pa1, __builtin_bit_cast(bf16x8, w), o1, 0, 0, 0);
                }
        } else {
            const float* vp = P.in[7] + (((size_t)b * PAST + k0 + 4 * hi) * 16 + h) * 64 + r32;
#pragma unroll
            for (int d = 0; d < 2; ++d)
#pragma unroll
                for (int s = 0; s < 2; ++s) {
                    float x[8];
#pragma unroll
                    for (int j = 0; j < 8; ++j) x[j] = vp[(size_t)(16 * s + 8 * (j >> 2) + (j & 3)) * 1024 + 32 * d];
                    u32x4 w; w.x = cvtpk(x[0], x[1]); w.y = cvtpk(x[2], x[3]); w.z = cvtpk(x[4], x[5]); w.w = cvtpk(x[6], x[7]);
                    if (d == 0) o0 = __builtin_amdgcn_mfma_f32_32x32x16_bf16(s == 0 ? pa0 : pa1, __builtin_bit_cast(bf16x8, w), o0, 0, 0, 0);
                    else o1 = __builtin_amdgcn_mfma_f32_32x32x16_bf16(s == 0 ? pa0 : pa1, __builtin_bit_cast(bf16x8, w), o1, 0, 0, 0);
                }
        }
        if (__all(run >= RUN_EXIT)) break;
    }
    const bf16_t* Z1 = (const bf16_t*)(P.ws + WS_Z1); bf16_t* O1 = (bf16_t*)(P.ws + WS_O1B);
#pragma unroll
    for (int r = 0; r < 16; ++r) {
        const int q = (r & 3) + 8 * (r >> 2) + 4 * hi;
        const size_t off = (size_t)(m0 + q) * D + 64 * h + r32;
        O1[off] = f2bf(o0[r] * silu(bf2f(Z1[off])));
        O1[off + 32] = f2bf(o1[r] * silu(bf2f(Z1[off + 32])));
    }
}

__device__ __forceinline__ void phase(const Ptrs& P, int gw, int ngw, int lane) {
#pragma unroll 1
    for (int i = gw; i < 16 * 512; i += ngw) unit_run<0>(P, 0, i & 15, i >> 4, lane);
#pragma unroll 1
    for (int i = gw; i < 16 * 32; i += ngw) unit_run<1>(P, i >> 4, i & 15, 0, lane);
}
}
#ifndef FAST_ATTN0
#define FAST_ATTN0 1
#endif
#ifndef FAST_ATTN1
#define FAST_ATTN1 1
#endif
#include <hip/hip_cooperative_groups.h>
namespace cg = cooperative_groups;
constexpr int NWAVES = 8, NTHREADS = 512;
constexpr int LDS_BYTES = 147456;
enum Phase { PH_PRO = 0, PH_GEMM1 = 1, PH_TOK = 2, PH_MIX = 3, PH_RWC = 4, PH_GEMM2 = 5, PH_GEMM3 = 6, PH_ATTN1 = 7, PH_GEMM4 = 8, PH_END = 9 };
#define LAS __attribute__((address_space(3)))
struct Args { Ptrs p; int ph_lo, ph_hi; int pad0, pad1; };

__global__ void __launch_bounds__(NTHREADS, 2) mk_fwd(Args a) {
    extern __shared__ __attribute__((aligned(16))) unsigned char lds[];
    const Ptrs& P = a.p;
    unsigned char* ws = P.ws;
    const int lo = a.ph_lo, hi = a.ph_hi;
    const int tid = threadIdx.x, lane = tid & 63, wave = tid >> 6;
    const int G = gridDim.x, gw = blockIdx.x * NWAVES + wave, NGW = G * NWAVES;
    float* wscr = (float*)lds + wave * 256;
#define IN(k) (lo <= (k) && (k) < hi)
#define SEAM(k) do { if (IN(k) && IN((k) + 1)) cg::this_grid().sync(); } while (0)
    if (IN(PH_PRO)) {
        const size_t gt = (size_t)blockIdx.x * NTHREADS + tid, NT = (size_t)G * NTHREADS;
        for (size_t i = gt; i < (size_t)N0P * D; i += NT) nv::d_transpose_w(P.in[10], D, N0, N0P, (bf16_t*)(ws + WS_WT0), nullptr, i);
        for (size_t i = gt; i < (size_t)D * D; i += NT) nv::d_transpose_w(P.in[11], D, D, D, (bf16_t*)(ws + WS_WO0T), nullptr, i);
        for (size_t i = gt; i < (size_t)N1 * D; i += NT) nv::d_transpose_w(P.in[30], D, N1, N1, (bf16_t*)(ws + WS_WT1), P.in[29], i);
        for (size_t i = gt; i < (size_t)D * D; i += NT) nv::d_transpose_w(P.in[31], D, D, D, (bf16_t*)(ws + WS_WO1T), nullptr, i);
        if (blockIdx.x == 0 && tid < 256) nv::d_tables(P, tid);
        for (int m = gw; m < M; m += NGW) nv::d_rmsnorm_x(P, m, lane);
    }
    SEAM(PH_PRO);
    if (IN(PH_GEMM1)) {
        pg8::Gemm g{(const bf16_t*)(ws + WS_XN0), (const bf16_t*)(ws + WS_WT0), M, N0P, D}; pg8::StaticOrder S; S.init(M, N0P, G, (int)blockIdx.x);
        pg8::EpiProj0F E{(bf16_t*)(ws + WS_PROJ0)};
        pg8::gemm_phase<pg8::EpiProj0F, pg8::StaticOrder, true, true>((LAS unsigned char*)lds, g, S, E);
    }
    SEAM(PH_GEMM1);
    if (IN(PH_TOK)) {
        for (int m = gw; m < M; m += NGW) nv::d_tok0(P, m, lane);
        __syncthreads();
        for (int m = blockIdx.x; m < M; m += G) { nv::d_rw_prep(P, m, tid, (float*)lds, (float*)lds + 64); __syncthreads(); }
    }
    SEAM(PH_TOK);
    if (IN(PH_MIX)) {
        if (gw < 33 * 8) nv::d_rw_scan(P, gw >> 3, gw & 7, lane);
#if FAST_ATTN0
        { const int vcu = (G % 8 == 0) ? ((int)blockIdx.x % 8) * (G / 8) + (int)blockIdx.x / 8 : (int)blockIdx.x;
          __syncthreads();
          da::phase(P, (LAS unsigned char*)lds, vcu, G, tid); }
#else
        for (int i = gw; i < M * 4; i += NGW) nv::d_attn0(P, i >> 2, i & 3, lane, wscr, wscr + 128);
#endif
    }
    SEAM(PH_MIX);
    SEAM(PH_RWC);
    if (IN(PH_GEMM2)) {
        pg8::Gemm g{(const bf16_t*)(ws + WS_CAT), (const bf16_t*)(ws + WS_WO0T), M, D, D}; pg8::StaticOrder S; S.init(M, D, G, (int)blockIdx.x);
        pg8::EpiY0F E{P};
        pg8::gemm_phase<pg8::EpiY0F, pg8::StaticOrder, true, true>((LAS unsigned char*)lds, g, S, E);
    }
    SEAM(PH_GEMM2);
    if (IN(PH_GEMM3)) {
        pg8::Gemm g{(const bf16_t*)(ws + WS_Y0B), (const bf16_t*)(ws + WS_WT1), M, N1, D}; pg8::StaticOrder S; S.init(M, N1, G, (int)blockIdx.x);
        pg8::EpiL1F E{P};
        pg8::gemm_phase<pg8::EpiL1F, pg8::StaticOrder, true, true>((LAS unsigned char*)lds, g, S, E);
    }
    SEAM(PH_GEMM3);
    if (IN(PH_ATTN1)) {
#if FAST_ATTN1
        sb::phase(P, gw, NGW, lane);
#else
        for (int i = gw; i < M * 16; i += NGW) nv::d_attn1(P, i >> 4, i & 15, lane, wscr, wscr + 64);
#endif
    }
    SEAM(PH_ATTN1);
    if (IN(PH_GEMM4)) {
        pg8::Gemm g{(const bf16_t*)(ws + WS_O1B), (const bf16_t*)(ws + WS_WO1T), M, D, D}; pg8::StaticOrder S; S.init(M, D, G, (int)blockIdx.x);
        pg8::EpiOutF E{P};
        pg8::gemm_phase<pg8::EpiOutF, pg8::StaticOrder, true, true>((LAS unsigned char*)lds, g, S, E);
    }
#undef IN
#undef SEAM
}
extern "C" void kernel_launch(void* const* d_in, const int* in_sizes, int n_in, void* d_out, int out_size, void* d_ws, size_t ws_size, hipStream_t stream) {
    static int grid = 0;
    if (n_in != 32 || (size_t)out_size != O_TOTAL || ws_size < WS_END) { fprintf(stderr, "kernel_launch: unexpected shapes n_in=%d out=%d ws=%zu\n", n_in, out_size, ws_size); return; }
    if (grid == 0) {
        int dev = 0, cus = 0, per_cu = 0;
        (void)hipGetDevice(&dev); (void)hipDeviceGetAttribute(&cus, hipDeviceAttributeMultiprocessorCount, dev);
        (void)hipFuncSetAttribute((const void*)mk_fwd, hipFuncAttributeMaxDynamicSharedMemorySize, LDS_BYTES);
        (void)hipOccupancyMaxActiveBlocksPerMultiprocessor(&per_cu, (const void*)mk_fwd, NTHREADS, LDS_BYTES);
        if (per_cu < 1) { fprintf(stderr, "kernel_launch: occupancy query says %d blocks/CU\n", per_cu); per_cu = 1; }
        grid = (cus > 0 ? cus : 256);
    }
    Args a{};
    for (int i = 0; i < 32; ++i) a.p.in[i] = (const float*)d_in[i];
    a.p.out = (float*)d_out; a.p.ws = (unsigned char*)d_ws; a.ph_lo = 0; a.ph_hi = PH_END;
    void* args[] = {&a};
    hipError_t e = hipLaunchCooperativeKernel((const void*)mk_fwd, dim3(grid), dim3(NTHREADS), args, LDS_BYTES, stream);
    if (e != hipSuccess) fprintf(stderr, "cooperative launch failed: %s (grid %d)\n", hipGetErrorString(e), grid);
}
```

```cpp
#include <hip/hip_runtime.h>
#include <stdint.h>
#include <cstdio>

typedef unsigned short bf16_t;
__device__ __forceinline__ float bf2f(bf16_t b) { return __uint_as_float(((unsigned)b) << 16); }
__device__ __forceinline__ bf16_t f2bf(float f) { unsigned u = __float_as_uint(f); return (bf16_t)((u + 0x7fffu + ((u >> 16) & 1u)) >> 16); }

constexpr int D = 1024, TP = 16384, NSEQ = 32, TS = 32, MS = NSEQ * TS, M = TP + MS, PAST = 1024;
constexpr int N0 = 4224, N0P = 4352, N1 = 4096;
constexpr int C_Q = 0, C_K = 512, C_V = 1024, C_ZA = 1536, C_PRW = 2048, C_ZB = 3712;
constexpr int RWS = 1664;
constexpr float EPS = 1e-6f, GN_EPS = 64e-5f;
constexpr float LOG2E = 1.4426950408889634f;
constexpr float LAMBDA_INIT = 0.2f;
constexpr float QSCALE = 0.125f * LOG2E;

constexpr size_t O_Y = 0;
constexpr size_t O_L0K_P = (size_t)M * D;
constexpr size_t O_L0V_P = O_L0K_P + (size_t)TP * 512;
constexpr size_t O_L0SH_P = O_L0V_P + (size_t)TP * 512;
constexpr size_t O_L0WKV_P = O_L0SH_P + RWS;
constexpr size_t O_L1K_P = O_L0WKV_P + 8 * 64 * 64;
constexpr size_t O_L1V_P = O_L1K_P + (size_t)TP * 1024;
constexpr size_t O_L0K_S = O_L1V_P + (size_t)TP * 1024;
constexpr size_t O_L0V_S = O_L0K_S + (size_t)MS * 512;
constexpr size_t O_L0SH_S = O_L0V_S + (size_t)MS * 512;
constexpr size_t O_L0WKV_S = O_L0SH_S + (size_t)NSEQ * RWS;
constexpr size_t O_L1K_S = O_L0WKV_S + (size_t)NSEQ * 8 * 64 * 64;
constexpr size_t O_L1V_S = O_L1K_S + (size_t)MS * 1024;
constexpr size_t O_TOTAL = O_L1V_S + (size_t)MS * 1024;
static_assert(O_TOTAL == 72439424, "output size");

__host__ __device__ __forceinline__ size_t off_l0k(int m) { return m < TP ? O_L0K_P + (size_t)m * 512 : O_L0K_S + (size_t)(m - TP) * 512; }
__host__ __device__ __forceinline__ size_t off_l0v(int m) { return m < TP ? O_L0V_P + (size_t)m * 512 : O_L0V_S + (size_t)(m - TP) * 512; }
__host__ __device__ __forceinline__ size_t off_l1k(int m) { return m < TP ? O_L1K_P + (size_t)m * 1024 : O_L1K_S + (size_t)(m - TP) * 1024; }
__host__ __device__ __forceinline__ size_t off_l1v(int m) { return m < TP ? O_L1V_P + (size_t)m * 1024 : O_L1V_S + (size_t)(m - TP) * 1024; }

constexpr size_t MiB = 1u << 20;
constexpr size_t WS_CTL = 0;
constexpr size_t WS_TAB = 512 * 1024;
constexpr size_t WS_WT0 = 1 * MiB, WS_WO0T = 10 * MiB, WS_WT1 = 12 * MiB, WS_WO1T = 20 * MiB, WS_LORA = 22 * MiB;
constexpr size_t WS_CAT = 24 * MiB, WS_XN0 = WS_CAT;
constexpr size_t WS_PROJ0 = 58 * MiB;
constexpr size_t WS_Q0 = 203 * MiB, WS_K0 = 220 * MiB;
constexpr size_t WS_RW = 237 * MiB;
constexpr size_t WS_SST = 407 * MiB;
constexpr size_t WS_END = 441 * MiB;
constexpr size_t WS_Y0 = WS_PROJ0, WS_Y0B = 126 * MiB, WS_SSQ = 160 * MiB;
constexpr size_t WS_O1B = WS_Q0;
constexpr size_t WS_Q1 = 237 * MiB, WS_K1 = 271 * MiB, WS_V1T = 305 * MiB, WS_Z1 = 339 * MiB;
static_assert(WS_PROJ0 + (size_t)M * N0P * 2 <= WS_Q0, "proj0");
static_assert(WS_WT0 + (size_t)N0P * D * 2 <= WS_WO0T, "wt0");

struct Tab {
    float lam;
    float m0;
    float pad[2];
    float bias[4][256];
    float biasfar[4];
};

struct Ptrs {
    const float* in[32];
    float* out;
    unsigned char* ws;
};

__device__ __forceinline__ const float* xrow(const Ptrs& P, int m) { return m < TP ? P.in[0] + (size_t)m * D : P.in[1] + (size_t)(m - TP) * D; }

__device__ __forceinline__ float wave_sum(float v) {
#pragma unroll
    for (int o = 1; o < 64; o <<= 1) v += __shfl_xor(v, o);
    return v;
}
__device__ __forceinline__ float wave_max(float v) {
#pragma unroll
    for (int o = 1; o < 64; o <<= 1) v = fmaxf(v, __shfl_xor(v, o));
    return v;
}
__device__ __forceinline__ float silu(float x) { return x / (1.f + __expf(-x)); }

__device__ __forceinline__ int t5_bucket(int rel) {
    int n = rel < 0 ? -rel : rel;
    int b;
    if (n < 8) b = n;
    else { unsigned n2 = (unsigned)n * (unsigned)n; int lg = 31 - __clz((int)n2); b = 8 + (lg - 6); if (b > 15) b = 15; }
    return (rel > 0 ? 16 : 0) + b;
}
namespace nv {

__device__ __forceinline__ void d_transpose_w(const float* W, int K, int N, int NP, bf16_t* WT, const float* g, size_t i) {
    int n = (int)(i / K), k = (int)(i % K);
    float v = 0.f;
    if (n < N) { v = W[(size_t)k * N + n]; if (g) v *= g[k]; }
    WT[i] = f2bf(v);
}
__global__ void k_transpose_w(const float* W, int K, int N, int NP, bf16_t* WT, const float* g) {
    size_t i = (size_t)blockIdx.x * blockDim.x + threadIdx.x; if (i < (size_t)NP * K) d_transpose_w(W, K, N, NP, WT, g, i); }
__global__ void k_lora_t(const float* w_up, const float* a_up, float* LT) {
    int i = blockIdx.x * blockDim.x + threadIdx.x;
    if (i >= 512 * 64) return;
    int c = i / 64, l = i % 64;
    LT[i] = w_up[l * 512 + c];
    LT[512 * 64 + i] = a_up[l * 512 + c];
}
__device__ __forceinline__ void d_tables(const Ptrs& P, int tid) {
    Tab* T = (Tab*)(P.ws + WS_TAB);
    if (tid < 64) {
        float a = P.in[14][tid] * P.in[15][tid], b = P.in[16][tid] * P.in[17][tid];
        a = wave_sum(a); b = wave_sum(b);
        float gq = fabsf(P.in[12][tid]), gk = fabsf(P.in[13][tid]);
        gq = wave_max(gq); gk = wave_max(gk);
        if (tid == 0) { T->lam = __expf(a) - __expf(b) + LAMBDA_INIT; T->m0 = 8.f * gq * gk * LOG2E * 1.0001f + 0.01f; }
    }
    if (tid < 255) { int rel = tid - 191; int b = t5_bucket(rel); for (int h = 0; h < 4; ++h) T->bias[h][tid] = P.in[8][b * 4 + h]; }
    if (tid == 255) for (int h = 0; h < 4; ++h) { T->bias[h][255] = 0.f; T->biasfar[h] = P.in[8][15 * 4 + h]; }
}
__global__ void k_tables(Ptrs P) { d_tables(P, threadIdx.x); }
__device__ __forceinline__ void d_rmsnorm_x(const Ptrs& P, int w, int lane) {
    const float* x = xrow(P, w); const float* g = P.in[9];
    bf16_t* o = (bf16_t*)(P.ws + WS_XN0) + (size_t)w * D;
    float v[16], s = 0.f;
#pragma unroll
    for (int j = 0; j < 16; ++j) { v[j] = x[lane + 64 * j]; s += v[j] * v[j]; }
    s = wave_sum(s);
    float r = rsqrtf(s * (1.f / D) + EPS);
#pragma unroll
    for (int j = 0; j < 16; ++j) o[lane + 64 * j] = f2bf(v[j] * r * g[lane + 64 * j]);
}
__global__ void k_rmsnorm_x(Ptrs P) { int w = (blockIdx.x * blockDim.x + threadIdx.x) >> 6; if (w < M) d_rmsnorm_x(P, w, threadIdx.x & 63); }

template <class Epi>
__global__ void __launch_bounds__(256) k_gemm(const bf16_t* A, const bf16_t* Bt, int K, Epi epi) {
    __shared__ float As[16][65], Bs[16][65];
    const int tx = threadIdx.x & 15, ty = threadIdx.x >> 4;
    const int m0 = blockIdx.y * 64, n0 = blockIdx.x * 64;
    float acc[4][4];
#pragma unroll
    for (int i = 0; i < 4; ++i)
#pragma unroll
        for (int j = 0; j < 4; ++j) acc[i][j] = 0.f;
    for (int k0 = 0; k0 < K; k0 += 16) {
#pragma unroll
        for (int i = 0; i < 4; ++i) {
            int e = threadIdx.x + 256 * i, r = e >> 4, c = e & 15;
            As[c][r] = bf2f(A[(size_t)(m0 + r) * K + k0 + c]);
            Bs[c][r] = bf2f(Bt[(size_t)(n0 + r) * K + k0 + c]);
        }
        __syncthreads();
#pragma unroll
        for (int kk = 0; kk < 16; ++kk) {
            float a[4], b[4];
#pragma unroll
            for (int i = 0; i < 4; ++i) { a[i] = As[kk][ty * 4 + i]; b[i] = Bs[kk][tx * 4 + i]; }
#pragma unroll
            for (int i = 0; i < 4; ++i)
#pragma unroll
                for (int j = 0; j < 4; ++j) acc[i][j] += a[i] * b[j];
        }
        __syncthreads();
    }
#pragma unroll
    for (int i = 0; i < 4; ++i)
#pragma unroll
        for (int j = 0; j < 4; ++j) epi(m0 + ty * 4 + i, n0 + tx * 4 + j, acc[i][j]);
}
struct EpiProj0 { bf16_t* O; __device__ void operator()(int m, int n, float v) const { O[(size_t)m * N0P + n] = f2bf(v); } };
struct EpiY0 {
    Ptrs P;
    __device__ void operator()(int m, int n, float v) const {
        float y = v + xrow(P, m)[n];
        ((float*)(P.ws + WS_Y0))[(size_t)m * D + n] = y;
        ((bf16_t*)(P.ws + WS_Y0B))[(size_t)m * D + n] = f2bf(y);
    }
};
struct EpiL1 {
    Ptrs P;
    __device__ void operator()(int m, int n, float v) const {
        const float* ss = (const float*)(P.ws + WS_SSQ) + (size_t)m * 16;
        float t = 0.f; for (int j = 0; j < 16; ++j) t += ss[j];
        float r = rsqrtf(t * (1.f / D) + EPS);
        float val = v * r;
        int c = n & 1023;
        if (n < 1024) ((bf16_t*)(P.ws + WS_Q1))[(size_t)m * D + c] = f2bf(val * QSCALE);
        else if (n < 2048) { ((bf16_t*)(P.ws + WS_K1))[(size_t)m * D + c] = f2bf(val); P.out[off_l1k(m) + c] = val; }
        else if (n < 3072) { ((bf16_t*)(P.ws + WS_V1T))[(size_t)c * M + m] = f2bf(val); P.out[off_l1v(m) + c] = val; }
        else ((bf16_t*)(P.ws + WS_Z1))[(size_t)m * D + c] = f2bf(val);
    }
};
struct EpiOut { Ptrs P; __device__ void operator()(int m, int n, float v) const { P.out[O_Y + (size_t)m * D + n] = v + ((const float*)(P.ws + WS_Y0))[(size_t)m * D + n]; } };

__device__ __forceinline__ void d_ssq(const Ptrs& P, int w, int lane) {
    const float* y = (const float*)(P.ws + WS_Y0) + (size_t)w * D;
    float* ss = (float*)(P.ws + WS_SSQ) + (size_t)w * 16;
    for (int j = 0; j < 16; ++j) { float v = y[64 * j + lane]; float s = wave_sum(v * v); if (lane == 0) ss[j] = s; }
}
__global__ void k_ssq(Ptrs P) { int w = (blockIdx.x * blockDim.x + threadIdx.x) >> 6; if (w < M) d_ssq(P, w, threadIdx.x & 63); }

__device__ __forceinline__ void d_tok0(const Ptrs& P, int m, int lane) {
    const bf16_t* pr = (const bf16_t*)(P.ws + WS_PROJ0) + (size_t)m * N0P;
    bf16_t* q0 = (bf16_t*)(P.ws + WS_Q0) + (size_t)m * 512;
    bf16_t* k0 = (bf16_t*)(P.ws + WS_K0) + (size_t)m * 512;
    const float gq = P.in[12][lane], gk = P.in[13][lane];
#pragma unroll 1
    for (int g = 0; g < 8; ++g) {
        float q = bf2f(pr[C_Q + 64 * g + lane]), k = bf2f(pr[C_K + 64 * g + lane]);
        float sq = wave_sum(q * q), sk = wave_sum(k * k);
        float qn = q * rsqrtf(sq * (1.f / 64) + EPS) * gq, kn = k * rsqrtf(sk * (1.f / 64) + EPS) * gk;
        q0[64 * g + lane] = f2bf(qn * QSCALE);
        k0[64 * g + lane] = f2bf(kn);
        P.out[off_l0k(m) + 64 * g + lane] = kn;
        P.out[off_l0v(m) + 64 * g + lane] = bf2f(pr[C_V + 64 * g + lane]);
    }
    int last = -1; size_t so = 0;
    if (m == TP - 1) { last = 1; so = O_L0SH_P; }
    else if (m >= TP && ((m - TP) & 31) == 31) { last = 1; so = O_L0SH_S + (size_t)((m - TP) >> 5) * RWS; }
    if (last > 0) for (int c = lane; c < RWS; c += 64) P.out[so + c] = bf2f(pr[C_PRW + c]);
}
__global__ void k_tok0(Ptrs P) { int m = (blockIdx.x * blockDim.x + threadIdx.x) >> 6; if (m < M) d_tok0(P, m, threadIdx.x & 63); }

template <class SP> __device__ __forceinline__ void d_attn0(const Ptrs& P, int m, int h, int lane, SP sqw, SP spw) {
    const Tab* T = (const Tab*)(P.ws + WS_TAB);
    const bf16_t* Q0 = (const bf16_t*)(P.ws + WS_Q0); const bf16_t* K0 = (const bf16_t*)(P.ws + WS_K0);
    const bf16_t* PR = (const bf16_t*)(P.ws + WS_PROJ0);
    int qpos, nk, b = 0; bool samp = m >= TP;
    if (!samp) { qpos = m; nk = ((m >> 6) + 1) * 64; } else { b = (m - TP) >> 5; qpos = PAST + ((m - TP) & 31); nk = PAST + TS; }
    sqw[lane] = bf2f(Q0[(size_t)m * 512 + 128 * h + lane]);
    sqw[64 + lane] = bf2f(Q0[(size_t)m * 512 + 128 * h + 64 + lane]);
    float m1 = -1e30f, m2 = -1e30f, l1 = 0.f, l2 = 0.f, o1[2] = {0.f, 0.f}, o2[2] = {0.f, 0.f};
    for (int j0 = 0; j0 < nk; j0 += 64) {
        int j = j0 + lane;
        bool valid = j < nk && ((j >> 6) <= (qpos >> 6));
        float s1 = 0.f, s2 = 0.f;
        if (valid) {
            if (samp && j < PAST) {
                const float* kr = P.in[2] + (((size_t)b * PAST + j) * 4 + h) * 128;
                for (int d = 0; d < 64; ++d) { s1 += sqw[d] * bf2f(f2bf(kr[d])); s2 += sqw[64 + d] * bf2f(f2bf(kr[64 + d])); }
            } else {
                int km = samp ? TP + 32 * b + (j - PAST) : j;
                const bf16_t* kr = K0 + (size_t)km * 512 + 128 * h;
                for (int d = 0; d < 64; ++d) { s1 += sqw[d] * bf2f(kr[d]); s2 += sqw[64 + d] * bf2f(kr[64 + d]); }
            }
            int rel = j - qpos; float bias = rel <= -128 ? T->biasfar[h] : T->bias[h][rel + 191];
            s1 += bias * LOG2E; s2 += bias * LOG2E;
        } else { s1 = -1e30f; s2 = -1e30f; }
        float bm1 = wave_max(s1), bm2 = wave_max(s2);
        float n1 = fmaxf(m1, bm1), n2 = fmaxf(m2, bm2);
        float f1 = exp2f(m1 - n1), f2 = exp2f(m2 - n2);
        float p1 = valid ? exp2f(s1 - n1) : 0.f, p2 = valid ? exp2f(s2 - n2) : 0.f;
        l1 = l1 * f1 + wave_sum(p1); l2 = l2 * f2 + wave_sum(p2);
        o1[0] *= f1; o1[1] *= f1; o2[0] *= f2; o2[1] *= f2; m1 = n1; m2 = n2;
        spw[lane] = p1; spw[64 + lane] = p2;
        __builtin_amdgcn_s_waitcnt(0);
        int jn = min(64, nk - j0);
        for (int jj = 0; jj < jn; ++jj) {
            int jp = j0 + jj; float a1 = spw[jj], a2 = spw[64 + jj];
            float v0, v1;
            if (samp && jp < PAST) { const float* vr = P.in[3] + (((size_t)b * PAST + jp) * 4 + h) * 128; v0 = bf2f(f2bf(vr[lane])); v1 = bf2f(f2bf(vr[64 + lane])); }
            else { int km = samp ? TP + 32 * b + (jp - PAST) : jp; const bf16_t* vr = PR + (size_t)km * N0P + C_V + 128 * h; v0 = bf2f(vr[lane]); v1 = bf2f(vr[64 + lane]); }
            o1[0] += a1 * v0; o1[1] += a1 * v1; o2[0] += a2 * v0; o2[1] += a2 * v1;
        }
    }
    const float lam = T->lam;
    float a0 = o1[0] / l1 - lam * o2[0] / l2, a1 = o1[1] / l1 - lam * o2[1] / l2;
    float ss = wave_sum(a0 * a0 + a1 * a1);
    float r = rsqrtf(ss * (1.f / 128) + EPS) * (1.f - LAMBDA_INIT);
    const float* sg = P.in[18];
    const bf16_t* za = PR + (size_t)m * N0P + C_ZA + 128 * h;
    bf16_t* cat = (bf16_t*)(P.ws + WS_CAT) + (size_t)m * D + 128 * h;
    cat[lane] = f2bf(a0 * r * sg[lane] * silu(bf2f(za[lane])));
    cat[64 + lane] = f2bf(a1 * r * sg[64 + lane] * silu(bf2f(za[64 + lane])));
}
__global__ void __launch_bounds__(256) k_attn0(Ptrs P) {
    __shared__ float sq[4][128], sp[4][128];
    const int wid = threadIdx.x >> 6, lane = threadIdx.x & 63, gw = blockIdx.x * 4 + wid;
    if ((gw >> 2) < M) d_attn0(P, gw >> 2, gw & 3, lane, &sq[wid][0], &sp[wid][0]);
}

constexpr size_t RWN = (size_t)M * 512;
__device__ __forceinline__ float prw_prev(const Ptrs& P, int m, int c) {
    if (m < TP) return m == 0 ? 0.f : bf2f(((const bf16_t*)(P.ws + WS_PROJ0))[(size_t)(m - 1) * N0P + C_PRW + c]);
    int i = (m - TP) & 31, b = (m - TP) >> 5;
    if (i == 0) return P.in[4][(size_t)b * RWS + c];
    return bf2f(((const bf16_t*)(P.ws + WS_PROJ0))[(size_t)(m - 1) * N0P + C_PRW + c]);
}
template <class SP> __device__ __forceinline__ void d_rw_prep(const Ptrs& P, int m, int c, SP swl, SP sal) {
    const bf16_t* pr = (const bf16_t*)(P.ws + WS_PROJ0) + (size_t)m * N0P + C_PRW;
    const float* mu = P.in[19];
#define NV_MIX(col) (bf2f(pr[col]) + (prw_prev(P, m, (col)) - bf2f(pr[col])) * mu[col])
    float r = NV_MIX(c), kr = NV_MIX(512 + c), vr = NV_MIX(1024 + c);
    if (c < 64) swl[c] = tanhf(NV_MIX(1536 + c)); else if (c < 128) sal[c - 64] = NV_MIX(1600 + c - 64);
#undef NV_MIX
    __syncthreads();
    float wa = P.in[20][c], aa = P.in[22][c];
    const float* wup = P.in[21]; const float* aup = P.in[23];
#pragma unroll 4
    for (int l = 0; l < 64; ++l) { wa += swl[l] * wup[l * 512 + c]; aa += sal[l] * aup[l * 512 + c]; }
    float spl = (-wa > 20.f) ? -wa : log1pf(__expf(-wa));
    float w = -spl - 0.5f;
    float dec = __expf(-__expf(w));
    float a = 1.f / (1.f + __expf(-aa));
    float kk = kr * P.in[24][c];
    float n2 = wave_sum(kk * kk);
    kk = kk / fmaxf(sqrtf(n2), 1e-12f);
    float km = kr * (1.f + (a - 1.f) * P.in[25][c]);
    float* R = (float*)(P.ws + WS_RW);
    size_t o = (size_t)m * 512 + c;
    R[o] = r; R[RWN + o] = dec; R[2 * RWN + o] = kk; R[3 * RWN + o] = kk * a; R[4 * RWN + o] = km; R[5 * RWN + o] = vr;
}
__global__ void __launch_bounds__(512) k_rw_prep(Ptrs P) { __shared__ float swl[64], sal[64]; d_rw_prep(P, blockIdx.x, threadIdx.x, &swl[0], &sal[0]); }
__device__ __forceinline__ void d_rw_scan(const Ptrs& P, int seq, int h, int lane) {
    const int m0 = seq == 0 ? 0 : TP + 32 * (seq - 1), T = seq == 0 ? TP : TS;
    float S[64];
    const float* s0 = P.in[5] + (((size_t)(seq > 0 ? seq - 1 : 0) * 8 + h) * 64 + lane) * 64;
#pragma unroll
    for (int k = 0; k < 64; ++k) S[k] = seq == 0 ? 0.f : s0[k];
    const float* R = (const float*)(P.ws + WS_RW);
    const float rk = P.in[26][h * 64 + lane], lg = P.in[27][h * 64 + lane], lb = P.in[28][h * 64 + lane];
    for (int t = 0; t < T; ++t) {
        size_t o = (size_t)(m0 + t) * 512 + h * 64 + lane;
        float r = R[o], dec = R[RWN + o], kk = R[2 * RWN + o], kka = R[3 * RWN + o], km = R[4 * RWN + o], v = R[5 * RWN + o];
        float sa = 0.f;
#pragma unroll
        for (int k = 0; k < 64; ++k) sa += S[k] * __shfl(kk, k);
        float ov = 0.f;
#pragma unroll
        for (int k = 0; k < 64; ++k) { S[k] = S[k] * __shfl(dec, k) - sa * __shfl(kka, k) + v * __shfl(km, k); ov += S[k] * __shfl(r, k); }
        float mu = wave_sum(ov) * (1.f / 64);
        float dv = ov - mu;
        float var = wave_sum(dv * dv) * (1.f / 64);
        float y = dv * rsqrtf(var + GN_EPS) * lg + lb;
        float bonus = wave_sum(r * km * rk) * v;
        int mm = m0 + t;
        float zb = bf2f(((const bf16_t*)(P.ws + WS_PROJ0))[(size_t)mm * N0P + C_ZB + h * 64 + lane]);
        ((bf16_t*)(P.ws + WS_CAT))[(size_t)mm * D + 512 + h * 64 + lane] = f2bf((y + bonus) * silu(zb));
    }
    float* so = P.out + (seq == 0 ? O_L0WKV_P + ((size_t)h * 64 + lane) * 64 : O_L0WKV_S + ((((size_t)(seq - 1)) * 8 + h) * 64 + lane) * 64);
#pragma unroll
    for (int k = 0; k < 64; ++k) so[k] = S[k];
}
__global__ void __launch_bounds__(64) k_rw_scan(Ptrs P) { d_rw_scan(P, blockIdx.x >> 3, blockIdx.x & 7, threadIdx.x); }

template <class SP> __device__ __forceinline__ void d_attn1(const Ptrs& P, int m, int h, int lane, SP sqw, SP saw) {
    const bf16_t* Q1 = (const bf16_t*)(P.ws + WS_Q1); const bf16_t* K1 = (const bf16_t*)(P.ws + WS_K1);
    const bf16_t* V1T = (const bf16_t*)(P.ws + WS_V1T);
    bool samp = m >= TP; int b = 0, qpos;
    if (!samp) qpos = m; else { b = (m - TP) >> 5; qpos = PAST + ((m - TP) & 31); }
    sqw[lane] = bf2f(Q1[(size_t)m * D + 64 * h + lane]);
    float run = 0.f, o = 0.f;
    for (int s0 = qpos - 1; s0 >= 0; s0 -= 64) {
        int s = s0 - lane;
        bool valid = s >= 0;
        float z = 0.f;
        if (valid) {
            if (samp && s < PAST) { const float* kr = P.in[6] + (((size_t)b * PAST + s) * 16 + h) * 64; for (int d = 0; d < 64; ++d) z += sqw[d] * bf2f(f2bf(kr[d])); }
            else { int km = samp ? TP + 32 * b + (s - PAST) : s; const bf16_t* kr = K1 + (size_t)km * D + 64 * h; for (int d = 0; d < 64; ++d) z += sqw[d] * bf2f(kr[d]); }
        }
        float spl = valid ? log2f(1.f + exp2f(z)) : 0.f;
        float inc = spl;
#pragma unroll
        for (int off = 1; off < 64; off <<= 1) { float t = __shfl_up(inc, off); if (lane >= off) inc += t; }
        float a = valid ? exp2f(z - inc - run) : 0.f;
        saw[lane] = a;
        run += __shfl(inc, 63);
        __builtin_amdgcn_s_waitcnt(0);
        int jn = min(64, s0 + 1);
        for (int jj = 0; jj < jn; ++jj) {
            int sp_ = s0 - jj; float v;
            if (samp && sp_ < PAST) v = bf2f(f2bf(P.in[7][(((size_t)b * PAST + sp_) * 16 + h) * 64 + lane]));
            else { int km = samp ? TP + 32 * b + (sp_ - PAST) : sp_; v = bf2f(V1T[(size_t)(64 * h + lane) * M + km]); }
            o += saw[jj] * v;
        }
        if (run > 200.f) break;
    }
    float z1 = bf2f(((const bf16_t*)(P.ws + WS_Z1))[(size_t)m * D + 64 * h + lane]);
    ((bf16_t*)(P.ws + WS_O1B))[(size_t)m * D + 64 * h + lane] = f2bf(o * silu(z1));
}
__global__ void __launch_bounds__(256) k_attn1(Ptrs P) {
    __shared__ float sq[4][64], sa[4][64];
    const int wid = threadIdx.x >> 6, lane = threadIdx.x & 63, gw = blockIdx.x * 4 + wid;
    if ((gw >> 4) < M) d_attn1(P, gw >> 4, gw & 15, lane, &sq[wid][0], &sa[wid][0]);
}

}
namespace pg8 {
#define PG8_LAS __attribute__((address_space(3)))
typedef unsigned short bf16_t;
typedef short bf16x8 __attribute__((ext_vector_type(8)));
typedef float f32x4 __attribute__((ext_vector_type(4)));
typedef unsigned u32x4 __attribute__((ext_vector_type(4)));
constexpr int BM = 256, BK = 64, HALF = 128, HTB = HALF * BK * 2  , STAGE_BYTES = 8 * HTB, NXCD = 8, WGM = 8;

__host__ __device__ __forceinline__ int lds_byte(int r, int c) { const int st = (r >> 4) * 2 + (c >> 5), rr = r & 15, cc = c & 31, ob = rr * 64 + cc * 2; return st * 1024 + (ob ^ (((ob >> 9) & 1) << 5)); }
__host__ __device__ __forceinline__ void stage_rc(int b, int& R, int& C) { const int st = b / 1024, sb = b % 1024, swz = sb ^ (((sb >> 9) & 1) << 5); R = (st >> 1) * 16 + swz / 64; C = (st & 1) * 32 + (swz % 64) / 2; }
__host__ __device__ __forceinline__ int perm32(int rho) { const int n = rho >> 4, i = rho & 15; return 8 * (i >> 2) + 4 * n + (i & 3); }

struct Unit { int pm, pn; };
struct Gemm { const bf16_t* A; const bf16_t* Bt; int M, N, K; };

struct StaticOrder {
    int nM, nN, nwg, G, c;
    __host__ __device__ void init(int M, int N, int G_, int c_) { nM = M / BM; nN = N / BM; nwg = nM * nN; G = G_; c = c_; }
    __host__ __device__ bool next(int i, Unit& u) const {
        const long L = (long)i * G + c; if (L >= nwg) return false;
        int wgid = (int)L; { const int q = nwg / NXCD, r = nwg % NXCD, xcd = wgid % NXCD, off = wgid / NXCD; wgid = (xcd < r ? xcd * (q + 1) : r * (q + 1) + (xcd - r) * q) + off; }
        const int nig = WGM * nN, gid = wgid / nig, fm = gid * WGM, gsz = (nM - fm) < WGM ? (nM - fm) : WGM;
        u.pm = fm + ((wgid % nig) % gsz); u.pn = (wgid % nig) / gsz; return true;
    }
    __device__ __forceinline__ void a_ready(const Unit&) const {}
    __device__ __forceinline__ void done(const Unit&) const {}
};


__device__ __forceinline__ unsigned cvt_pk_bf16(float lo, float hi) { unsigned r; asm volatile("v_cvt_pk_bf16_f32 %0, %1, %2" : "=v"(r) : "v"(lo), "v"(hi)); return r; }
__device__ __forceinline__ u32x4 pack8(const f32x4& v0, const f32x4& v1) { u32x4 w; w.x = cvt_pk_bf16(v0[0], v0[1]); w.y = cvt_pk_bf16(v0[2], v0[3]); w.z = cvt_pk_bf16(v1[0], v1[1]); w.w = cvt_pk_bf16(v1[2], v1[3]); return w; }

struct EpiProj0F {
    static constexpr bool PERM = true, AFTER_DRAIN = false;
    bf16_t* O;
    __device__ __forceinline__ void operator()(const f32x4 (&acc)[2][2][4][2], const Unit& u, int wr, int wc, int fr, int fq) const {
        const int row0 = u.pm * BM + wr * 64 + fr, col0 = u.pn * BM + wc * 32 + 8 * fq;
#pragma unroll
        for (int ai = 0; ai < 2; ++ai)
#pragma unroll
            for (int m = 0; m < 4; ++m) { bf16_t* rowp = O + (size_t)(row0 + ai * HALF + m * 16) * N0P + col0;
#pragma unroll
                for (int bj = 0; bj < 2; ++bj) *(u32x4*)(rowp + bj * HALF) = pack8(acc[ai][bj][m][0], acc[ai][bj][m][1]); }
    }
};
struct EpiY0F {
    static constexpr bool PERM = true, AFTER_DRAIN = false;
    Ptrs P;
    __device__ __forceinline__ void operator()(const f32x4 (&acc)[2][2][4][2], const Unit& u, int wr, int wc, int fr, int fq) const {
        const int row0 = u.pm * BM + wr * 64 + fr, col0 = u.pn * BM + wc * 32 + 8 * fq;
        float* Y0 = (float*)(P.ws + WS_Y0); bf16_t* YB = (bf16_t*)(P.ws + WS_Y0B); float* SSQ = (float*)(P.ws + WS_SSQ);
#pragma unroll
        for (int ai = 0; ai < 2; ++ai)
#pragma unroll
            for (int m = 0; m < 4; ++m) { const int row = row0 + ai * HALF + m * 16; const float* xr = xrow(P, row) + col0; float ss = 0.f;
#pragma unroll
                for (int bj = 0; bj < 2; ++bj) {
                    const f32x4 y0 = acc[ai][bj][m][0] + *(const f32x4*)(xr + bj * HALF), y1 = acc[ai][bj][m][1] + *(const f32x4*)(xr + bj * HALF + 4);
                    *(f32x4*)(Y0 + (size_t)row * D + col0 + bj * HALF) = y0; *(f32x4*)(Y0 + (size_t)row * D + col0 + bj * HALF + 4) = y1;
                    *(u32x4*)(YB + (size_t)row * D + col0 + bj * HALF) = pack8(y0, y1);
                    ss += (y0[0] * y0[0] + y0[1] * y0[1]) + (y0[2] * y0[2] + y0[3] * y0[3]) + (y1[0] * y1[0] + y1[1] * y1[1]) + (y1[2] * y1[2] + y1[3] * y1[3]); }
                ss += __shfl_xor(ss, 16); ss += __shfl_xor(ss, 32);
                if (fq == 0) SSQ[(size_t)row * 16 + u.pn * 4 + wc] = ss; }
    }
};
struct EpiL1F {
    static constexpr bool PERM = true, AFTER_DRAIN = false;
    Ptrs P;
    __device__ __forceinline__ void operator()(const f32x4 (&acc)[2][2][4][2], const Unit& u, int wr, int wc, int fr, int fq) const {
        const int row0 = u.pm * BM + wr * 64 + fr, colt = u.pn * BM, reg = colt >> 10, c0 = (colt & 1023) + wc * 32 + 8 * fq;
        const float* SSQ = (const float*)(P.ws + WS_SSQ);
#pragma unroll
        for (int ai = 0; ai < 2; ++ai)
#pragma unroll
            for (int m = 0; m < 4; ++m) { const int row = row0 + ai * HALF + m * 16;
                const f32x4* sp = (const f32x4*)(SSQ + (size_t)row * 16); const f32x4 s0 = sp[0], s1 = sp[1], s2 = sp[2], s3 = sp[3];
                const f32x4 st = (s0 + s1) + (s2 + s3); const float rs = rsqrtf(((st[0] + st[1]) + (st[2] + st[3])) * (1.f / D) + EPS);
#pragma unroll
                for (int bj = 0; bj < 2; ++bj) { const int c = c0 + bj * HALF; f32x4 v0 = acc[ai][bj][m][0] * rs, v1 = acc[ai][bj][m][1] * rs;
                    if (reg == 0) { *(u32x4*)((bf16_t*)(P.ws + WS_Q1) + (size_t)row * D + c) = pack8(v0 * QSCALE, v1 * QSCALE); }
                    else if (reg == 1) { *(u32x4*)((bf16_t*)(P.ws + WS_K1) + (size_t)row * D + c) = pack8(v0, v1); float* o = P.out + off_l1k(row) + c; *(f32x4*)o = v0; *(f32x4*)(o + 4) = v1; }
                    else if (reg == 2) { bf16_t* vt = (bf16_t*)(P.ws + WS_V1T) + (size_t)c * M + row;
#pragma unroll
                        for (int j = 0; j < 4; ++j) { vt[(size_t)j * M] = f2bf(v0[j]); vt[(size_t)(4 + j) * M] = f2bf(v1[j]); }
                        float* o = P.out + off_l1v(row) + c; *(f32x4*)o = v0; *(f32x4*)(o + 4) = v1; }
                    else { *(u32x4*)((bf16_t*)(P.ws + WS_Z1) + (size_t)row * D + c) = pack8(v0, v1); } } }
    }
};
struct EpiOutF {
    static constexpr bool PERM = true, AFTER_DRAIN = false;
    Ptrs P;
    __device__ __forceinline__ void operator()(const f32x4 (&acc)[2][2][4][2], const Unit& u, int wr, int wc, int fr, int fq) const {
        const int row0 = u.pm * BM + wr * 64 + fr, col0 = u.pn * BM + wc * 32 + 8 * fq;
        const float* Y0 = (const float*)(P.ws + WS_Y0);
#pragma unroll
        for (int ai = 0; ai < 2; ++ai)
#pragma unroll
            for (int m = 0; m < 4; ++m) { const size_t ro = (size_t)(row0 + ai * HALF + m * 16) * D + col0;
#pragma unroll
                for (int bj = 0; bj < 2; ++bj) {
                    *(f32x4*)(P.out + O_Y + ro + bj * HALF) = acc[ai][bj][m][0] + *(const f32x4*)(Y0 + ro + bj * HALF);
                    *(f32x4*)(P.out + O_Y + ro + bj * HALF + 4) = acc[ai][bj][m][1] + *(const f32x4*)(Y0 + ro + bj * HALF + 4); } }
    }
};
template <class Epi, class Sched, bool ALIGN_EPI = false, bool SP2 = false>
__device__ __forceinline__ void gemm_phase(PG8_LAS unsigned char* lds, const Gemm g, const Sched& S, const Epi& E) {
    const int tid = threadIdx.x, wid = __builtin_amdgcn_readfirstlane(tid >> 6), lane = tid & 63, wr = wid >> 2, wc = wid & 3, fr = lane & 15, fq = lane >> 4;
    const int K = g.K, nt = K / BK;
    unsigned voffA[2], voffB[2];
#pragma unroll
    for (int i = 0; i < 2; ++i) { int R, C; stage_rc(tid * 16 + i * 8192, R, C); const int Rb = Epi::PERM ? ((R & ~31) + perm32(R & 31)) : R;
        voffA[i] = (unsigned)(R * K + C) * 2u; voffB[i] = (unsigned)(Rb * K + C) * 2u; }
    const size_t kstep = (size_t)(BK * 2);
    const size_t hstep = (size_t)HALF * K * 2;
    const size_t tstep = 2 * hstep;
    const unsigned ldsw = (unsigned)wid * 1024u;
    const int aoff = lds_byte(wr * 64 + fr, fq * 8), boff = lds_byte(wc * 32 + fr, fq * 8);
#define PG8_SA(b, h) (((b) * 2 + (h)) * HTB)
#define PG8_SB(b, h) ((4 + (b) * 2 + (h)) * HTB)
#define PG8_STAGE(bufoff, gbase, voff) do { _Pragma("unroll") for (int _i = 0; _i < 2; ++_i) \
        __builtin_amdgcn_global_load_lds((const unsigned*)((const char*)(gbase) + (voff)[_i]), (PG8_LAS unsigned*)(lds + (bufoff) + ldsw + _i * 8192), 16, 0, 0); } while (0)
#define PG8_LDA(dst, b, h) do { _Pragma("unroll") for (int m = 0; m < 4; ++m) _Pragma("unroll") for (int k = 0; k < 2; ++k) dst[m][k] = *(const PG8_LAS bf16x8*)(lds + PG8_SA(b, h) + aoff + m * 2048 + k * 1024); } while (0)
#define PG8_LDB(dst, b, h) do { _Pragma("unroll") for (int n = 0; n < 2; ++n) _Pragma("unroll") for (int k = 0; k < 2; ++k) dst[n][k] = *(const PG8_LAS bf16x8*)(lds + PG8_SB(b, h) + boff + n * 2048 + k * 1024); } while (0)
#define PG8_MMA(ai, bj, At, Bt) do { __builtin_amdgcn_s_setprio(1); _Pragma("unroll") for (int m = 0; m < 4; ++m) _Pragma("unroll") for (int n = 0; n < 2; ++n) _Pragma("unroll") for (int k = 0; k < 2; ++k) \
        acc[ai][bj][m][n] = __builtin_amdgcn_mfma_f32_16x16x32_bf16(Bt[n][k], At[m][k], acc[ai][bj][m][n], 0, 0, 0); __builtin_amdgcn_s_setprio(0); } while (0)
#define PG8_WAIT_V(n) asm volatile("s_waitcnt vmcnt(" #n ")" ::: "memory")
#define PG8_WAIT_L(n) asm volatile("s_waitcnt lgkmcnt(" #n ")" ::: "memory")
#define PG8_BAR __builtin_amdgcn_s_barrier()
#define PG8_SCHED __builtin_amdgcn_sched_barrier(0)
    Unit cur, nxt; int ui = 0;
    if (!S.next(0, cur)) return;
    f32x4 acc[2][2][4][2];
#pragma unroll
    for (int a = 0; a < 2; ++a)
#pragma unroll
        for (int b = 0; b < 2; ++b)
#pragma unroll
            for (int m = 0; m < 4; ++m)
#pragma unroll
                for (int n = 0; n < 2; ++n) acc[a][b][m][n] = (f32x4){0.f, 0.f, 0.f, 0.f};
    bf16x8 At[4][2], B0[2][2], B1[2][2];
    const char* cA = (const char*)g.A + (size_t)cur.pm * tstep; const char* cB = (const char*)g.Bt + (size_t)cur.pn * tstep;
    S.a_ready(cur);
    if constexpr (SP2) {
        PG8_STAGE(PG8_SB(0, 0), cB, voffB); PG8_STAGE(PG8_SB(0, 1), cB + hstep, voffB); PG8_STAGE(PG8_SA(0, 0), cA, voffA); PG8_STAGE(PG8_SA(0, 1), cA + hstep, voffA);
        if (wr == 1) PG8_BAR;
        PG8_WAIT_V(2); PG8_BAR;
        PG8_STAGE(PG8_SB(1, 0), cB + kstep, voffB); PG8_STAGE(PG8_SA(1, 0), cA + kstep, voffA); PG8_STAGE(PG8_SB(1, 1), cB + hstep + kstep, voffB);
        PG8_WAIT_V(6); PG8_BAR;
    } else {
        PG8_STAGE(PG8_SB(0, 0), cB, voffB); PG8_STAGE(PG8_SA(0, 0), cA, voffA); PG8_STAGE(PG8_SB(0, 1), cB + hstep, voffB); PG8_STAGE(PG8_SA(0, 1), cA + hstep, voffA);
        if (wr == 1) PG8_BAR;
        PG8_WAIT_V(4); PG8_BAR;
        PG8_STAGE(PG8_SB(1, 0), cB + kstep, voffB); PG8_STAGE(PG8_SA(1, 0), cA + kstep, voffA); PG8_STAGE(PG8_SB(1, 1), cB + hstep + kstep, voffB);
        PG8_WAIT_V(6); PG8_BAR;
    }
    for (;;) {
        const bool has_next = S.next(ui + 1, nxt);
        const char* nA = has_next ? (const char*)g.A + (size_t)nxt.pm * tstep : cA; const char* nB = has_next ? (const char*)g.Bt + (size_t)nxt.pn * tstep : cB;
        for (int t = 0; t < nt; t += 2) {
            const bool last = (t == nt - 2);
            const char* a1 = cA + (size_t)(t + 1) * kstep;
            const char* a2 = last ? nA : cA + (size_t)(t + 2) * kstep; const char* b2 = last ? nB : cB + (size_t)(t + 2) * kstep;
            const char* a3 = a2 + kstep; const char* b3 = b2 + kstep;
            if (last && has_next) S.a_ready(nxt);
            if constexpr (SP2) {
            PG8_LDB(B0, 0, 0); PG8_LDB(B1, 0, 1); PG8_SCHED; PG8_LDA(At, 0, 0); PG8_STAGE(PG8_SA(1, 1), a1 + hstep, voffA);
            PG8_WAIT_V(8); PG8_WAIT_L(0); PG8_BAR; PG8_MMA(0, 0, At, B0); PG8_MMA(0, 1, At, B1); PG8_BAR; PG8_SCHED;
            PG8_LDA(At, 0, 1); PG8_STAGE(PG8_SB(0, 0), b2, voffB); PG8_STAGE(PG8_SB(0, 1), b2 + hstep, voffB); PG8_STAGE(PG8_SA(0, 0), a2, voffA);
            PG8_WAIT_V(8); PG8_WAIT_L(0); PG8_BAR; PG8_MMA(1, 0, At, B0); PG8_MMA(1, 1, At, B1); PG8_BAR; PG8_SCHED;
            PG8_LDB(B0, 1, 0); PG8_LDB(B1, 1, 1); PG8_SCHED; PG8_LDA(At, 1, 0); PG8_STAGE(PG8_SA(0, 1), a2 + hstep, voffA);
            PG8_WAIT_V(8); PG8_WAIT_L(0); PG8_BAR; PG8_MMA(0, 0, At, B0); PG8_MMA(0, 1, At, B1); PG8_BAR; PG8_SCHED;
            PG8_LDA(At, 1, 1); PG8_STAGE(PG8_SB(1, 0), b3, voffB); PG8_STAGE(PG8_SB(1, 1), b3 + hstep, voffB); PG8_STAGE(PG8_SA(1, 0), a3, voffA);
            PG8_WAIT_V(8); PG8_WAIT_L(0); PG8_BAR; PG8_MMA(1, 0, At, B0); PG8_MMA(1, 1, At, B1); PG8_BAR; PG8_SCHED;
            } else {
            PG8_LDB(B0, 0, 0); PG8_SCHED; PG8_LDA(At, 0, 0); PG8_STAGE(PG8_SA(1, 1), a1 + hstep, voffA);
            PG8_WAIT_L(8); PG8_BAR; PG8_WAIT_L(0); PG8_MMA(0, 0, At, B0); PG8_BAR; PG8_SCHED;
            PG8_LDB(B1, 0, 1); PG8_STAGE(PG8_SB(0, 0), b2, voffB);
            PG8_BAR; PG8_WAIT_L(0); PG8_MMA(0, 1, At, B1); PG8_BAR;
            PG8_LDA(At, 0, 1); PG8_STAGE(PG8_SA(0, 0), a2, voffA);
            PG8_BAR; PG8_WAIT_L(0); PG8_MMA(1, 0, At, B0); PG8_BAR; PG8_SCHED;
            PG8_STAGE(PG8_SB(0, 1), b2 + hstep, voffB);
            PG8_WAIT_V(6); PG8_BAR; PG8_MMA(1, 1, At, B1); PG8_BAR;
            PG8_LDB(B0, 1, 0); PG8_SCHED; PG8_LDA(At, 1, 0); PG8_STAGE(PG8_SA(0, 1), a2 + hstep, voffA);
            PG8_WAIT_L(8); PG8_BAR; PG8_WAIT_L(0); PG8_MMA(0, 0, At, B0); PG8_BAR; PG8_SCHED;
            PG8_LDB(B1, 1, 1); PG8_STAGE(PG8_SB(1, 0), b3, voffB);
            PG8_BAR; PG8_WAIT_L(0); PG8_MMA(0, 1, At, B1); PG8_BAR;
            PG8_LDA(At, 1, 1); PG8_STAGE(PG8_SA(1, 0), a3, voffA);
            PG8_BAR; PG8_WAIT_L(0); PG8_MMA(1, 0, At, B0); PG8_BAR; PG8_SCHED;
            PG8_STAGE(PG8_SB(1, 1), b3 + hstep, voffB);
            PG8_WAIT_V(6); PG8_BAR; PG8_MMA(1, 1, At, B1); PG8_BAR;
            }
        }
        if constexpr (ALIGN_EPI) { if (wr == 0) PG8_BAR; }
        if constexpr (!Epi::AFTER_DRAIN) { E(acc, cur, wr, wc, fr, fq); S.done(cur); }
        if (!has_next) break;
#pragma unroll
        for (int a = 0; a < 2; ++a)
#pragma unroll
            for (int b = 0; b < 2; ++b)
#pragma unroll
                for (int m = 0; m < 4; ++m)
#pragma unroll
                    for (int n = 0; n < 2; ++n) acc[a][b][m][n] = (f32x4){0.f, 0.f, 0.f, 0.f};
        cur = nxt; cA = nA; cB = nB; ++ui;
        if constexpr (ALIGN_EPI) { if (wr == 1) PG8_BAR; }
    }
    PG8_WAIT_V(0);
    if constexpr (!ALIGN_EPI) { if (wr == 0) PG8_BAR; }
    PG8_BAR;
    if constexpr (Epi::AFTER_DRAIN) { E.fused(acc, cur, wr, wc, fr, fq, lds, wid, lane); S.done(cur); }
#undef PG8_SA
#undef PG8_SB
#undef PG8_STAGE
#undef PG8_LDA
#undef PG8_LDB
#undef PG8_MMA
#undef PG8_WAIT_V
#undef PG8_WAIT_L
#undef PG8_BAR
#undef PG8_SCHED
}
}
namespace da {
#define DLAS __attribute__((address_space(3)))
typedef short bf16x8 __attribute__((ext_vector_type(8)));
typedef short s16x4 __attribute__((ext_vector_type(4)));
typedef float f32x16 __attribute__((ext_vector_type(16)));
typedef float f32x4 __attribute__((ext_vector_type(4)));
typedef unsigned u32x4 __attribute__((ext_vector_type(4)));

constexpr int KROW = 272, KBUF = 64 * KROW, VBUF = 16384;
constexpr int OFF_K = 0, OFF_V = 2 * KBUF;
constexpr int OFF_STAGE = 0;
constexpr int OFF_LST = 131072;
constexpr int OFF_BIAS = OFF_LST + 1024;
constexpr int DA_LDS_END = OFF_BIAS + 1024;

struct Unit { int kind, h, idx; };

__device__ __forceinline__ unsigned cvtpk(float lo, float hi) { unsigned r; asm volatile("v_cvt_pk_bf16_f32 %0, %1, %2" : "=v"(r) : "v"(lo), "v"(hi)); return r; }
__device__ __forceinline__ u32x4 pack8(const f32x4& a, const f32x4& b) { u32x4 w; w.x = cvtpk(a[0], a[1]); w.y = cvtpk(a[2], a[3]); w.z = cvtpk(b[0], b[1]); w.w = cvtpk(b[2], b[3]); return w; }

struct Stage { f32x4 kA0, kA1, vA0, vA1, kB0, kB1, vB0, vB1; };
template <int KIND> __device__ __forceinline__ void chunk_issue(const Ptrs& P, const Unit& u, int t, int c, f32x4& k0, f32x4& k1, f32x4& v0, f32x4& v1) {
    const int row = c >> 4, ch = c & 15;
    if (KIND == 0 || t == 16) {
        const int m = (KIND == 0) ? 64 * t + row : TP + 32 * u.idx + (row & 31);
        const bf16_t* kp = (const bf16_t*)(P.ws + WS_K0) + (size_t)m * 512 + 128 * u.h + ch * 8;
        const bf16_t* vp = (const bf16_t*)(P.ws + WS_PROJ0) + (size_t)m * N0P + C_V + 128 * u.h + ch * 8;
        f32x4 kv = *(const f32x4*)kp, vv = *(const f32x4*)vp;
        if (KIND != 0 && row >= 32) { kv = (f32x4){0.f, 0.f, 0.f, 0.f}; vv = kv; }
        k0 = kv; v0 = vv;
    } else {
        const size_t ro = (((size_t)u.idx * PAST + 64 * t + row) * 4 + u.h) * 128 + ch * 8;
        const float* kp = P.in[2] + ro; const float* vp = P.in[3] + ro;
        k0 = *(const f32x4*)kp; k1 = *(const f32x4*)(kp + 4); v0 = *(const f32x4*)vp; v1 = *(const f32x4*)(vp + 4);
    }
}
template <int KIND> __device__ __forceinline__ void chunk_write(int t, int c, DLAS unsigned char* lds, int buf, const f32x4& k0, const f32x4& k1, const f32x4& v0, const f32x4& v1) {
    const int row = c >> 4, ch = c & 15;
    DLAS unsigned char* kd = lds + OFF_K + buf * KBUF + row * KROW + ch * 16;
    DLAS unsigned char* vd = lds + OFF_V + buf * VBUF + (ch >> 2) * 4096 + row * 64 + (ch & 3) * 16;
    if (KIND == 0 || t == 16) { *(DLAS f32x4*)kd = k0; *(DLAS f32x4*)vd = v0; }
    else { *(DLAS u32x4*)kd = pack8(k0, k1); *(DLAS u32x4*)vd = pack8(v0, v1); }
}
#define TILE_ISSUE(t_) do { chunk_issue<KIND>(P, u, (t_), tid, S.kA0, S.kA1, S.vA0, S.vA1); chunk_issue<KIND>(P, u, (t_), tid + 512, S.kB0, S.kB1, S.vB0, S.vB1); } while (0)
#define TILE_WRITE(t_, buf_) do { chunk_write<KIND>((t_), tid, lds, (buf_), S.kA0, S.kA1, S.vA0, S.vA1); chunk_write<KIND>((t_), tid + 512, lds, (buf_), S.kB0, S.kB1, S.vB0, S.vB1); } while (0)

template <int KIND> __device__ __forceinline__ void unit_run(const Ptrs& P, const Unit& u0, DLAS unsigned char* lds, int tid) {
    const Unit u{KIND, u0.h, u0.idx};
    const int lane = tid & 63, wave = __builtin_amdgcn_readfirstlane(tid >> 6), r32 = lane & 31, hi = lane >> 5, mp = wave >> 2, w4 = wave & 3;
    constexpr bool is_s = KIND != 0;
    int m0row, qpos0, NT, cq;
    if (!is_s) { m0row = 128 * u.idx + 32 * w4; qpos0 = m0row; NT = 2 * u.idx + 2; cq = m0row >> 6; }
    else { m0row = TP + 32 * u.idx; qpos0 = PAST; NT = 17; cq = 16; }
    const Tab* T = (const Tab*)(P.ws + WS_TAB);
    DLAS float* lst = (DLAS float*)(lds + OFF_LST);
    DLAS float* bl = (DLAS float*)(lds + OFF_BIAS);
    if (tid < 256) { bl[tid] = (T->bias[u.h][tid] - T->biasfar[u.h]) * LOG2E; lst[tid] = 0.f; }
    bf16x8 qf[4];
    { const bf16_t* qp = (const bf16_t*)(P.ws + WS_Q0) + (size_t)(m0row + r32) * 512 + 128 * u.h + 64 * mp + 8 * hi;
#pragma unroll
      for (int s = 0; s < 4; ++s) qf[s] = *(const bf16x8*)(qp + 16 * s); }
    f32x16 o[4];
#pragma unroll
    for (int d = 0; d < 4; ++d)
#pragma unroll
        for (int r = 0; r < 16; ++r) o[d][r] = 0.f;
    float lsum = 0.f;
    Stage S;
    { const f32x4 z = (f32x4){0.f, 0.f, 0.f, 0.f}; S.kA0 = z; S.kA1 = z; S.vA0 = z; S.vA1 = z; S.kB0 = z; S.kB1 = z; S.vB0 = z; S.vB1 = z; }
    TILE_ISSUE(0);
    TILE_WRITE(0, 0);
    __syncthreads();
    const int vaddr = (4 * hi + ((lane & 15) >> 2)) * 64 + (16 * ((lane >> 4) & 1) + 4 * (lane & 3)) * 2;
    for (int t = 0; t < NT; ++t) {
        const int buf = t & 1;
        const bool has_next = t + 1 < NT;
        if (has_next) TILE_ISSUE(t + 1);
        const bool active = is_s ? ((t & 3) == w4) : (t <= cq);
        if (active) {
            const DLAS unsigned char* kb = lds + OFF_K + buf * KBUF + r32 * KROW + mp * 128 + hi * 16;
            f32x16 p0, p1;
#pragma unroll
            for (int r = 0; r < 16; ++r) { p0[r] = 0.f; p1[r] = 0.f; }
#pragma unroll
            for (int s = 0; s < 4; ++s) {
                const bf16x8 a0 = *(const DLAS bf16x8*)(kb + s * 32), a1 = *(const DLAS bf16x8*)(kb + 32 * KROW + s * 32);
                p0 = __builtin_amdgcn_mfma_f32_32x32x16_bf16(a0, qf[s], p0, 0, 0, 0);
                p1 = __builtin_amdgcn_mfma_f32_32x32x16_bf16(a1, qf[s], p1, 0, 0, 0);
            }
            if (t >= cq - 2) {
                const int rb = 64 * t - qpos0 - r32 + 191 + 4 * hi;
#pragma unroll
                for (int r = 0; r < 16; ++r) { const int kk = (r & 3) + 8 * (r >> 2); p0[r] += bl[rb + kk]; p1[r] += bl[rb + 32 + kk]; }
            }
#pragma unroll
            for (int r = 0; r < 16; ++r) { p0[r] = __builtin_amdgcn_exp2f(p0[r]); p1[r] = __builtin_amdgcn_exp2f(p1[r]); }
            if (is_s && t == 16) {
#pragma unroll
                for (int r = 0; r < 16; ++r) p1[r] = 0.f;
            }
            float sa = 0.f, sb = 0.f;
#pragma unroll
            for (int r = 0; r < 16; ++r) { sa += p0[r]; sb += p1[r]; }
            lsum += sa + sb;
            bf16x8 pa[4];
            pa[0] = __builtin_bit_cast(bf16x8, pack8((f32x4){p0[0], p0[1], p0[2], p0[3]}, (f32x4){p0[4], p0[5], p0[6], p0[7]}));
            pa[1] = __builtin_bit_cast(bf16x8, pack8((f32x4){p0[8], p0[9], p0[10], p0[11]}, (f32x4){p0[12], p0[13], p0[14], p0[15]}));
            pa[2] = __builtin_bit_cast(bf16x8, pack8((f32x4){p1[0], p1[1], p1[2], p1[3]}, (f32x4){p1[4], p1[5], p1[6], p1[7]}));
            pa[3] = __builtin_bit_cast(bf16x8, pack8((f32x4){p1[8], p1[9], p1[10], p1[11]}, (f32x4){p1[12], p1[13], p1[14], p1[15]}));
            const DLAS unsigned char* vb = lds + OFF_V + buf * VBUF + vaddr;
#pragma unroll
            for (int d = 0; d < 4; ++d)
#pragma unroll
                for (int k = 0; k < 4; ++k) {
                    const s16x4 lo = __builtin_bit_cast(s16x4, __builtin_amdgcn_ds_read_tr16_b64_v4i16((DLAS s16x4*)(vb + d * 4096 + k * 1024)));
                    const s16x4 hh = __builtin_bit_cast(s16x4, __builtin_amdgcn_ds_read_tr16_b64_v4i16((DLAS s16x4*)(vb + d * 4096 + k * 1024 + 512)));
                    const bf16x8 bf = (bf16x8){lo[0], lo[1], lo[2], lo[3], hh[0], hh[1], hh[2], hh[3]};
                    o[d] = __builtin_amdgcn_mfma_f32_32x32x16_bf16(pa[k], bf, o[d], 0, 0, 0);
                    if (k == 3) __builtin_amdgcn_sched_barrier(0);
                }
        }
        if (has_next) TILE_WRITE(t + 1, buf ^ 1);
        __syncthreads();
    }
    lsum += __shfl_xor(lsum, 32);
    DLAS float* stage = (DLAS float*)(lds + OFF_STAGE);
    {
        const int rowb = is_s ? 0 : 32 * w4;
        DLAS float* st0 = stage + (mp * 128 + rowb + 4 * hi) * 128 + r32;
#pragma unroll 1
        for (int round = 0; round < (is_s ? 4 : 1); ++round) {
            if (!is_s || round == w4) {
                const bool first = !is_s || round == 0;
#pragma unroll
                for (int d = 0; d < 4; ++d)
#pragma unroll
                    for (int r = 0; r < 16; ++r) {
                        DLAS float* st = st0 + ((r & 3) + 8 * (r >> 2)) * 128 + d * 32;
                        *st = first ? o[d][r] : *st + o[d][r];
                    }
                if (hi == 0) { DLAS float* lp = &lst[mp * 128 + rowb + r32]; *lp = first ? lsum : *lp + lsum; }
            }
            __syncthreads();
        }
    }
    {
        const int nrow = is_s ? 4 : 16;
        const float lam = T->lam;
        const float* sg = P.in[18];
        for (int i = 0; i < nrow; ++i) {
            const int row = wave * nrow + i;
            const float l1 = lst[row], l2 = lst[128 + row];
            const float il1 = 1.f / l1, il2 = lam / l2;
            const float a0 = stage[row * 128 + lane] * il1 - stage[(128 + row) * 128 + lane] * il2;
            const float a1 = stage[row * 128 + 64 + lane] * il1 - stage[(128 + row) * 128 + 64 + lane] * il2;
            const float ss = wave_sum(a0 * a0 + a1 * a1);
            const float rr = rsqrtf(ss * (1.f / 128) + EPS) * (1.f - LAMBDA_INIT);
            const int m = is_s ? TP + 32 * u.idx + row : 128 * u.idx + row;
            const bf16_t* za = (const bf16_t*)(P.ws + WS_PROJ0) + (size_t)m * N0P + C_ZA + 128 * u.h;
            bf16_t* cat = (bf16_t*)(P.ws + WS_CAT) + (size_t)m * D + 128 * u.h;
            cat[lane] = f2bf(a0 * rr * sg[lane] * silu(bf2f(za[lane])));
            cat[64 + lane] = f2bf(a1 * rr * sg[64 + lane] * silu(bf2f(za[64 + lane])));
        }
    }
    __syncthreads();
}

__device__ __forceinline__ void phase(const Ptrs& P, DLAS unsigned char* lds, int vcu, int nvcu, int tid) {
    if (nvcu == 256) {
        const int v = vcu, h = v >> 6, s = v & 63;
        unit_run<0>(P, Unit{0, h, 127 - s}, lds, tid);
        unit_run<0>(P, Unit{0, h, s}, lds, tid);
        if (v < 128) unit_run<1>(P, Unit{1, v & 3, v >> 2}, lds, tid);
    } else {
#pragma unroll 1
        for (int i = vcu; i < 512; i += nvcu) unit_run<0>(P, Unit{0, i >> 7, 127 - (i & 127)}, lds, tid);
#pragma unroll 1
        for (int i = vcu; i < 128; i += nvcu) unit_run<1>(P, Unit{1, i & 3, i >> 2}, lds, tid);
    }
}
#undef DLAS
}
namespace sb {
typedef short bf16x8 __attribute__((ext_vector_type(8)));
typedef short s16x4 __attribute__((ext_vector_type(4)));
typedef float f32x16 __attribute__((ext_vector_type(16)));
typedef float f32x4 __attribute__((ext_vector_type(4)));
typedef unsigned u32x4 __attribute__((ext_vector_type(4)));
typedef unsigned u32x2 __attribute__((ext_vector_type(2)));

__device__ __forceinline__ unsigned cvtpk(float lo, float hi) { unsigned r; asm volatile("v_cvt_pk_bf16_f32 %0, %1, %2" : "=v"(r) : "v"(lo), "v"(hi)); return r; }
constexpr float RUN_EXIT = 160.f;

template <int SAMPLE> __device__ __forceinline__ void unit_run(const Ptrs& P, int b, int h, int qt, int lane) {
    const int r32 = lane & 31, hi = lane >> 5;
    const bf16_t* Q1 = (const bf16_t*)(P.ws + WS_Q1); const bf16_t* K1 = (const bf16_t*)(P.ws + WS_K1); const bf16_t* V1T = (const bf16_t*)(P.ws + WS_V1T);
    const int m0 = SAMPLE ? TP + 32 * b : 32 * qt;
    const int q0 = SAMPLE ? PAST : 32 * qt;
    bf16x8 qf[4];
    { const bf16_t* qp = Q1 + (size_t)(m0 + r32) * D + 64 * h + 8 * hi;
#pragma unroll
      for (int s = 0; s < 4; ++s) qf[s] = *(const bf16x8*)(qp + 16 * s); }
    f32x16 o0, o1;
#pragma unroll
    for (int r = 0; r < 16; ++r) { o0[r] = 0.f; o1[r] = 0.f; }
    float run = 0.f;
#pragma unroll 1
    for (int k0 = q0; k0 >= 0; k0 -= 32) {
        const bool diag = (k0 == q0);
        const bool cache = SAMPLE && !diag;
        f32x16 p;
#pragma unroll
        for (int r = 0; r < 16; ++r) p[r] = 0.f;
        if (!cache) {
            const int mk = SAMPLE ? TP + 32 * b : k0;
            const bf16_t* kp = K1 + (size_t)(mk + r32) * D + 64 * h + 8 * hi;
#pragma unroll
            for (int s = 0; s < 4; ++s) { const bf16x8 a = *(const bf16x8*)(kp + 16 * s); p = __builtin_amdgcn_mfma_f32_32x32x16_bf16(a, qf[s], p, 0, 0, 0); }
        } else {
            const float* kp = P.in[6] + (((size_t)b * PAST + k0 + r32) * 16 + h) * 64 + 8 * hi;
#pragma unroll
            for (int s = 0; s < 4; ++s) { const f32x4 x0 = *(const f32x4*)(kp + 16 * s), x1 = *(const f32x4*)(kp + 16 * s + 4);
                u32x4 w; w.x = cvtpk(x0[0], x0[1]); w.y = cvtpk(x0[2], x0[3]); w.z = cvtpk(x1[0], x1[1]); w.w = cvtpk(x1[2], x1[3]);
                p = __builtin_amdgcn_mfma_f32_32x32x16_bf16(__builtin_bit_cast(bf16x8, w), qf[s], p, 0, 0, 0); }
        }
        float sp[16];
#pragma unroll
        for (int r = 0; r < 16; ++r) {
            const int kk = (r & 3) + 8 * (r >> 2) + 4 * hi;
            const float e = __builtin_amdgcn_exp2f(p[r]);
            float s = __builtin_amdgcn_logf(1.f + e);
            if (diag && !(kk < r32)) s = 0.f;
            sp[r] = s;
        }
        float a[4], bsum[4];
#pragma unroll
        for (int g = 0; g < 4; ++g) { a[g] = (sp[4 * g] + sp[4 * g + 1]) + (sp[4 * g + 2] + sp[4 * g + 3]); bsum[g] = __shfl_xor(a[g], 32); }
        float Tg[4];
        { float accA = 0.f, accB = 0.f;
#pragma unroll
          for (int g = 3; g >= 0; --g) {
              const float pb = hi ? accB : accB + bsum[g];
              Tg[g] = accA + pb;
              accA += a[g]; accB += bsum[g];
          }
          const float tot = accA + accB;
#pragma unroll
          for (int g = 0; g < 4; ++g) {
              float c = Tg[g] + run;
#pragma unroll
              for (int i = 3; i >= 0; --i) {
                  const int r = 4 * g + i, kk = i + 8 * g + 4 * hi;
                  c += sp[r];
                  float w = __builtin_amdgcn_exp2f(p[r] - c);
                  if (diag && !(kk < r32)) w = 0.f;
                  p[r] = w;
              }
          }
          run += tot;
        }
        u32x4 w0, w1;
        w0.x = cvtpk(p[0], p[1]); w0.y = cvtpk(p[2], p[3]); w0.z = cvtpk(p[4], p[5]); w0.w = cvtpk(p[6], p[7]);
        w1.x = cvtpk(p[8], p[9]); w1.y = cvtpk(p[10], p[11]); w1.z = cvtpk(p[12], p[13]); w1.w = cvtpk(p[14], p[15]);
        const bf16x8 pa0 = __builtin_bit_cast(bf16x8, w0), pa1 = __builtin_bit_cast(bf16x8, w1);
        if (!cache) {
            const int mk = SAMPLE ? TP + 32 * b : k0;
            const bf16_t* vp = V1T + (size_t)(64 * h + r32) * M + mk + 4 * hi;
#pragma unroll
            for (int d = 0; d < 2; ++d)
#pragma unroll
                for (int s = 0; s < 2; ++s) {
                    const u32x2 lo = *(const u32x2*)(vp + (size_t)(32 * d) * M + 16 * s), hh = *(const u32x2*)(vp + (size_t)(32 * d) * M + 16 * s + 8);
                    const u32x4 w = (u32x4){lo.x, lo.y, hh.x, hh.y};
                    if (d == 0) o0 = __builtin_amdgcn_mfma_f32_32x32x16_bf16(s == 0 ? pa0 : pa1, __builtin_bit_cast(bf16x8, w), o0, 0, 0, 0);
                    else o1 = __builtin_amdgcn_mfma_f32_32x32x16_bf16(s == 0 ? pa0 : pa1, __builtin_bit_cast(bf16x8, w), o1, 0, 0, 0);
                }
        } else {
            const float* vp = P.in[7] + (((size_t)b * PAST + k0 + 4 * hi) * 16 + h) * 64 + r32;
#pragma unroll
            for (int d = 0; d < 2; ++d)
#pragma unroll
                for (int s = 0; s < 2; ++s) {
                    float x[8];
#pragma unroll
                    for (int j = 0; j < 8; ++j) x[j] = vp[(size_t)(16 * s + 8 * (j >> 2) + (j & 3)) * 1024 + 32 * d];
                    u32x4 w; w.x = cvtpk(x[0], x[1]); w.y = cvtpk(x[2], x[3]); w.z = cvtpk(x[4], x[5]); w.w = cvtpk(x[6], x[7]);
                    if (d == 0) o0 = __builtin_amdgcn_mfma_f32_32x32x16_bf16(s == 0 ? pa0 : pa1, __builtin_bit_cast(bf16x8, w), o0, 0, 0, 0);
                    else o1 = __builtin_amdgcn_mfma_f32_32x32x16_bf16(s == 0 ? pa0 : pa1, __builtin_bit_cast(bf16x8, w), o1, 0, 0, 0);
                }
        }
        if (__all(run >= RUN_EXIT)) break;
    }
    const bf16_t* Z1 = (const bf16_t*)(P.ws + WS_Z1); bf16_t* O1 = (bf16_t*)(P.ws + WS_O1B);
#pragma unroll
    for (int r = 0; r < 16; ++r) {
        const int q = (r & 3) + 8 * (r >> 2) + 4 * hi;
        const size_t off = (size_t)(m0 + q) * D + 64 * h + r32;
        O1[off] = f2bf(o0[r] * silu(bf2f(Z1[off])));
        O1[off + 32] = f2bf(o1[r] * silu(bf2f(Z1[off + 32])));
    }
}

__device__ __forceinline__ void phase(const Ptrs& P, int gw, int ngw, int lane) {
#pragma unroll 1
    for (int i = gw; i < 16 * 512; i += ngw) unit_run<0>(P, 0, i & 15, i >> 4, lane);
#pragma unroll 1
    for (int i = gw; i < 16 * 32; i += ngw) unit_run<1>(P, i >> 4, i & 15, 0, lane);
}
}
namespace rw {
#define RLAS __attribute__((address_space(3)))
typedef short bf16x8 __attribute__((ext_vector_type(8)));
typedef float f32x16 __attribute__((ext_vector_type(16)));
typedef float f32x4 __attribute__((ext_vector_type(4)));
typedef unsigned u32x4 __attribute__((ext_vector_type(4)));
typedef unsigned u32x2 __attribute__((ext_vector_type(2)));

constexpr int NUNIT = 2048 + 256;
constexpr size_t U_MFRAG = 0;
constexpr size_t U_NRAW = 16384;
constexpr size_t U_HRAW = 32768;
constexpr size_t U_G = 49152;
constexpr size_t U_BON = 57344;
constexpr size_t U_BYTES = 65536;
static_assert(WS_RW + (size_t)NUNIT * U_BYTES <= WS_SST, "rw region");

constexpr int SB = 144, SF = 272;
constexpr int BSZ = 64 * SB, FSZ = 64 * SF;
constexpr int L_S0 = 0, L_S1 = BSZ, L_S2 = 2 * BSZ, L_S3 = 3 * BSZ, L_S4 = 4 * BSZ, L_S5 = 5 * BSZ, L_S6 = 6 * BSZ, L_S7 = 7 * BSZ, L_S8 = 8 * BSZ, L_S9 = 9 * BSZ;
constexpr int L_F0 = 10 * BSZ, L_F1 = L_F0 + FSZ, L_F2 = L_F1 + FSZ;
constexpr int L_PC = L_F2 + FSZ;
constexpr int L_TOT = L_PC + 256;
constexpr int RW_LDS_END = L_TOT + 2048;
static_assert(RW_LDS_END <= 147456, "rw lds");

__device__ __forceinline__ unsigned cvtpk(float lo, float hi) { unsigned r; asm volatile("v_cvt_pk_bf16_f32 %0, %1, %2" : "=v"(r) : "v"(lo), "v"(hi)); return r; }
__device__ __forceinline__ float bflo(unsigned w) { return __uint_as_float(w << 16); }
__device__ __forceinline__ float bfhi(unsigned w) { return __uint_as_float(w & 0xffff0000u); }

__device__ __forceinline__ f32x16 mm_tile(f32x16 acc, const RLAS unsigned char* A, int arow0, const RLAS unsigned char* B, int brow0, int r32, int hi) {
    const RLAS unsigned char* ap = A + (arow0 + r32) * SB + hi * 16;
    const RLAS unsigned char* bp = B + (brow0 + r32) * SB + hi * 16;
#pragma unroll
    for (int s = 0; s < 4; ++s) acc = __builtin_amdgcn_mfma_f32_32x32x16_bf16(*(const RLAS bf16x8*)(ap + 32 * s), *(const RLAS bf16x8*)(bp + 32 * s), acc, 0, 0, 0);
    return acc;
}
__device__ __forceinline__ f32x16 zero16() { f32x16 z;
#pragma unroll
    for (int r = 0; r < 16; ++r) z[r] = 0.f; return z; }

template <int J> struct SolveStep {
    static __device__ __forceinline__ void run(float (&R)[16], const RLAS unsigned char* ap  ) {
        constexpr int jq = J & 3, jg = J >> 2;
        const float xj = __builtin_bit_cast(float, __builtin_amdgcn_update_dpp(0, __builtin_bit_cast(int, R[jg]), jq | (jq << 2) | (jq << 4) | (jq << 6), 0xf, 0xf, false));
#pragma unroll
        for (int gq = jg >> 2; gq < 4; ++gq) {
            const f32x4 a = *(const RLAS f32x4*)(ap + J * SF + 16 * gq);
#pragma unroll
            for (int i = 0; i < 4; ++i) { if (4 * gq + i >= jg) R[4 * gq + i] -= a[i] * xj; }
        }
        SolveStep<J + 1>::run(R, ap);
    }
};
template <> struct SolveStep<63> { static __device__ __forceinline__ void run(float (&)[16], const RLAS unsigned char*) {} };

__device__ __forceinline__ void unit_a(const Ptrs& P, int unit, RLAS unsigned char* lds, int tid) {
    asm volatile("" : "+v"(tid));
    const int lane = tid & 63, wave = __builtin_amdgcn_readfirstlane(tid >> 6), r32 = lane & 31, hi = lane >> 5;
    const bool samp = unit >= 2048;
    const int h = unit & 7, cb = samp ? (unit - 2048) >> 3 : unit >> 3;
    const int m_base = samp ? TP + 32 * cb : 64 * cb;
    const int nvalid = samp ? 32 : 64;
    const bf16_t* PR = (const bf16_t*)(P.ws + WS_PROJ0);
    unsigned char* urec = P.ws + WS_RW + (size_t)unit * U_BYTES;
    const float* mu = P.in[19];
    const int ch = 64 * h + lane;
    float rr[8], kr[8], vr[8];
    {
        const float mu_r = mu[ch], mu_k = mu[512 + ch], mu_v = mu[1024 + ch], mu_w = mu[1536 + lane], mu_a = mu[1600 + lane];
        float pr_r, pr_k, pr_v, pr_w, pr_a;
        const int t0 = 8 * wave;
        {
            const int m = m_base + t0;
            if ((!samp && m == 0) || t0 >= nvalid) { pr_r = pr_k = pr_v = pr_w = pr_a = 0.f; }
            else if (samp && t0 == 0) { const float* sh = P.in[4] + (size_t)cb * RWS; pr_r = sh[ch]; pr_k = sh[512 + ch]; pr_v = sh[1024 + ch]; pr_w = sh[1536 + lane]; pr_a = sh[1600 + lane]; }
            else { const bf16_t* p = PR + (size_t)(m - 1) * N0P + C_PRW; pr_r = bf2f(p[ch]); pr_k = bf2f(p[512 + ch]); pr_v = bf2f(p[1024 + ch]); pr_w = bf2f(p[1536 + lane]); pr_a = bf2f(p[1600 + lane]); }
        }
#pragma unroll
        for (int i = 0; i < 8; ++i) {
            const int t = t0 + i;
            float c_r = 0.f, c_k = 0.f, c_v = 0.f, c_w = 0.f, c_a = 0.f;
            if (t < nvalid) { const bf16_t* p = PR + (size_t)(m_base + t) * N0P + C_PRW; c_r = bf2f(p[ch]); c_k = bf2f(p[512 + ch]); c_v = bf2f(p[1024 + ch]); c_w = bf2f(p[1536 + lane]); c_a = bf2f(p[1600 + lane]); }
            rr[i] = c_r + (pr_r - c_r) * mu_r; kr[i] = c_k + (pr_k - c_k) * mu_k; vr[i] = c_v + (pr_v - c_v) * mu_v;
            const float wl = c_w + (pr_w - c_w) * mu_w, al = c_a + (pr_a - c_a) * mu_a;
            *(RLAS bf16_t*)(lds + L_S0 + t * SB + lane * 2) = f2bf(tanhf(wl));
            *(RLAS bf16_t*)(lds + L_S1 + t * SB + lane * 2) = f2bf(al);
            pr_r = c_r; pr_k = c_k; pr_v = c_v; pr_w = c_w; pr_a = c_a;
        }
    }
    __syncthreads();
    {
        const int which = wave >> 2, tile = wave & 3, ti = tile >> 1, tj = tile & 1;
        const bf16_t* WT = (const bf16_t*)(P.ws + WS_LORA) + (size_t)which * 512 * 64 + (size_t)(64 * h + 32 * tj + r32) * 64 + 8 * hi;
        const RLAS unsigned char* ap = lds + (which ? L_S1 : L_S0) + (32 * ti + r32) * SB + hi * 16;
        f32x16 acc = zero16();
#pragma unroll
        for (int s = 0; s < 4; ++s) acc = __builtin_amdgcn_mfma_f32_32x32x16_bf16(*(const RLAS bf16x8*)(ap + 32 * s), *(const bf16x8*)(WT + 16 * s), acc, 0, 0, 0);
        RLAS unsigned char* o = lds + (which ? L_F1 : L_F0) + (32 * tj + r32) * 4;
#pragma unroll
        for (int r = 0; r < 16; ++r) *(RLAS float*)(o + (32 * ti + (r & 3) + 8 * (r >> 2) + 4 * hi) * SF) = acc[r];
    }
    __syncthreads();
    {
        const float w0 = P.in[20][ch], a0 = P.in[22][ch], k_k = P.in[24][ch], k_a = P.in[25][ch], r_k = P.in[26][ch];
        const int t0 = 8 * wave;
        float kk[8], kka[8], km[8], ld[8];
        float run = 0.f;
#pragma unroll
        for (int i = 0; i < 8; ++i) {
            const int t = t0 + i;
            const float wa = w0 + *(const RLAS float*)(lds + L_F0 + t * SF + lane * 4), aa = a0 + *(const RLAS float*)(lds + L_F1 + t * SF + lane * 4);
            const float nw = -wa;
            const float spl = nw > 20.f ? nw : log1pf(__expf(nw));
            const float w = -spl - 0.5f;
            float logd = -__expf(w);
            const float a = 1.f / (1.f + __expf(-aa));
            float kx = kr[i] * k_k;
            const float n2 = wave_sum(kx * kx);
            kx = kx / fmaxf(sqrtf(n2), 1e-12f);
            float kmod = kr[i] * (1.f + (a - 1.f) * k_a);
            if (t >= nvalid) { kx = 0.f; kmod = 0.f; logd = 0.f; rr[i] = 0.f; vr[i] = 0.f; }
            kk[i] = kx; kka[i] = kx * a; km[i] = kmod;
            const float scal = wave_sum(rr[i] * kmod * r_k);
            ((bf16_t*)(urec + U_BON))[t * 64 + lane] = f2bf(scal * vr[i]);
            run += logd; ld[i] = run;
        }
        *(RLAS float*)(lds + L_TOT + (wave * 64 + lane) * 4) = run;
        __syncthreads();
        float base = 0.f, lc = 0.f;
#pragma unroll
        for (int w = 0; w < 8; ++w) { const float tw = *(const RLAS float*)(lds + L_TOT + (w * 64 + lane) * 4); if (w < wave) base += tw; lc += tw; }
        if (wave == 0) *(RLAS float*)(lds + L_PC + lane * 4) = __expf(lc);
        float kbt[8], kdt[8], kkt[8];
#pragma unroll
        for (int i = 0; i < 8; ++i) {
            const int t = t0 + i;
            const float L = base + ld[i], Lm1 = L - (i == 0 ? ld[0] : ld[i] - ld[i - 1]);
            const float eL = __expf(L), eLm1 = __expf(Lm1), enL = __expf(-L), eCL = __expf(lc - L);
            kkt[i] = kk[i] * eLm1;
            *(RLAS bf16_t*)(lds + L_S2 + t * SB + lane * 2) = f2bf(kkt[i]);
            *(RLAS bf16_t*)(lds + L_S5 + t * SB + lane * 2) = f2bf(rr[i] * eL);
            *(RLAS bf16_t*)(lds + L_S3 + t * SB + lane * 2) = f2bf(kka[i] * enL);
            *(RLAS bf16_t*)(lds + L_S4 + t * SB + lane * 2) = f2bf(km[i] * enL);
            kbt[i] = kka[i] * eCL; kdt[i] = km[i] * eCL;
        }
        u32x4 w;
        w.x = cvtpk(kbt[0], kbt[1]); w.y = cvtpk(kbt[2], kbt[3]); w.z = cvtpk(kbt[4], kbt[5]); w.w = cvtpk(kbt[6], kbt[7]);
        *(RLAS u32x4*)(lds + L_S6 + lane * SB + t0 * 2) = w;
        w.x = cvtpk(kdt[0], kdt[1]); w.y = cvtpk(kdt[2], kdt[3]); w.z = cvtpk(kdt[4], kdt[5]); w.w = cvtpk(kdt[6], kdt[7]);
        *(RLAS u32x4*)(lds + L_S7 + lane * SB + t0 * 2) = w;
        w.x = cvtpk(vr[0], vr[1]); w.y = cvtpk(vr[2], vr[3]); w.z = cvtpk(vr[4], vr[5]); w.w = cvtpk(vr[6], vr[7]);
        *(RLAS u32x4*)(lds + L_S8 + lane * SB + t0 * 2) = w;
        *(RLAS f32x4*)(lds + L_F2 + lane * SF + t0 * 4) = (f32x4){kkt[0], kkt[1], kkt[2], kkt[3]};
        *(RLAS f32x4*)(lds + L_F2 + lane * SF + t0 * 4 + 16) = (f32x4){kkt[4], kkt[5], kkt[6], kkt[7]};
    }
    __syncthreads();
    {
        const int q = wave >> 1;
#pragma unroll
        for (int tl = 0; tl < 2; ++tl) {
            const int tile = 2 * (wave & 1) + tl, ti = tile >> 1, tj = tile & 1;
            f32x16 acc = zero16();
            if (q == 0) {
                if (!(ti == 0 && tj == 1)) acc = mm_tile(acc, lds + L_S2, 32 * ti, lds + L_S3, 32 * tj, r32, hi);
                const int j = 32 * tj + r32;
#pragma unroll
                for (int g = 0; g < 4; ++g) { const int tb = 32 * ti + 8 * g + 4 * hi;
#pragma unroll
                    for (int i = 0; i < 4; ++i) *(RLAS float*)(lds + L_F0 + j * SF + (i * 16 + (tb >> 2)) * 4) = (j < tb + i) ? acc[4 * g + i] : 0.f; }
            } else {
                const RLAS unsigned char* Am = lds + ((q == 2) ? L_S3 : L_S4);
                const RLAS unsigned char* Bm = lds + ((q == 1) ? L_S2 : L_S5);
                if (!(ti == 1 && tj == 0)) acc = mm_tile(acc, Am, 32 * ti, Bm, 32 * tj, r32, hi);
                const int t = 32 * tj + r32;
                RLAS unsigned char* O = lds + (q == 1 ? L_S0 : q == 2 ? L_S1 : L_S9);
#pragma unroll
                for (int g = 0; g < 4; ++g) { const int jb = 32 * ti + 8 * g + 4 * hi; float v[4];
#pragma unroll
                    for (int i = 0; i < 4; ++i) { const int j = jb + i; const bool keep = (q == 1) ? (j < t) : (j <= t); v[i] = keep ? acc[4 * g + i] : 0.f; }
                    u32x2 pk; pk.x = cvtpk(v[0], v[1]); pk.y = cvtpk(v[2], v[3]);
                    *(RLAS u32x2*)(O + t * SB + jb * 2) = pk; }
            }
        }
    }
    __syncthreads();
    if (wave < 4) {
        const int ti = wave >> 1, tj = wave & 1;
        f32x16 acc = mm_tile(zero16(), lds + L_S0, 32 * ti, lds + L_S8, 32 * tj, r32, hi);
        const int v = 32 * tj + r32;
#pragma unroll
        for (int g = 0; g < 4; ++g) { const int tb = 32 * ti + 8 * g + 4 * hi; *(RLAS f32x4*)(lds + L_F1 + v * SF + tb * 4) = (f32x4){acc[4 * g], acc[4 * g + 1], acc[4 * g + 2], acc[4 * g + 3]}; }
    }
    __syncthreads();
    {
        const int q = lane & 3, col = 16 * wave + (lane >> 2);
        const RLAS unsigned char* rhs = lds + (col < 64 ? L_F2 + col * SF : L_F1 + (col - 64) * SF);
        float R[16];
#pragma unroll
        for (int g = 0; g < 16; ++g) { const f32x4 v = *(const RLAS f32x4*)(rhs + 16 * g); R[g] = q == 0 ? v[0] : q == 1 ? v[1] : q == 2 ? v[2] : v[3]; }
        SolveStep<0>::run(R, lds + L_F0 + q * 64);
        RLAS unsigned char* O = lds + (col < 64 ? L_S2 + col * SB : L_S3 + (col - 64) * SB) + q * 2;
#pragma unroll
        for (int g = 0; g < 16; ++g) *(RLAS bf16_t*)(O + 8 * g) = f2bf(-R[g]);
    }
    __syncthreads();
    {
        const int which = wave >> 1;
#pragma unroll
        for (int tl = 0; tl < 2; ++tl) {
            const int tile = 2 * (wave & 1) + tl, ti = tile >> 1, tj = tile & 1;
            if (which == 0) {
                f32x16 acc = mm_tile(zero16(), lds + L_S2, 32 * ti, lds + L_S6, 32 * tj, r32, hi);
                if (ti == tj) { const float pc = *(const RLAS float*)(lds + L_PC + (32 * tj + r32) * 4);
#pragma unroll
                    for (int r = 0; r < 16; ++r) if (((r & 3) + 8 * (r >> 2) + 4 * hi) == r32) acc[r] += pc; }
#pragma unroll
                for (int sp = 0; sp < 2; ++sp) {
                    u32x4 wh, wl; float lo[8];
                    wh.x = cvtpk(acc[8 * sp], acc[8 * sp + 1]); wh.y = cvtpk(acc[8 * sp + 2], acc[8 * sp + 3]); wh.z = cvtpk(acc[8 * sp + 4], acc[8 * sp + 5]); wh.w = cvtpk(acc[8 * sp + 6], acc[8 * sp + 7]);
                    lo[0] = acc[8 * sp] - bflo(wh.x); lo[1] = acc[8 * sp + 1] - bfhi(wh.x); lo[2] = acc[8 * sp + 2] - bflo(wh.y); lo[3] = acc[8 * sp + 3] - bfhi(wh.y);
                    lo[4] = acc[8 * sp + 4] - bflo(wh.z); lo[5] = acc[8 * sp + 5] - bfhi(wh.z); lo[6] = acc[8 * sp + 6] - bflo(wh.w); lo[7] = acc[8 * sp + 7] - bfhi(wh.w);
                    wl.x = cvtpk(lo[0], lo[1]); wl.y = cvtpk(lo[2], lo[3]); wl.z = cvtpk(lo[4], lo[5]); wl.w = cvtpk(lo[6], lo[7]);
                    unsigned char* f = urec + U_MFRAG + (size_t)(((tj * 4 + (2 * ti + sp)) * 2) * 64 + lane) * 16;
                    *(u32x4*)f = wh; *(u32x4*)(f + 1024) = wl;
                }
            } else if (which == 1) {
                f32x16 acc = mm_tile(zero16(), lds + L_S7, 32 * ti, lds + L_S8, 32 * tj, r32, hi);
                acc = mm_tile(acc, lds + L_S6, 32 * ti, lds + L_S3, 32 * tj, r32, hi);
                float* o = (float*)(urec + U_NRAW) + (size_t)(ti * 2 + tj) * 1024 + lane;
#pragma unroll
                for (int r = 0; r < 16; ++r) o[r * 64] = acc[r];
            } else if (which == 2) {
                f32x16 acc = mm_tile(zero16(), lds + L_S2, 32 * ti, lds + L_S1, 32 * tj, r32, hi);
                const int t = 32 * tj + r32;
#pragma unroll
                for (int g = 0; g < 4; ++g) { const int kb = 32 * ti + 8 * g + 4 * hi;
                    const u32x2 rt = *(const RLAS u32x2*)(lds + L_S5 + t * SB + kb * 2);
                    u32x2 pk; pk.x = cvtpk(acc[4 * g] + bflo(rt.x), acc[4 * g + 1] + bfhi(rt.x)); pk.y = cvtpk(acc[4 * g + 2] + bflo(rt.y), acc[4 * g + 3] + bfhi(rt.y));
                    *(u32x2*)(urec + U_G + (size_t)(t * 64 + kb) * 2) = pk; }
            } else {
                f32x16 acc = mm_tile(zero16(), lds + L_S8, 32 * ti, lds + L_S9, 32 * tj, r32, hi);
                acc = mm_tile(acc, lds + L_S3, 32 * ti, lds + L_S1, 32 * tj, r32, hi);
                float* o = (float*)(urec + U_HRAW) + (size_t)(ti * 2 + tj) * 1024 + lane;
#pragma unroll
                for (int r = 0; r < 16; ++r) o[r * 64] = acc[r];
            }
        }
    }
    __syncthreads();
}

__device__ __forceinline__ void split8(const f32x16& x, int sp, bf16x8& bh, bf16x8& bl) {
    u32x4 wh, wl; float lo[8];
    wh.x = cvtpk(x[8 * sp], x[8 * sp + 1]); wh.y = cvtpk(x[8 * sp + 2], x[8 * sp + 3]); wh.z = cvtpk(x[8 * sp + 4], x[8 * sp + 5]); wh.w = cvtpk(x[8 * sp + 6], x[8 * sp + 7]);
    lo[0] = x[8 * sp] - bflo(wh.x); lo[1] = x[8 * sp + 1] - bfhi(wh.x); lo[2] = x[8 * sp + 2] - bflo(wh.y); lo[3] = x[8 * sp + 3] - bfhi(wh.y);
    lo[4] = x[8 * sp + 4] - bflo(wh.z); lo[5] = x[8 * sp + 5] - bfhi(wh.z); lo[6] = x[8 * sp + 6] - bflo(wh.w); lo[7] = x[8 * sp + 7] - bfhi(wh.w);
    wl.x = cvtpk(lo[0], lo[1]); wl.y = cvtpk(lo[2], lo[3]); wl.z = cvtpk(lo[4], lo[5]); wl.w = cvtpk(lo[6], lo[7]);
    bh = __builtin_bit_cast(bf16x8, wh); bl = __builtin_bit_cast(bf16x8, wl);
}
__device__ __forceinline__ void store_state(float* dst  , const f32x16& s0, const f32x16& s1, int v, int hi) {
#pragma unroll
    for (int g = 0; g < 4; ++g) {
        *(f32x4*)(dst + v * 64 + 8 * g + 4 * hi) = (f32x4){s0[4 * g], s0[4 * g + 1], s0[4 * g + 2], s0[4 * g + 3]};
        *(f32x4*)(dst + v * 64 + 32 + 8 * g + 4 * hi) = (f32x4){s1[4 * g], s1[4 * g + 1], s1[4 * g + 2], s1[4 * g + 3]};
    }
}
__device__ __forceinline__ void scan_step(const unsigned char* urec, int tv, int lane, f32x16& s0, f32x16& s1) {
    bf16x8 bh[4], bl[4];
    split8(s0, 0, bh[0], bl[0]); split8(s0, 1, bh[1], bl[1]); split8(s1, 0, bh[2], bl[2]); split8(s1, 1, bh[3], bl[3]);
    f32x16 n0, n1;
    { const float* nr = (const float*)(urec + U_NRAW) + lane;
#pragma unroll
      for (int r = 0; r < 16; ++r) { n0[r] = nr[(size_t)(0 * 2 + tv) * 1024 + r * 64]; n1[r] = nr[(size_t)(1 * 2 + tv) * 1024 + r * 64]; } }
#pragma unroll
    for (int s = 0; s < 4; ++s) {
        const unsigned char* f0 = urec + U_MFRAG + (size_t)(((0 * 4 + s) * 2) * 64 + lane) * 16;
        const unsigned char* f1 = urec + U_MFRAG + (size_t)(((1 * 4 + s) * 2) * 64 + lane) * 16;
        const bf16x8 a0h = *(const bf16x8*)f0, a0l = *(const bf16x8*)(f0 + 1024), a1h = *(const bf16x8*)f1, a1l = *(const bf16x8*)(f1 + 1024);
        n0 = __builtin_amdgcn_mfma_f32_32x32x16_bf16(a0h, bh[s], n0, 0, 0, 0);
        n0 = __builtin_amdgcn_mfma_f32_32x32x16_bf16(a0h, bl[s], n0, 0, 0, 0);
        n0 = __builtin_amdgcn_mfma_f32_32x32x16_bf16(a0l, bh[s], n0, 0, 0, 0);
        n1 = __builtin_amdgcn_mfma_f32_32x32x16_bf16(a1h, bh[s], n1, 0, 0, 0);
        n1 = __builtin_amdgcn_mfma_f32_32x32x16_bf16(a1h, bl[s], n1, 0, 0, 0);
        n1 = __builtin_amdgcn_mfma_f32_32x32x16_bf16(a1l, bh[s], n1, 0, 0, 0);
    }
    s0 = n0; s1 = n1;
}
__device__ __forceinline__ void scan_chain(const Ptrs& P, int seq, int h, int tv, int lane) {
    const int r32 = lane & 31, hi = lane >> 5, v = 32 * tv + r32;
    f32x16 s0 = zero16(), s1 = zero16();
    if (seq == 0) {
        float* sst = (float*)(P.ws + WS_SST);
#pragma unroll 1
        for (int c = 0; c < 256; ++c) {
            store_state(sst + ((size_t)c * 8 + h) * 4096, s0, s1, v, hi);
            scan_step(P.ws + WS_RW + (size_t)(c * 8 + h) * U_BYTES, tv, lane, s0, s1);
        }
        store_state(P.out + O_L0WKV_P + (size_t)h * 4096, s0, s1, v, hi);
    } else {
        const int b = seq - 1;
        const float* src = P.in[5] + ((size_t)b * 8 + h) * 4096;
#pragma unroll
        for (int g = 0; g < 4; ++g) {
            const f32x4 x0 = *(const f32x4*)(src + v * 64 + 8 * g + 4 * hi), x1 = *(const f32x4*)(src + v * 64 + 32 + 8 * g + 4 * hi);
#pragma unroll
            for (int i = 0; i < 4; ++i) { s0[4 * g + i] = x0[i]; s1[4 * g + i] = x1[i]; }
        }
        scan_step(P.ws + WS_RW + (size_t)(2048 + b * 8 + h) * U_BYTES, tv, lane, s0, s1);
        store_state(P.out + O_L0WKV_S + ((size_t)b * 8 + h) * 4096, s0, s1, v, hi);
    }
}

__device__ __forceinline__ void unit_c(const Ptrs& P, int unit, int lane) {
    const int r32 = lane & 31, hi = lane >> 5;
    const bool samp = unit >= 2048;
    const int h = unit & 7, cb = samp ? (unit - 2048) >> 3 : unit >> 3;
    const int m_base = samp ? TP + 32 * cb : 64 * cb;
    const unsigned char* urec = P.ws + WS_RW + (size_t)unit * U_BYTES;
    const float* S0 = samp ? P.in[5] + ((size_t)cb * 8 + h) * 4096 : (const float*)(P.ws + WS_SST) + ((size_t)cb * 8 + h) * 4096;
    bf16x8 af[2][4];
#pragma unroll
    for (int tvb = 0; tvb < 2; ++tvb)
#pragma unroll
        for (int s = 0; s < 4; ++s) { const float* p = S0 + (32 * tvb + r32) * 64 + 16 * s + 8 * hi; const f32x4 x0 = *(const f32x4*)p, x1 = *(const f32x4*)(p + 4);
            u32x4 w; w.x = cvtpk(x0[0], x0[1]); w.y = cvtpk(x0[2], x0[3]); w.z = cvtpk(x1[0], x1[1]); w.w = cvtpk(x1[2], x1[3]); af[tvb][s] = __builtin_bit_cast(bf16x8, w); }
    const float* lng = P.in[27] + 64 * h; const float* lnb = P.in[28] + 64 * h;
#pragma unroll 1
    for (int tt = 0; tt < (samp ? 1 : 2); ++tt) {
        const int t = 32 * tt + r32;
        f32x16 acc[2];
#pragma unroll
        for (int tvb = 0; tvb < 2; ++tvb) { const float* hr = (const float*)(urec + U_HRAW) + (size_t)(tvb * 2 + tt) * 1024 + lane;
#pragma unroll
            for (int r = 0; r < 16; ++r) acc[tvb][r] = hr[r * 64]; }
        const bf16_t* gp = (const bf16_t*)(urec + U_G) + t * 64 + 8 * hi;
#pragma unroll
        for (int s = 0; s < 4; ++s) { const bf16x8 bfr = *(const bf16x8*)(gp + 16 * s);
            acc[0] = __builtin_amdgcn_mfma_f32_32x32x16_bf16(af[0][s], bfr, acc[0], 0, 0, 0);
            acc[1] = __builtin_amdgcn_mfma_f32_32x32x16_bf16(af[1][s], bfr, acc[1], 0, 0, 0); }
        float sm = 0.f;
#pragma unroll
        for (int r = 0; r < 16; ++r) sm += acc[0][r] + acc[1][r];
        sm += __shfl_xor(sm, 32);
        const float mean = sm * (1.f / 64);
        float sq = 0.f;
#pragma unroll
        for (int r = 0; r < 16; ++r) { const float d0 = acc[0][r] - mean, d1 = acc[1][r] - mean; sq += d0 * d0 + d1 * d1; }
        sq += __shfl_xor(sq, 32);
        const float rstd = rsqrtf(sq * (1.f / 64) + GN_EPS);
        const int m = m_base + t;
        const bf16_t* bon = (const bf16_t*)(urec + U_BON) + t * 64;
        const bf16_t* zb = (const bf16_t*)(P.ws + WS_PROJ0) + (size_t)m * N0P + C_ZB + 64 * h;
        bf16_t* cat = (bf16_t*)(P.ws + WS_CAT) + (size_t)m * D + 512 + 64 * h;
#pragma unroll
        for (int tvb = 0; tvb < 2; ++tvb)
#pragma unroll
            for (int g = 0; g < 4; ++g) {
                const int vb = 32 * tvb + 8 * g + 4 * hi;
                const u32x2 bo = *(const u32x2*)(bon + vb), zz = *(const u32x2*)(zb + vb);
                const f32x4 gg = *(const f32x4*)(lng + vb), bb = *(const f32x4*)(lnb + vb);
                float y[4];
                y[0] = ((acc[tvb][4 * g] - mean) * rstd * gg[0] + bb[0] + bflo(bo.x)) * silu(bflo(zz.x));
                y[1] = ((acc[tvb][4 * g + 1] - mean) * rstd * gg[1] + bb[1] + bfhi(bo.x)) * silu(bfhi(zz.x));
                y[2] = ((acc[tvb][4 * g + 2] - mean) * rstd * gg[2] + bb[2] + bflo(bo.y)) * silu(bflo(zz.y));
                y[3] = ((acc[tvb][4 * g + 3] - mean) * rstd * gg[3] + bb[3] + bfhi(bo.y)) * silu(bfhi(zz.y));
                u32x2 pk; pk.x = cvtpk(y[0], y[1]); pk.y = cvtpk(y[2], y[3]);
                *(u32x2*)(cat + vb) = pk;
            }
    }
}
#undef RLAS
}
#ifndef FAST_ATTN0
#define FAST_ATTN0 1
#endif
#ifndef FAST_RW
#define FAST_RW 1
#endif
#ifndef FAST_ATTN1
#define FAST_ATTN1 1
#endif
#include <hip/hip_cooperative_groups.h>
namespace cg = cooperative_groups;
constexpr int NWAVES = 8, NTHREADS = 512;
constexpr int LDS_BYTES = 147456;
enum Phase { PH_PRO = 0, PH_GEMM1 = 1, PH_TOK = 2, PH_MIX = 3, PH_RWC = 4, PH_GEMM2 = 5, PH_GEMM3 = 6, PH_ATTN1 = 7, PH_GEMM4 = 8, PH_END = 9 };
#define LAS __attribute__((address_space(3)))
struct Args { Ptrs p; int ph_lo, ph_hi; int pad0, pad1; };

__global__ void __launch_bounds__(NTHREADS, 2) mk_fwd(Args a) {
    extern __shared__ __attribute__((aligned(16))) unsigned char lds[];
    const Ptrs& P = a.p;
    unsigned char* ws = P.ws;
    const int lo = a.ph_lo, hi = a.ph_hi;
    const int tid = threadIdx.x, lane = tid & 63, wave = tid >> 6;
    const int G = gridDim.x, gw = blockIdx.x * NWAVES + wave, NGW = G * NWAVES;
    float* wscr = (float*)lds + wave * 256;
#define IN(k) (lo <= (k) && (k) < hi)
#define SEAM(k) do { if (IN(k) && IN((k) + 1)) cg::this_grid().sync(); } while (0)
    if (IN(PH_PRO)) {
        const size_t gt = (size_t)blockIdx.x * NTHREADS + tid, NT = (size_t)G * NTHREADS;
        for (size_t i = gt; i < (size_t)N0P * D; i += NT) nv::d_transpose_w(P.in[10], D, N0, N0P, (bf16_t*)(ws + WS_WT0), nullptr, i);
        for (size_t i = gt; i < (size_t)D * D; i += NT) nv::d_transpose_w(P.in[11], D, D, D, (bf16_t*)(ws + WS_WO0T), nullptr, i);
        for (size_t i = gt; i < (size_t)N1 * D; i += NT) nv::d_transpose_w(P.in[30], D, N1, N1, (bf16_t*)(ws + WS_WT1), P.in[29], i);
        for (size_t i = gt; i < (size_t)D * D; i += NT) nv::d_transpose_w(P.in[31], D, D, D, (bf16_t*)(ws + WS_WO1T), nullptr, i);
        if (blockIdx.x == 0 && tid < 256) nv::d_tables(P, tid);
        if (blockIdx.x == 0 && tid == 256) { ((unsigned*)(ws + WS_CTL))[0] = 0u; }
        for (size_t i = gt; i < 512 * 64; i += NT) { const int c = (int)(i >> 6), l = (int)(i & 63); bf16_t* LT = (bf16_t*)(ws + WS_LORA);
            LT[i] = f2bf(P.in[21][l * 512 + c]); LT[32768 + i] = f2bf(P.in[23][l * 512 + c]); }
        for (int m = gw; m < M; m += NGW) nv::d_rmsnorm_x(P, m, lane);
    }
    SEAM(PH_PRO);
    if (IN(PH_GEMM1)) {
        pg8::Gemm g{(const bf16_t*)(ws + WS_XN0), (const bf16_t*)(ws + WS_WT0), M, N0P, D}; pg8::StaticOrder S; S.init(M, N0P, G, (int)blockIdx.x);
        pg8::EpiProj0F E{(bf16_t*)(ws + WS_PROJ0)};
        pg8::gemm_phase<pg8::EpiProj0F, pg8::StaticOrder, true, true>((LAS unsigned char*)lds, g, S, E);
    }
    SEAM(PH_GEMM1);
    if (IN(PH_TOK)) {
        for (int m = gw; m < M; m += NGW) nv::d_tok0(P, m, lane);
        __syncthreads();
#if FAST_RW
        for (int u = blockIdx.x; u < rw::NUNIT; u += G) rw::unit_a(P, u, (LAS unsigned char*)lds, tid);
#else
        for (int m = blockIdx.x; m < M; m += G) { nv::d_rw_prep(P, m, tid, (float*)lds, (float*)lds + 64); __syncthreads(); }
#endif
    }
    SEAM(PH_TOK);
    if (IN(PH_MIX)) {
#if FAST_RW
        if (blockIdx.x < 16) {
            if (wave == 0) rw::scan_chain(P, 0, (int)blockIdx.x >> 1, (int)blockIdx.x & 1, lane);
            else for (int i = (int)blockIdx.x * 7 + (wave - 1); i < 512; i += 16 * 7) rw::scan_chain(P, 1 + (i >> 4), (i >> 1) & 7, i & 1, lane);
        }
#else
        if (gw < 33 * 8) nv::d_rw_scan(P, gw >> 3, gw & 7, lane);
#endif
#if FAST_ATTN0
        { const int vcu = (G % 8 == 0) ? ((int)blockIdx.x % 8) * (G / 8) + (int)blockIdx.x / 8 : (int)blockIdx.x;
          __syncthreads();
          da::phase(P, (LAS unsigned char*)lds, vcu, G, tid); }
#else
        for (int i = gw; i < M * 4; i += NGW) nv::d_attn0(P, i >> 2, i & 3, lane, wscr, wscr + 128);
#endif
    }
    SEAM(PH_MIX);
#if FAST_RW
    if (IN(PH_RWC)) { for (int u = gw; u < rw::NUNIT; u += NGW) rw::unit_c(P, u, lane); }
#endif
    SEAM(PH_RWC);
    if (IN(PH_GEMM2)) {
        pg8::Gemm g{(const bf16_t*)(ws + WS_CAT), (const bf16_t*)(ws + WS_WO0T), M, D, D}; pg8::StaticOrder S; S.init(M, D, G, (int)blockIdx.x);
        pg8::EpiY0F E{P};
        pg8::gemm_phase<pg8::EpiY0F, pg8::StaticOrder, true, true>((LAS unsigned char*)lds, g, S, E);
    }
    SEAM(PH_GEMM2);
    if (IN(PH_GEMM3)) {
        pg8::Gemm g{(const bf16_t*)(ws + WS_Y0B), (const bf16_t*)(ws + WS_WT1), M, N1, D}; pg8::StaticOrder S; S.init(M, N1, G, (int)blockIdx.x);
        pg8::EpiL1F E{P};
        pg8::gemm_phase<pg8::EpiL1F, pg8::StaticOrder, true, true>((LAS unsigned char*)lds, g, S, E);
    }
    SEAM(PH_GEMM3);
    if (IN(PH_ATTN1)) {
#if FAST_ATTN1
        sb::phase(P, gw, NGW, lane);
#else
        for (int i = gw; i < M * 16; i += NGW) nv::d_attn1(P, i >> 4, i & 15, lane, wscr, wscr + 64);
#endif
    }
    SEAM(PH_ATTN1);
    if (IN(PH_GEMM4)) {
        pg8::Gemm g{(const bf16_t*)(ws + WS_O1B), (const bf16_t*)(ws + WS_WO1T), M, D, D}; pg8::StaticOrder S; S.init(M, D, G, (int)blockIdx.x);
        pg8::EpiOutF E{P};
        pg8::gemm_phase<pg8::EpiOutF, pg8::StaticOrder, true, true>((LAS unsigned char*)lds, g, S, E);
    }
#undef IN
#undef SEAM
}
extern "C" void kernel_launch(void* const* d_in, const int* in_sizes, int n_in, void* d_out, int out_size, void* d_ws, size_t ws_size, hipStream_t stream) {
    static int grid = 0;
    if (n_in != 32 || (size_t)out_size != O_TOTAL || ws_size < WS_END) { fprintf(stderr, "kernel_launch: unexpected shapes n_in=%d out=%d ws=%zu\n", n_in, out_size, ws_size); return; }
    if (grid == 0) {
        int dev = 0, cus = 0, per_cu = 0;
        (void)hipGetDevice(&dev); (void)hipDeviceGetAttribute(&cus, hipDeviceAttributeMultiprocessorCount, dev);
        (void)hipFuncSetAttribute((const void*)mk_fwd, hipFuncAttributeMaxDynamicSharedMemorySize, LDS_BYTES);
        (void)hipOccupancyMaxActiveBlocksPerMultiprocessor(&per_cu, (const void*)mk_fwd, NTHREADS, LDS_BYTES);
        if (per_cu < 1) { fprintf(stderr, "kernel_launch: occupancy query says %d blocks/CU\n", per_cu); per_cu = 1; }
        grid = (cus > 0 ? cus : 256);
    }
    Args a{};
    for (int i = 0; i < 32; ++i) a.p.in[i] = (const float*)d_in[i];
    a.p.out = (float*)d_out; a.p.ws = (unsigned char*)d_ws; a.ph_lo = 0; a.ph_hi = PH_END;
    void* args[] = {&a};
    hipError_t e = hipLaunchCooperativeKernel((const void*)mk_fwd, dim3(grid), dim3(NTHREADS), args, LDS_BYTES, stream);
    if (e != hipSuccess) fprintf(stderr, "cooperative launch failed: %s (grid %d)\n", hipGetErrorString(e), grid);
}
```

```cpp
#include <hip/hip_runtime.h>
#include <stdint.h>
#include <cstdio>

typedef unsigned short bf16_t;
__device__ __forceinline__ float bf2f(bf16_t b) { return __uint_as_float(((unsigned)b) << 16); }
__device__ __forceinline__ bf16_t f2bf(float f) { unsigned u = __float_as_uint(f); return (bf16_t)((u + 0x7fffu + ((u >> 16) & 1u)) >> 16); }

constexpr int D = 1024, TP = 16384, NSEQ = 32, TS = 32, MS = NSEQ * TS, M = TP + MS, PAST = 1024;
constexpr int N0 = 4224, N0P = 4352, N1 = 4096;
constexpr int C_Q = 0, C_K = 512, C_V = 1024, C_ZA = 1536, C_PRW = 2048, C_ZB = 3712;
constexpr int RWS = 1664;
constexpr float EPS = 1e-6f, GN_EPS = 64e-5f;
constexpr float LOG2E = 1.4426950408889634f;
constexpr float LAMBDA_INIT = 0.2f;
constexpr float QSCALE = 0.125f * LOG2E;

constexpr size_t O_Y = 0;
constexpr size_t O_L0K_P = (size_t)M * D;
constexpr size_t O_L0V_P = O_L0K_P + (size_t)TP * 512;
constexpr size_t O_L0SH_P = O_L0V_P + (size_t)TP * 512;
constexpr size_t O_L0WKV_P = O_L0SH_P + RWS;
constexpr size_t O_L1K_P = O_L0WKV_P + 8 * 64 * 64;
constexpr size_t O_L1V_P = O_L1K_P + (size_t)TP * 1024;
constexpr size_t O_L0K_S = O_L1V_P + (size_t)TP * 1024;
constexpr size_t O_L0V_S = O_L0K_S + (size_t)MS * 512;
constexpr size_t O_L0SH_S = O_L0V_S + (size_t)MS * 512;
constexpr size_t O_L0WKV_S = O_L0SH_S + (size_t)NSEQ * RWS;
constexpr size_t O_L1K_S = O_L0WKV_S + (size_t)NSEQ * 8 * 64 * 64;
constexpr size_t O_L1V_S = O_L1K_S + (size_t)MS * 1024;
constexpr size_t O_TOTAL = O_L1V_S + (size_t)MS * 1024;
static_assert(O_TOTAL == 72439424, "output size");

__host__ __device__ __forceinline__ size_t off_l0k(int m) { return m < TP ? O_L0K_P + (size_t)m * 512 : O_L0K_S + (size_t)(m - TP) * 512; }
__host__ __device__ __forceinline__ size_t off_l0v(int m) { return m < TP ? O_L0V_P + (size_t)m * 512 : O_L0V_S + (size_t)(m - TP) * 512; }
__host__ __device__ __forceinline__ size_t off_l1k(int m) { return m < TP ? O_L1K_P + (size_t)m * 1024 : O_L1K_S + (size_t)(m - TP) * 1024; }
__host__ __device__ __forceinline__ size_t off_l1v(int m) { return m < TP ? O_L1V_P + (size_t)m * 1024 : O_L1V_S + (size_t)(m - TP) * 1024; }

constexpr size_t MiB = 1u << 20;
constexpr size_t WS_CTL = 0;
constexpr size_t WS_TAB = 512 * 1024;
constexpr size_t WS_WT0 = 1 * MiB, WS_WO0T = 10 * MiB, WS_WT1 = 12 * MiB, WS_WO1T = 20 * MiB, WS_LORA = 22 * MiB;
constexpr size_t WS_CAT = 24 * MiB, WS_XN0 = WS_CAT;
constexpr size_t WS_PROJ0 = 58 * MiB;
constexpr size_t WS_Q0 = 203 * MiB, WS_K0 = 220 * MiB;
constexpr size_t WS_RW = 237 * MiB;
constexpr size_t WS_SST = 407 * MiB;
constexpr size_t WS_END = 441 * MiB;
constexpr size_t WS_Y0 = WS_PROJ0, WS_Y0B = 126 * MiB, WS_SSQ = 160 * MiB;
constexpr size_t WS_O1B = WS_Q0;
constexpr size_t WS_Q1 = 237 * MiB, WS_K1 = 271 * MiB, WS_V1T = 305 * MiB, WS_Z1 = 339 * MiB;
static_assert(WS_PROJ0 + (size_t)M * N0P * 2 <= WS_Q0, "proj0");
static_assert(WS_WT0 + (size_t)N0P * D * 2 <= WS_WO0T, "wt0");

struct Tab {
    float lam;
    float m0;
    float pad[2];
    float bias[4][256];
    float biasfar[4];
};

struct Ptrs {
    const float* in[32];
    float* out;
    unsigned char* ws;
};

__device__ __forceinline__ const float* xrow(const Ptrs& P, int m) { return m < TP ? P.in[0] + (size_t)m * D : P.in[1] + (size_t)(m - TP) * D; }

__device__ __forceinline__ float wave_sum(float v) {
#pragma unroll
    for (int o = 1; o < 64; o <<= 1) v += __shfl_xor(v, o);
    return v;
}
__device__ __forceinline__ float wave_max(float v) {
#pragma unroll
    for (int o = 1; o < 64; o <<= 1) v = fmaxf(v, __shfl_xor(v, o));
    return v;
}
__device__ __forceinline__ float silu(float x) { return x / (1.f + __expf(-x)); }

__device__ __forceinline__ int t5_bucket(int rel) {
    int n = rel < 0 ? -rel : rel;
    int b;
    if (n < 8) b = n;
    else { unsigned n2 = (unsigned)n * (unsigned)n; int lg = 31 - __clz((int)n2); b = 8 + (lg - 6); if (b > 15) b = 15; }
    return (rel > 0 ? 16 : 0) + b;
}
namespace nv {

__device__ __forceinline__ void d_transpose_w(const float* W, int K, int N, int NP, bf16_t* WT, const float* g, size_t i) {
    int n = (int)(i / K), k = (int)(i % K);
    float v = 0.f;
    if (n < N) { v = W[(size_t)k * N + n]; if (g) v *= g[k]; }
    WT[i] = f2bf(v);
}
__global__ void k_transpose_w(const float* W, int K, int N, int NP, bf16_t* WT, const float* g) {
    size_t i = (size_t)blockIdx.x * blockDim.x + threadIdx.x; if (i < (size_t)NP * K) d_transpose_w(W, K, N, NP, WT, g, i); }
__global__ void k_lora_t(const float* w_up, const float* a_up, float* LT) {
    int i = blockIdx.x * blockDim.x + threadIdx.x;
    if (i >= 512 * 64) return;
    int c = i / 64, l = i % 64;
    LT[i] = w_up[l * 512 + c];
    LT[512 * 64 + i] = a_up[l * 512 + c];
}
__device__ __forceinline__ void d_tables(const Ptrs& P, int tid) {
    Tab* T = (Tab*)(P.ws + WS_TAB);
    if (tid < 64) {
        float a = P.in[14][tid] * P.in[15][tid], b = P.in[16][tid] * P.in[17][tid];
        a = wave_sum(a); b = wave_sum(b);
        float gq = fabsf(P.in[12][tid]), gk = fabsf(P.in[13][tid]);
        gq = wave_max(gq); gk = wave_max(gk);
        if (tid == 0) { T->lam = __expf(a) - __expf(b) + LAMBDA_INIT; T->m0 = 8.f * gq * gk * LOG2E * 1.0001f + 0.01f; }
    }
    if (tid < 255) { int rel = tid - 191; int b = t5_bucket(rel); for (int h = 0; h < 4; ++h) T->bias[h][tid] = P.in[8][b * 4 + h]; }
    if (tid == 255) for (int h = 0; h < 4; ++h) { T->bias[h][255] = 0.f; T->biasfar[h] = P.in[8][15 * 4 + h]; }
}
__global__ void k_tables(Ptrs P) { d_tables(P, threadIdx.x); }
__device__ __forceinline__ void d_rmsnorm_x(const Ptrs& P, int w, int lane) {
    const float* x = xrow(P, w); const float* g = P.in[9];
    bf16_t* o = (bf16_t*)(P.ws + WS_XN0) + (size_t)w * D;
    float v[16], s = 0.f;
#pragma unroll
    for (int j = 0; j < 16; ++j) { v[j] = x[lane + 64 * j]; s += v[j] * v[j]; }
    s = wave_sum(s);
    float r = rsqrtf(s * (1.f / D) + EPS);
#pragma unroll
    for (int j = 0; j < 16; ++j) o[lane + 64 * j] = f2bf(v[j] * r * g[lane + 64 * j]);
}
__global__ void k_rmsnorm_x(Ptrs P) { int w = (blockIdx.x * blockDim.x + threadIdx.x) >> 6; if (w < M) d_rmsnorm_x(P, w, threadIdx.x & 63); }

template <class Epi>
__global__ void __launch_bounds__(256) k_gemm(const bf16_t* A, const bf16_t* Bt, int K, Epi epi) {
    __shared__ float As[16][65], Bs[16][65];
    const int tx = threadIdx.x & 15, ty = threadIdx.x >> 4;
    const int m0 = blockIdx.y * 64, n0 = blockIdx.x * 64;
    float acc[4][4];
#pragma unroll
    for (int i = 0; i < 4; ++i)
#pragma unroll
        for (int j = 0; j < 4; ++j) acc[i][j] = 0.f;
    for (int k0 = 0; k0 < K; k0 += 16) {
#pragma unroll
        for (int i = 0; i < 4; ++i) {
            int e = threadIdx.x + 256 * i, r = e >> 4, c = e & 15;
            As[c][r] = bf2f(A[(size_t)(m0 + r) * K + k0 + c]);
            Bs[c][r] = bf2f(Bt[(size_t)(n0 + r) * K + k0 + c]);
        }
        __syncthreads();
#pragma unroll
        for (int kk = 0; kk < 16; ++kk) {
            float a[4], b[4];
#pragma unroll
            for (int i = 0; i < 4; ++i) { a[i] = As[kk][ty * 4 + i]; b[i] = Bs[kk][tx * 4 + i]; }
#pragma unroll
            for (int i = 0; i < 4; ++i)
#pragma unroll
                for (int j = 0; j < 4; ++j) acc[i][j] += a[i] * b[j];
        }
        __syncthreads();
    }
#pragma unroll
    for (int i = 0; i < 4; ++i)
#pragma unroll
        for (int j = 0; j < 4; ++j) epi(m0 + ty * 4 + i, n0 + tx * 4 + j, acc[i][j]);
}
struct EpiProj0 { bf16_t* O; __device__ void operator()(int m, int n, float v) const { O[(size_t)m * N0P + n] = f2bf(v); } };
struct EpiY0 {
    Ptrs P;
    __device__ void operator()(int m, int n, float v) const {
        float y = v + xrow(P, m)[n];
        ((float*)(P.ws + WS_Y0))[(size_t)m * D + n] = y;
        ((bf16_t*)(P.ws + WS_Y0B))[(size_t)m * D + n] = f2bf(y);
    }
};
struct EpiL1 {
    Ptrs P;
    __device__ void operator()(int m, int n, float v) const {
        const float* ss = (const float*)(P.ws + WS_SSQ) + (size_t)m * 16;
        float t = 0.f; for (int j = 0; j < 16; ++j) t += ss[j];
        float r = rsqrtf(t * (1.f / D) + EPS);
        float val = v * r;
        int c = n & 1023;
        if (n < 1024) ((bf16_t*)(P.ws + WS_Q1))[(size_t)m * D + c] = f2bf(val * QSCALE);
        else if (n < 2048) { ((bf16_t*)(P.ws + WS_K1))[(size_t)m * D + c] = f2bf(val); P.out[off_l1k(m) + c] = val; }
        else if (n < 3072) { ((bf16_t*)(P.ws + WS_V1T))[(size_t)c * M + m] = f2bf(val); P.out[off_l1v(m) + c] = val; }
        else ((bf16_t*)(P.ws + WS_Z1))[(size_t)m * D + c] = f2bf(val);
    }
};
struct EpiOut { Ptrs P; __device__ void operator()(int m, int n, float v) const { P.out[O_Y + (size_t)m * D + n] = v + ((const float*)(P.ws + WS_Y0))[(size_t)m * D + n]; } };

__device__ __forceinline__ void d_ssq(const Ptrs& P, int w, int lane) {
    const float* y = (const float*)(P.ws + WS_Y0) + (size_t)w * D;
    float* ss = (float*)(P.ws + WS_SSQ) + (size_t)w * 16;
    for (int j = 0; j < 16; ++j) { float v = y[64 * j + lane]; float s = wave_sum(v * v); if (lane == 0) ss[j] = s; }
}
__global__ void k_ssq(Ptrs P) { int w = (blockIdx.x * blockDim.x + threadIdx.x) >> 6; if (w < M) d_ssq(P, w, threadIdx.x & 63); }

__device__ __forceinline__ void d_tok0(const Ptrs& P, int m, int lane) {
    const bf16_t* pr = (const bf16_t*)(P.ws + WS_PROJ0) + (size_t)m * N0P;
    bf16_t* q0 = (bf16_t*)(P.ws + WS_Q0) + (size_t)m * 512;
    bf16_t* k0 = (bf16_t*)(P.ws + WS_K0) + (size_t)m * 512;
    const float gq = P.in[12][lane], gk = P.in[13][lane];
#pragma unroll 1
    for (int g = 0; g < 8; ++g) {
        float q = bf2f(pr[C_Q + 64 * g + lane]), k = bf2f(pr[C_K + 64 * g + lane]);
        float sq = wave_sum(q * q), sk = wave_sum(k * k);
        float qn = q * rsqrtf(sq * (1.f / 64) + EPS) * gq, kn = k * rsqrtf(sk * (1.f / 64) + EPS) * gk;
        q0[64 * g + lane] = f2bf(qn * QSCALE);
        k0[64 * g + lane] = f2bf(kn);
        P.out[off_l0k(m) + 64 * g + lane] = kn;
        P.out[off_l0v(m) + 64 * g + lane] = bf2f(pr[C_V + 64 * g + lane]);
    }
    int last = -1; size_t so = 0;
    if (m == TP - 1) { last = 1; so = O_L0SH_P; }
    else if (m >= TP && ((m - TP) & 31) == 31) { last = 1; so = O_L0SH_S + (size_t)((m - TP) >> 5) * RWS; }
    if (last > 0) for (int c = lane; c < RWS; c += 64) P.out[so + c] = bf2f(pr[C_PRW + c]);
}
__global__ void k_tok0(Ptrs P) { int m = (blockIdx.x * blockDim.x + threadIdx.x) >> 6; if (m < M) d_tok0(P, m, threadIdx.x & 63); }

template <class SP> __device__ __forceinline__ void d_attn0(const Ptrs& P, int m, int h, int lane, SP sqw, SP spw) {
    const Tab* T = (const Tab*)(P.ws + WS_TAB);
    const bf16_t* Q0 = (const bf16_t*)(P.ws + WS_Q0); const bf16_t* K0 = (const bf16_t*)(P.ws + WS_K0);
    const bf16_t* PR = (const bf16_t*)(P.ws + WS_PROJ0);
    int qpos, nk, b = 0; bool samp = m >= TP;
    if (!samp) { qpos = m; nk = ((m >> 6) + 1) * 64; } else { b = (m - TP) >> 5; qpos = PAST + ((m - TP) & 31); nk = PAST + TS; }
    sqw[lane] = bf2f(Q0[(size_t)m * 512 + 128 * h + lane]);
    sqw[64 + lane] = bf2f(Q0[(size_t)m * 512 + 128 * h + 64 + lane]);
    float m1 = -1e30f, m2 = -1e30f, l1 = 0.f, l2 = 0.f, o1[2] = {0.f, 0.f}, o2[2] = {0.f, 0.f};
    for (int j0 = 0; j0 < nk; j0 += 64) {
        int j = j0 + lane;
        bool valid = j < nk && ((j >> 6) <= (qpos >> 6));
        float s1 = 0.f, s2 = 0.f;
        if (valid) {
            if (samp && j < PAST) {
                const float* kr = P.in[2] + (((size_t)b * PAST + j) * 4 + h) * 128;
                for (int d = 0; d < 64; ++d) { s1 += sqw[d] * bf2f(f2bf(kr[d])); s2 += sqw[64 + d] * bf2f(f2bf(kr[64 + d])); }
            } else {
                int km = samp ? TP + 32 * b + (j - PAST) : j;
                const bf16_t* kr = K0 + (size_t)km * 512 + 128 * h;
                for (int d = 0; d < 64; ++d) { s1 += sqw[d] * bf2f(kr[d]); s2 += sqw[64 + d] * bf2f(kr[64 + d]); }
            }
            int rel = j - qpos; float bias = rel <= -128 ? T->biasfar[h] : T->bias[h][rel + 191];
            s1 += bias * LOG2E; s2 += bias * LOG2E;
        } else { s1 = -1e30f; s2 = -1e30f; }
        float bm1 = wave_max(s1), bm2 = wave_max(s2);
        float n1 = fmaxf(m1, bm1), n2 = fmaxf(m2, bm2);
        float f1 = exp2f(m1 - n1), f2 = exp2f(m2 - n2);
        float p1 = valid ? exp2f(s1 - n1) : 0.f, p2 = valid ? exp2f(s2 - n2) : 0.f;
        l1 = l1 * f1 + wave_sum(p1); l2 = l2 * f2 + wave_sum(p2);
        o1[0] *= f1; o1[1] *= f1; o2[0] *= f2; o2[1] *= f2; m1 = n1; m2 = n2;
        spw[lane] = p1; spw[64 + lane] = p2;
        __builtin_amdgcn_s_waitcnt(0);
        int jn = min(64, nk - j0);
        for (int jj = 0; jj < jn; ++jj) {
            int jp = j0 + jj; float a1 = spw[jj], a2 = spw[64 + jj];
            float v0, v1;
            if (samp && jp < PAST) { const float* vr = P.in[3] + (((size_t)b * PAST + jp) * 4 + h) * 128; v0 = bf2f(f2bf(vr[lane])); v1 = bf2f(f2bf(vr[64 + lane])); }
            else { int km = samp ? TP + 32 * b + (jp - PAST) : jp; const bf16_t* vr = PR + (size_t)km * N0P + C_V + 128 * h; v0 = bf2f(vr[lane]); v1 = bf2f(vr[64 + lane]); }
            o1[0] += a1 * v0; o1[1] += a1 * v1; o2[0] += a2 * v0; o2[1] += a2 * v1;
        }
    }
    const float lam = T->lam;
    float a0 = o1[0] / l1 - lam * o2[0] / l2, a1 = o1[1] / l1 - lam * o2[1] / l2;
    float ss = wave_sum(a0 * a0 + a1 * a1);
    float r = rsqrtf(ss * (1.f / 128) + EPS) * (1.f - LAMBDA_INIT);
    const float* sg = P.in[18];
    const bf16_t* za = PR + (size_t)m * N0P + C_ZA + 128 * h;
    bf16_t* cat = (bf16_t*)(P.ws + WS_CAT) + (size_t)m * D + 128 * h;
    cat[lane] = f2bf(a0 * r * sg[lane] * silu(bf2f(za[lane])));
    cat[64 + lane] = f2bf(a1 * r * sg[64 + lane] * silu(bf2f(za[64 + lane])));
}
__global__ void __launch_bounds__(256) k_attn0(Ptrs P) {
    __shared__ float sq[4][128], sp[4][128];
    const int wid = threadIdx.x >> 6, lane = threadIdx.x & 63, gw = blockIdx.x * 4 + wid;
    if ((gw >> 2) < M) d_attn0(P, gw >> 2, gw & 3, lane, &sq[wid][0], &sp[wid][0]);
}

constexpr size_t RWN = (size_t)M * 512;
__device__ __forceinline__ float prw_prev(const Ptrs& P, int m, int c) {
    if (m < TP) return m == 0 ? 0.f : bf2f(((const bf16_t*)(P.ws + WS_PROJ0))[(size_t)(m - 1) * N0P + C_PRW + c]);
    int i = (m - TP) & 31, b = (m - TP) >> 5;
    if (i == 0) return P.in[4][(size_t)b * RWS + c];
    return bf2f(((const bf16_t*)(P.ws + WS_PROJ0))[(size_t)(m - 1) * N0P + C_PRW + c]);
}
template <class SP> __device__ __forceinline__ void d_rw_prep(const Ptrs& P, int m, int c, SP swl, SP sal) {
    const bf16_t* pr = (const bf16_t*)(P.ws + WS_PROJ0) + (size_t)m * N0P + C_PRW;
    const float* mu = P.in[19];
#define NV_MIX(col) (bf2f(pr[col]) + (prw_prev(P, m, (col)) - bf2f(pr[col])) * mu[col])
    float r = NV_MIX(c), kr = NV_MIX(512 + c), vr = NV_MIX(1024 + c);
    if (c < 64) swl[c] = tanhf(NV_MIX(1536 + c)); else if (c < 128) sal[c - 64] = NV_MIX(1600 + c - 64);
#undef NV_MIX
    __syncthreads();
    float wa = P.in[20][c], aa = P.in[22][c];
    const float* wup = P.in[21]; const float* aup = P.in[23];
#pragma unroll 4
    for (int l = 0; l < 64; ++l) { wa += swl[l] * wup[l * 512 + c]; aa += sal[l] * aup[l * 512 + c]; }
    float spl = (-wa > 20.f) ? -wa : log1pf(__expf(-wa));
    float w = -spl - 0.5f;
    float dec = __expf(-__expf(w));
    float a = 1.f / (1.f + __expf(-aa));
    float kk = kr * P.in[24][c];
    float n2 = wave_sum(kk * kk);
    kk = kk / fmaxf(sqrtf(n2), 1e-12f);
    float km = kr * (1.f + (a - 1.f) * P.in[25][c]);
    float* R = (float*)(P.ws + WS_RW);
    size_t o = (size_t)m * 512 + c;
    R[o] = r; R[RWN + o] = dec; R[2 * RWN + o] = kk; R[3 * RWN + o] = kk * a; R[4 * RWN + o] = km; R[5 * RWN + o] = vr;
}
__global__ void __launch_bounds__(512) k_rw_prep(Ptrs P) { __shared__ float swl[64], sal[64]; d_rw_prep(P, blockIdx.x, threadIdx.x, &swl[0], &sal[0]); }
__device__ __forceinline__ void d_rw_scan(const Ptrs& P, int seq, int h, int lane) {
    const int m0 = seq == 0 ? 0 : TP + 32 * (seq - 1), T = seq == 0 ? TP : TS;
    float S[64];
    const float* s0 = P.in[5] + (((size_t)(seq > 0 ? seq - 1 : 0) * 8 + h) * 64 + lane) * 64;
#pragma unroll
    for (int k = 0; k < 64; ++k) S[k] = seq == 0 ? 0.f : s0[k];
    const float* R = (const float*)(P.ws + WS_RW);
    const float rk = P.in[26][h * 64 + lane], lg = P.in[27][h * 64 + lane], lb = P.in[28][h * 64 + lane];
    for (int t = 0; t < T; ++t) {
        size_t o = (size_t)(m0 + t) * 512 + h * 64 + lane;
        float r = R[o], dec = R[RWN + o], kk = R[2 * RWN + o], kka = R[3 * RWN + o], km = R[4 * RWN + o], v = R[5 * RWN + o];
        float sa = 0.f;
#pragma unroll
        for (int k = 0; k < 64; ++k) sa += S[k] * __shfl(kk, k);
        float ov = 0.f;
#pragma unroll
        for (int k = 0; k < 64; ++k) { S[k] = S[k] * __shfl(dec, k) - sa * __shfl(kka, k) + v * __shfl(km, k); ov += S[k] * __shfl(r, k); }
        float mu = wave_sum(ov) * (1.f / 64);
        float dv = ov - mu;
        float var = wave_sum(dv * dv) * (1.f / 64);
        float y = dv * rsqrtf(var + GN_EPS) * lg + lb;
        float bonus = wave_sum(r * km * rk) * v;
        int mm = m0 + t;
        float zb = bf2f(((const bf16_t*)(P.ws + WS_PROJ0))[(size_t)mm * N0P + C_ZB + h * 64 + lane]);
        ((bf16_t*)(P.ws + WS_CAT))[(size_t)mm * D + 512 + h * 64 + lane] = f2bf((y + bonus) * silu(zb));
    }
    float* so = P.out + (seq == 0 ? O_L0WKV_P + ((size_t)h * 64 + lane) * 64 : O_L0WKV_S + ((((size_t)(seq - 1)) * 8 + h) * 64 + lane) * 64);
#pragma unroll
    for (int k = 0; k < 64; ++k) so[k] = S[k];
}
__global__ void __launch_bounds__(64) k_rw_scan(Ptrs P) { d_rw_scan(P, blockIdx.x >> 3, blockIdx.x & 7, threadIdx.x); }

template <class SP> __device__ __forceinline__ void d_attn1(const Ptrs& P, int m, int h, int lane, SP sqw, SP saw) {
    const bf16_t* Q1 = (const bf16_t*)(P.ws + WS_Q1); const bf16_t* K1 = (const bf16_t*)(P.ws + WS_K1);
    const bf16_t* V1T = (const bf16_t*)(P.ws + WS_V1T);
    bool samp = m >= TP; int b = 0, qpos;
    if (!samp) qpos = m; else { b = (m - TP) >> 5; qpos = PAST + ((m - TP) & 31); }
    sqw[lane] = bf2f(Q1[(size_t)m * D + 64 * h + lane]);
    float run = 0.f, o = 0.f;
    for (int s0 = qpos - 1; s0 >= 0; s0 -= 64) {
        int s = s0 - lane;
        bool valid = s >= 0;
        float z = 0.f;
        if (valid) {
            if (samp && s < PAST) { const float* kr = P.in[6] + (((size_t)b * PAST + s) * 16 + h) * 64; for (int d = 0; d < 64; ++d) z += sqw[d] * bf2f(f2bf(kr[d])); }
            else { int km = samp ? TP + 32 * b + (s - PAST) : s; const bf16_t* kr = K1 + (size_t)km * D + 64 * h; for (int d = 0; d < 64; ++d) z += sqw[d] * bf2f(kr[d]); }
        }
        float spl = valid ? log2f(1.f + exp2f(z)) : 0.f;
        float inc = spl;
#pragma unroll
        for (int off = 1; off < 64; off <<= 1) { float t = __shfl_up(inc, off); if (lane >= off) inc += t; }
        float a = valid ? exp2f(z - inc - run) : 0.f;
        saw[lane] = a;
        run += __shfl(inc, 63);
        __builtin_amdgcn_s_waitcnt(0);
        int jn = min(64, s0 + 1);
        for (int jj = 0; jj < jn; ++jj) {
            int sp_ = s0 - jj; float v;
            if (samp && sp_ < PAST) v = bf2f(f2bf(P.in[7][(((size_t)b * PAST + sp_) * 16 + h) * 64 + lane]));
            else { int km = samp ? TP + 32 * b + (sp_ - PAST) : sp_; v = bf2f(V1T[(size_t)(64 * h + lane) * M + km]); }
            o += saw[jj] * v;
        }
        if (run > 200.f) break;
    }
    float z1 = bf2f(((const bf16_t*)(P.ws + WS_Z1))[(size_t)m * D + 64 * h + lane]);
    ((bf16_t*)(P.ws + WS_O1B))[(size_t)m * D + 64 * h + lane] = f2bf(o * silu(z1));
}
__global__ void __launch_bounds__(256) k_attn1(Ptrs P) {
    __shared__ float sq[4][64], sa[4][64];
    const int wid = threadIdx.x >> 6, lane = threadIdx.x & 63, gw = blockIdx.x * 4 + wid;
    if ((gw >> 4) < M) d_attn1(P, gw >> 4, gw & 15, lane, &sq[wid][0], &sa[wid][0]);
}

}
namespace pg8 {
#define PG8_LAS __attribute__((address_space(3)))
typedef unsigned short bf16_t;
typedef short bf16x8 __attribute__((ext_vector_type(8)));
typedef float f32x4 __attribute__((ext_vector_type(4)));
typedef unsigned u32x4 __attribute__((ext_vector_type(4)));
constexpr int BM = 256, BK = 64, HALF = 128, HTB = HALF * BK * 2  , STAGE_BYTES = 8 * HTB, NXCD = 8, WGM = 8;

__host__ __device__ __forceinline__ int lds_byte(int r, int c) { const int st = (r >> 4) * 2 + (c >> 5), rr = r & 15, cc = c & 31, ob = rr * 64 + cc * 2; return st * 1024 + (ob ^ (((ob >> 9) & 1) << 5)); }
__host__ __device__ __forceinline__ void stage_rc(int b, int& R, int& C) { const int st = b / 1024, sb = b % 1024, swz = sb ^ (((sb >> 9) & 1) << 5); R = (st >> 1) * 16 + swz / 64; C = (st & 1) * 32 + (swz % 64) / 2; }
__host__ __device__ __forceinline__ int perm32(int rho) { const int n = rho >> 4, i = rho & 15; return 8 * (i >> 2) + 4 * n + (i & 3); }

struct Unit { int pm, pn; };
struct Gemm { const bf16_t* A; const bf16_t* Bt; int M, N, K; };

struct StaticOrder {
    int nM, nN, nwg, G, c;
    __host__ __device__ void init(int M, int N, int G_, int c_) { nM = M / BM; nN = N / BM; nwg = nM * nN; G = G_; c = c_; }
    __host__ __device__ bool next(int i, Unit& u) const {
        const long L = (long)i * G + c; if (L >= nwg) return false;
        int wgid = (int)L; { const int q = nwg / NXCD, r = nwg % NXCD, xcd = wgid % NXCD, off = wgid / NXCD; wgid = (xcd < r ? xcd * (q + 1) : r * (q + 1) + (xcd - r) * q) + off; }
        const int nig = WGM * nN, gid = wgid / nig, fm = gid * WGM, gsz = (nM - fm) < WGM ? (nM - fm) : WGM;
        u.pm = fm + ((wgid % nig) % gsz); u.pn = (wgid % nig) / gsz; return true;
    }
    __device__ __forceinline__ void a_ready(const Unit&) const {}
    __device__ __forceinline__ void done(const Unit&) const {}
};


__device__ __forceinline__ unsigned cvt_pk_bf16(float lo, float hi) { unsigned r; asm volatile("v_cvt_pk_bf16_f32 %0, %1, %2" : "=v"(r) : "v"(lo), "v"(hi)); return r; }
__device__ __forceinline__ u32x4 pack8(const f32x4& v0, const f32x4& v1) { u32x4 w; w.x = cvt_pk_bf16(v0[0], v0[1]); w.y = cvt_pk_bf16(v0[2], v0[3]); w.z = cvt_pk_bf16(v1[0], v1[1]); w.w = cvt_pk_bf16(v1[2], v1[3]); return w; }

struct EpiProj0F {
    static constexpr bool PERM = true, AFTER_DRAIN = false;
    bf16_t* O;
    __device__ __forceinline__ void operator()(const f32x4 (&acc)[2][2][4][2], const Unit& u, int wr, int wc, int fr, int fq) const {
        const int row0 = u.pm * BM + wr * 64 + fr, col0 = u.pn * BM + wc * 32 + 8 * fq;
#pragma unroll
        for (int ai = 0; ai < 2; ++ai)
#pragma unroll
            for (int m = 0; m < 4; ++m) { bf16_t* rowp = O + (size_t)(row0 + ai * HALF + m * 16) * N0P + col0;
#pragma unroll
                for (int bj = 0; bj < 2; ++bj) *(u32x4*)(rowp + bj * HALF) = pack8(acc[ai][bj][m][0], acc[ai][bj][m][1]); }
    }
};
struct EpiY0F {
    static constexpr bool PERM = true, AFTER_DRAIN = false;
    Ptrs P;
    __device__ __forceinline__ void operator()(const f32x4 (&acc)[2][2][4][2], const Unit& u, int wr, int wc, int fr, int fq) const {
        const int row0 = u.pm * BM + wr * 64 + fr, col0 = u.pn * BM + wc * 32 + 8 * fq;
        float* Y0 = (float*)(P.ws + WS_Y0); bf16_t* YB = (bf16_t*)(P.ws + WS_Y0B); float* SSQ = (float*)(P.ws + WS_SSQ);
#pragma unroll
        for (int ai = 0; ai < 2; ++ai)
#pragma unroll
            for (int m = 0; m < 4; ++m) { const int row = row0 + ai * HALF + m * 16; const float* xr = xrow(P, row) + col0; float ss = 0.f;
#pragma unroll
                for (int bj = 0; bj < 2; ++bj) {
                    const f32x4 y0 = acc[ai][bj][m][0] + *(const f32x4*)(xr + bj * HALF), y1 = acc[ai][bj][m][1] + *(const f32x4*)(xr + bj * HALF + 4);
                    *(f32x4*)(Y0 + (size_t)row * D + col0 + bj * HALF) = y0; *(f32x4*)(Y0 + (size_t)row * D + col0 + bj * HALF + 4) = y1;
                    *(u32x4*)(YB + (size_t)row * D + col0 + bj * HALF) = pack8(y0, y1);
                    ss += (y0[0] * y0[0] + y0[1] * y0[1]) + (y0[2] * y0[2] + y0[3] * y0[3]) + (y1[0] * y1[0] + y1[1] * y1[1]) + (y1[2] * y1[2] + y1[3] * y1[3]); }
                ss += __shfl_xor(ss, 16); ss += __shfl_xor(ss, 32);
                if (fq == 0) SSQ[(size_t)row * 16 + u.pn * 4 + wc] = ss; }
    }
};
struct EpiL1F {
    static constexpr bool PERM = true, AFTER_DRAIN = false;
    Ptrs P;
    __device__ __forceinline__ void operator()(const f32x4 (&acc)[2][2][4][2], const Unit& u, int wr, int wc, int fr, int fq) const {
        const int row0 = u.pm * BM + wr * 64 + fr, colt = u.pn * BM, reg = colt >> 10, c0 = (colt & 1023) + wc * 32 + 8 * fq;
        const float* SSQ = (const float*)(P.ws + WS_SSQ);
#pragma unroll
        for (int ai = 0; ai < 2; ++ai)
#pragma unroll
            for (int m = 0; m < 4; ++m) { const int row = row0 + ai * HALF + m * 16;
                const f32x4* sp = (const f32x4*)(SSQ + (size_t)row * 16); const f32x4 s0 = sp[0], s1 = sp[1], s2 = sp[2], s3 = sp[3];
                const f32x4 st = (s0 + s1) + (s2 + s3); const float rs = rsqrtf(((st[0] + st[1]) + (st[2] + st[3])) * (1.f / D) + EPS);
#pragma unroll
                for (int bj = 0; bj < 2; ++bj) { const int c = c0 + bj * HALF; f32x4 v0 = acc[ai][bj][m][0] * rs, v1 = acc[ai][bj][m][1] * rs;
                    if (reg == 0) { *(u32x4*)((bf16_t*)(P.ws + WS_Q1) + (size_t)row * D + c) = pack8(v0 * QSCALE, v1 * QSCALE); }
                    else if (reg == 1) { *(u32x4*)((bf16_t*)(P.ws + WS_K1) + (size_t)row * D + c) = pack8(v0, v1); float* o = P.out + off_l1k(row) + c; *(f32x4*)o = v0; *(f32x4*)(o + 4) = v1; }
                    else if (reg == 2) { bf16_t* vt = (bf16_t*)(P.ws + WS_V1T) + (size_t)c * M + row;
#pragma unroll
                        for (int j = 0; j < 4; ++j) { vt[(size_t)j * M] = f2bf(v0[j]); vt[(size_t)(4 + j) * M] = f2bf(v1[j]); }
                        float* o = P.out + off_l1v(row) + c; *(f32x4*)o = v0; *(f32x4*)(o + 4) = v1; }
                    else { *(u32x4*)((bf16_t*)(P.ws + WS_Z1) + (size_t)row * D + c) = pack8(v0, v1); } } }
    }
};
struct EpiOutF {
    static constexpr bool PERM = true, AFTER_DRAIN = false;
    Ptrs P;
    __device__ __forceinline__ void operator()(const f32x4 (&acc)[2][2][4][2], const Unit& u, int wr, int wc, int fr, int fq) const {
        const int row0 = u.pm * BM + wr * 64 + fr, col0 = u.pn * BM + wc * 32 + 8 * fq;
        const float* Y0 = (const float*)(P.ws + WS_Y0);
#pragma unroll
        for (int ai = 0; ai < 2; ++ai)
#pragma unroll
            for (int m = 0; m < 4; ++m) { const size_t ro = (size_t)(row0 + ai * HALF + m * 16) * D + col0;
#pragma unroll
                for (int bj = 0; bj < 2; ++bj) {
                    *(f32x4*)(P.out + O_Y + ro + bj * HALF) = acc[ai][bj][m][0] + *(const f32x4*)(Y0 + ro + bj * HALF);
                    *(f32x4*)(P.out + O_Y + ro + bj * HALF + 4) = acc[ai][bj][m][1] + *(const f32x4*)(Y0 + ro + bj * HALF + 4); } }
    }
};
template <class Epi, class Sched, bool ALIGN_EPI = false, bool SP2 = false>
__device__ __forceinline__ void gemm_phase(PG8_LAS unsigned char* lds, const Gemm g, const Sched& S, const Epi& E) {
    const int tid = threadIdx.x, wid = __builtin_amdgcn_readfirstlane(tid >> 6), lane = tid & 63, wr = wid >> 2, wc = wid & 3, fr = lane & 15, fq = lane >> 4;
    const int K = g.K, nt = K / BK;
    unsigned voffA[2], voffB[2];
#pragma unroll
    for (int i = 0; i < 2; ++i) { int R, C; stage_rc(tid * 16 + i * 8192, R, C); const int Rb = Epi::PERM ? ((R & ~31) + perm32(R & 31)) : R;
        voffA[i] = (unsigned)(R * K + C) * 2u; voffB[i] = (unsigned)(Rb * K + C) * 2u; }
    const size_t kstep = (size_t)(BK * 2);
    const size_t hstep = (size_t)HALF * K * 2;
    const size_t tstep = 2 * hstep;
    const unsigned ldsw = (unsigned)wid * 1024u;
    const int aoff = lds_byte(wr * 64 + fr, fq * 8), boff = lds_byte(wc * 32 + fr, fq * 8);
#define PG8_SA(b, h) (((b) * 2 + (h)) * HTB)
#define PG8_SB(b, h) ((4 + (b) * 2 + (h)) * HTB)
#define PG8_STAGE(bufoff, gbase, voff) do { _Pragma("unroll") for (int _i = 0; _i < 2; ++_i) \
        __builtin_amdgcn_global_load_lds((const unsigned*)((const char*)(gbase) + (voff)[_i]), (PG8_LAS unsigned*)(lds + (bufoff) + ldsw + _i * 8192), 16, 0, 0); } while (0)
#define PG8_LDA(dst, b, h) do { _Pragma("unroll") for (int m = 0; m < 4; ++m) _Pragma("unroll") for (int k = 0; k < 2; ++k) dst[m][k] = *(const PG8_LAS bf16x8*)(lds + PG8_SA(b, h) + aoff + m * 2048 + k * 1024); } while (0)
#define PG8_LDB(dst, b, h) do { _Pragma("unroll") for (int n = 0; n < 2; ++n) _Pragma("unroll") for (int k = 0; k < 2; ++k) dst[n][k] = *(const PG8_LAS bf16x8*)(lds + PG8_SB(b, h) + boff + n * 2048 + k * 1024); } while (0)
#define PG8_MMA(ai, bj, At, Bt) do { __builtin_amdgcn_s_setprio(1); _Pragma("unroll") for (int m = 0; m < 4; ++m) _Pragma("unroll") for (int n = 0; n < 2; ++n) _Pragma("unroll") for (int k = 0; k < 2; ++k) \
        acc[ai][bj][m][n] = __builtin_amdgcn_mfma_f32_16x16x32_bf16(Bt[n][k], At[m][k], acc[ai][bj][m][n], 0, 0, 0); __builtin_amdgcn_s_setprio(0); } while (0)
#define PG8_WAIT_V(n) asm volatile("s_waitcnt vmcnt(" #n ")" ::: "memory")
#define PG8_WAIT_L(n) asm volatile("s_waitcnt lgkmcnt(" #n ")" ::: "memory")
#define PG8_BAR __builtin_amdgcn_s_barrier()
#define PG8_SCHED __builtin_amdgcn_sched_barrier(0)
    Unit cur, nxt; int ui = 0;
    if (!S.next(0, cur)) return;
    f32x4 acc[2][2][4][2];
#pragma unroll
    for (int a = 0; a < 2; ++a)
#pragma unroll
        for (int b = 0; b < 2; ++b)
#pragma unroll
            for (int m = 0; m < 4; ++m)
#pragma unroll
                for (int n = 0; n < 2; ++n) acc[a][b][m][n] = (f32x4){0.f, 0.f, 0.f, 0.f};
    bf16x8 At[4][2], B0[2][2], B1[2][2];
    const char* cA = (const char*)g.A + (size_t)cur.pm * tstep; const char* cB = (const char*)g.Bt + (size_t)cur.pn * tstep;
    S.a_ready(cur);
    if constexpr (SP2) {
        PG8_STAGE(PG8_SB(0, 0), cB, voffB); PG8_STAGE(PG8_SB(0, 1), cB + hstep, voffB); PG8_STAGE(PG8_SA(0, 0), cA, voffA); PG8_STAGE(PG8_SA(0, 1), cA + hstep, voffA);
        if (wr == 1) PG8_BAR;
        PG8_WAIT_V(2); PG8_BAR;
        PG8_STAGE(PG8_SB(1, 0), cB + kstep, voffB); PG8_STAGE(PG8_SA(1, 0), cA + kstep, voffA); PG8_STAGE(PG8_SB(1, 1), cB + hstep + kstep, voffB);
        PG8_WAIT_V(6); PG8_BAR;
    } else {
        PG8_STAGE(PG8_SB(0, 0), cB, voffB); PG8_STAGE(PG8_SA(0, 0), cA, voffA); PG8_STAGE(PG8_SB(0, 1), cB + hstep, voffB); PG8_STAGE(PG8_SA(0, 1), cA + hstep, voffA);
        if (wr == 1) PG8_BAR;
        PG8_WAIT_V(4); PG8_BAR;
        PG8_STAGE(PG8_SB(1, 0), cB + kstep, voffB); PG8_STAGE(PG8_SA(1, 0), cA + kstep, voffA); PG8_STAGE(PG8_SB(1, 1), cB + hstep + kstep, voffB);
        PG8_WAIT_V(6); PG8_BAR;
    }
    for (;;) {
        const bool has_next = S.next(ui + 1, nxt);
        const char* nA = has_next ? (const char*)g.A + (size_t)nxt.pm * tstep : cA; const char* nB = has_next ? (const char*)g.Bt + (size_t)nxt.pn * tstep : cB;
        for (int t = 0; t < nt; t += 2) {
            const bool last = (t == nt - 2);
            const char* a1 = cA + (size_t)(t + 1) * kstep;
            const char* a2 = last ? nA : cA + (size_t)(t + 2) * kstep; const char* b2 = last ? nB : cB + (size_t)(t + 2) * kstep;
            const char* a3 = a2 + kstep; const char* b3 = b2 + kstep;
            if (last && has_next) S.a_ready(nxt);
            if constexpr (SP2) {
            PG8_LDB(B0, 0, 0); PG8_LDB(B1, 0, 1); PG8_SCHED; PG8_LDA(At, 0, 0); PG8_STAGE(PG8_SA(1, 1), a1 + hstep, voffA);
            PG8_WAIT_V(8); PG8_WAIT_L(0); PG8_BAR; PG8_MMA(0, 0, At, B0); PG8_MMA(0, 1, At, B1); PG8_BAR; PG8_SCHED;
            PG8_LDA(At, 0, 1); PG8_STAGE(PG8_SB(0, 0), b2, voffB); PG8_STAGE(PG8_SB(0, 1), b2 + hstep, voffB); PG8_STAGE(PG8_SA(0, 0), a2, voffA);
            PG8_WAIT_V(8); PG8_WAIT_L(0); PG8_BAR; PG8_MMA(1, 0, At, B0); PG8_MMA(1, 1, At, B1); PG8_BAR; PG8_SCHED;
            PG8_LDB(B0, 1, 0); PG8_LDB(B1, 1, 1); PG8_SCHED; PG8_LDA(At, 1, 0); PG8_STAGE(PG8_SA(0, 1), a2 + hstep, voffA);
            PG8_WAIT_V(8); PG8_WAIT_L(0); PG8_BAR; PG8_MMA(0, 0, At, B0); PG8_MMA(0, 1, At, B1); PG8_BAR; PG8_SCHED;
            PG8_LDA(At, 1, 1); PG8_STAGE(PG8_SB(1, 0), b3, voffB); PG8_STAGE(PG8_SB(1, 1), b3 + hstep, voffB); PG8_STAGE(PG8_SA(1, 0), a3, voffA);
            PG8_WAIT_V(8); PG8_WAIT_L(0); PG8_BAR; PG8_MMA(1, 0, At, B0); PG8_MMA(1, 1, At, B1); PG8_BAR; PG8_SCHED;
            } else {
            PG8_LDB(B0, 0, 0); PG8_SCHED; PG8_LDA(At, 0, 0); PG8_STAGE(PG8_SA(1, 1), a1 + hstep, voffA);
            PG8_WAIT_L(8); PG8_BAR; PG8_WAIT_L(0); PG8_MMA(0, 0, At, B0); PG8_BAR; PG8_SCHED;
            PG8_LDB(B1, 0, 1); PG8_STAGE(PG8_SB(0, 0), b2, voffB);
            PG8_BAR; PG8_WAIT_L(0); PG8_MMA(0, 1, At, B1); PG8_BAR;
            PG8_LDA(At, 0, 1); PG8_STAGE(PG8_SA(0, 0), a2, voffA);
            PG8_BAR; PG8_WAIT_L(0); PG8_MMA(1, 0, At, B0); PG8_BAR; PG8_SCHED;
            PG8_STAGE(PG8_SB(0, 1), b2 + hstep, voffB);
            PG8_WAIT_V(6); PG8_BAR; PG8_MMA(1, 1, At, B1); PG8_BAR;
            PG8_LDB(B0, 1, 0); PG8_SCHED; PG8_LDA(At, 1, 0); PG8_STAGE(PG8_SA(0, 1), a2 + hstep, voffA);
            PG8_WAIT_L(8); PG8_BAR; PG8_WAIT_L(0); PG8_MMA(0, 0, At, B0); PG8_BAR; PG8_SCHED;
            PG8_LDB(B1, 1, 1); PG8_STAGE(PG8_SB(1, 0), b3, voffB);
            PG8_BAR; PG8_WAIT_L(0); PG8_MMA(0, 1, At, B1); PG8_BAR;
            PG8_LDA(At, 1, 1); PG8_STAGE(PG8_SA(1, 0), a3, voffA);
            PG8_BAR; PG8_WAIT_L(0); PG8_MMA(1, 0, At, B0); PG8_BAR; PG8_SCHED;
            PG8_STAGE(PG8_SB(1, 1), b3 + hstep, voffB);
            PG8_WAIT_V(6); PG8_BAR; PG8_MMA(1, 1, At, B1); PG8_BAR;
            }
        }
        if constexpr (ALIGN_EPI) { if (wr == 0) PG8_BAR; }
        if constexpr (!Epi::AFTER_DRAIN) { E(acc, cur, wr, wc, fr, fq); S.done(cur); }
        if (!has_next) break;
#pragma unroll
        for (int a = 0; a < 2; ++a)
#pragma unroll
            for (int b = 0; b < 2; ++b)
#pragma unroll
                for (int m = 0; m < 4; ++m)
#pragma unroll
                    for (int n = 0; n < 2; ++n) acc[a][b][m][n] = (f32x4){0.f, 0.f, 0.f, 0.f};
        cur = nxt; cA = nA; cB = nB; ++ui;
        if constexpr (ALIGN_EPI) { if (wr == 1) PG8_BAR; }
    }
    PG8_WAIT_V(0);
    if constexpr (!ALIGN_EPI) { if (wr == 0) PG8_BAR; }
    PG8_BAR;
    if constexpr (Epi::AFTER_DRAIN) { E.fused(acc, cur, wr, wc, fr, fq, lds, wid, lane); S.done(cur); }
#undef PG8_SA
#undef PG8_SB
#undef PG8_STAGE
#undef PG8_LDA
#undef PG8_LDB
#undef PG8_MMA
#undef PG8_WAIT_V
#undef PG8_WAIT_L
#undef PG8_BAR
#undef PG8_SCHED
}
}
namespace da {
#define DLAS __attribute__((address_space(3)))
typedef short bf16x8 __attribute__((ext_vector_type(8)));
typedef short s16x4 __attribute__((ext_vector_type(4)));
typedef float f32x16 __attribute__((ext_vector_type(16)));
typedef float f32x4 __attribute__((ext_vector_type(4)));
typedef unsigned u32x4 __attribute__((ext_vector_type(4)));

constexpr int KROW = 272, KBUF = 64 * KROW, VBUF = 16384;
constexpr int OFF_K = 0, OFF_V = 2 * KBUF;
constexpr int OFF_STAGE = 0;
constexpr int OFF_LST = 131072;
constexpr int OFF_BIAS = OFF_LST + 1024;
constexpr int DA_LDS_END = OFF_BIAS + 1024;

struct Unit { int kind, h, idx; };

__device__ __forceinline__ unsigned cvtpk(float lo, float hi) { unsigned r; asm volatile("v_cvt_pk_bf16_f32 %0, %1, %2" : "=v"(r) : "v"(lo), "v"(hi)); return r; }
__device__ __forceinline__ u32x4 pack8(const f32x4& a, const f32x4& b) { u32x4 w; w.x = cvtpk(a[0], a[1]); w.y = cvtpk(a[2], a[3]); w.z = cvtpk(b[0], b[1]); w.w = cvtpk(b[2], b[3]); return w; }

struct Stage { f32x4 kA0, kA1, vA0, vA1, kB0, kB1, vB0, vB1; };
template <int KIND> __device__ __forceinline__ void chunk_issue(const Ptrs& P, const Unit& u, int t, int c, f32x4& k0, f32x4& k1, f32x4& v0, f32x4& v1) {
    const int row = c >> 4, ch = c & 15;
    if (KIND == 0 || t == 16) {
        const int m = (KIND == 0) ? 64 * t + row : TP + 32 * u.idx + (row & 31);
        const bf16_t* kp = (const bf16_t*)(P.ws + WS_K0) + (size_t)m * 512 + 128 * u.h + ch * 8;
        const bf16_t* vp = (const bf16_t*)(P.ws + WS_PROJ0) + (size_t)m * N0P + C_V + 128 * u.h + ch * 8;
        f32x4 kv = *(const f32x4*)kp, vv = *(const f32x4*)vp;
        if (KIND != 0 && row >= 32) { kv = (f32x4){0.f, 0.f, 0.f, 0.f}; vv = kv; }
        k0 = kv; v0 = vv;
    } else {
        const size_t ro = (((size_t)u.idx * PAST + 64 * t + row) * 4 + u.h) * 128 + ch * 8;
        const float* kp = P.in[2] + ro; const float* vp = P.in[3] + ro;
        k0 = *(const f32x4*)kp; k1 = *(const f32x4*)(kp + 4); v0 = *(const f32x4*)vp; v1 = *(const f32x4*)(vp + 4);
    }
}
template <int KIND> __device__ __forceinline__ void chunk_write(int t, int c, DLAS unsigned char* lds, int buf, const f32x4& k0, const f32x4& k1, const f32x4& v0, const f32x4& v1) {
    const int row = c >> 4, ch = c & 15;
    DLAS unsigned char* kd = lds + OFF_K + buf * KBUF + row * KROW + ch * 16;
    DLAS unsigned char* vd = lds + OFF_V + buf * VBUF + (ch >> 2) * 4096 + row * 64 + (ch & 3) * 16;
    if (KIND == 0 || t == 16) { *(DLAS f32x4*)kd = k0; *(DLAS f32x4*)vd = v0; }
    else { *(DLAS u32x4*)kd = pack8(k0, k1); *(DLAS u32x4*)vd = pack8(v0, v1); }
}
#define TILE_ISSUE(t_) do { chunk_issue<KIND>(P, u, (t_), tid, S.kA0, S.kA1, S.vA0, S.vA1); chunk_issue<KIND>(P, u, (t_), tid + 512, S.kB0, S.kB1, S.vB0, S.vB1); } while (0)
#define TILE_WRITE(t_, buf_) do { chunk_write<KIND>((t_), tid, lds, (buf_), S.kA0, S.kA1, S.vA0, S.vA1); chunk_write<KIND>((t_), tid + 512, lds, (buf_), S.kB0, S.kB1, S.vB0, S.vB1); } while (0)

template <int KIND> __device__ __forceinline__ void unit_run(const Ptrs& P, const Unit& u0, DLAS unsigned char* lds, int tid) {
    const Unit u{KIND, u0.h, u0.idx};
    const int lane = tid & 63, wave = __builtin_amdgcn_readfirstlane(tid >> 6), r32 = lane & 31, hi = lane >> 5, mp = wave >> 2, w4 = wave & 3;
    constexpr bool is_s = KIND != 0;
    int m0row, qpos0, NT, cq;
    if (!is_s) { m0row = 128 * u.idx + 32 * w4; qpos0 = m0row; NT = 2 * u.idx + 2; cq = m0row >> 6; }
    else { m0row = TP + 32 * u.idx; qpos0 = PAST; NT = 17; cq = 16; }
    const Tab* T = (const Tab*)(P.ws + WS_TAB);
    DLAS float* lst = (DLAS float*)(lds + OFF_LST);
    DLAS float* bl = (DLAS float*)(lds + OFF_BIAS);
    if (tid < 256) { bl[tid] = (T->bias[u.h][tid] - T->biasfar[u.h]) * LOG2E; lst[tid] = 0.f; }
    bf16x8 qf[4];
    { const bf16_t* qp = (const bf16_t*)(P.ws + WS_Q0) + (size_t)(m0row + r32) * 512 + 128 * u.h + 64 * mp + 8 * hi;
#pragma unroll
      for (int s = 0; s < 4; ++s) qf[s] = *(const bf16x8*)(qp + 16 * s); }
    f32x16 o[4];
#pragma unroll
    for (int d = 0; d < 4; ++d)
#pragma unroll
        for (int r = 0; r < 16; ++r) o[d][r] = 0.f;
    float lsum = 0.f;
    Stage S;
    { const f32x4 z = (f32x4){0.f, 0.f, 0.f, 0.f}; S.kA0 = z; S.kA1 = z; S.vA0 = z; S.vA1 = z; S.kB0 = z; S.kB1 = z; S.vB0 = z; S.vB1 = z; }
    TILE_ISSUE(0);
    TILE_WRITE(0, 0);
    __syncthreads();
    const int vaddr = (4 * hi + ((lane & 15) >> 2)) * 64 + (16 * ((lane >> 4) & 1) + 4 * (lane & 3)) * 2;
    for (int t = 0; t < NT; ++t) {
        const int buf = t & 1;
        const bool has_next = t + 1 < NT;
        if (has_next) TILE_ISSUE(t + 1);
        const bool active = is_s ? ((t & 3) == w4) : (t <= cq);
        if (active) {
            const DLAS unsigned char* kb = lds + OFF_K + buf * KBUF + r32 * KROW + mp * 128 + hi * 16;
            f32x16 p0, p1;
#pragma unroll
            for (int r = 0; r < 16; ++r) { p0[r] = 0.f; p1[r] = 0.f; }
#pragma unroll
            for (int s = 0; s < 4; ++s) {
                const bf16x8 a0 = *(const DLAS bf16x8*)(kb + s * 32), a1 = *(const DLAS bf16x8*)(kb + 32 * KROW + s * 32);
                p0 = __builtin_amdgcn_mfma_f32_32x32x16_bf16(a0, qf[s], p0, 0, 0, 0);
                p1 = __builtin_amdgcn_mfma_f32_32x32x16_bf16(a1, qf[s], p1, 0, 0, 0);
            }
            if (t >= cq - 2) {
                const int rb = 64 * t - qpos0 - r32 + 191 + 4 * hi;
#pragma unroll
                for (int r = 0; r < 16; ++r) { const int kk = (r & 3) + 8 * (r >> 2); p0[r] += bl[rb + kk]; p1[r] += bl[rb + 32 + kk]; }
            }
#pragma unroll
            for (int r = 0; r < 16; ++r) { p0[r] = __builtin_amdgcn_exp2f(p0[r]); p1[r] = __builtin_amdgcn_exp2f(p1[r]); }
            if (is_s && t == 16) {
#pragma unroll
                for (int r = 0; r < 16; ++r) p1[r] = 0.f;
            }
            float sa = 0.f, sb = 0.f;
#pragma unroll
            for (int r = 0; r < 16; ++r) { sa += p0[r]; sb += p1[r]; }
            lsum += sa + sb;
            bf16x8 pa[4];
            pa[0] = __builtin_bit_cast(bf16x8, pack8((f32x4){p0[0], p0[1], p0[2], p0[3]}, (f32x4){p0[4], p0[5], p0[6], p0[7]}));
            pa[1] = __builtin_bit_cast(bf16x8, pack8((f32x4){p0[8], p0[9], p0[10], p0[11]}, (f32x4){p0[12], p0[13], p0[14], p0[15]}));
            pa[2] = __builtin_bit_cast(bf16x8, pack8((f32x4){p1[0], p1[1], p1[2], p1[3]}, (f32x4){p1[4], p1[5], p1[6], p1[7]}));
            pa[3] = __builtin_bit_cast(bf16x8, pack8((f32x4){p1[8], p1[9], p1[10], p1[11]}, (f32x4){p1[12], p1[13], p1[14], p1[15]}));
            const DLAS unsigned char* vb = lds + OFF_V + buf * VBUF + vaddr;
#pragma unroll
            for (int d = 0; d < 4; ++d)
#pragma unroll
                for (int k = 0; k < 4; ++k) {
                    const s16x4 lo = __builtin_bit_cast(s16x4, __builtin_amdgcn_ds_read_tr16_b64_v4i16((DLAS s16x4*)(vb + d * 4096 + k * 1024)));
                    const s16x4 hh = __builtin_bit_cast(s16x4, __builtin_amdgcn_ds_read_tr16_b64_v4i16((DLAS s16x4*)(vb + d * 4096 + k * 1024 + 512)));
                    const bf16x8 bf = (bf16x8){lo[0], lo[1], lo[2], lo[3], hh[0], hh[1], hh[2], hh[3]};
                    o[d] = __builtin_amdgcn_mfma_f32_32x32x16_bf16(pa[k], bf, o[d], 0, 0, 0);
                    if (k == 3) __builtin_amdgcn_sched_barrier(0);
                }
        }
        if (has_next) TILE_WRITE(t + 1, buf ^ 1);
        __syncthreads();
    }
    lsum += __shfl_xor(lsum, 32);
    DLAS float* stage = (DLAS float*)(lds + OFF_STAGE);
    {
        const int rowb = is_s ? 0 : 32 * w4;
        DLAS float* st0 = stage + (mp * 128 + rowb + 4 * hi) * 128 + r32;
#pragma unroll 1
        for (int round = 0; round < (is_s ? 4 : 1); ++round) {
            if (!is_s || round == w4) {
                const bool first = !is_s || round == 0;
#pragma unroll
                for (int d = 0; d < 4; ++d)
#pragma unroll
                    for (int r = 0; r < 16; ++r) {
                        DLAS float* st = st0 + ((r & 3) + 8 * (r >> 2)) * 128 + d * 32;
                        *st = first ? o[d][r] : *st + o[d][r];
                    }
                if (hi == 0) { DLAS float* lp = &lst[mp * 128 + rowb + r32]; *lp = first ? lsum : *lp + lsum; }
            }
            __syncthreads();
        }
    }
    {
        const int nrow = is_s ? 4 : 16;
        const float lam = T->lam;
        const float* sg = P.in[18];
        for (int i = 0; i < nrow; ++i) {
            const int row = wave * nrow + i;
            const float l1 = lst[row], l2 = lst[128 + row];
            const float il1 = 1.f / l1, il2 = lam / l2;
            const float a0 = stage[row * 128 + lane] * il1 - stage[(128 + row) * 128 + lane] * il2;
            const float a1 = stage[row * 128 + 64 + lane] * il1 - stage[(128 + row) * 128 + 64 + lane] * il2;
            const float ss = wave_sum(a0 * a0 + a1 * a1);
            const float rr = rsqrtf(ss * (1.f / 128) + EPS) * (1.f - LAMBDA_INIT);
            const int m = is_s ? TP + 32 * u.idx + row : 128 * u.idx + row;
            const bf16_t* za = (const bf16_t*)(P.ws + WS_PROJ0) + (size_t)m * N0P + C_ZA + 128 * u.h;
            bf16_t* cat = (bf16_t*)(P.ws + WS_CAT) + (size_t)m * D + 128 * u.h;
            cat[lane] = f2bf(a0 * rr * sg[lane] * silu(bf2f(za[lane])));
            cat[64 + lane] = f2bf(a1 * rr * sg[64 + lane] * silu(bf2f(za[64 + lane])));
        }
    }
    __syncthreads();
}

__device__ __forceinline__ void phase(const Ptrs& P, DLAS unsigned char* lds, int vcu, int nvcu, int tid) {
    if (nvcu == 256) {
        const int v = vcu, h = v >> 6, s = v & 63;
        unit_run<0>(P, Unit{0, h, 127 - s}, lds, tid);
        unit_run<0>(P, Unit{0, h, s}, lds, tid);
        if (v < 128) unit_run<1>(P, Unit{1, v & 3, v >> 2}, lds, tid);
    } else {
#pragma unroll 1
        for (int i = vcu; i < 512; i += nvcu) unit_run<0>(P, Unit{0, i >> 7, 127 - (i & 127)}, lds, tid);
#pragma unroll 1
        for (int i = vcu; i < 128; i += nvcu) unit_run<1>(P, Unit{1, i & 3, i >> 2}, lds, tid);
    }
}
#undef DLAS
}
namespace sb {
typedef short bf16x8 __attribute__((ext_vector_type(8)));
typedef short s16x4 __attribute__((ext_vector_type(4)));
typedef float f32x16 __attribute__((ext_vector_type(16)));
typedef float f32x4 __attribute__((ext_vector_type(4)));
typedef unsigned u32x4 __attribute__((ext_vector_type(4)));
typedef unsigned u32x2 __attribute__((ext_vector_type(2)));

__device__ __forceinline__ unsigned cvtpk(float lo, float hi) { unsigned r; asm volatile("v_cvt_pk_bf16_f32 %0, %1, %2" : "=v"(r) : "v"(lo), "v"(hi)); return r; }
constexpr float RUN_EXIT = 160.f;

template <int SAMPLE> __device__ __forceinline__ void unit_run(const Ptrs& P, int b, int h, int qt, int lane) {
    const int r32 = lane & 31, hi = lane >> 5;
    const bf16_t* Q1 = (const bf16_t*)(P.ws + WS_Q1); const bf16_t* K1 = (const bf16_t*)(P.ws + WS_K1); const bf16_t* V1T = (const bf16_t*)(P.ws + WS_V1T);
    const int m0 = SAMPLE ? TP + 32 * b : 32 * qt;
    const int q0 = SAMPLE ? PAST : 32 * qt;
    bf16x8 qf[4];
    { const bf16_t* qp = Q1 + (size_t)(m0 + r32) * D + 64 * h + 8 * hi;
#pragma unroll
      for (int s = 0; s < 4; ++s) qf[s] = *(const bf16x8*)(qp + 16 * s); }
    f32x16 o0, o1;
#pragma unroll
    for (int r = 0; r < 16; ++r) { o0[r] = 0.f; o1[r] = 0.f; }
    float run = 0.f;
#pragma unroll 1
    for (int k0 = q0; k0 >= 0; k0 -= 32) {
        const bool diag = (k0 == q0);
        const bool cache = SAMPLE && !diag;
        f32x16 p;
#pragma unroll
        for (int r = 0; r < 16; ++r) p[r] = 0.f;
        if (!cache) {
            const int mk = SAMPLE ? TP + 32 * b : k0;
            const bf16_t* kp = K1 + (size_t)(mk + r32) * D + 64 * h + 8 * hi;
#pragma unroll
            for (int s = 0; s < 4; ++s) { const bf16x8 a = *(const bf16x8*)(kp + 16 * s); p = __builtin_amdgcn_mfma_f32_32x32x16_bf16(a, qf[s], p, 0, 0, 0); }
        } else {
            const float* kp = P.in[6] + (((size_t)b * PAST + k0 + r32) * 16 + h) * 64 + 8 * hi;
#pragma unroll
            for (int s = 0; s < 4; ++s) { const f32x4 x0 = *(const f32x4*)(kp + 16 * s), x1 = *(const f32x4*)(kp + 16 * s + 4);
                u32x4 w; w.x = cvtpk(x0[0], x0[1]); w.y = cvtpk(x0[2], x0[3]); w.z = cvtpk(x1[0], x1[1]); w.w = cvtpk(x1[2], x1[3]);
                p = __builtin_amdgcn_mfma_f32_32x32x16_bf16(__builtin_bit_cast(bf16x8, w), qf[s], p, 0, 0, 0); }
        }
        float sp[16];
#pragma unroll
        for (int r = 0; r < 16; ++r) {
            const int kk = (r & 3) + 8 * (r >> 2) + 4 * hi;
            const float e = __builtin_amdgcn_exp2f(p[r]);
            float s = __builtin_amdgcn_logf(1.f + e);
            if (diag && !(kk < r32)) s = 0.f;
            sp[r] = s;
        }
        float a[4], bsum[4];
#pragma unroll
        for (int g = 0; g < 4; ++g) { a[g] = (sp[4 * g] + sp[4 * g + 1]) + (sp[4 * g + 2] + sp[4 * g + 3]); bsum[g] = __shfl_xor(a[g], 32); }
        float Tg[4];
        { float accA = 0.f, accB = 0.f;
#pragma unroll
          for (int g = 3; g >= 0; --g) {
              const float pb = hi ? accB : accB + bsum[g];
              Tg[g] = accA + pb;
              accA += a[g]; accB += bsum[g];
          }
          const float tot = accA + accB;
#pragma unroll
          for (int g = 0; g < 4; ++g) {
              float c = Tg[g] + run;
#pragma unroll
              for (int i = 3; i >= 0; --i) {
                  const int r = 4 * g + i, kk = i + 8 * g + 4 * hi;
                  c += sp[r];
                  float w = __builtin_amdgcn_exp2f(p[r] - c);
                  if (diag && !(kk < r32)) w = 0.f;
                  p[r] = w;
              }
          }
          run += tot;
        }
        u32x4 w0, w1;
        w0.x = cvtpk(p[0], p[1]); w0.y = cvtpk(p[2], p[3]); w0.z = cvtpk(p[4], p[5]); w0.w = cvtpk(p[6], p[7]);
        w1.x = cvtpk(p[8], p[9]); w1.y = cvtpk(p[10], p[11]); w1.z = cvtpk(p[12], p[13]); w1.w = cvtpk(p[14], p[15]);
        const bf16x8 pa0 = __builtin_bit_cast(bf16x8, w0), pa1 = __builtin_bit_cast(bf16x8, w1);
        if (!cache) {
            const int mk = SAMPLE ? TP + 32 * b : k0;
            const bf16_t* vp = V1T + (size_t)(64 * h + r32) * M + mk + 4 * hi;
#pragma unroll
            for (int d = 0; d < 2; ++d)
#pragma unroll
                for (int s = 0; s < 2; ++s) {
                    const u32x2 lo = *(const u32x2*)(vp + (size_t)(32 * d) * M + 16 * s), hh = *(const u32x2*)(vp + (size_t)(32 * d) * M + 16 * s + 8);
                    const u32x4 w = (u32x4){lo.x, lo.y, hh.x, hh.y};
                    if (d == 0) o0 = __builtin_amdgcn_mfma_f32_32x32x16_bf16(s == 0 ? pa0 : pa1, __builtin_bit_cast(bf16x8, w), o0, 0, 0, 0);
                    else o1 = __builtin_amdgcn_mfma_f32_32x32x16_bf16(s == 0 ? pa0 : pa1, __builtin_bit_cast(bf16x8, w), o1, 0, 0, 0);
                }
        } else {
            const float* vp = P.in[7] + (((size_t)b * PAST + k0 + 4 * hi) * 16 + h) * 64 + r32;
#pragma unroll
            for (int d = 0; d < 2; ++d)
#pragma unroll
                for (int s = 0; s < 2; ++s) {
                    float x[8];
#pragma unroll
                    for (int j = 0; j < 8; ++j) x[j] = vp[(size_t)(16 * s + 8 * (j >> 2) + (j & 3)) * 1024 + 32 * d];
                    u32x4 w; w.x = cvtpk(x[0], x[1]); w.y = cvtpk(x[2], x[3]); w.z = cvtpk(x[4], x[5]); w.w = cvtpk(x[6], x[7]);
                    if (d == 0) o0 = __builtin_amdgcn_mfma_f32_32x32x16_bf16(s == 0 ? pa0 : pa1, __builtin_bit_cast(bf16x8, w), o0, 0, 0, 0);
                    else o1 = __builtin_amdgcn_mfma_f32_32x32x16_bf16(s == 0 ? pa0 : pa1, __builtin_bit_cast(bf16x8, w), o1, 0, 0, 0);
                }
        }
        if (__all(run >= RUN_EXIT)) break;
    }
    const bf16_t* Z1 = (const bf16_t*)(P.ws + WS_Z1); bf16_t* O1 = (bf16_t*)(P.ws + WS_O1B);
#pragma unroll
    for (int r = 0; r < 16; ++r) {
        const int q = (r & 3) + 8 * (r >> 2) + 4 * hi;
        const size_t off = (size_t)(m0 + q) * D + 64 * h + r32;
        O1[off] = f2bf(o0[r] * silu(bf2f(Z1[off])));
        O1[off + 32] = f2bf(o1[r] * silu(bf2f(Z1[off + 32])));
    }
}

__device__ __forceinline__ void phase(const Ptrs& P, int gw, int ngw, int lane) {
#pragma unroll 1
    for (int i = gw; i < 16 * 512; i += ngw) unit_run<0>(P, 0, i & 15, i >> 4, lane);
#pragma unroll 1
    for (int i = gw; i < 16 * 32; i += ngw) unit_run<1>(P, i >> 4, i & 15, 0, lane);
}
}
namespace rw {
#define RLAS __attribute__((address_space(3)))
typedef short bf16x8 __attribute__((ext_vector_type(8)));
typedef float f32x16 __attribute__((ext_vector_type(16)));
typedef float f32x4 __attribute__((ext_vector_type(4)));
typedef unsigned u32x4 __attribute__((ext_vector_type(4)));
typedef unsigned u32x2 __attribute__((ext_vector_type(2)));

constexpr int NUNIT = 2048 + 256;
constexpr size_t U_MFRAG = 0;
constexpr size_t U_NRAW = 16384;
constexpr size_t U_HRAW = 32768;
constexpr size_t U_G = 49152;
constexpr size_t U_BON = 57344;
constexpr size_t U_BYTES = 65536;
static_assert(WS_RW + (size_t)NUNIT * U_BYTES <= WS_SST, "rw region");

constexpr int SB = 144, SF = 272;
constexpr int BSZ = 64 * SB, FSZ = 64 * SF;
constexpr int L_S0 = 0, L_S1 = BSZ, L_S2 = 2 * BSZ, L_S3 = 3 * BSZ, L_S4 = 4 * BSZ, L_S5 = 5 * BSZ, L_S6 = 6 * BSZ, L_S7 = 7 * BSZ, L_S8 = 8 * BSZ, L_S9 = 9 * BSZ;
constexpr int L_F0 = 10 * BSZ, L_F1 = L_F0 + FSZ, L_F2 = L_F1 + FSZ;
constexpr int L_PC = L_F2 + FSZ;
constexpr int L_TOT = L_PC + 256;
constexpr int RW_LDS_END = L_TOT + 2048;
static_assert(RW_LDS_END <= 147456, "rw lds");

__device__ __forceinline__ unsigned cvtpk(float lo, float hi) { unsigned r; asm volatile("v_cvt_pk_bf16_f32 %0, %1, %2" : "=v"(r) : "v"(lo), "v"(hi)); return r; }
__device__ __forceinline__ float bflo(unsigned w) { return __uint_as_float(w << 16); }
__device__ __forceinline__ float bfhi(unsigned w) { return __uint_as_float(w & 0xffff0000u); }

__device__ __forceinline__ f32x16 mm_tile(f32x16 acc, const RLAS unsigned char* A, int arow0, const RLAS unsigned char* B, int brow0, int r32, int hi) {
    const RLAS unsigned char* ap = A + (arow0 + r32) * SB + hi * 16;
    const RLAS unsigned char* bp = B + (brow0 + r32) * SB + hi * 16;
#pragma unroll
    for (int s = 0; s < 4; ++s) acc = __builtin_amdgcn_mfma_f32_32x32x16_bf16(*(const RLAS bf16x8*)(ap + 32 * s), *(const RLAS bf16x8*)(bp + 32 * s), acc, 0, 0, 0);
    return acc;
}
__device__ __forceinline__ f32x16 zero16() { f32x16 z;
#pragma unroll
    for (int r = 0; r < 16; ++r) z[r] = 0.f; return z; }

template <int J> struct SolveStep {
    static __device__ __forceinline__ void run(float (&R)[16], const RLAS unsigned char* ap  ) {
        constexpr int jq = J & 3, jg = J >> 2;
        const float xj = __builtin_bit_cast(float, __builtin_amdgcn_update_dpp(0, __builtin_bit_cast(int, R[jg]), jq | (jq << 2) | (jq << 4) | (jq << 6), 0xf, 0xf, false));
#pragma unroll
        for (int gq = jg >> 2; gq < 4; ++gq) {
            const f32x4 a = *(const RLAS f32x4*)(ap + J * SF + 16 * gq);
#pragma unroll
            for (int i = 0; i < 4; ++i) { if (4 * gq + i >= jg) R[4 * gq + i] -= a[i] * xj; }
        }
        SolveStep<J + 1>::run(R, ap);
    }
};
template <> struct SolveStep<63> { static __device__ __forceinline__ void run(float (&)[16], const RLAS unsigned char*) {} };

__device__ __forceinline__ void unit_a(const Ptrs& P, int unit, RLAS unsigned char* lds, int tid) {
    asm volatile("" : "+v"(tid));
    const int lane = tid & 63, wave = __builtin_amdgcn_readfirstlane(tid >> 6), r32 = lane & 31, hi = lane >> 5;
    const bool samp = unit >= 2048;
    const int h = unit & 7, cb = samp ? (unit - 2048) >> 3 : unit >> 3;
    const int m_base = samp ? TP + 32 * cb : 64 * cb;
    const int nvalid = samp ? 32 : 64;
    const bf16_t* PR = (const bf16_t*)(P.ws + WS_PROJ0);
    unsigned char* urec = P.ws + WS_RW + (size_t)unit * U_BYTES;
    const float* mu = P.in[19];
    const int ch = 64 * h + lane;
    float rr[8], kr[8], vr[8];
    {
        const float mu_r = mu[ch], mu_k = mu[512 + ch], mu_v = mu[1024 + ch], mu_w = mu[1536 + lane], mu_a = mu[1600 + lane];
        float pr_r, pr_k, pr_v, pr_w, pr_a;
        const int t0 = 8 * wave;
        {
            const int m = m_base + t0;
            if ((!samp && m == 0) || t0 >= nvalid) { pr_r = pr_k = pr_v = pr_w = pr_a = 0.f; }
            else if (samp && t0 == 0) { const float* sh = P.in[4] + (size_t)cb * RWS; pr_r = sh[ch]; pr_k = sh[512 + ch]; pr_v = sh[1024 + ch]; pr_w = sh[1536 + lane]; pr_a = sh[1600 + lane]; }
            else { const bf16_t* p = PR + (size_t)(m - 1) * N0P + C_PRW; pr_r = bf2f(p[ch]); pr_k = bf2f(p[512 + ch]); pr_v = bf2f(p[1024 + ch]); pr_w = bf2f(p[1536 + lane]); pr_a = bf2f(p[1600 + lane]); }
        }
#pragma unroll
        for (int i = 0; i < 8; ++i) {
            const int t = t0 + i;
            float c_r = 0.f, c_k = 0.f, c_v = 0.f, c_w = 0.f, c_a = 0.f;
            if (t < nvalid) { const bf16_t* p = PR + (size_t)(m_base + t) * N0P + C_PRW; c_r = bf2f(p[ch]); c_k = bf2f(p[512 + ch]); c_v = bf2f(p[1024 + ch]); c_w = bf2f(p[1536 + lane]); c_a = bf2f(p[1600 + lane]); }
            rr[i] = c_r + (pr_r - c_r) * mu_r; kr[i] = c_k + (pr_k - c_k) * mu_k; vr[i] = c_v + (pr_v - c_v) * mu_v;
            const float wl = c_w + (pr_w - c_w) * mu_w, al = c_a + (pr_a - c_a) * mu_a;
            *(RLAS bf16_t*)(lds + L_S0 + t * SB + lane * 2) = f2bf(tanhf(wl));
            *(RLAS bf16_t*)(lds + L_S1 + t * SB + lane * 2) = f2bf(al);
            pr_r = c_r; pr_k = c_k; pr_v = c_v; pr_w = c_w; pr_a = c_a;
        }
    }
    __syncthreads();
    {
        const int which = wave >> 2, tile = wave & 3, ti = tile >> 1, tj = tile & 1;
        const bf16_t* WT = (const bf16_t*)(P.ws + WS_LORA) + (size_t)which * 512 * 64 + (size_t)(64 * h + 32 * tj + r32) * 64 + 8 * hi;
        const RLAS unsigned char* ap = lds + (which ? L_S1 : L_S0) + (32 * ti + r32) * SB + hi * 16;
        f32x16 acc = zero16();
#pragma unroll
        for (int s = 0; s < 4; ++s) acc = __builtin_amdgcn_mfma_f32_32x32x16_bf16(*(const RLAS bf16x8*)(ap + 32 * s), *(const bf16x8*)(WT + 16 * s), acc, 0, 0, 0);
        RLAS unsigned char* o = lds + (which ? L_F1 : L_F0) + (32 * tj + r32) * 4;
#pragma unroll
        for (int r = 0; r < 16; ++r) *(RLAS float*)(o + (32 * ti + (r & 3) + 8 * (r >> 2) + 4 * hi) * SF) = acc[r];
    }
    __syncthreads();
    {
        const float w0 = P.in[20][ch], a0 = P.in[22][ch], k_k = P.in[24][ch], k_a = P.in[25][ch], r_k = P.in[26][ch];
        const int t0 = 8 * wave;
        float kk[8], kka[8], km[8], ld[8];
        float run = 0.f;
#pragma unroll
        for (int i = 0; i < 8; ++i) {
            const int t = t0 + i;
            const float wa = w0 + *(const RLAS float*)(lds + L_F0 + t * SF + lane * 4), aa = a0 + *(const RLAS float*)(lds + L_F1 + t * SF + lane * 4);
            const float nw = -wa;
            const float spl = nw > 20.f ? nw : log1pf(__expf(nw));
            const float w = -spl - 0.5f;
            float logd = -__expf(w);
            const float a = 1.f / (1.f + __expf(-aa));
            float kx = kr[i] * k_k;
            const float n2 = wave_sum(kx * kx);
            kx = kx / fmaxf(sqrtf(n2), 1e-12f);
            float kmod = kr[i] * (1.f + (a - 1.f) * k_a);
            if (t >= nvalid) { kx = 0.f; kmod = 0.f; logd = 0.f; rr[i] = 0.f; vr[i] = 0.f; }
            kk[i] = kx; kka[i] = kx * a; km[i] = kmod;
            const float scal = wave_sum(rr[i] * kmod * r_k);
            ((bf16_t*)(urec + U_BON))[t * 64 + lane] = f2bf(scal * vr[i]);
            run += logd; ld[i] = run;
        }
        *(RLAS float*)(lds + L_TOT + (wave * 64 + lane) * 4) = run;
        __syncthreads();
        float base = 0.f, lc = 0.f;
#pragma unroll
        for (int w = 0; w < 8; ++w) { const float tw = *(const RLAS float*)(lds + L_TOT + (w * 64 + lane) * 4); if (w < wave) base += tw; lc += tw; }
        if (wave == 0) *(RLAS float*)(lds + L_PC + lane * 4) = __expf(lc);
        float kbt[8], kdt[8], kkt[8];
#pragma unroll
        for (int i = 0; i < 8; ++i) {
            const int t = t0 + i;
            const float L = base + ld[i], Lm1 = L - (i == 0 ? ld[0] : ld[i] - ld[i - 1]);
            const float eL = __expf(L), eLm1 = __expf(Lm1), enL = __expf(-L), eCL = __expf(lc - L);
            kkt[i] = kk[i] * eLm1;
            *(RLAS bf16_t*)(lds + L_S2 + t * SB + lane * 2) = f2bf(kkt[i]);
            *(RLAS bf16_t*)(lds + L_S5 + t * SB + lane * 2) = f2bf(rr[i] * eL);
            *(RLAS bf16_t*)(lds + L_S3 + t * SB + lane * 2) = f2bf(kka[i] * enL);
            *(RLAS bf16_t*)(lds + L_S4 + t * SB + lane * 2) = f2bf(km[i] * enL);
            kbt[i] = kka[i] * eCL; kdt[i] = km[i] * eCL;
        }
        u32x4 w;
        w.x = cvtpk(kbt[0], kbt[1]); w.y = cvtpk(kbt[2], kbt[3]); w.z = cvtpk(kbt[4], kbt[5]); w.w = cvtpk(kbt[6], kbt[7]);
        *(RLAS u32x4*)(lds + L_S6 + lane * SB + t0 * 2) = w;
        w.x = cvtpk(kdt[0], kdt[1]); w.y = cvtpk(kdt[2], kdt[3]); w.z = cvtpk(kdt[4], kdt[5]); w.w = cvtpk(kdt[6], kdt[7]);
        *(RLAS u32x4*)(lds + L_S7 + lane * SB + t0 * 2) = w;
        w.x = cvtpk(vr[0], vr[1]); w.y = cvtpk(vr[2], vr[3]); w.z = cvtpk(vr[4], vr[5]); w.w = cvtpk(vr[6], vr[7]);
        *(RLAS u32x4*)(lds + L_S8 + lane * SB + t0 * 2) = w;
        *(RLAS f32x4*)(lds + L_F2 + lane * SF + t0 * 4) = (f32x4){kkt[0], kkt[1], kkt[2], kkt[3]};
        *(RLAS f32x4*)(lds + L_F2 + lane * SF + t0 * 4 + 16) = (f32x4){kkt[4], kkt[5], kkt[6], kkt[7]};
    }
    __syncthreads();
    {
        const int q = wave >> 1;
#pragma unroll
        for (int tl = 0; tl < 2; ++tl) {
            const int tile = 2 * (wave & 1) + tl, ti = tile >> 1, tj = tile & 1;
            f32x16 acc = zero16();
            if (q == 0) {
                if (!(ti == 0 && tj == 1)) acc = mm_tile(acc, lds + L_S2, 32 * ti, lds + L_S3, 32 * tj, r32, hi);
                const int j = 32 * tj + r32;
#pragma unroll
                for (int g = 0; g < 4; ++g) { const int tb = 32 * ti + 8 * g + 4 * hi;
#pragma unroll
                    for (int i = 0; i < 4; ++i) *(RLAS float*)(lds + L_F0 + j * SF + (i * 16 + (tb >> 2)) * 4) = (j < tb + i) ? acc[4 * g + i] : 0.f; }
            } else {
                const RLAS unsigned char* Am = lds + ((q == 2) ? L_S3 : L_S4);
                const RLAS unsigned char* Bm = lds + ((q == 1) ? L_S2 : L_S5);
                if (!(ti == 1 && tj == 0)) acc = mm_tile(acc, Am, 32 * ti, Bm, 32 * tj, r32, hi);
                const int t = 32 * tj + r32;
                RLAS unsigned char* O = lds + (q == 1 ? L_S0 : q == 2 ? L_S1 : L_S9);
#pragma unroll
                for (int g = 0; g < 4; ++g) { const int jb = 32 * ti + 8 * g + 4 * hi; float v[4];
#pragma unroll
                    for (int i = 0; i < 4; ++i) { const int j = jb + i; const bool keep = (q == 1) ? (j < t) : (j <= t); v[i] = keep ? acc[4 * g + i] : 0.f; }
                    u32x2 pk; pk.x = cvtpk(v[0], v[1]); pk.y = cvtpk(v[2], v[3]);
                    *(RLAS u32x2*)(O + t * SB + jb * 2) = pk; }
            }
        }
    }
    __syncthreads();
    if (wave < 4) {
        const int ti = wave >> 1, tj = wave & 1;
        f32x16 acc = mm_tile(zero16(), lds + L_S0, 32 * ti, lds + L_S8, 32 * tj, r32, hi);
        const int v = 32 * tj + r32;
#pragma unroll
        for (int g = 0; g < 4; ++g) { const int tb = 32 * ti + 8 * g + 4 * hi; *(RLAS f32x4*)(lds + L_F1 + v * SF + tb * 4) = (f32x4){acc[4 * g], acc[4 * g + 1], acc[4 * g + 2], acc[4 * g + 3]}; }
    }
    __syncthreads();
    {
        const int q = lane & 3, col = 16 * wave + (lane >> 2);
        const RLAS unsigned char* rhs = lds + (col < 64 ? L_F2 + col * SF : L_F1 + (col - 64) * SF);
        float R[16];
#pragma unroll
        for (int g = 0; g < 16; ++g) { const f32x4 v = *(const RLAS f32x4*)(rhs + 16 * g); R[g] = q == 0 ? v[0] : q == 1 ? v[1] : q == 2 ? v[2] : v[3]; }
        SolveStep<0>::run(R, lds + L_F0 + q * 64);
        RLAS unsigned char* O = lds + (col < 64 ? L_S2 + col * SB : L_S3 + (col - 64) * SB) + q * 2;
#pragma unroll
        for (int g = 0; g < 16; ++g) *(RLAS bf16_t*)(O + 8 * g) = f2bf(-R[g]);
    }
    __syncthreads();
    {
        const int which = wave >> 1;
#pragma unroll
        for (int tl = 0; tl < 2; ++tl) {
            const int tile = 2 * (wave & 1) + tl, ti = tile >> 1, tj = tile & 1;
            if (which == 0) {
                f32x16 acc = mm_tile(zero16(), lds + L_S2, 32 * ti, lds + L_S6, 32 * tj, r32, hi);
                if (ti == tj) { const float pc = *(const RLAS float*)(lds + L_PC + (32 * tj + r32) * 4);
#pragma unroll
                    for (int r = 0; r < 16; ++r) if (((r & 3) + 8 * (r >> 2) + 4 * hi) == r32) acc[r] += pc; }
#pragma unroll
                for (int sp = 0; sp < 2; ++sp) {
                    u32x4 wh, wl; float lo[8];
                    wh.x = cvtpk(acc[8 * sp], acc[8 * sp + 1]); wh.y = cvtpk(acc[8 * sp + 2], acc[8 * sp + 3]); wh.z = cvtpk(acc[8 * sp + 4], acc[8 * sp + 5]); wh.w = cvtpk(acc[8 * sp + 6], acc[8 * sp + 7]);
                    lo[0] = acc[8 * sp] - bflo(wh.x); lo[1] = acc[8 * sp + 1] - bfhi(wh.x); lo[2] = acc[8 * sp + 2] - bflo(wh.y); lo[3] = acc[8 * sp + 3] - bfhi(wh.y);
                    lo[4] = acc[8 * sp + 4] - bflo(wh.z); lo[5] = acc[8 * sp + 5] - bfhi(wh.z); lo[6] = acc[8 * sp + 6] - bflo(wh.w); lo[7] = acc[8 * sp + 7] - bfhi(wh.w);
                    wl.x = cvtpk(lo[0], lo[1]); wl.y = cvtpk(lo[2], lo[3]); wl.z = cvtpk(lo[4], lo[5]); wl.w = cvtpk(lo[6], lo[7]);
                    unsigned char* f = urec + U_MFRAG + (size_t)(((tj * 4 + (2 * ti + sp)) * 2) * 64 + lane) * 16;
                    *(u32x4*)f = wh; *(u32x4*)(f + 1024) = wl;
                }
            } else if (which == 1) {
                f32x16 acc = mm_tile(zero16(), lds + L_S7, 32 * ti, lds + L_S8, 32 * tj, r32, hi);
                acc = mm_tile(acc, lds + L_S6, 32 * ti, lds + L_S3, 32 * tj, r32, hi);
                float* o = (float*)(urec + U_NRAW) + (size_t)(ti * 2 + tj) * 1024 + lane;
#pragma unroll
                for (int r = 0; r < 16; ++r) o[r * 64] = acc[r];
            } else if (which == 2) {
                f32x16 acc = mm_tile(zero16(), lds + L_S2, 32 * ti, lds + L_S1, 32 * tj, r32, hi);
                const int t = 32 * tj + r32;
#pragma unroll
                for (int g = 0; g < 4; ++g) { const int kb = 32 * ti + 8 * g + 4 * hi;
                    const u32x2 rt = *(const RLAS u32x2*)(lds + L_S5 + t * SB + kb * 2);
                    u32x2 pk; pk.x = cvtpk(acc[4 * g] + bflo(rt.x), acc[4 * g + 1] + bfhi(rt.x)); pk.y = cvtpk(acc[4 * g + 2] + bflo(rt.y), acc[4 * g + 3] + bfhi(rt.y));
                    *(u32x2*)(urec + U_G + (size_t)(t * 64 + kb) * 2) = pk; }
            } else {
                f32x16 acc = mm_tile(zero16(), lds + L_S8, 32 * ti, lds + L_S9, 32 * tj, r32, hi);
                acc = mm_tile(acc, lds + L_S3, 32 * ti, lds + L_S1, 32 * tj, r32, hi);
                float* o = (float*)(urec + U_HRAW) + (size_t)(ti * 2 + tj) * 1024 + lane;
#pragma unroll
                for (int r = 0; r < 16; ++r) o[r * 64] = acc[r];
            }
        }
    }
    __syncthreads();
}

__device__ __forceinline__ void split8(const f32x16& x, int sp, bf16x8& bh, bf16x8& bl) {
    u32x4 wh, wl; float lo[8];
    wh.x = cvtpk(x[8 * sp], x[8 * sp + 1]); wh.y = cvtpk(x[8 * sp + 2], x[8 * sp + 3]); wh.z = cvtpk(x[8 * sp + 4], x[8 * sp + 5]); wh.w = cvtpk(x[8 * sp + 6], x[8 * sp + 7]);
    lo[0] = x[8 * sp] - bflo(wh.x); lo[1] = x[8 * sp + 1] - bfhi(wh.x); lo[2] = x[8 * sp + 2] - bflo(wh.y); lo[3] = x[8 * sp + 3] - bfhi(wh.y);
    lo[4] = x[8 * sp + 4] - bflo(wh.z); lo[5] = x[8 * sp + 5] - bfhi(wh.z); lo[6] = x[8 * sp + 6] - bflo(wh.w); lo[7] = x[8 * sp + 7] - bfhi(wh.w);
    wl.x = cvtpk(lo[0], lo[1]); wl.y = cvtpk(lo[2], lo[3]); wl.z = cvtpk(lo[4], lo[5]); wl.w = cvtpk(lo[6], lo[7]);
    bh = __builtin_bit_cast(bf16x8, wh); bl = __builtin_bit_cast(bf16x8, wl);
}
__device__ __forceinline__ void store_state(float* dst  , const f32x16& s0, const f32x16& s1, int v, int hi) {
#pragma unroll
    for (int g = 0; g < 4; ++g) {
        *(f32x4*)(dst + v * 64 + 8 * g + 4 * hi) = (f32x4){s0[4 * g], s0[4 * g + 1], s0[4 * g + 2], s0[4 * g + 3]};
        *(f32x4*)(dst + v * 64 + 32 + 8 * g + 4 * hi) = (f32x4){s1[4 * g], s1[4 * g + 1], s1[4 * g + 2], s1[4 * g + 3]};
    }
}
__device__ __forceinline__ void scan_step(const unsigned char* urec, int tv, int lane, f32x16& s0, f32x16& s1) {
    bf16x8 bh[4], bl[4];
    split8(s0, 0, bh[0], bl[0]); split8(s0, 1, bh[1], bl[1]); split8(s1, 0, bh[2], bl[2]); split8(s1, 1, bh[3], bl[3]);
    f32x16 n0, n1;
    { const float* nr = (const float*)(urec + U_NRAW) + lane;
#pragma unroll
      for (int r = 0; r < 16; ++r) { n0[r] = nr[(size_t)(0 * 2 + tv) * 1024 + r * 64]; n1[r] = nr[(size_t)(1 * 2 + tv) * 1024 + r * 64]; } }
#pragma unroll
    for (int s = 0; s < 4; ++s) {
        const unsigned char* f0 = urec + U_MFRAG + (size_t)(((0 * 4 + s) * 2) * 64 + lane) * 16;
        const unsigned char* f1 = urec + U_MFRAG + (size_t)(((1 * 4 + s) * 2) * 64 + lane) * 16;
        const bf16x8 a0h = *(const bf16x8*)f0, a0l = *(const bf16x8*)(f0 + 1024), a1h = *(const bf16x8*)f1, a1l = *(const bf16x8*)(f1 + 1024);
        n0 = __builtin_amdgcn_mfma_f32_32x32x16_bf16(a0h, bh[s], n0, 0, 0, 0);
        n0 = __builtin_amdgcn_mfma_f32_32x32x16_bf16(a0h, bl[s], n0, 0, 0, 0);
        n0 = __builtin_amdgcn_mfma_f32_32x32x16_bf16(a0l, bh[s], n0, 0, 0, 0);
        n1 = __builtin_amdgcn_mfma_f32_32x32x16_bf16(a1h, bh[s], n1, 0, 0, 0);
        n1 = __builtin_amdgcn_mfma_f32_32x32x16_bf16(a1h, bl[s], n1, 0, 0, 0);
        n1 = __builtin_amdgcn_mfma_f32_32x32x16_bf16(a1l, bh[s], n1, 0, 0, 0);
    }
    s0 = n0; s1 = n1;
}
__device__ __forceinline__ void scan_chain(const Ptrs& P, int seq, int h, int tv, int lane) {
    const int r32 = lane & 31, hi = lane >> 5, v = 32 * tv + r32;
    f32x16 s0 = zero16(), s1 = zero16();
    if (seq == 0) {
        float* sst = (float*)(P.ws + WS_SST);
#pragma unroll 1
        for (int c = 0; c < 256; ++c) {
            store_state(sst + ((size_t)c * 8 + h) * 4096, s0, s1, v, hi);
            scan_step(P.ws + WS_RW + (size_t)(c * 8 + h) * U_BYTES, tv, lane, s0, s1);
        }
        store_state(P.out + O_L0WKV_P + (size_t)h * 4096, s0, s1, v, hi);
    } else {
        const int b = seq - 1;
        const float* src = P.in[5] + ((size_t)b * 8 + h) * 4096;
#pragma unroll
        for (int g = 0; g < 4; ++g) {
            const f32x4 x0 = *(const f32x4*)(src + v * 64 + 8 * g + 4 * hi), x1 = *(const f32x4*)(src + v * 64 + 32 + 8 * g + 4 * hi);
#pragma unroll
            for (int i = 0; i < 4; ++i) { s0[4 * g + i] = x0[i]; s1[4 * g + i] = x1[i]; }
        }
        scan_step(P.ws + WS_RW + (size_t)(2048 + b * 8 + h) * U_BYTES, tv, lane, s0, s1);
        store_state(P.out + O_L0WKV_S + ((size_t)b * 8 + h) * 4096, s0, s1, v, hi);
    }
}

__device__ __forceinline__ void unit_c(const Ptrs& P, int unit, int lane) {
    const int r32 = lane & 31, hi = lane >> 5;
    const bool samp = unit >= 2048;
    const int h = unit & 7, cb = samp ? (unit - 2048) >> 3 : unit >> 3;
    const int m_base = samp ? TP + 32 * cb : 64 * cb;
    const unsigned char* urec = P.ws + WS_RW + (size_t)unit * U_BYTES;
    const float* S0 = samp ? P.in[5] + ((size_t)cb * 8 + h) * 4096 : (const float*)(P.ws + WS_SST) + ((size_t)cb * 8 + h) * 4096;
    bf16x8 af[2][4];
#pragma unroll
    for (int tvb = 0; tvb < 2; ++tvb)
#pragma unroll
        for (int s = 0; s < 4; ++s) { const float* p = S0 + (32 * tvb + r32) * 64 + 16 * s + 8 * hi; const f32x4 x0 = *(const f32x4*)p, x1 = *(const f32x4*)(p + 4);
            u32x4 w; w.x = cvtpk(x0[0], x0[1]); w.y = cvtpk(x0[2], x0[3]); w.z = cvtpk(x1[0], x1[1]); w.w = cvtpk(x1[2], x1[3]); af[tvb][s] = __builtin_bit_cast(bf16x8, w); }
    const float* lng = P.in[27] + 64 * h; const float* lnb = P.in[28] + 64 * h;
#pragma unroll 1
    for (int tt = 0; tt < (samp ? 1 : 2); ++tt) {
        const int t = 32 * tt + r32;
        f32x16 acc[2];
#pragma unroll
        for (int tvb = 0; tvb < 2; ++tvb) { const float* hr = (const float*)(urec + U_HRAW) + (size_t)(tvb * 2 + tt) * 1024 + lane;
#pragma unroll
            for (int r = 0; r < 16; ++r) acc[tvb][r] = hr[r * 64]; }
        const bf16_t* gp = (const bf16_t*)(urec + U_G) + t * 64 + 8 * hi;
#pragma unroll
        for (int s = 0; s < 4; ++s) { const bf16x8 bfr = *(const bf16x8*)(gp + 16 * s);
            acc[0] = __builtin_amdgcn_mfma_f32_32x32x16_bf16(af[0][s], bfr, acc[0], 0, 0, 0);
            acc[1] = __builtin_amdgcn_mfma_f32_32x32x16_bf16(af[1][s], bfr, acc[1], 0, 0, 0); }
        float sm = 0.f;
#pragma unroll
        for (int r = 0; r < 16; ++r) sm += acc[0][r] + acc[1][r];
        sm += __shfl_xor(sm, 32);
        const float mean = sm * (1.f / 64);
        float sq = 0.f;
#pragma unroll
        for (int r = 0; r < 16; ++r) { const float d0 = acc[0][r] - mean, d1 = acc[1][r] - mean; sq += d0 * d0 + d1 * d1; }
        sq += __shfl_xor(sq, 32);
        const float rstd = rsqrtf(sq * (1.f / 64) + GN_EPS);
        const int m = m_base + t;
        const bf16_t* bon = (const bf16_t*)(urec + U_BON) + t * 64;
        const bf16_t* zb = (const bf16_t*)(P.ws + WS_PROJ0) + (size_t)m * N0P + C_ZB + 64 * h;
        bf16_t* cat = (bf16_t*)(P.ws + WS_CAT) + (size_t)m * D + 512 + 64 * h;
#pragma unroll
        for (int tvb = 0; tvb < 2; ++tvb)
#pragma unroll
            for (int g = 0; g < 4; ++g) {
                const int vb = 32 * tvb + 8 * g + 4 * hi;
                const u32x2 bo = *(const u32x2*)(bon + vb), zz = *(const u32x2*)(zb + vb);
                const f32x4 gg = *(const f32x4*)(lng + vb), bb = *(const f32x4*)(lnb + vb);
                float y[4];
                y[0] = ((acc[tvb][4 * g] - mean) * rstd * gg[0] + bb[0] + bflo(bo.x)) * silu(bflo(zz.x));
                y[1] = ((acc[tvb][4 * g + 1] - mean) * rstd * gg[1] + bb[1] + bfhi(bo.x)) * silu(bfhi(zz.x));
                y[2] = ((acc[tvb][4 * g + 2] - mean) * rstd * gg[2] + bb[2] + bflo(bo.y)) * silu(bflo(zz.y));
                y[3] = ((acc[tvb][4 * g + 3] - mean) * rstd * gg[3] + bb[3] + bfhi(bo.y)) * silu(bfhi(zz.y));
                u32x2 pk; pk.x = cvtpk(y[0], y[1]); pk.y = cvtpk(y[2], y[3]);
                *(u32x2*)(cat + vb) = pk;
            }
    }
}
#undef RLAS
}
#define LAS __attribute__((address_space(3)))
#define XB_TMO      128
#define XB_XCNT(j)  (256  + 64 * (j))
#define XB_XSUB(j)  (1280 + 64 * (j))
#define XB_XGEN(j)  (2304 + 64 * (j))
#define XB_TOP      3328
#define XB_TOPGEN   3392
#define XCD_BAR_WORDS 3456
#define XB_SPIN_CAP (1u << 18)

__device__ __forceinline__ unsigned xb_ld(unsigned* p)              { return __hip_atomic_load(p, __ATOMIC_RELAXED, __HIP_MEMORY_SCOPE_AGENT); }
__device__ __forceinline__ unsigned xb_add(unsigned* p, unsigned v) { return __hip_atomic_fetch_add(p, v, __ATOMIC_RELAXED, __HIP_MEMORY_SCOPE_AGENT); }
__device__ __forceinline__ unsigned xb_xcc_id() { return (unsigned)__builtin_amdgcn_s_getreg((3 << 11) | 20) & 0xFu; }
#define XB_SPIN(cond, bar) do { unsigned _sp = 0; while (cond) { __builtin_amdgcn_s_sleep(1); \
    if ((++_sp & 255u) == 0u) { if (xb_ld(&(bar)[XB_TMO])) break; if (_sp > XB_SPIN_CAP) { atomicAdd(&(bar)[XB_TMO], 1u); break; } } } } while (0)

struct XcdBarrier {
    unsigned* bar; unsigned x;
    volatile LAS unsigned* st;
};

__device__ __forceinline__ XcdBarrier xcd_barrier_post(unsigned* bar, volatile LAS unsigned* st) {
    XcdBarrier b; b.bar = bar; b.x = xb_xcc_id(); b.st = st;
    if (threadIdx.x == 0) (void)xb_add(&bar[XB_XCNT(b.x)], 1u);
    return b;
}
__device__ __forceinline__ void xcd_barrier_complete(unsigned* bar, unsigned x, unsigned& nloc, unsigned& nx) {
    const unsigned G = gridDim.x * gridDim.y * gridDim.z;
    unsigned sum, cnt, mine, sp = 0u;
    for (;;) {
        sum = 0u; cnt = 0u; mine = 0u;
#pragma unroll
        for (unsigned j = 0; j < 16; ++j) { const unsigned c = xb_ld(&bar[XB_XCNT(j)]); sum += c; cnt += (c > 0u) ? 1u : 0u; mine = (j == x) ? c : mine; }
        if (sum == G) break;
        __builtin_amdgcn_s_sleep(1);
        if ((++sp & 255u) == 0u) { if (xb_ld(&bar[XB_TMO])) break; if (sp > XB_SPIN_CAP) { atomicAdd(&bar[XB_TMO], 1u); break; } }
    }
    nloc = mine > 0u ? mine : 1u; nx = cnt > 0u ? cnt : 1u;
}

__device__ __forceinline__ void xcd_barrier(const XcdBarrier& b) {
    asm volatile("s_waitcnt vmcnt(0)" ::: "memory");
    __syncthreads();
    if (threadIdx.x == 0) {
        unsigned* bar = b.bar;
        __builtin_amdgcn_s_waitcnt(0);
        unsigned nloc = b.st[0], nx = b.st[1];
        if (nloc == 0u) { xcd_barrier_complete(bar, b.x, nloc, nx); b.st[0] = nloc; b.st[1] = nx; }
        const unsigned old = xb_add(&bar[XB_XSUB(b.x)], 1u);
        const unsigned gen = old / nloc;
        if (old + 1u == (gen + 1u) * nloc) {
            __builtin_amdgcn_fence(__ATOMIC_RELEASE, "agent");
            asm volatile("s_waitcnt vmcnt(0)" ::: "memory");
            const unsigned og = xb_add(&bar[XB_TOP], 1u);
            const unsigned tg = og / nx;
            if (og + 1u == (tg + 1u) * nx) xb_add(&bar[XB_TOPGEN], 1u);
            else XB_SPIN(xb_ld(&bar[XB_TOPGEN]) == tg, bar);
            __builtin_amdgcn_fence(__ATOMIC_ACQUIRE, "agent");
            xb_add(&bar[XB_XGEN(b.x)], 1u);
            asm volatile("s_waitcnt vmcnt(0)" ::: "memory");
        } else {
            XB_SPIN(xb_ld(&bar[XB_XGEN(b.x)]) == gen, bar);
            __builtin_amdgcn_fence(__ATOMIC_ACQUIRE, "agent");
            asm volatile("s_waitcnt vmcnt(0)" ::: "memory");
        }
    }
    __syncthreads();
}


#ifndef FAST_ATTN0
#define FAST_ATTN0 1
#endif
#ifndef FAST_RW
#define FAST_RW 1
#endif
#ifndef FAST_ATTN1
#define FAST_ATTN1 1
#endif
#include <hip/hip_cooperative_groups.h>
namespace cg = cooperative_groups;
constexpr int NWAVES = 8, NTHREADS = 512;
constexpr int LDS_BYTES = 147456;
enum Phase { PH_PRO = 0, PH_GEMM1 = 1, PH_TOK = 2, PH_MIX = 3, PH_RWC = 4, PH_GEMM2 = 5, PH_GEMM3 = 6, PH_ATTN1 = 7, PH_GEMM4 = 8, PH_END = 9 };
struct Args { Ptrs p; int ph_lo, ph_hi; int pad0, pad1; };

__global__ void __launch_bounds__(NTHREADS, 2) mk_fwd(Args a) {
    extern __shared__ __attribute__((aligned(16))) unsigned char lds[];
    const Ptrs& P = a.p;
    unsigned char* ws = P.ws;
    const int lo = a.ph_lo, hi = a.ph_hi;
    const int tid = threadIdx.x, lane = tid & 63, wave = tid >> 6;
    const int G = gridDim.x, gw = blockIdx.x * NWAVES + wave, NGW = G * NWAVES;
    float* wscr = (float*)lds + wave * 256;
    volatile LAS unsigned* bst = (volatile LAS unsigned*)((LAS unsigned char*)lds + LDS_BYTES - 64);
    if (tid < 2) bst[tid] = 0u;
    __syncthreads();
    XcdBarrier bar = xcd_barrier_post((unsigned*)(ws + WS_CTL) + 4096, bst);
#define IN(k) (lo <= (k) && (k) < hi)
#define SEAM(k) do { if (IN(k) && IN((k) + 1)) xcd_barrier(bar); } while (0)
    if (IN(PH_PRO)) {
        const size_t gt = (size_t)blockIdx.x * NTHREADS + tid, NT = (size_t)G * NTHREADS;
        for (size_t i = gt; i < (size_t)N0P * D; i += NT) nv::d_transpose_w(P.in[10], D, N0, N0P, (bf16_t*)(ws + WS_WT0), nullptr, i);
        for (size_t i = gt; i < (size_t)D * D; i += NT) nv::d_transpose_w(P.in[11], D, D, D, (bf16_t*)(ws + WS_WO0T), nullptr, i);
        for (size_t i = gt; i < (size_t)N1 * D; i += NT) nv::d_transpose_w(P.in[30], D, N1, N1, (bf16_t*)(ws + WS_WT1), P.in[29], i);
        for (size_t i = gt; i < (size_t)D * D; i += NT) nv::d_transpose_w(P.in[31], D, D, D, (bf16_t*)(ws + WS_WO1T), nullptr, i);
        if (blockIdx.x == 0 && tid < 256) nv::d_tables(P, tid);
        for (size_t i = gt; i < 512 * 64; i += NT) { const int c = (int)(i >> 6), l = (int)(i & 63); bf16_t* LT = (bf16_t*)(ws + WS_LORA);
            LT[i] = f2bf(P.in[21][l * 512 + c]); LT[32768 + i] = f2bf(P.in[23][l * 512 + c]); }
        for (int m = gw; m < M; m += NGW) nv::d_rmsnorm_x(P, m, lane);
    }
    SEAM(PH_PRO);
    if (IN(PH_GEMM1)) {
        pg8::Gemm g{(const bf16_t*)(ws + WS_XN0), (const bf16_t*)(ws + WS_WT0), M, N0P, D}; pg8::StaticOrder S; S.init(M, N0P, G, (int)blockIdx.x);
        pg8::EpiProj0F E{(bf16_t*)(ws + WS_PROJ0)};
        pg8::gemm_phase<pg8::EpiProj0F, pg8::StaticOrder, true, true>((LAS unsigned char*)lds, g, S, E);
    }
    SEAM(PH_GEMM1);
    if (IN(PH_TOK)) {
        for (int m = gw; m < M; m += NGW) nv::d_tok0(P, m, lane);
        __syncthreads();
#if FAST_RW
        for (int u = blockIdx.x; u < rw::NUNIT; u += G) rw::unit_a(P, u, (LAS unsigned char*)lds, tid);
#else
        for (int m = blockIdx.x; m < M; m += G) { nv::d_rw_prep(P, m, tid, (float*)lds, (float*)lds + 64); __syncthreads(); }
#endif
    }
    SEAM(PH_TOK);
    if (IN(PH_MIX)) {
#if FAST_RW
        if (blockIdx.x < 16) {
            if (wave == 0) rw::scan_chain(P, 0, (int)blockIdx.x >> 1, (int)blockIdx.x & 1, lane);
            else for (int i = (int)blockIdx.x * 7 + (wave - 1); i < 512; i += 16 * 7) rw::scan_chain(P, 1 + (i >> 4), (i >> 1) & 7, i & 1, lane);
        }
#else
        if (gw < 33 * 8) nv::d_rw_scan(P, gw >> 3, gw & 7, lane);
#endif
#if FAST_ATTN0
        { const int vcu = (G % 8 == 0) ? ((int)blockIdx.x % 8) * (G / 8) + (int)blockIdx.x / 8 : (int)blockIdx.x;
          __syncthreads();
          da::phase(P, (LAS unsigned char*)lds, vcu, G, tid); }
#else
        for (int i = gw; i < M * 4; i += NGW) nv::d_attn0(P, i >> 2, i & 3, lane, wscr, wscr + 128);
#endif
    }
    SEAM(PH_MIX);
#if FAST_RW
    if (IN(PH_RWC)) { for (int u = gw; u < rw::NUNIT; u += NGW) rw::unit_c(P, u, lane); }
#endif
    SEAM(PH_RWC);
    if (IN(PH_GEMM2)) {
        pg8::Gemm g{(const bf16_t*)(ws + WS_CAT), (const bf16_t*)(ws + WS_WO0T), M, D, D}; pg8::StaticOrder S; S.init(M, D, G, (int)blockIdx.x);
        pg8::EpiY0F E{P};
        pg8::gemm_phase<pg8::EpiY0F, pg8::StaticOrder, true, true>((LAS unsigned char*)lds, g, S, E);
    }
    SEAM(PH_GEMM2);
    if (IN(PH_GEMM3)) {
        pg8::Gemm g{(const bf16_t*)(ws + WS_Y0B), (const bf16_t*)(ws + WS_WT1), M, N1, D}; pg8::StaticOrder S; S.init(M, N1, G, (int)blockIdx.x);
        pg8::EpiL1F E{P};
        pg8::gemm_phase<pg8::EpiL1F, pg8::StaticOrder, true, true>((LAS unsigned char*)lds, g, S, E);
    }
    SEAM(PH_GEMM3);
    if (IN(PH_ATTN1)) {
#if FAST_ATTN1
        sb::phase(P, gw, NGW, lane);
#else
        for (int i = gw; i < M * 16; i += NGW) nv::d_attn1(P, i >> 4, i & 15, lane, wscr, wscr + 64);
#endif
    }
    SEAM(PH_ATTN1);
    if (IN(PH_GEMM4)) {
        pg8::Gemm g{(const bf16_t*)(ws + WS_O1B), (const bf16_t*)(ws + WS_WO1T), M, D, D}; pg8::StaticOrder S; S.init(M, D, G, (int)blockIdx.x);
        pg8::EpiOutF E{P};
        pg8::gemm_phase<pg8::EpiOutF, pg8::StaticOrder, true, true>((LAS unsigned char*)lds, g, S, E);
    }
#undef IN
#undef SEAM
}
extern "C" void kernel_launch(void* const* d_in, const int* in_sizes, int n_in, void* d_out, int out_size, void* d_ws, size_t ws_size, hipStream_t stream) {
    static int grid = 0;
    if (n_in != 32 || (size_t)out_size != O_TOTAL || ws_size < WS_END) { fprintf(stderr, "kernel_launch: unexpected shapes n_in=%d out=%d ws=%zu\n", n_in, out_size, ws_size); return; }
    if (grid == 0) {
        int dev = 0, cus = 0, per_cu = 0;
        (void)hipGetDevice(&dev); (void)hipDeviceGetAttribute(&cus, hipDeviceAttributeMultiprocessorCount, dev);
        (void)hipFuncSetAttribute((const void*)mk_fwd, hipFuncAttributeMaxDynamicSharedMemorySize, LDS_BYTES);
        (void)hipOccupancyMaxActiveBlocksPerMultiprocessor(&per_cu, (const void*)mk_fwd, NTHREADS, LDS_BYTES);
        if (per_cu < 1) { fprintf(stderr, "kernel_launch: occupancy query says %d blocks/CU\n", per_cu); per_cu = 1; }
        grid = (cus > 0 ? cus : 256);
    }
    Args a{};
    for (int i = 0; i < 32; ++i) a.p.in[i] = (const float*)d_in[i];
    a.p.out = (float*)d_out; a.p.ws = (unsigned char*)d_ws; a.ph_lo = 0; a.ph_hi = PH_END;
    (void)hipMemsetAsync((char*)d_ws + WS_CTL, 0, 256 * 1024, stream);
    void* args[] = {&a};
    hipError_t e = hipLaunchCooperativeKernel((const void*)mk_fwd, dim3(grid), dim3(NTHREADS), args, LDS_BYTES, stream);
    if (e != hipSuccess) fprintf(stderr, "cooperative launch failed: %s (grid %d)\n", hipGetErrorString(e), grid);
}
```

```cpp
#include <hip/hip_runtime.h>
#include <stdint.h>
#include <cstdio>

typedef unsigned short bf16_t;
__device__ __forceinline__ float bf2f(bf16_t b) { return __uint_as_float(((unsigned)b) << 16); }
__device__ __forceinline__ bf16_t f2bf(float f) { unsigned u = __float_as_uint(f); return (bf16_t)((u + 0x7fffu + ((u >> 16) & 1u)) >> 16); }

constexpr int D = 1024, TP = 16384, NSEQ = 32, TS = 32, MS = NSEQ * TS, M = TP + MS, PAST = 1024;
constexpr int N0 = 4224, N0P = 4352, N1 = 4096;
constexpr int C_Q = 0, C_K = 512, C_V = 1024, C_ZA = 1536, C_PRW = 2048, C_ZB = 3712;
constexpr int RWS = 1664;
constexpr float EPS = 1e-6f, GN_EPS = 64e-5f;
constexpr float LOG2E = 1.4426950408889634f;
constexpr float LAMBDA_INIT = 0.2f;
constexpr float QSCALE = 0.125f * LOG2E;

constexpr size_t O_Y = 0;
constexpr size_t O_L0K_P = (size_t)M * D;
constexpr size_t O_L0V_P = O_L0K_P + (size_t)TP * 512;
constexpr size_t O_L0SH_P = O_L0V_P + (size_t)TP * 512;
constexpr size_t O_L0WKV_P = O_L0SH_P + RWS;
constexpr size_t O_L1K_P = O_L0WKV_P + 8 * 64 * 64;
constexpr size_t O_L1V_P = O_L1K_P + (size_t)TP * 1024;
constexpr size_t O_L0K_S = O_L1V_P + (size_t)TP * 1024;
constexpr size_t O_L0V_S = O_L0K_S + (size_t)MS * 512;
constexpr size_t O_L0SH_S = O_L0V_S + (size_t)MS * 512;
constexpr size_t O_L0WKV_S = O_L0SH_S + (size_t)NSEQ * RWS;
constexpr size_t O_L1K_S = O_L0WKV_S + (size_t)NSEQ * 8 * 64 * 64;
constexpr size_t O_L1V_S = O_L1K_S + (size_t)MS * 1024;
constexpr size_t O_TOTAL = O_L1V_S + (size_t)MS * 1024;
static_assert(O_TOTAL == 72439424, "output size");

__host__ __device__ __forceinline__ size_t off_l0k(int m) { return m < TP ? O_L0K_P + (size_t)m * 512 : O_L0K_S + (size_t)(m - TP) * 512; }
__host__ __device__ __forceinline__ size_t off_l0v(int m) { return m < TP ? O_L0V_P + (size_t)m * 512 : O_L0V_S + (size_t)(m - TP) * 512; }
__host__ __device__ __forceinline__ size_t off_l1k(int m) { return m < TP ? O_L1K_P + (size_t)m * 1024 : O_L1K_S + (size_t)(m - TP) * 1024; }
__host__ __device__ __forceinline__ size_t off_l1v(int m) { return m < TP ? O_L1V_P + (size_t)m * 1024 : O_L1V_S + (size_t)(m - TP) * 1024; }

constexpr size_t MiB = 1u << 20;
constexpr size_t WS_CTL = 0;
constexpr size_t WS_TAB = 512 * 1024;
constexpr size_t WS_WT0 = 1 * MiB, WS_WO0T = 10 * MiB, WS_WT1 = 12 * MiB, WS_WO1T = 20 * MiB, WS_LORA = 22 * MiB;
constexpr size_t WS_CAT = 24 * MiB, WS_XN0 = WS_CAT;
constexpr size_t WS_PROJ0 = 58 * MiB;
constexpr size_t WS_Q0 = 203 * MiB, WS_K0 = 220 * MiB;
constexpr size_t WS_RW = 237 * MiB;
constexpr size_t WS_SST = 407 * MiB;
constexpr size_t WS_END = 441 * MiB;
constexpr size_t WS_Y0 = WS_PROJ0, WS_Y0B = 126 * MiB, WS_SSQ = 160 * MiB;
constexpr size_t WS_O1B = WS_Q0;
constexpr size_t WS_Q1 = 237 * MiB, WS_K1 = 271 * MiB, WS_V1T = 305 * MiB, WS_Z1 = 339 * MiB;
static_assert(WS_PROJ0 + (size_t)M * N0P * 2 <= WS_Q0, "proj0");
static_assert(WS_WT0 + (size_t)N0P * D * 2 <= WS_WO0T, "wt0");

struct Tab {
    float lam;
    float m0;
    float pad[2];
    float bias[4][256];
    float biasfar[4];
};

struct Ptrs {
    const float* in[32];
    float* out;
    unsigned char* ws;
};

__device__ __forceinline__ const float* xrow(const Ptrs& P, int m) { return m < TP ? P.in[0] + (size_t)m * D : P.in[1] + (size_t)(m - TP) * D; }

__device__ __forceinline__ float wave_sum(float v) {
#pragma unroll
    for (int o = 1; o < 64; o <<= 1) v += __shfl_xor(v, o);
    return v;
}
__device__ __forceinline__ float wave_max(float v) {
#pragma unroll
    for (int o = 1; o < 64; o <<= 1) v = fmaxf(v, __shfl_xor(v, o));
    return v;
}
__device__ __forceinline__ float silu(float x) { return x / (1.f + __expf(-x)); }

__device__ __forceinline__ int t5_bucket(int rel) {
    int n = rel < 0 ? -rel : rel;
    int b;
    if (n < 8) b = n;
    else { unsigned n2 = (unsigned)n * (unsigned)n; int lg = 31 - __clz((int)n2); b = 8 + (lg - 6); if (b > 15) b = 15; }
    return (rel > 0 ? 16 : 0) + b;
}
namespace nv {

__device__ __forceinline__ void d_transpose_w(const float* W, int K, int N, int NP, bf16_t* WT, const float* g, size_t i) {
    int n = (int)(i / K), k = (int)(i % K);
    float v = 0.f;
    if (n < N) { v = W[(size_t)k * N + n]; if (g) v *= g[k]; }
    WT[i] = f2bf(v);
}
__global__ void k_transpose_w(const float* W, int K, int N, int NP, bf16_t* WT, const float* g) {
    size_t i = (size_t)blockIdx.x * blockDim.x + threadIdx.x; if (i < (size_t)NP * K) d_transpose_w(W, K, N, NP, WT, g, i); }
__global__ void k_lora_t(const float* w_up, const float* a_up, float* LT) {
    int i = blockIdx.x * blockDim.x + threadIdx.x;
    if (i >= 512 * 64) return;
    int c = i / 64, l = i % 64;
    LT[i] = w_up[l * 512 + c];
    LT[512 * 64 + i] = a_up[l * 512 + c];
}
__device__ __forceinline__ void d_tables(const Ptrs& P, int tid) {
    Tab* T = (Tab*)(P.ws + WS_TAB);
    if (tid < 64) {
        float a = P.in[14][tid] * P.in[15][tid], b = P.in[16][tid] * P.in[17][tid];
        a = wave_sum(a); b = wave_sum(b);
        float gq = fabsf(P.in[12][tid]), gk = fabsf(P.in[13][tid]);
        gq = wave_max(gq); gk = wave_max(gk);
        if (tid == 0) { T->lam = __expf(a) - __expf(b) + LAMBDA_INIT; T->m0 = 8.f * gq * gk * LOG2E * 1.0001f + 0.01f; }
    }
    if (tid < 255) { int rel = tid - 191; int b = t5_bucket(rel); for (int h = 0; h < 4; ++h) T->bias[h][tid] = P.in[8][b * 4 + h]; }
    if (tid == 255) for (int h = 0; h < 4; ++h) { T->bias[h][255] = 0.f; T->biasfar[h] = P.in[8][15 * 4 + h]; }
}
__global__ void k_tables(Ptrs P) { d_tables(P, threadIdx.x); }
__device__ __forceinline__ void d_rmsnorm_x(const Ptrs& P, int w, int lane) {
    const float* x = xrow(P, w); const float* g = P.in[9];
    bf16_t* o = (bf16_t*)(P.ws + WS_XN0) + (size_t)w * D;
    float v[16], s = 0.f;
#pragma unroll
    for (int j = 0; j < 16; ++j) { v[j] = x[lane + 64 * j]; s += v[j] * v[j]; }
    s = wave_sum(s);
    float r = rsqrtf(s * (1.f / D) + EPS);
#pragma unroll
    for (int j = 0; j < 16; ++j) o[lane + 64 * j] = f2bf(v[j] * r * g[lane + 64 * j]);
}
__global__ void k_rmsnorm_x(Ptrs P) { int w = (blockIdx.x * blockDim.x + threadIdx.x) >> 6; if (w < M) d_rmsnorm_x(P, w, threadIdx.x & 63); }

template <class Epi>
__global__ void __launch_bounds__(256) k_gemm(const bf16_t* A, const bf16_t* Bt, int K, Epi epi) {
    __shared__ float As[16][65], Bs[16][65];
    const int tx = threadIdx.x & 15, ty = threadIdx.x >> 4;
    const int m0 = blockIdx.y * 64, n0 = blockIdx.x * 64;
    float acc[4][4];
#pragma unroll
    for (int i = 0; i < 4; ++i)
#pragma unroll
        for (int j = 0; j < 4; ++j) acc[i][j] = 0.f;
    for (int k0 = 0; k0 < K; k0 += 16) {
#pragma unroll
        for (int i = 0; i < 4; ++i) {
            int e = threadIdx.x + 256 * i, r = e >> 4, c = e & 15;
            As[c][r] = bf2f(A[(size_t)(m0 + r) * K + k0 + c]);
            Bs[c][r] = bf2f(Bt[(size_t)(n0 + r) * K + k0 + c]);
        }
        __syncthreads();
#pragma unroll
        for (int kk = 0; kk < 16; ++kk) {
            float a[4], b[4];
#pragma unroll
            for (int i = 0; i < 4; ++i) { a[i] = As[kk][ty * 4 + i]; b[i] = Bs[kk][tx * 4 + i]; }
#pragma unroll
            for (int i = 0; i < 4; ++i)
#pragma unroll
                for (int j = 0; j < 4; ++j) acc[i][j] += a[i] * b[j];
        }
        __syncthreads();
    }
#pragma unroll
    for (int i = 0; i < 4; ++i)
#pragma unroll
        for (int j = 0; j < 4; ++j) epi(m0 + ty * 4 + i, n0 + tx * 4 + j, acc[i][j]);
}
struct EpiProj0 { bf16_t* O; __device__ void operator()(int m, int n, float v) const { O[(size_t)m * N0P + n] = f2bf(v); } };
struct EpiY0 {
    Ptrs P;
    __device__ void operator()(int m, int n, float v) const {
        float y = v + xrow(P, m)[n];
        ((float*)(P.ws + WS_Y0))[(size_t)m * D + n] = y;
        ((bf16_t*)(P.ws + WS_Y0B))[(size_t)m * D + n] = f2bf(y);
    }
};
struct EpiL1 {
    Ptrs P;
    __device__ void operator()(int m, int n, float v) const {
        const float* ss = (const float*)(P.ws + WS_SSQ) + (size_t)m * 16;
        float t = 0.f; for (int j = 0; j < 16; ++j) t += ss[j];
        float r = rsqrtf(t * (1.f / D) + EPS);
        float val = v * r;
        int c = n & 1023;
        if (n < 1024) ((bf16_t*)(P.ws + WS_Q1))[(size_t)m * D + c] = f2bf(val * QSCALE);
        else if (n < 2048) { ((bf16_t*)(P.ws + WS_K1))[(size_t)m * D + c] = f2bf(val); P.out[off_l1k(m) + c] = val; }
        else if (n < 3072) { ((bf16_t*)(P.ws + WS_V1T))[(size_t)c * M + m] = f2bf(val); P.out[off_l1v(m) + c] = val; }
        else ((bf16_t*)(P.ws + WS_Z1))[(size_t)m * D + c] = f2bf(val);
    }
};
struct EpiOut { Ptrs P; __device__ void operator()(int m, int n, float v) const { P.out[O_Y + (size_t)m * D + n] = v + ((const float*)(P.ws + WS_Y0))[(size_t)m * D + n]; } };

__device__ __forceinline__ void d_ssq(const Ptrs& P, int w, int lane) {
    const float* y = (const float*)(P.ws + WS_Y0) + (size_t)w * D;
    float* ss = (float*)(P.ws + WS_SSQ) + (size_t)w * 16;
    for (int j = 0; j < 16; ++j) { float v = y[64 * j + lane]; float s = wave_sum(v * v); if (lane == 0) ss[j] = s; }
}
__global__ void k_ssq(Ptrs P) { int w = (blockIdx.x * blockDim.x + threadIdx.x) >> 6; if (w < M) d_ssq(P, w, threadIdx.x & 63); }

__device__ __forceinline__ void d_tok0(const Ptrs& P, int m, int lane) {
    const bf16_t* pr = (const bf16_t*)(P.ws + WS_PROJ0) + (size_t)m * N0P;
    bf16_t* q0 = (bf16_t*)(P.ws + WS_Q0) + (size_t)m * 512;
    bf16_t* k0 = (bf16_t*)(P.ws + WS_K0) + (size_t)m * 512;
    const float gq = P.in[12][lane], gk = P.in[13][lane];
#pragma unroll 1
    for (int g = 0; g < 8; ++g) {
        float q = bf2f(pr[C_Q + 64 * g + lane]), k = bf2f(pr[C_K + 64 * g + lane]);
        float sq = wave_sum(q * q), sk = wave_sum(k * k);
        float qn = q * rsqrtf(sq * (1.f / 64) + EPS) * gq, kn = k * rsqrtf(sk * (1.f / 64) + EPS) * gk;
        q0[64 * g + lane] = f2bf(qn * QSCALE);
        k0[64 * g + lane] = f2bf(kn);
        P.out[off_l0k(m) + 64 * g + lane] = kn;
        P.out[off_l0v(m) + 64 * g + lane] = bf2f(pr[C_V + 64 * g + lane]);
    }
    int last = -1; size_t so = 0;
    if (m == TP - 1) { last = 1; so = O_L0SH_P; }
    else if (m >= TP && ((m - TP) & 31) == 31) { last = 1; so = O_L0SH_S + (size_t)((m - TP) >> 5) * RWS; }
    if (last > 0) for (int c = lane; c < RWS; c += 64) P.out[so + c] = bf2f(pr[C_PRW + c]);
}
__global__ void k_tok0(Ptrs P) { int m = (blockIdx.x * blockDim.x + threadIdx.x) >> 6; if (m < M) d_tok0(P, m, threadIdx.x & 63); }

template <class SP> __device__ __forceinline__ void d_attn0(const Ptrs& P, int m, int h, int lane, SP sqw, SP spw) {
    const Tab* T = (const Tab*)(P.ws + WS_TAB);
    const bf16_t* Q0 = (const bf16_t*)(P.ws + WS_Q0); const bf16_t* K0 = (const bf16_t*)(P.ws + WS_K0);
    const bf16_t* PR = (const bf16_t*)(P.ws + WS_PROJ0);
    int qpos, nk, b = 0; bool samp = m >= TP;
    if (!samp) { qpos = m; nk = ((m >> 6) + 1) * 64; } else { b = (m - TP) >> 5; qpos = PAST + ((m - TP) & 31); nk = PAST + TS; }
    sqw[lane] = bf2f(Q0[(size_t)m * 512 + 128 * h + lane]);
    sqw[64 + lane] = bf2f(Q0[(size_t)m * 512 + 128 * h + 64 + lane]);
    float m1 = -1e30f, m2 = -1e30f, l1 = 0.f, l2 = 0.f, o1[2] = {0.f, 0.f}, o2[2] = {0.f, 0.f};
    for (int j0 = 0; j0 < nk; j0 += 64) {
        int j = j0 + lane;
        bool valid = j < nk && ((j >> 6) <= (qpos >> 6));
        float s1 = 0.f, s2 = 0.f;
        if (valid) {
            if (samp && j < PAST) {
                const float* kr = P.in[2] + (((size_t)b * PAST + j) * 4 + h) * 128;
                for (int d = 0; d < 64; ++d) { s1 += sqw[d] * bf2f(f2bf(kr[d])); s2 += sqw[64 + d] * bf2f(f2bf(kr[64 + d])); }
            } else {
                int km = samp ? TP + 32 * b + (j - PAST) : j;
                const bf16_t* kr = K0 + (size_t)km * 512 + 128 * h;
                for (int d = 0; d < 64; ++d) { s1 += sqw[d] * bf2f(kr[d]); s2 += sqw[64 + d] * bf2f(kr[64 + d]); }
            }
            int rel = j - qpos; float bias = rel <= -128 ? T->biasfar[h] : T->bias[h][rel + 191];
            s1 += bias * LOG2E; s2 += bias * LOG2E;
        } else { s1 = -1e30f; s2 = -1e30f; }
        float bm1 = wave_max(s1), bm2 = wave_max(s2);
        float n1 = fmaxf(m1, bm1), n2 = fmaxf(m2, bm2);
        float f1 = exp2f(m1 - n1), f2 = exp2f(m2 - n2);
        float p1 = valid ? exp2f(s1 - n1) : 0.f, p2 = valid ? exp2f(s2 - n2) : 0.f;
        l1 = l1 * f1 + wave_sum(p1); l2 = l2 * f2 + wave_sum(p2);
        o1[0] *= f1; o1[1] *= f1; o2[0] *= f2; o2[1] *= f2; m1 = n1; m2 = n2;
        spw[lane] = p1; spw[64 + lane] = p2;
        __builtin_amdgcn_s_waitcnt(0);
        int jn = min(64, nk - j0);
        for (int jj = 0; jj < jn; ++jj) {
            int jp = j0 + jj; float a1 = spw[jj], a2 = spw[64 + jj];
            float v0, v1;
            if (samp && jp < PAST) { const float* vr = P.in[3] + (((size_t)b * PAST + jp) * 4 + h) * 128; v0 = bf2f(f2bf(vr[lane])); v1 = bf2f(f2bf(vr[64 + lane])); }
            else { int km = samp ? TP + 32 * b + (jp - PAST) : jp; const bf16_t* vr = PR + (size_t)km * N0P + C_V + 128 * h; v0 = bf2f(vr[lane]); v1 = bf2f(vr[64 + lane]); }
            o1[0] += a1 * v0; o1[1] += a1 * v1; o2[0] += a2 * v0; o2[1] += a2 * v1;
        }
    }
    const float lam = T->lam;
    float a0 = o1[0] / l1 - lam * o2[0] / l2, a1 = o1[1] / l1 - lam * o2[1] / l2;
    float ss = wave_sum(a0 * a0 + a1 * a1);
    float r = rsqrtf(ss * (1.f / 128) + EPS) * (1.f - LAMBDA_INIT);
    const float* sg = P.in[18];
    const bf16_t* za = PR + (size_t)m * N0P + C_ZA + 128 * h;
    bf16_t* cat = (bf16_t*)(P.ws + WS_CAT) + (size_t)m * D + 128 * h;
    cat[lane] = f2bf(a0 * r * sg[lane] * silu(bf2f(za[lane])));
    cat[64 + lane] = f2bf(a1 * r * sg[64 + lane] * silu(bf2f(za[64 + lane])));
}
__global__ void __launch_bounds__(256) k_attn0(Ptrs P) {
    __shared__ float sq[4][128], sp[4][128];
    const int wid = threadIdx.x >> 6, lane = threadIdx.x & 63, gw = blockIdx.x * 4 + wid;
    if ((gw >> 2) < M) d_attn0(P, gw >> 2, gw & 3, lane, &sq[wid][0], &sp[wid][0]);
}

constexpr size_t RWN = (size_t)M * 512;
__device__ __forceinline__ float prw_prev(const Ptrs& P, int m, int c) {
    if (m < TP) return m == 0 ? 0.f : bf2f(((const bf16_t*)(P.ws + WS_PROJ0))[(size_t)(m - 1) * N0P + C_PRW + c]);
    int i = (m - TP) & 31, b = (m - TP) >> 5;
    if (i == 0) return P.in[4][(size_t)b * RWS + c];
    return bf2f(((const bf16_t*)(P.ws + WS_PROJ0))[(size_t)(m - 1) * N0P + C_PRW + c]);
}
template <class SP> __device__ __forceinline__ void d_rw_prep(const Ptrs& P, int m, int c, SP swl, SP sal) {
    const bf16_t* pr = (const bf16_t*)(P.ws + WS_PROJ0) + (size_t)m * N0P + C_PRW;
    const float* mu = P.in[19];
#define NV_MIX(col) (bf2f(pr[col]) + (prw_prev(P, m, (col)) - bf2f(pr[col])) * mu[col])
    float r = NV_MIX(c), kr = NV_MIX(512 + c), vr = NV_MIX(1024 + c);
    if (c < 64) swl[c] = tanhf(NV_MIX(1536 + c)); else if (c < 128) sal[c - 64] = NV_MIX(1600 + c - 64);
#undef NV_MIX
    __syncthreads();
    float wa = P.in[20][c], aa = P.in[22][c];
    const float* wup = P.in[21]; const float* aup = P.in[23];
#pragma unroll 4
    for (int l = 0; l < 64; ++l) { wa += swl[l] * wup[l * 512 + c]; aa += sal[l] * aup[l * 512 + c]; }
    float spl = (-wa > 20.f) ? -wa : log1pf(__expf(-wa));
    float w = -spl - 0.5f;
    float dec = __expf(-__expf(w));
    float a = 1.f / (1.f + __expf(-aa));
    float kk = kr * P.in[24][c];
    float n2 = wave_sum(kk * kk);
    kk = kk / fmaxf(sqrtf(n2), 1e-12f);
    float km = kr * (1.f + (a - 1.f) * P.in[25][c]);
    float* R = (float*)(P.ws + WS_RW);
    size_t o = (size_t)m * 512 + c;
    R[o] = r; R[RWN + o] = dec; R[2 * RWN + o] = kk; R[3 * RWN + o] = kk * a; R[4 * RWN + o] = km; R[5 * RWN + o] = vr;
}
__global__ void __launch_bounds__(512) k_rw_prep(Ptrs P) { __shared__ float swl[64], sal[64]; d_rw_prep(P, blockIdx.x, threadIdx.x, &swl[0], &sal[0]); }
__device__ __forceinline__ void d_rw_scan(const Ptrs& P, int seq, int h, int lane) {
    const int m0 = seq == 0 ? 0 : TP + 32 * (seq - 1), T = seq == 0 ? TP : TS;
    float S[64];
    const float* s0 = P.in[5] + (((size_t)(seq > 0 ? seq - 1 : 0) * 8 + h) * 64 + lane) * 64;
#pragma unroll
    for (int k = 0; k < 64; ++k) S[k] = seq == 0 ? 0.f : s0[k];
    const float* R = (const float*)(P.ws + WS_RW);
    const float rk = P.in[26][h * 64 + lane], lg = P.in[27][h * 64 + lane], lb = P.in[28][h * 64 + lane];
    for (int t = 0; t < T; ++t) {
        size_t o = (size_t)(m0 + t) * 512 + h * 64 + lane;
        float r = R[o], dec = R[RWN + o], kk = R[2 * RWN + o], kka = R[3 * RWN + o], km = R[4 * RWN + o], v = R[5 * RWN + o];
        float sa = 0.f;
#pragma unroll
        for (int k = 0; k < 64; ++k) sa += S[k] * __shfl(kk, k);
        float ov = 0.f;
#pragma unroll
        for (int k = 0; k < 64; ++k) { S[k] = S[k] * __shfl(dec, k) - sa * __shfl(kka, k) + v * __shfl(km, k); ov += S[k] * __shfl(r, k); }
        float mu = wave_sum(ov) * (1.f / 64);
        float dv = ov - mu;
        float var = wave_sum(dv * dv) * (1.f / 64);
        float y = dv * rsqrtf(var + GN_EPS) * lg + lb;
        float bonus = wave_sum(r * km * rk) * v;
        int mm = m0 + t;
        float zb = bf2f(((const bf16_t*)(P.ws + WS_PROJ0))[(size_t)mm * N0P + C_ZB + h * 64 + lane]);
        ((bf16_t*)(P.ws + WS_CAT))[(size_t)mm * D + 512 + h * 64 + lane] = f2bf((y + bonus) * silu(zb));
    }
    float* so = P.out + (seq == 0 ? O_L0WKV_P + ((size_t)h * 64 + lane) * 64 : O_L0WKV_S + ((((size_t)(seq - 1)) * 8 + h) * 64 + lane) * 64);
#pragma unroll
    for (int k = 0; k < 64; ++k) so[k] = S[k];
}
__global__ void __launch_bounds__(64) k_rw_scan(Ptrs P) { d_rw_scan(P, blockIdx.x >> 3, blockIdx.x & 7, threadIdx.x); }

template <class SP> __device__ __forceinline__ void d_attn1(const Ptrs& P, int m, int h, int lane, SP sqw, SP saw) {
    const bf16_t* Q1 = (const bf16_t*)(P.ws + WS_Q1); const bf16_t* K1 = (const bf16_t*)(P.ws + WS_K1);
    const bf16_t* V1T = (const bf16_t*)(P.ws + WS_V1T);
    bool samp = m >= TP; int b = 0, qpos;
    if (!samp) qpos = m; else { b = (m - TP) >> 5; qpos = PAST + ((m - TP) & 31); }
    sqw[lane] = bf2f(Q1[(size_t)m * D + 64 * h + lane]);
    float run = 0.f, o = 0.f;
    for (int s0 = qpos - 1; s0 >= 0; s0 -= 64) {
        int s = s0 - lane;
        bool valid = s >= 0;
        float z = 0.f;
        if (valid) {
            if (samp && s < PAST) { const float* kr = P.in[6] + (((size_t)b * PAST + s) * 16 + h) * 64; for (int d = 0; d < 64; ++d) z += sqw[d] * bf2f(f2bf(kr[d])); }
            else { int km = samp ? TP + 32 * b + (s - PAST) : s; const bf16_t* kr = K1 + (size_t)km * D + 64 * h; for (int d = 0; d < 64; ++d) z += sqw[d] * bf2f(kr[d]); }
        }
        float spl = valid ? log2f(1.f + exp2f(z)) : 0.f;
        float inc = spl;
#pragma unroll
        for (int off = 1; off < 64; off <<= 1) { float t = __shfl_up(inc, off); if (lane >= off) inc += t; }
        float a = valid ? exp2f(z - inc - run) : 0.f;
        saw[lane] = a;
        run += __shfl(inc, 63);
        __builtin_amdgcn_s_waitcnt(0);
        int jn = min(64, s0 + 1);
        for (int jj = 0; jj < jn; ++jj) {
            int sp_ = s0 - jj; float v;
            if (samp && sp_ < PAST) v = bf2f(f2bf(P.in[7][(((size_t)b * PAST + sp_) * 16 + h) * 64 + lane]));
            else { int km = samp ? TP + 32 * b + (sp_ - PAST) : sp_; v = bf2f(V1T[(size_t)(64 * h + lane) * M + km]); }
            o += saw[jj] * v;
        }
        if (run > 200.f) break;
    }
    float z1 = bf2f(((const bf16_t*)(P.ws + WS_Z1))[(size_t)m * D + 64 * h + lane]);
    ((bf16_t*)(P.ws + WS_O1B))[(size_t)m * D + 64 * h + lane] = f2bf(o * silu(z1));
}
__global__ void __launch_bounds__(256) k_attn1(Ptrs P) {
    __shared__ float sq[4][64], sa[4][64];
    const int wid = threadIdx.x >> 6, lane = threadIdx.x & 63, gw = blockIdx.x * 4 + wid;
    if ((gw >> 4) < M) d_attn1(P, gw >> 4, gw & 15, lane, &sq[wid][0], &sa[wid][0]);
}

}
namespace pg8 {
#define PG8_LAS __attribute__((address_space(3)))
typedef unsigned short bf16_t;
typedef short bf16x8 __attribute__((ext_vector_type(8)));
typedef float f32x4 __attribute__((ext_vector_type(4)));
typedef unsigned u32x4 __attribute__((ext_vector_type(4)));
constexpr int BM = 256, BK = 64, HALF = 128, HTB = HALF * BK * 2  , STAGE_BYTES = 8 * HTB, NXCD = 8, WGM = 8;

__host__ __device__ __forceinline__ int lds_byte(int r, int c) { const int st = (r >> 4) * 2 + (c >> 5), rr = r & 15, cc = c & 31, ob = rr * 64 + cc * 2; return st * 1024 + (ob ^ (((ob >> 9) & 1) << 5)); }
__host__ __device__ __forceinline__ void stage_rc(int b, int& R, int& C) { const int st = b / 1024, sb = b % 1024, swz = sb ^ (((sb >> 9) & 1) << 5); R = (st >> 1) * 16 + swz / 64; C = (st & 1) * 32 + (swz % 64) / 2; }
__host__ __device__ __forceinline__ int perm32(int rho) { const int n = rho >> 4, i = rho & 15; return 8 * (i >> 2) + 4 * n + (i & 3); }

struct Unit { int pm, pn; };
struct Gemm { const bf16_t* A; const bf16_t* Bt; int M, N, K; };

struct StaticOrder {
    int nM, nN, nwg, G, c;
    __host__ __device__ void init(int M, int N, int G_, int c_) { nM = M / BM; nN = N / BM; nwg = nM * nN; G = G_; c = c_; }
    __host__ __device__ bool next(int i, Unit& u) const {
        const long L = (long)i * G + c; if (L >= nwg) return false;
        int wgid = (int)L; { const int q = nwg / NXCD, r = nwg % NXCD, xcd = wgid % NXCD, off = wgid / NXCD; wgid = (xcd < r ? xcd * (q + 1) : r * (q + 1) + (xcd - r) * q) + off; }
        const int nig = WGM * nN, gid = wgid / nig, fm = gid * WGM, gsz = (nM - fm) < WGM ? (nM - fm) : WGM;
        u.pm = fm + ((wgid % nig) % gsz); u.pn = (wgid % nig) / gsz; return true;
    }
    __device__ __forceinline__ void a_ready(const Unit&) const {}
    __device__ __forceinline__ void done(const Unit&) const {}
};


__device__ __forceinline__ unsigned cvt_pk_bf16(float lo, float hi) { unsigned r; asm volatile("v_cvt_pk_bf16_f32 %0, %1, %2" : "=v"(r) : "v"(lo), "v"(hi)); return r; }
__device__ __forceinline__ u32x4 pack8(const f32x4& v0, const f32x4& v1) { u32x4 w; w.x = cvt_pk_bf16(v0[0], v0[1]); w.y = cvt_pk_bf16(v0[2], v0[3]); w.z = cvt_pk_bf16(v1[0], v1[1]); w.w = cvt_pk_bf16(v1[2], v1[3]); return w; }

struct EpiProj0F {
    static constexpr bool PERM = true, AFTER_DRAIN = false;
    bf16_t* O;
    __device__ __forceinline__ void operator()(const f32x4 (&acc)[2][2][4][2], const Unit& u, int wr, int wc, int fr, int fq) const {
        const int row0 = u.pm * BM + wr * 64 + fr, col0 = u.pn * BM + wc * 32 + 8 * fq;
#pragma unroll
        for (int ai = 0; ai < 2; ++ai)
#pragma unroll
            for (int m = 0; m < 4; ++m) { bf16_t* rowp = O + (size_t)(row0 + ai * HALF + m * 16) * N0P + col0;
#pragma unroll
                for (int bj = 0; bj < 2; ++bj) *(u32x4*)(rowp + bj * HALF) = pack8(acc[ai][bj][m][0], acc[ai][bj][m][1]); }
    }
};
struct EpiY0F {
    static constexpr bool PERM = true, AFTER_DRAIN = false;
    Ptrs P;
    __device__ __forceinline__ void operator()(const f32x4 (&acc)[2][2][4][2], const Unit& u, int wr, int wc, int fr, int fq) const {
        const int row0 = u.pm * BM + wr * 64 + fr, col0 = u.pn * BM + wc * 32 + 8 * fq;
        float* Y0 = (float*)(P.ws + WS_Y0); bf16_t* YB = (bf16_t*)(P.ws + WS_Y0B); float* SSQ = (float*)(P.ws + WS_SSQ);
#pragma unroll
        for (int ai = 0; ai < 2; ++ai)
#pragma unroll
            for (int m = 0; m < 4; ++m) { const int row = row0 + ai * HALF + m * 16; const float* xr = xrow(P, row) + col0; float ss = 0.f;
#pragma unroll
                for (int bj = 0; bj < 2; ++bj) {
                    const f32x4 y0 = acc[ai][bj][m][0] + *(const f32x4*)(xr + bj * HALF), y1 = acc[ai][bj][m][1] + *(const f32x4*)(xr + bj * HALF + 4);
                    *(f32x4*)(Y0 + (size_t)row * D + col0 + bj * HALF) = y0; *(f32x4*)(Y0 + (size_t)row * D + col0 + bj * HALF + 4) = y1;
                    *(u32x4*)(YB + (size_t)row * D + col0 + bj * HALF) = pack8(y0, y1);
                    ss += (y0[0] * y0[0] + y0[1] * y0[1]) + (y0[2] * y0[2] + y0[3] * y0[3]) + (y1[0] * y1[0] + y1[1] * y1[1]) + (y1[2] * y1[2] + y1[3] * y1[3]); }
                ss += __shfl_xor(ss, 16); ss += __shfl_xor(ss, 32);
                if (fq == 0) SSQ[(size_t)row * 16 + u.pn * 4 + wc] = ss; }
    }
};
struct EpiL1F {
    static constexpr bool PERM = true, AFTER_DRAIN = false;
    Ptrs P;
    __device__ __forceinline__ void operator()(const f32x4 (&acc)[2][2][4][2], const Unit& u, int wr, int wc, int fr, int fq) const {
        const int row0 = u.pm * BM + wr * 64 + fr, colt = u.pn * BM, reg = colt >> 10, c0 = (colt & 1023) + wc * 32 + 8 * fq;
        const float* SSQ = (const float*)(P.ws + WS_SSQ);
#pragma unroll
        for (int ai = 0; ai < 2; ++ai)
#pragma unroll
            for (int m = 0; m < 4; ++m) { const int row = row0 + ai * HALF + m * 16;
                const f32x4* sp = (const f32x4*)(SSQ + (size_t)row * 16); const f32x4 s0 = sp[0], s1 = sp[1], s2 = sp[2], s3 = sp[3];
                const f32x4 st = (s0 + s1) + (s2 + s3); const float rs = rsqrtf(((st[0] + st[1]) + (st[2] + st[3])) * (1.f / D) + EPS);
#pragma unroll
                for (int bj = 0; bj < 2; ++bj) { const int c = c0 + bj * HALF; f32x4 v0 = acc[ai][bj][m][0] * rs, v1 = acc[ai][bj][m][1] * rs;
                    if (reg == 0) { *(u32x4*)((bf16_t*)(P.ws + WS_Q1) + (size_t)row * D + c) = pack8(v0 * QSCALE, v1 * QSCALE); }
                    else if (reg == 1) { *(u32x4*)((bf16_t*)(P.ws + WS_K1) + (size_t)row * D + c) = pack8(v0, v1); float* o = P.out + off_l1k(row) + c; *(f32x4*)o = v0; *(f32x4*)(o + 4) = v1; }
                    else if (reg == 2) { bf16_t* vt = (bf16_t*)(P.ws + WS_V1T) + (size_t)c * M + row;
#pragma unroll
                        for (int j = 0; j < 4; ++j) { vt[(size_t)j * M] = f2bf(v0[j]); vt[(size_t)(4 + j) * M] = f2bf(v1[j]); }
                        float* o = P.out + off_l1v(row) + c; *(f32x4*)o = v0; *(f32x4*)(o + 4) = v1; }
                    else { *(u32x4*)((bf16_t*)(P.ws + WS_Z1) + (size_t)row * D + c) = pack8(v0, v1); } } }
    }
};
struct EpiOutF {
    static constexpr bool PERM = true, AFTER_DRAIN = false;
    Ptrs P;
    __device__ __forceinline__ void operator()(const f32x4 (&acc)[2][2][4][2], const Unit& u, int wr, int wc, int fr, int fq) const {
        const int row0 = u.pm * BM + wr * 64 + fr, col0 = u.pn * BM + wc * 32 + 8 * fq;
        const float* Y0 = (const float*)(P.ws + WS_Y0);
#pragma unroll
        for (int ai = 0; ai < 2; ++ai)
#pragma unroll
            for (int m = 0; m < 4; ++m) { const size_t ro = (size_t)(row0 + ai * HALF + m * 16) * D + col0;
#pragma unroll
                for (int bj = 0; bj < 2; ++bj) {
                    *(f32x4*)(P.out + O_Y + ro + bj * HALF) = acc[ai][bj][m][0] + *(const f32x4*)(Y0 + ro + bj * HALF);
                    *(f32x4*)(P.out + O_Y + ro + bj * HALF + 4) = acc[ai][bj][m][1] + *(const f32x4*)(Y0 + ro + bj * HALF + 4); } }
    }
};
template <class Epi, class Sched, bool ALIGN_EPI = false, bool SP2 = false>
__device__ __forceinline__ void gemm_phase(PG8_LAS unsigned char* lds, const Gemm g, const Sched& S, const Epi& E) {
    const int tid = threadIdx.x, wid = __builtin_amdgcn_readfirstlane(tid >> 6), lane = tid & 63, wr = wid >> 2, wc = wid & 3, fr = lane & 15, fq = lane >> 4;
    const int K = g.K, nt = K / BK;
    unsigned voffA[2], voffB[2];
#pragma unroll
    for (int i = 0; i < 2; ++i) { int R, C; stage_rc(tid * 16 + i * 8192, R, C); const int Rb = Epi::PERM ? ((R & ~31) + perm32(R & 31)) : R;
        voffA[i] = (unsigned)(R * K + C) * 2u; voffB[i] = (unsigned)(Rb * K + C) * 2u; }
    const size_t kstep = (size_t)(BK * 2);
    const size_t hstep = (size_t)HALF * K * 2;
    const size_t tstep = 2 * hstep;
    const unsigned ldsw = (unsigned)wid * 1024u;
    const int aoff = lds_byte(wr * 64 + fr, fq * 8), boff = lds_byte(wc * 32 + fr, fq * 8);
#define PG8_SA(b, h) (((b) * 2 + (h)) * HTB)
#define PG8_SB(b, h) ((4 + (b) * 2 + (h)) * HTB)
#define PG8_STAGE(bufoff, gbase, voff) do { _Pragma("unroll") for (int _i = 0; _i < 2; ++_i) \
        __builtin_amdgcn_global_load_lds((const unsigned*)((const char*)(gbase) + (voff)[_i]), (PG8_LAS unsigned*)(lds + (bufoff) + ldsw + _i * 8192), 16, 0, 0); } while (0)
#define PG8_LDA(dst, b, h) do { _Pragma("unroll") for (int m = 0; m < 4; ++m) _Pragma("unroll") for (int k = 0; k < 2; ++k) dst[m][k] = *(const PG8_LAS bf16x8*)(lds + PG8_SA(b, h) + aoff + m * 2048 + k * 1024); } while (0)
#define PG8_LDB(dst, b, h) do { _Pragma("unroll") for (int n = 0; n < 2; ++n) _Pragma("unroll") for (int k = 0; k < 2; ++k) dst[n][k] = *(const PG8_LAS bf16x8*)(lds + PG8_SB(b, h) + boff + n * 2048 + k * 1024); } while (0)
#define PG8_MMA(ai, bj, At, Bt) do { __builtin_amdgcn_s_setprio(1); _Pragma("unroll") for (int m = 0; m < 4; ++m) _Pragma("unroll") for (int n = 0; n < 2; ++n) _Pragma("unroll") for (int k = 0; k < 2; ++k) \
        acc[ai][bj][m][n] = __builtin_amdgcn_mfma_f32_16x16x32_bf16(Bt[n][k], At[m][k], acc[ai][bj][m][n], 0, 0, 0); __builtin_amdgcn_s_setprio(0); } while (0)
#define PG8_WAIT_V(n) asm volatile("s_waitcnt vmcnt(" #n ")" ::: "memory")
#define PG8_WAIT_L(n) asm volatile("s_waitcnt lgkmcnt(" #n ")" ::: "memory")
#define PG8_BAR __builtin_amdgcn_s_barrier()
#define PG8_SCHED __builtin_amdgcn_sched_barrier(0)
    Unit cur, nxt; int ui = 0;
    if (!S.next(0, cur)) return;
    f32x4 acc[2][2][4][2];
#pragma unroll
    for (int a = 0; a < 2; ++a)
#pragma unroll
        for (int b = 0; b < 2; ++b)
#pragma unroll
            for (int m = 0; m < 4; ++m)
#pragma unroll
                for (int n = 0; n < 2; ++n) acc[a][b][m][n] = (f32x4){0.f, 0.f, 0.f, 0.f};
    bf16x8 At[4][2], B0[2][2], B1[2][2];
    const char* cA = (const char*)g.A + (size_t)cur.pm * tstep; const char* cB = (const char*)g.Bt + (size_t)cur.pn * tstep;
    S.a_ready(cur);
    if constexpr (SP2) {
        PG8_STAGE(PG8_SB(0, 0), cB, voffB); PG8_STAGE(PG8_SB(0, 1), cB + hstep, voffB); PG8_STAGE(PG8_SA(0, 0), cA, voffA); PG8_STAGE(PG8_SA(0, 1), cA + hstep, voffA);
        if (wr == 1) PG8_BAR;
        PG8_WAIT_V(2); PG8_BAR;
        PG8_STAGE(PG8_SB(1, 0), cB + kstep, voffB); PG8_STAGE(PG8_SA(1, 0), cA + kstep, voffA); PG8_STAGE(PG8_SB(1, 1), cB + hstep + kstep, voffB);
        PG8_WAIT_V(6); PG8_BAR;
    } else {
        PG8_STAGE(PG8_SB(0, 0), cB, voffB); PG8_STAGE(PG8_SA(0, 0), cA, voffA); PG8_STAGE(PG8_SB(0, 1), cB + hstep, voffB); PG8_STAGE(PG8_SA(0, 1), cA + hstep, voffA);
        if (wr == 1) PG8_BAR;
        PG8_WAIT_V(4); PG8_BAR;
        PG8_STAGE(PG8_SB(1, 0), cB + kstep, voffB); PG8_STAGE(PG8_SA(1, 0), cA + kstep, voffA); PG8_STAGE(PG8_SB(1, 1), cB + hstep + kstep, voffB);
        PG8_WAIT_V(6); PG8_BAR;
    }
    for (;;) {
        const bool has_next = S.next(ui + 1, nxt);
        const char* nA = has_next ? (const char*)g.A + (size_t)nxt.pm * tstep : cA; const char* nB = has_next ? (const char*)g.Bt + (size_t)nxt.pn * tstep : cB;
        for (int t = 0; t < nt; t += 2) {
            const bool last = (t == nt - 2);
            const char* a1 = cA + (size_t)(t + 1) * kstep;
            const char* a2 = last ? nA : cA + (size_t)(t + 2) * kstep; const char* b2 = last ? nB : cB + (size_t)(t + 2) * kstep;
            const char* a3 = a2 + kstep; const char* b3 = b2 + kstep;
            if (last && has_next) S.a_ready(nxt);
            if constexpr (SP2) {
            PG8_LDB(B0, 0, 0); PG8_LDB(B1, 0, 1); PG8_SCHED; PG8_LDA(At, 0, 0); PG8_STAGE(PG8_SA(1, 1), a1 + hstep, voffA);
            PG8_WAIT_V(8); PG8_WAIT_L(0); PG8_BAR; PG8_MMA(0, 0, At, B0); PG8_MMA(0, 1, At, B1); PG8_BAR; PG8_SCHED;
            PG8_LDA(At, 0, 1); PG8_STAGE(PG8_SB(0, 0), b2, voffB); PG8_STAGE(PG8_SB(0, 1), b2 + hstep, voffB); PG8_STAGE(PG8_SA(0, 0), a2, voffA);
            PG8_WAIT_V(8); PG8_WAIT_L(0); PG8_BAR; PG8_MMA(1, 0, At, B0); PG8_MMA(1, 1, At, B1); PG8_BAR; PG8_SCHED;
            PG8_LDB(B0, 1, 0); PG8_LDB(B1, 1, 1); PG8_SCHED; PG8_LDA(At, 1, 0); PG8_STAGE(PG8_SA(0, 1), a2 + hstep, voffA);
            PG8_WAIT_V(8); PG8_WAIT_L(0); PG8_BAR; PG8_MMA(0, 0, At, B0); PG8_MMA(0, 1, At, B1); PG8_BAR; PG8_SCHED;
            PG8_LDA(At, 1, 1); PG8_STAGE(PG8_SB(1, 0), b3, voffB); PG8_STAGE(PG8_SB(1, 1), b3 + hstep, voffB); PG8_STAGE(PG8_SA(1, 0), a3, voffA);
            PG8_WAIT_V(8); PG8_WAIT_L(0); PG8_BAR; PG8_MMA(1, 0, At, B0); PG8_MMA(1, 1, At, B1); PG8_BAR; PG8_SCHED;
            } else {
            PG8_LDB(B0, 0, 0); PG8_SCHED; PG8_LDA(At, 0, 0); PG8_STAGE(PG8_SA(1, 1), a1 + hstep, voffA);
            PG8_WAIT_L(8); PG8_BAR; PG8_WAIT_L(0); PG8_MMA(0, 0, At, B0); PG8_BAR; PG8_SCHED;
            PG8_LDB(B1, 0, 1); PG8_STAGE(PG8_SB(0, 0), b2, voffB);
            PG8_BAR; PG8_WAIT_L(0); PG8_MMA(0, 1, At, B1); PG8_BAR;
            PG8_LDA(At, 0, 1); PG8_STAGE(PG8_SA(0, 0), a2, voffA);
            PG8_BAR; PG8_WAIT_L(0); PG8_MMA(1, 0, At, B0); PG8_BAR; PG8_SCHED;
            PG8_STAGE(PG8_SB(0, 1), b2 + hstep, voffB);
            PG8_WAIT_V(6); PG8_BAR; PG8_MMA(1, 1, At, B1); PG8_BAR;
            PG8_LDB(B0, 1, 0); PG8_SCHED; PG8_LDA(At, 1, 0); PG8_STAGE(PG8_SA(0, 1), a2 + hstep, voffA);
            PG8_WAIT_L(8); PG8_BAR; PG8_WAIT_L(0); PG8_MMA(0, 0, At, B0); PG8_BAR; PG8_SCHED;
            PG8_LDB(B1, 1, 1); PG8_STAGE(PG8_SB(1, 0), b3, voffB);
            PG8_BAR; PG8_WAIT_L(0); PG8_MMA(0, 1, At, B1); PG8_BAR;
            PG8_LDA(At, 1, 1); PG8_STAGE(PG8_SA(1, 0), a3, voffA);
            PG8_BAR; PG8_WAIT_L(0); PG8_MMA(1, 0, At, B0); PG8_BAR; PG8_SCHED;
            PG8_STAGE(PG8_SB(1, 1), b3 + hstep, voffB);
            PG8_WAIT_V(6); PG8_BAR; PG8_MMA(1, 1, At, B1); PG8_BAR;
            }
        }
        if constexpr (ALIGN_EPI) { if (wr == 0) PG8_BAR; }
        if constexpr (!Epi::AFTER_DRAIN) { E(acc, cur, wr, wc, fr, fq); S.done(cur); }
        if (!has_next) break;
#pragma unroll
        for (int a = 0; a < 2; ++a)
#pragma unroll
            for (int b = 0; b < 2; ++b)
#pragma unroll
                for (int m = 0; m < 4; ++m)
#pragma unroll
                    for (int n = 0; n < 2; ++n) acc[a][b][m][n] = (f32x4){0.f, 0.f, 0.f, 0.f};
        cur = nxt; cA = nA; cB = nB; ++ui;
        if constexpr (ALIGN_EPI) { if (wr == 1) PG8_BAR; }
    }
    PG8_WAIT_V(0);
    if constexpr (!ALIGN_EPI) { if (wr == 0) PG8_BAR; }
    PG8_BAR;
    if constexpr (Epi::AFTER_DRAIN) { E.fused(acc, cur, wr, wc, fr, fq, lds, wid, lane); S.done(cur); }
#undef PG8_SA
#undef PG8_SB
#undef PG8_STAGE
#undef PG8_LDA
#undef PG8_LDB
#undef PG8_MMA
#undef PG8_WAIT_V
#undef PG8_WAIT_L
#undef PG8_BAR
#undef PG8_SCHED
}
}
namespace da {
#define DLAS __attribute__((address_space(3)))
typedef short bf16x8 __attribute__((ext_vector_type(8)));
typedef short s16x4 __attribute__((ext_vector_type(4)));
typedef float f32x16 __attribute__((ext_vector_type(16)));
typedef float f32x4 __attribute__((ext_vector_type(4)));
typedef unsigned u32x4 __attribute__((ext_vector_type(4)));

constexpr int KROW = 272, KBUF = 64 * KROW, VBUF = 16384;
constexpr int OFF_K = 0, OFF_V = 2 * KBUF;
constexpr int OFF_STAGE = 0;
constexpr int OFF_LST = 131072;
constexpr int OFF_BIAS = OFF_LST + 1024;
constexpr int DA_LDS_END = OFF_BIAS + 1024;

struct Unit { int kind, h, idx; };

__device__ __forceinline__ unsigned cvtpk(float lo, float hi) { unsigned r; asm volatile("v_cvt_pk_bf16_f32 %0, %1, %2" : "=v"(r) : "v"(lo), "v"(hi)); return r; }
__device__ __forceinline__ u32x4 pack8(const f32x4& a, const f32x4& b) { u32x4 w; w.x = cvtpk(a[0], a[1]); w.y = cvtpk(a[2], a[3]); w.z = cvtpk(b[0], b[1]); w.w = cvtpk(b[2], b[3]); return w; }

struct Stage { f32x4 kA0, kA1, vA0, vA1, kB0, kB1, vB0, vB1; };
template <int KIND> __device__ __forceinline__ void chunk_issue(const Ptrs& P, const Unit& u, int t, int c, f32x4& k0, f32x4& k1, f32x4& v0, f32x4& v1) {
    const int row = c >> 4, ch = c & 15;
    if (KIND == 0 || t == 16) {
        const int m = (KIND == 0) ? 64 * t + row : TP + 32 * u.idx + (row & 31);
        const bf16_t* kp = (const bf16_t*)(P.ws + WS_K0) + (size_t)m * 512 + 128 * u.h + ch * 8;
        const bf16_t* vp = (const bf16_t*)(P.ws + WS_PROJ0) + (size_t)m * N0P + C_V + 128 * u.h + ch * 8;
        f32x4 kv = *(const f32x4*)kp, vv = *(const f32x4*)vp;
        if (KIND != 0 && row >= 32) { kv = (f32x4){0.f, 0.f, 0.f, 0.f}; vv = kv; }
        k0 = kv; v0 = vv;
    } else {
        const size_t ro = (((size_t)u.idx * PAST + 64 * t + row) * 4 + u.h) * 128 + ch * 8;
        const float* kp = P.in[2] + ro; const float* vp = P.in[3] + ro;
        k0 = *(const f32x4*)kp; k1 = *(const f32x4*)(kp + 4); v0 = *(const f32x4*)vp; v1 = *(const f32x4*)(vp + 4);
    }
}
template <int KIND> __device__ __forceinline__ void chunk_write(int t, int c, DLAS unsigned char* lds, int buf, const f32x4& k0, const f32x4& k1, const f32x4& v0, const f32x4& v1) {
    const int row = c >> 4, ch = c & 15;
    DLAS unsigned char* kd = lds + OFF_K + buf * KBUF + row * KROW + ch * 16;
    DLAS unsigned char* vd = lds + OFF_V + buf * VBUF + (ch >> 2) * 4096 + row * 64 + (ch & 3) * 16;
    if (KIND == 0 || t == 16) { *(DLAS f32x4*)kd = k0; *(DLAS f32x4*)vd = v0; }
    else { *(DLAS u32x4*)kd = pack8(k0, k1); *(DLAS u32x4*)vd = pack8(v0, v1); }
}
#define TILE_ISSUE(t_) do { chunk_issue<KIND>(P, u, (t_), tid, S.kA0, S.kA1, S.vA0, S.vA1); chunk_issue<KIND>(P, u, (t_), tid + 512, S.kB0, S.kB1, S.vB0, S.vB1); } while (0)
#define TILE_WRITE(t_, buf_) do { chunk_write<KIND>((t_), tid, lds, (buf_), S.kA0, S.kA1, S.vA0, S.vA1); chunk_write<KIND>((t_), tid + 512, lds, (buf_), S.kB0, S.kB1, S.vB0, S.vB1); } while (0)

template <int KIND> __device__ __forceinline__ void unit_run(const Ptrs& P, const Unit& u0, DLAS unsigned char* lds, int tid) {
    const Unit u{KIND, u0.h, u0.idx};
    asm volatile("" : "+v"(tid));
    const int lane = tid & 63, wave = __builtin_amdgcn_readfirstlane(tid >> 6), r32 = lane & 31, hi = lane >> 5, mp = wave >> 2, w4 = wave & 3;
    constexpr bool is_s = KIND != 0;
    int m0row, qpos0, NT, cq;
    if (!is_s) { m0row = 128 * u.idx + 32 * w4; qpos0 = m0row; NT = 2 * u.idx + 2; cq = m0row >> 6; }
    else { m0row = TP + 32 * u.idx; qpos0 = PAST; NT = 17; cq = 16; }
    const Tab* T = (const Tab*)(P.ws + WS_TAB);
    DLAS float* lst = (DLAS float*)(lds + OFF_LST);
    DLAS float* bl = (DLAS float*)(lds + OFF_BIAS);
    if (tid < 256) { bl[tid] = (T->bias[u.h][tid] - T->biasfar[u.h]) * LOG2E; lst[tid] = 0.f; }
    bf16x8 qf[4];
    { const bf16_t* qp = (const bf16_t*)(P.ws + WS_Q0) + (size_t)(m0row + r32) * 512 + 128 * u.h + 64 * mp + 8 * hi;
#pragma unroll
      for (int s = 0; s < 4; ++s) qf[s] = *(const bf16x8*)(qp + 16 * s); }
    f32x16 o[4];
#pragma unroll
    for (int d = 0; d < 4; ++d)
#pragma unroll
        for (int r = 0; r < 16; ++r) o[d][r] = 0.f;
    float lsum = 0.f;
    Stage S;
    { const f32x4 z = (f32x4){0.f, 0.f, 0.f, 0.f}; S.kA0 = z; S.kA1 = z; S.vA0 = z; S.vA1 = z; S.kB0 = z; S.kB1 = z; S.vB0 = z; S.vB1 = z; }
    TILE_ISSUE(0);
    TILE_WRITE(0, 0);
    __syncthreads();
    const int vaddr = (4 * hi + ((lane & 15) >> 2)) * 64 + (16 * ((lane >> 4) & 1) + 4 * (lane & 3)) * 2;
    for (int t = 0; t < NT; ++t) {
        const int buf = t & 1;
        const bool has_next = t + 1 < NT;
        if (has_next) TILE_ISSUE(t + 1);
        const bool active = is_s ? ((t & 3) == w4) : (t <= cq);
        if (active) {
            const DLAS unsigned char* kb = lds + OFF_K + buf * KBUF + r32 * KROW + mp * 128 + hi * 16;
            f32x16 p0, p1;
#pragma unroll
            for (int r = 0; r < 16; ++r) { p0[r] = 0.f; p1[r] = 0.f; }
#pragma unroll
            for (int s = 0; s < 4; ++s) {
                const bf16x8 a0 = *(const DLAS bf16x8*)(kb + s * 32), a1 = *(const DLAS bf16x8*)(kb + 32 * KROW + s * 32);
                p0 = __builtin_amdgcn_mfma_f32_32x32x16_bf16(a0, qf[s], p0, 0, 0, 0);
                p1 = __builtin_amdgcn_mfma_f32_32x32x16_bf16(a1, qf[s], p1, 0, 0, 0);
            }
            if (t >= cq - 2) {
                const int rb = 64 * t - qpos0 - r32 + 191 + 4 * hi;
#pragma unroll
                for (int r = 0; r < 16; ++r) { const int kk = (r & 3) + 8 * (r >> 2); p0[r] += bl[rb + kk]; p1[r] += bl[rb + 32 + kk]; }
            }
#pragma unroll
            for (int r = 0; r < 16; ++r) { p0[r] = __builtin_amdgcn_exp2f(p0[r]); p1[r] = __builtin_amdgcn_exp2f(p1[r]); }
            if (is_s && t == 16) {
#pragma unroll
                for (int r = 0; r < 16; ++r) p1[r] = 0.f;
            }
            float sa = 0.f, sb = 0.f;
#pragma unroll
            for (int r = 0; r < 16; ++r) { sa += p0[r]; sb += p1[r]; }
            lsum += sa + sb;
            bf16x8 pa[4];
            pa[0] = __builtin_bit_cast(bf16x8, pack8((f32x4){p0[0], p0[1], p0[2], p0[3]}, (f32x4){p0[4], p0[5], p0[6], p0[7]}));
            pa[1] = __builtin_bit_cast(bf16x8, pack8((f32x4){p0[8], p0[9], p0[10], p0[11]}, (f32x4){p0[12], p0[13], p0[14], p0[15]}));
            pa[2] = __builtin_bit_cast(bf16x8, pack8((f32x4){p1[0], p1[1], p1[2], p1[3]}, (f32x4){p1[4], p1[5], p1[6], p1[7]}));
            pa[3] = __builtin_bit_cast(bf16x8, pack8((f32x4){p1[8], p1[9], p1[10], p1[11]}, (f32x4){p1[12], p1[13], p1[14], p1[15]}));
            const DLAS unsigned char* vb = lds + OFF_V + buf * VBUF + vaddr;
#pragma unroll
            for (int d = 0; d < 4; ++d)
#pragma unroll
                for (int k = 0; k < 4; ++k) {
                    const s16x4 lo = __builtin_bit_cast(s16x4, __builtin_amdgcn_ds_read_tr16_b64_v4i16((DLAS s16x4*)(vb + d * 4096 + k * 1024)));
                    const s16x4 hh = __builtin_bit_cast(s16x4, __builtin_amdgcn_ds_read_tr16_b64_v4i16((DLAS s16x4*)(vb + d * 4096 + k * 1024 + 512)));
                    const bf16x8 bf = (bf16x8){lo[0], lo[1], lo[2], lo[3], hh[0], hh[1], hh[2], hh[3]};
                    o[d] = __builtin_amdgcn_mfma_f32_32x32x16_bf16(pa[k], bf, o[d], 0, 0, 0);
                    if (k == 3) __builtin_amdgcn_sched_barrier(0);
                }
        }
        if (has_next) TILE_WRITE(t + 1, buf ^ 1);
        __syncthreads();
    }
    lsum += __shfl_xor(lsum, 32);
    DLAS float* stage = (DLAS float*)(lds + OFF_STAGE);
    {
        const int rowb = is_s ? 0 : 32 * w4;
        DLAS float* st0 = stage + (mp * 128 + rowb + 4 * hi) * 128 + r32;
#pragma unroll 1
        for (int round = 0; round < (is_s ? 4 : 1); ++round) {
            if (!is_s || round == w4) {
                const bool first = !is_s || round == 0;
#pragma unroll
                for (int d = 0; d < 4; ++d)
#pragma unroll
                    for (int r = 0; r < 16; ++r) {
                        DLAS float* st = st0 + ((r & 3) + 8 * (r >> 2)) * 128 + d * 32;
                        *st = first ? o[d][r] : *st + o[d][r];
                    }
                if (hi == 0) { DLAS float* lp = &lst[mp * 128 + rowb + r32]; *lp = first ? lsum : *lp + lsum; }
            }
            __syncthreads();
        }
    }
    {
        const int nrow = is_s ? 4 : 16;
        const float lam = T->lam;
        const float* sg = P.in[18];
        for (int i = 0; i < nrow; ++i) {
            const int row = wave * nrow + i;
            const float l1 = lst[row], l2 = lst[128 + row];
            const float il1 = 1.f / l1, il2 = lam / l2;
            const float a0 = stage[row * 128 + lane] * il1 - stage[(128 + row) * 128 + lane] * il2;
            const float a1 = stage[row * 128 + 64 + lane] * il1 - stage[(128 + row) * 128 + 64 + lane] * il2;
            const float ss = wave_sum(a0 * a0 + a1 * a1);
            const float rr = rsqrtf(ss * (1.f / 128) + EPS) * (1.f - LAMBDA_INIT);
            const int m = is_s ? TP + 32 * u.idx + row : 128 * u.idx + row;
            const bf16_t* za = (const bf16_t*)(P.ws + WS_PROJ0) + (size_t)m * N0P + C_ZA + 128 * u.h;
            bf16_t* cat = (bf16_t*)(P.ws + WS_CAT) + (size_t)m * D + 128 * u.h;
            cat[lane] = f2bf(a0 * rr * sg[lane] * silu(bf2f(za[lane])));
            cat[64 + lane] = f2bf(a1 * rr * sg[64 + lane] * silu(bf2f(za[64 + lane])));
        }
    }
    __syncthreads();
}

__device__ __forceinline__ void phase(const Ptrs& P, DLAS unsigned char* lds, unsigned* qhead, volatile DLAS unsigned* slot, int tid) {
#pragma unroll 1
    for (;;) {
        if (tid == 0) *slot = __hip_atomic_fetch_add(qhead, 1u, __ATOMIC_RELAXED, __HIP_MEMORY_SCOPE_AGENT);
        __syncthreads();
        const int i = (int)*slot;
        __syncthreads();
        if (i >= 640) break;
        if (i < 512) unit_run<0>(P, Unit{0, i & 3, 127 - (i >> 2)}, lds, tid);
        else unit_run<1>(P, Unit{1, (i - 512) & 3, (i - 512) >> 2}, lds, tid);
    }
}
#undef DLAS
}
namespace sb {
typedef short bf16x8 __attribute__((ext_vector_type(8)));
typedef short s16x4 __attribute__((ext_vector_type(4)));
typedef float f32x16 __attribute__((ext_vector_type(16)));
typedef float f32x4 __attribute__((ext_vector_type(4)));
typedef unsigned u32x4 __attribute__((ext_vector_type(4)));
typedef unsigned u32x2 __attribute__((ext_vector_type(2)));

__device__ __forceinline__ unsigned cvtpk(float lo, float hi) { unsigned r; asm volatile("v_cvt_pk_bf16_f32 %0, %1, %2" : "=v"(r) : "v"(lo), "v"(hi)); return r; }
constexpr float RUN_EXIT = 160.f;

template <int SAMPLE> __device__ __forceinline__ void unit_run(const Ptrs& P, int b, int h, int qt, int lane) {
    const int r32 = lane & 31, hi = lane >> 5;
    const bf16_t* Q1 = (const bf16_t*)(P.ws + WS_Q1); const bf16_t* K1 = (const bf16_t*)(P.ws + WS_K1); const bf16_t* V1T = (const bf16_t*)(P.ws + WS_V1T);
    const int m0 = SAMPLE ? TP + 32 * b : 32 * qt;
    const int q0 = SAMPLE ? PAST : 32 * qt;
    bf16x8 qf[4];
    { const bf16_t* qp = Q1 + (size_t)(m0 + r32) * D + 64 * h + 8 * hi;
#pragma unroll
      for (int s = 0; s < 4; ++s) qf[s] = *(const bf16x8*)(qp + 16 * s); }
    f32x16 o0, o1;
#pragma unroll
    for (int r = 0; r < 16; ++r) { o0[r] = 0.f; o1[r] = 0.f; }
    float run = 0.f;
#pragma unroll 1
    for (int k0 = q0; k0 >= 0; k0 -= 32) {
        const bool diag = (k0 == q0);
        const bool cache = SAMPLE && !diag;
        f32x16 p;
#pragma unroll
        for (int r = 0; r < 16; ++r) p[r] = 0.f;
        if (!cache) {
            const int mk = SAMPLE ? TP + 32 * b : k0;
            const bf16_t* kp = K1 + (size_t)(mk + r32) * D + 64 * h + 8 * hi;
#pragma unroll
            for (int s = 0; s < 4; ++s) { const bf16x8 a = *(const bf16x8*)(kp + 16 * s); p = __builtin_amdgcn_mfma_f32_32x32x16_bf16(a, qf[s], p, 0, 0, 0); }
        } else {
            const float* kp = P.in[6] + (((size_t)b * PAST + k0 + r32) * 16 + h) * 64 + 8 * hi;
#pragma unroll
            for (int s = 0; s < 4; ++s) { const f32x4 x0 = *(const f32x4*)(kp + 16 * s), x1 = *(const f32x4*)(kp + 16 * s + 4);
                u32x4 w; w.x = cvtpk(x0[0], x0[1]); w.y = cvtpk(x0[2], x0[3]); w.z = cvtpk(x1[0], x1[1]); w.w = cvtpk(x1[2], x1[3]);
                p = __builtin_amdgcn_mfma_f32_32x32x16_bf16(__builtin_bit_cast(bf16x8, w), qf[s], p, 0, 0, 0); }
        }
        float sp[16];
#pragma unroll
        for (int r = 0; r < 16; ++r) {
            const int kk = (r & 3) + 8 * (r >> 2) + 4 * hi;
            const float e = __builtin_amdgcn_exp2f(p[r]);
            float s = __builtin_amdgcn_logf(1.f + e);
            if (diag && !(kk < r32)) s = 0.f;
            sp[r] = s;
        }
        float a[4], bsum[4];
#pragma unroll
        for (int g = 0; g < 4; ++g) { a[g] = (sp[4 * g] + sp[4 * g + 1]) + (sp[4 * g + 2] + sp[4 * g + 3]); bsum[g] = __shfl_xor(a[g], 32); }
        float Tg[4];
        { float accA = 0.f, accB = 0.f;
#pragma unroll
          for (int g = 3; g >= 0; --g) {
              const float pb = hi ? accB : accB + bsum[g];
              Tg[g] = accA + pb;
              accA += a[g]; accB += bsum[g];
          }
          const float tot = accA + accB;
#pragma unroll
          for (int g = 0; g < 4; ++g) {
              float c = Tg[g] + run;
#pragma unroll
              for (int i = 3; i >= 0; --i) {
                  const int r = 4 * g + i, kk = i + 8 * g + 4 * hi;
                  c += sp[r];
                  float w = __builtin_amdgcn_exp2f(p[r] - c);
                  if (diag && !(kk < r32)) w = 0.f;
                  p[r] = w;
              }
          }
          run += tot;
        }
        u32x4 w0, w1;
        w0.x = cvtpk(p[0], p[1]); w0.y = cvtpk(p[2], p[3]); w0.z = cvtpk(p[4], p[5]); w0.w = cvtpk(p[6], p[7]);
        w1.x = cvtpk(p[8], p[9]); w1.y = cvtpk(p[10], p[11]); w1.z = cvtpk(p[12], p[13]); w1.w = cvtpk(p[14], p[15]);
        const bf16x8 pa0 = __builtin_bit_cast(bf16x8, w0), pa1 = __builtin_bit_cast(bf16x8, w1);
        if (!cache) {
            const int mk = SAMPLE ? TP + 32 * b : k0;
            const bf16_t* vp = V1T + (size_t)(64 * h + r32) * M + mk + 4 * hi;
#pragma unroll
            for (int d = 0; d < 2; ++d)
#pragma unroll
                for (int s = 0; s < 2; ++s) {
                    const u32x2 lo = *(const u32x2*)(vp + (size_t)(32 * d) * M + 16 * s), hh = *(const u32x2*)(vp + (size_t)(32 * d) * M + 16 * s + 8);
                    const u32x4 w = (u32x4){lo.x, lo.y, hh.x, hh.y};
                    if (d == 0) o0 = __builtin_amdgcn_mfma_f32_32x32x16_bf16(s == 0 ? pa0 : pa1, __builtin_bit_cast(bf16x8, w), o0, 0, 0, 0);
                    else o1 = __builtin_amdgcn_mfma_f32_32x32x16_bf16(s == 0 ? pa0 : pa1, __builtin_bit_cast(bf16x8, w), o1, 0, 0, 0);
                }
        } else {
            const float* vp = P.in[7] + (((size_t)b * PAST + k0 + 4 * hi) * 16 + h) * 64 + r32;
#pragma unroll
            for (int d = 0; d < 2; ++d)
#pragma unroll
                for (int s = 0; s < 2; ++s) {
                    float x[8];
#pragma unroll
                    for (int j = 0; j < 8; ++j) x[j] = vp[(size_t)(16 * s + 8 * (j >> 2) + (j & 3)) * 1024 + 32 * d];
                    u32x4 w; w.x = cvtpk(x[0], x[1]); w.y = cvtpk(x[2], x[3]); w.z = cvtpk(x[4], x[5]); w.w = cvtpk(x[6], x[7]);
                    if (d == 0) o0 = __builtin_amdgcn_mfma_f32_32x32x16_bf16(s == 0 ? pa0 : pa1, __builtin_bit_cast(bf16x8, w), o0, 0, 0, 0);
                    else o1 = __builtin_amdgcn_mfma_f32_32x32x16_bf16(s == 0 ? pa0 : pa1, __builtin_bit_cast(bf16x8, w), o1, 0, 0, 0);
                }
        }
        if (__all(run >= RUN_EXIT)) break;
    }
    const bf16_t* Z1 = (const bf16_t*)(P.ws + WS_Z1); bf16_t* O1 = (bf16_t*)(P.ws + WS_O1B);
#pragma unroll
    for (int r = 0; r < 16; ++r) {
        const int q = (r & 3) + 8 * (r >> 2) + 4 * hi;
        const size_t off = (size_t)(m0 + q) * D + 64 * h + r32;
        O1[off] = f2bf(o0[r] * silu(bf2f(Z1[off])));
        O1[off + 32] = f2bf(o1[r] * silu(bf2f(Z1[off + 32])));
    }
}

__device__ __forceinline__ void phase(const Ptrs& P, int gw, int ngw, int lane) {
#pragma unroll 1
    for (int i = gw; i < 16 * 512; i += ngw) unit_run<0>(P, 0, i & 15, i >> 4, lane);
#pragma unroll 1
    for (int i = gw; i < 16 * 32; i += ngw) unit_run<1>(P, i >> 4, i & 15, 0, lane);
}
}
namespace rw {
#define RLAS __attribute__((address_space(3)))
typedef short bf16x8 __attribute__((ext_vector_type(8)));
typedef float f32x16 __attribute__((ext_vector_type(16)));
typedef float f32x4 __attribute__((ext_vector_type(4)));
typedef unsigned u32x4 __attribute__((ext_vector_type(4)));
typedef unsigned u32x2 __attribute__((ext_vector_type(2)));

constexpr int NUNIT = 2048 + 256;
constexpr size_t U_MFRAG = 0;
constexpr size_t U_NRAW = 16384;
constexpr size_t U_HRAW = 32768;
constexpr size_t U_G = 49152;
constexpr size_t U_BON = 57344;
constexpr size_t U_BYTES = 65536;
static_assert(WS_RW + (size_t)NUNIT * U_BYTES <= WS_SST, "rw region");

constexpr int SB = 144, SF = 272;
constexpr int BSZ = 64 * SB, FSZ = 64 * SF;
constexpr int L_S0 = 0, L_S1 = BSZ, L_S2 = 2 * BSZ, L_S3 = 3 * BSZ, L_S4 = 4 * BSZ, L_S5 = 5 * BSZ, L_S6 = 6 * BSZ, L_S7 = 7 * BSZ, L_S8 = 8 * BSZ, L_S9 = 9 * BSZ;
constexpr int L_F0 = 10 * BSZ, L_F1 = L_F0 + FSZ, L_F2 = L_F1 + FSZ;
constexpr int L_PC = L_F2 + FSZ;
constexpr int L_TOT = L_PC + 256;
constexpr int RW_LDS_END = L_TOT + 2048;
static_assert(RW_LDS_END <= 147456, "rw lds");

__device__ __forceinline__ unsigned cvtpk(float lo, float hi) { unsigned r; asm volatile("v_cvt_pk_bf16_f32 %0, %1, %2" : "=v"(r) : "v"(lo), "v"(hi)); return r; }
__device__ __forceinline__ float bflo(unsigned w) { return __uint_as_float(w << 16); }
__device__ __forceinline__ float bfhi(unsigned w) { return __uint_as_float(w & 0xffff0000u); }

__device__ __forceinline__ f32x16 mm_tile(f32x16 acc, const RLAS unsigned char* A, int arow0, const RLAS unsigned char* B, int brow0, int r32, int hi) {
    const RLAS unsigned char* ap = A + (arow0 + r32) * SB + hi * 16;
    const RLAS unsigned char* bp = B + (brow0 + r32) * SB + hi * 16;
#pragma unroll
    for (int s = 0; s < 4; ++s) acc = __builtin_amdgcn_mfma_f32_32x32x16_bf16(*(const RLAS bf16x8*)(ap + 32 * s), *(const RLAS bf16x8*)(bp + 32 * s), acc, 0, 0, 0);
    return acc;
}
__device__ __forceinline__ f32x16 zero16() { f32x16 z;
#pragma unroll
    for (int r = 0; r < 16; ++r) z[r] = 0.f; return z; }

template <int J> struct SolveStep {
    static __device__ __forceinline__ void run(float (&R)[16], const RLAS unsigned char* ap  ) {
        constexpr int jq = J & 3, jg = J >> 2;
        const float xj = __builtin_bit_cast(float, __builtin_amdgcn_update_dpp(0, __builtin_bit_cast(int, R[jg]), jq | (jq << 2) | (jq << 4) | (jq << 6), 0xf, 0xf, false));
#pragma unroll
        for (int gq = jg >> 2; gq < 4; ++gq) {
            const f32x4 a = *(const RLAS f32x4*)(ap + J * SF + 16 * gq);
#pragma unroll
            for (int i = 0; i < 4; ++i) { if (4 * gq + i >= jg) R[4 * gq + i] -= a[i] * xj; }
        }
        SolveStep<J + 1>::run(R, ap);
    }
};
template <> struct SolveStep<63> { static __device__ __forceinline__ void run(float (&)[16], const RLAS unsigned char*) {} };

__device__ __forceinline__ void unit_a(const Ptrs& P, int unit, RLAS unsigned char* lds, int tid) {
    asm volatile("" : "+v"(tid));
    const int lane = tid & 63, wave = __builtin_amdgcn_readfirstlane(tid >> 6), r32 = lane & 31, hi = lane >> 5;
    const bool samp = unit >= 2048;
    const int h = unit & 7, cb = samp ? (unit - 2048) >> 3 : unit >> 3;
    const int m_base = samp ? TP + 32 * cb : 64 * cb;
    const int nvalid = samp ? 32 : 64;
    const bf16_t* PR = (const bf16_t*)(P.ws + WS_PROJ0);
    unsigned char* urec = P.ws + WS_RW + (size_t)unit * U_BYTES;
    const float* mu = P.in[19];
    const int ch = 64 * h + lane;
    float rr[8], kr[8], vr[8];
    {
        const float mu_r = mu[ch], mu_k = mu[512 + ch], mu_v = mu[1024 + ch], mu_w = mu[1536 + lane], mu_a = mu[1600 + lane];
        float pr_r, pr_k, pr_v, pr_w, pr_a;
        const int t0 = 8 * wave;
        {
            const int m = m_base + t0;
            if ((!samp && m == 0) || t0 >= nvalid) { pr_r = pr_k = pr_v = pr_w = pr_a = 0.f; }
            else if (samp && t0 == 0) { const float* sh = P.in[4] + (size_t)cb * RWS; pr_r = sh[ch]; pr_k = sh[512 + ch]; pr_v = sh[1024 + ch]; pr_w = sh[1536 + lane]; pr_a = sh[1600 + lane]; }
            else { const bf16_t* p = PR + (size_t)(m - 1) * N0P + C_PRW; pr_r = bf2f(p[ch]); pr_k = bf2f(p[512 + ch]); pr_v = bf2f(p[1024 + ch]); pr_w = bf2f(p[1536 + lane]); pr_a = bf2f(p[1600 + lane]); }
        }
#pragma unroll
        for (int i = 0; i < 8; ++i) {
            const int t = t0 + i;
            float c_r = 0.f, c_k = 0.f, c_v = 0.f, c_w = 0.f, c_a = 0.f;
            if (t < nvalid) { const bf16_t* p = PR + (size_t)(m_base + t) * N0P + C_PRW; c_r = bf2f(p[ch]); c_k = bf2f(p[512 + ch]); c_v = bf2f(p[1024 + ch]); c_w = bf2f(p[1536 + lane]); c_a = bf2f(p[1600 + lane]); }
            rr[i] = c_r + (pr_r - c_r) * mu_r; kr[i] = c_k + (pr_k - c_k) * mu_k; vr[i] = c_v + (pr_v - c_v) * mu_v;
            const float wl = c_w + (pr_w - c_w) * mu_w, al = c_a + (pr_a - c_a) * mu_a;
            *(RLAS bf16_t*)(lds + L_S0 + t * SB + lane * 2) = f2bf(tanhf(wl));
            *(RLAS bf16_t*)(lds + L_S1 + t * SB + lane * 2) = f2bf(al);
            pr_r = c_r; pr_k = c_k; pr_v = c_v; pr_w = c_w; pr_a = c_a;
        }
    }
    __syncthreads();
    {
        const int which = wave >> 2, tile = wave & 3, ti = tile >> 1, tj = tile & 1;
        const bf16_t* WT = (const bf16_t*)(P.ws + WS_LORA) + (size_t)which * 512 * 64 + (size_t)(64 * h + 32 * tj + r32) * 64 + 8 * hi;
        const RLAS unsigned char* ap = lds + (which ? L_S1 : L_S0) + (32 * ti + r32) * SB + hi * 16;
        f32x16 acc = zero16();
#pragma unroll
        for (int s = 0; s < 4; ++s) acc = __builtin_amdgcn_mfma_f32_32x32x16_bf16(*(const RLAS bf16x8*)(ap + 32 * s), *(const bf16x8*)(WT + 16 * s), acc, 0, 0, 0);
        RLAS unsigned char* o = lds + (which ? L_F1 : L_F0) + (32 * tj + r32) * 4;
#pragma unroll
        for (int r = 0; r < 16; ++r) *(RLAS float*)(o + (32 * ti + (r & 3) + 8 * (r >> 2) + 4 * hi) * SF) = acc[r];
    }
    __syncthreads();
    {
        const float w0 = P.in[20][ch], a0 = P.in[22][ch], k_k = P.in[24][ch], k_a = P.in[25][ch], r_k = P.in[26][ch];
        const int t0 = 8 * wave;
        float kk[8], kka[8], km[8], ld[8];
        float run = 0.f;
#pragma unroll
        for (int i = 0; i < 8; ++i) {
            const int t = t0 + i;
            const float wa = w0 + *(const RLAS float*)(lds + L_F0 + t * SF + lane * 4), aa = a0 + *(const RLAS float*)(lds + L_F1 + t * SF + lane * 4);
            const float nw = -wa;
            const float spl = nw > 20.f ? nw : log1pf(__expf(nw));
            const float w = -spl - 0.5f;
            float logd = -__expf(w);
            const float a = 1.f / (1.f + __expf(-aa));
            float kx = kr[i] * k_k;
            const float n2 = wave_sum(kx * kx);
            kx = kx / fmaxf(sqrtf(n2), 1e-12f);
            float kmod = kr[i] * (1.f + (a - 1.f) * k_a);
            if (t >= nvalid) { kx = 0.f; kmod = 0.f; logd = 0.f; rr[i] = 0.f; vr[i] = 0.f; }
            kk[i] = kx; kka[i] = kx * a; km[i] = kmod;
            const float scal = wave_sum(rr[i] * kmod * r_k);
            ((bf16_t*)(urec + U_BON))[t * 64 + lane] = f2bf(scal * vr[i]);
            run += logd; ld[i] = run;
        }
        *(RLAS float*)(lds + L_TOT + (wave * 64 + lane) * 4) = run;
        __syncthreads();
        float base = 0.f, lc = 0.f;
#pragma unroll
        for (int w = 0; w < 8; ++w) { const float tw = *(const RLAS float*)(lds + L_TOT + (w * 64 + lane) * 4); if (w < wave) base += tw; lc += tw; }
        if (wave == 0) *(RLAS float*)(lds + L_PC + lane * 4) = __expf(lc);
        float kbt[8], kdt[8], kkt[8];
#pragma unroll
        for (int i = 0; i < 8; ++i) {
            const int t = t0 + i;
            const float L = base + ld[i], Lm1 = L - (i == 0 ? ld[0] : ld[i] - ld[i - 1]);
            const float eL = __expf(L), eLm1 = __expf(Lm1), enL = __expf(-L), eCL = __expf(lc - L);
            kkt[i] = kk[i] * eLm1;
            *(RLAS bf16_t*)(lds + L_S2 + t * SB + lane * 2) = f2bf(kkt[i]);
            *(RLAS bf16_t*)(lds + L_S5 + t * SB + lane * 2) = f2bf(rr[i] * eL);
            *(RLAS bf16_t*)(lds + L_S3 + t * SB + lane * 2) = f2bf(kka[i] * enL);
            *(RLAS bf16_t*)(lds + L_S4 + t * SB + lane * 2) = f2bf(km[i] * enL);
            kbt[i] = kka[i] * eCL; kdt[i] = km[i] * eCL;
        }
        u32x4 w;
        w.x = cvtpk(kbt[0], kbt[1]); w.y = cvtpk(kbt[2], kbt[3]); w.z = cvtpk(kbt[4], kbt[5]); w.w = cvtpk(kbt[6], kbt[7]);
        *(RLAS u32x4*)(lds + L_S6 + lane * SB + t0 * 2) = w;
        w.x = cvtpk(kdt[0], kdt[1]); w.y = cvtpk(kdt[2], kdt[3]); w.z = cvtpk(kdt[4], kdt[5]); w.w = cvtpk(kdt[6], kdt[7]);
        *(RLAS u32x4*)(lds + L_S7 + lane * SB + t0 * 2) = w;
        w.x = cvtpk(vr[0], vr[1]); w.y = cvtpk(vr[2], vr[3]); w.z = cvtpk(vr[4], vr[5]); w.w = cvtpk(vr[6], vr[7]);
        *(RLAS u32x4*)(lds + L_S8 + lane * SB + t0 * 2) = w;
        *(RLAS f32x4*)(lds + L_F2 + lane * SF + t0 * 4) = (f32x4){kkt[0], kkt[1], kkt[2], kkt[3]};
        *(RLAS f32x4*)(lds + L_F2 + lane * SF + t0 * 4 + 16) = (f32x4){kkt[4], kkt[5], kkt[6], kkt[7]};
    }
    __syncthreads();
    {
        const int q = wave >> 1;
#pragma unroll
        for (int tl = 0; tl < 2; ++tl) {
            const int tile = 2 * (wave & 1) + tl, ti = tile >> 1, tj = tile & 1;
            f32x16 acc = zero16();
            if (q == 0) {
                if (!(ti == 0 && tj == 1)) acc = mm_tile(acc, lds + L_S2, 32 * ti, lds + L_S3, 32 * tj, r32, hi);
                const int j = 32 * tj + r32;
#pragma unroll
                for (int g = 0; g < 4; ++g) { const int tb = 32 * ti + 8 * g + 4 * hi;
#pragma unroll
                    for (int i = 0; i < 4; ++i) *(RLAS float*)(lds + L_F0 + j * SF + (i * 16 + (tb >> 2)) * 4) = (j < tb + i) ? acc[4 * g + i] : 0.f; }
            } else {
                const RLAS unsigned char* Am = lds + ((q == 2) ? L_S3 : L_S4);
                const RLAS unsigned char* Bm = lds + ((q == 1) ? L_S2 : L_S5);
                if (!(ti == 1 && tj == 0)) acc = mm_tile(acc, Am, 32 * ti, Bm, 32 * tj, r32, hi);
                const int t = 32 * tj + r32;
                RLAS unsigned char* O = lds + (q == 1 ? L_S0 : q == 2 ? L_S1 : L_S9);
#pragma unroll
                for (int g = 0; g < 4; ++g) { const int jb = 32 * ti + 8 * g + 4 * hi; float v[4];
#pragma unroll
                    for (int i = 0; i < 4; ++i) { const int j = jb + i; const bool keep = (q == 1) ? (j < t) : (j <= t); v[i] = keep ? acc[4 * g + i] : 0.f; }
                    u32x2 pk; pk.x = cvtpk(v[0], v[1]); pk.y = cvtpk(v[2], v[3]);
                    *(RLAS u32x2*)(O + t * SB + jb * 2) = pk; }
            }
        }
    }
    __syncthreads();
    if (wave < 4) {
        const int ti = wave >> 1, tj = wave & 1;
        f32x16 acc = mm_tile(zero16(), lds + L_S0, 32 * ti, lds + L_S8, 32 * tj, r32, hi);
        const int v = 32 * tj + r32;
#pragma unroll
        for (int g = 0; g < 4; ++g) { const int tb = 32 * ti + 8 * g + 4 * hi; *(RLAS f32x4*)(lds + L_F1 + v * SF + tb * 4) = (f32x4){acc[4 * g], acc[4 * g + 1], acc[4 * g + 2], acc[4 * g + 3]}; }
    }
    __syncthreads();
    {
        const int q = lane & 3, col = 16 * wave + (lane >> 2);
        const RLAS unsigned char* rhs = lds + (col < 64 ? L_F2 + col * SF : L_F1 + (col - 64) * SF);
        float R[16];
#pragma unroll
        for (int g = 0; g < 16; ++g) { const f32x4 v = *(const RLAS f32x4*)(rhs + 16 * g); R[g] = q == 0 ? v[0] : q == 1 ? v[1] : q == 2 ? v[2] : v[3]; }
        SolveStep<0>::run(R, lds + L_F0 + q * 64);
        RLAS unsigned char* O = lds + (col < 64 ? L_S2 + col * SB : L_S3 + (col - 64) * SB) + q * 2;
#pragma unroll
        for (int g = 0; g < 16; ++g) *(RLAS bf16_t*)(O + 8 * g) = f2bf(-R[g]);
    }
    __syncthreads();
    {
        const int which = wave >> 1;
#pragma unroll
        for (int tl = 0; tl < 2; ++tl) {
            const int tile = 2 * (wave & 1) + tl, ti = tile >> 1, tj = tile & 1;
            if (which == 0) {
                f32x16 acc = mm_tile(zero16(), lds + L_S2, 32 * ti, lds + L_S6, 32 * tj, r32, hi);
                if (ti == tj) { const float pc = *(const RLAS float*)(lds + L_PC + (32 * tj + r32) * 4);
#pragma unroll
                    for (int r = 0; r < 16; ++r) if (((r & 3) + 8 * (r >> 2) + 4 * hi) == r32) acc[r] += pc; }
#pragma unroll
                for (int sp = 0; sp < 2; ++sp) {
                    u32x4 wh, wl; float lo[8];
                    wh.x = cvtpk(acc[8 * sp], acc[8 * sp + 1]); wh.y = cvtpk(acc[8 * sp + 2], acc[8 * sp + 3]); wh.z = cvtpk(acc[8 * sp + 4], acc[8 * sp + 5]); wh.w = cvtpk(acc[8 * sp + 6], acc[8 * sp + 7]);
                    lo[0] = acc[8 * sp] - bflo(wh.x); lo[1] = acc[8 * sp + 1] - bfhi(wh.x); lo[2] = acc[8 * sp + 2] - bflo(wh.y); lo[3] = acc[8 * sp + 3] - bfhi(wh.y);
                    lo[4] = acc[8 * sp + 4] - bflo(wh.z); lo[5] = acc[8 * sp + 5] - bfhi(wh.z); lo[6] = acc[8 * sp + 6] - bflo(wh.w); lo[7] = acc[8 * sp + 7] - bfhi(wh.w);
                    wl.x = cvtpk(lo[0], lo[1]); wl.y = cvtpk(lo[2], lo[3]); wl.z = cvtpk(lo[4], lo[5]); wl.w = cvtpk(lo[6], lo[7]);
                    unsigned char* f = urec + U_MFRAG + (size_t)(((tj * 4 + (2 * ti + sp)) * 2) * 64 + lane) * 16;
                    *(u32x4*)f = wh; *(u32x4*)(f + 1024) = wl;
                }
            } else if (which == 1) {
                f32x16 acc = mm_tile(zero16(), lds + L_S7, 32 * ti, lds + L_S8, 32 * tj, r32, hi);
                acc = mm_tile(acc, lds + L_S6, 32 * ti, lds + L_S3, 32 * tj, r32, hi);
                float* o = (float*)(urec + U_NRAW) + (size_t)(ti * 2 + tj) * 1024 + lane;
#pragma unroll
                for (int r = 0; r < 16; ++r) o[r * 64] = acc[r];
            } else if (which == 2) {
                f32x16 acc = mm_tile(zero16(), lds + L_S2, 32 * ti, lds + L_S1, 32 * tj, r32, hi);
                const int t = 32 * tj + r32;
#pragma unroll
                for (int g = 0; g < 4; ++g) { const int kb = 32 * ti + 8 * g + 4 * hi;
                    const u32x2 rt = *(const RLAS u32x2*)(lds + L_S5 + t * SB + kb * 2);
                    u32x2 pk; pk.x = cvtpk(acc[4 * g] + bflo(rt.x), acc[4 * g + 1] + bfhi(rt.x)); pk.y = cvtpk(acc[4 * g + 2] + bflo(rt.y), acc[4 * g + 3] + bfhi(rt.y));
                    *(u32x2*)(urec + U_G + (size_t)(t * 64 + kb) * 2) = pk; }
            } else {
                f32x16 acc = mm_tile(zero16(), lds + L_S8, 32 * ti, lds + L_S9, 32 * tj, r32, hi);
                acc = mm_tile(acc, lds + L_S3, 32 * ti, lds + L_S1, 32 * tj, r32, hi);
                float* o = (float*)(urec + U_HRAW) + (size_t)(ti * 2 + tj) * 1024 + lane;
#pragma unroll
                for (int r = 0; r < 16; ++r) o[r * 64] = acc[r];
            }
        }
    }
    __syncthreads();
}

__device__ __forceinline__ void split8(const f32x16& x, int sp, bf16x8& bh, bf16x8& bl) {
    u32x4 wh, wl; float lo[8];
    wh.x = cvtpk(x[8 * sp], x[8 * sp + 1]); wh.y = cvtpk(x[8 * sp + 2], x[8 * sp + 3]); wh.z = cvtpk(x[8 * sp + 4], x[8 * sp + 5]); wh.w = cvtpk(x[8 * sp + 6], x[8 * sp + 7]);
    lo[0] = x[8 * sp] - bflo(wh.x); lo[1] = x[8 * sp + 1] - bfhi(wh.x); lo[2] = x[8 * sp + 2] - bflo(wh.y); lo[3] = x[8 * sp + 3] - bfhi(wh.y);
    lo[4] = x[8 * sp + 4] - bflo(wh.z); lo[5] = x[8 * sp + 5] - bfhi(wh.z); lo[6] = x[8 * sp + 6] - bflo(wh.w); lo[7] = x[8 * sp + 7] - bfhi(wh.w);
    wl.x = cvtpk(lo[0], lo[1]); wl.y = cvtpk(lo[2], lo[3]); wl.z = cvtpk(lo[4], lo[5]); wl.w = cvtpk(lo[6], lo[7]);
    bh = __builtin_bit_cast(bf16x8, wh); bl = __builtin_bit_cast(bf16x8, wl);
}
__device__ __forceinline__ void store_state(float* dst  , const f32x16& s0, const f32x16& s1, int v, int hi) {
#pragma unroll
    for (int g = 0; g < 4; ++g) {
        *(f32x4*)(dst + v * 64 + 8 * g + 4 * hi) = (f32x4){s0[4 * g], s0[4 * g + 1], s0[4 * g + 2], s0[4 * g + 3]};
        *(f32x4*)(dst + v * 64 + 32 + 8 * g + 4 * hi) = (f32x4){s1[4 * g], s1[4 * g + 1], s1[4 * g + 2], s1[4 * g + 3]};
    }
}
struct StepOps { bf16x8 a0h[4], a0l[4], a1h[4], a1l[4]; f32x16 n0, n1; };
__device__ __forceinline__ void scan_load(const unsigned char* urec, int tv, int lane, StepOps& F) {
    const float* nr = (const float*)(urec + U_NRAW) + lane;
#pragma unroll
    for (int r = 0; r < 16; ++r) { F.n0[r] = nr[(size_t)(0 * 2 + tv) * 1024 + r * 64]; F.n1[r] = nr[(size_t)(1 * 2 + tv) * 1024 + r * 64]; }
#pragma unroll
    for (int s = 0; s < 4; ++s) {
        const unsigned char* f0 = urec + U_MFRAG + (size_t)(((0 * 4 + s) * 2) * 64 + lane) * 16;
        const unsigned char* f1 = urec + U_MFRAG + (size_t)(((1 * 4 + s) * 2) * 64 + lane) * 16;
        F.a0h[s] = *(const bf16x8*)f0; F.a0l[s] = *(const bf16x8*)(f0 + 1024); F.a1h[s] = *(const bf16x8*)f1; F.a1l[s] = *(const bf16x8*)(f1 + 1024);
    }
}
__device__ __forceinline__ void scan_compute(StepOps& F, f32x16& s0, f32x16& s1) {
    bf16x8 bh[4], bl[4];
    split8(s0, 0, bh[0], bl[0]); split8(s0, 1, bh[1], bl[1]); split8(s1, 0, bh[2], bl[2]); split8(s1, 1, bh[3], bl[3]);
#pragma unroll
    for (int s = 0; s < 4; ++s) {
        F.n0 = __builtin_amdgcn_mfma_f32_32x32x16_bf16(F.a0h[s], bh[s], F.n0, 0, 0, 0);
        F.n1 = __builtin_amdgcn_mfma_f32_32x32x16_bf16(F.a1h[s], bh[s], F.n1, 0, 0, 0);
        F.n0 = __builtin_amdgcn_mfma_f32_32x32x16_bf16(F.a0h[s], bl[s], F.n0, 0, 0, 0);
        F.n1 = __builtin_amdgcn_mfma_f32_32x32x16_bf16(F.a1h[s], bl[s], F.n1, 0, 0, 0);
        F.n0 = __builtin_amdgcn_mfma_f32_32x32x16_bf16(F.a0l[s], bh[s], F.n0, 0, 0, 0);
        F.n1 = __builtin_amdgcn_mfma_f32_32x32x16_bf16(F.a1l[s], bh[s], F.n1, 0, 0, 0);
    }
    s0 = F.n0; s1 = F.n1;
}
__device__ __forceinline__ void scan_sample(const Ptrs& P, int b, int h, int tv, int lane) {
    const int r32 = lane & 31, hi = lane >> 5, v = 32 * tv + r32;
    f32x16 s0, s1;
    const float* src = P.in[5] + ((size_t)b * 8 + h) * 4096;
#pragma unroll
    for (int g = 0; g < 4; ++g) {
        const f32x4 x0 = *(const f32x4*)(src + v * 64 + 8 * g + 4 * hi), x1 = *(const f32x4*)(src + v * 64 + 32 + 8 * g + 4 * hi);
#pragma unroll
        for (int i = 0; i < 4; ++i) { s0[4 * g + i] = x0[i]; s1[4 * g + i] = x1[i]; }
    }
    StepOps fa;
    scan_load(P.ws + WS_RW + (size_t)(2048 + b * 8 + h) * U_BYTES, tv, lane, fa);
    scan_compute(fa, s0, s1);
    store_state(P.out + O_L0WKV_S + ((size_t)b * 8 + h) * 4096, s0, s1, v, hi);
}
__device__ __forceinline__ void scan_prompt_wg(const Ptrs& P, int h, RLAS unsigned char* lds, int tid) {
    const int lane = tid & 63, wave = __builtin_amdgcn_readfirstlane(tid >> 6), r32 = lane & 31, hi = lane >> 5;
    constexpr int SLOT = 32768;
    const unsigned char* rec0 = P.ws + WS_RW + (size_t)h * U_BYTES;
    const size_t rstep = (size_t)8 * U_BYTES;
    for (int i = tid; i < 2 * 2048; i += 512) { const int st = i >> 11, j = i & 2047; *(RLAS f32x4*)(lds + st * SLOT + j * 16) = *(const f32x4*)(rec0 + st * rstep + (size_t)j * 16); }
    const int hl = (wave - 2) * 64 + lane;
    f32x4 hr[6];
#pragma unroll
    for (int i = 0; i < 6; ++i) hr[i] = (f32x4){0.f, 0.f, 0.f, 0.f};
    if (wave >= 2) {
#pragma unroll
        for (int i = 0; i < 6; ++i) { const int j = hl + 384 * i; if (j < 2048) hr[i] = *(const f32x4*)(rec0 + 2 * rstep + (size_t)j * 16); }
    }
    __syncthreads();
    const int tv = wave & 1, v = 32 * tv + r32;
    f32x16 s0 = zero16(), s1 = zero16();
    float* sst = (float*)(P.ws + WS_SST);
#pragma unroll 1
    for (int c = 0; c < 256; ++c) {
        if (wave >= 2) {
            if (c + 2 < 256) {
                RLAS unsigned char* dst = lds + ((c + 2) & 3) * SLOT;
#pragma unroll
                for (int i = 0; i < 6; ++i) { const int j = hl + 384 * i; if (j < 2048) *(RLAS f32x4*)(dst + j * 16) = hr[i]; }
            }
            if (c + 3 < 256) {
                const unsigned char* src = rec0 + (size_t)(c + 3) * rstep;
#pragma unroll
                for (int i = 0; i < 6; ++i) { const int j = hl + 384 * i; if (j < 2048) hr[i] = *(const f32x4*)(src + (size_t)j * 16); }
            }
        } else {
            store_state(sst + ((size_t)c * 8 + h) * 4096, s0, s1, v, hi);
            const RLAS unsigned char* sl = lds + (c & 3) * SLOT;
            bf16x8 bh[4], bl[4];
            split8(s0, 0, bh[0], bl[0]); split8(s0, 1, bh[1], bl[1]); split8(s1, 0, bh[2], bl[2]); split8(s1, 1, bh[3], bl[3]);
            f32x16 n0, n1;
            { const RLAS float* nr = (const RLAS float*)(sl + 16384) + lane;
#pragma unroll
              for (int r = 0; r < 16; ++r) { n0[r] = nr[(0 * 2 + tv) * 1024 + r * 64]; n1[r] = nr[(1 * 2 + tv) * 1024 + r * 64]; } }
#pragma unroll
            for (int s = 0; s < 4; ++s) {
                const RLAS unsigned char* f0 = sl + (((0 * 4 + s) * 2) * 64 + lane) * 16;
                const RLAS unsigned char* f1 = sl + (((1 * 4 + s) * 2) * 64 + lane) * 16;
                const bf16x8 a0h = *(const RLAS bf16x8*)f0, a0l = *(const RLAS bf16x8*)(f0 + 1024), a1h = *(const RLAS bf16x8*)f1, a1l = *(const RLAS bf16x8*)(f1 + 1024);
                n0 = __builtin_amdgcn_mfma_f32_32x32x16_bf16(a0h, bh[s], n0, 0, 0, 0);
                n1 = __builtin_amdgcn_mfma_f32_32x32x16_bf16(a1h, bh[s], n1, 0, 0, 0);
                n0 = __builtin_amdgcn_mfma_f32_32x32x16_bf16(a0h, bl[s], n0, 0, 0, 0);
                n1 = __builtin_amdgcn_mfma_f32_32x32x16_bf16(a1h, bl[s], n1, 0, 0, 0);
                n0 = __builtin_amdgcn_mfma_f32_32x32x16_bf16(a0l, bh[s], n0, 0, 0, 0);
                n1 = __builtin_amdgcn_mfma_f32_32x32x16_bf16(a1l, bh[s], n1, 0, 0, 0);
            }
            s0 = n0; s1 = n1;
        }
        __syncthreads();
    }
    if (wave < 2) store_state(P.out + O_L0WKV_P + (size_t)h * 4096, s0, s1, v, hi);
    __syncthreads();
}

__device__ __forceinline__ void unit_c(const Ptrs& P, int unit, int lane) {
    const int r32 = lane & 31, hi = lane >> 5;
    const bool samp = unit >= 2048;
    const int h = unit & 7, cb = samp ? (unit - 2048) >> 3 : unit >> 3;
    const int m_base = samp ? TP + 32 * cb : 64 * cb;
    const unsigned char* urec = P.ws + WS_RW + (size_t)unit * U_BYTES;
    const float* S0 = samp ? P.in[5] + ((size_t)cb * 8 + h) * 4096 : (const float*)(P.ws + WS_SST) + ((size_t)cb * 8 + h) * 4096;
    bf16x8 af[2][4];
#pragma unroll
    for (int tvb = 0; tvb < 2; ++tvb)
#pragma unroll
        for (int s = 0; s < 4; ++s) { const float* p = S0 + (32 * tvb + r32) * 64 + 16 * s + 8 * hi; const f32x4 x0 = *(const f32x4*)p, x1 = *(const f32x4*)(p + 4);
            u32x4 w; w.x = cvtpk(x0[0], x0[1]); w.y = cvtpk(x0[2], x0[3]); w.z = cvtpk(x1[0], x1[1]); w.w = cvtpk(x1[2], x1[3]); af[tvb][s] = __builtin_bit_cast(bf16x8, w); }
    const float* lng = P.in[27] + 64 * h; const float* lnb = P.in[28] + 64 * h;
#pragma unroll 1
    for (int tt = 0; tt < (samp ? 1 : 2); ++tt) {
        const int t = 32 * tt + r32;
        f32x16 acc[2];
#pragma unroll
        for (int tvb = 0; tvb < 2; ++tvb) { const float* hr = (const float*)(urec + U_HRAW) + (size_t)(tvb * 2 + tt) * 1024 + lane;
#pragma unroll
            for (int r = 0; r < 16; ++r) acc[tvb][r] = hr[r * 64]; }
        const bf16_t* gp = (const bf16_t*)(urec + U_G) + t * 64 + 8 * hi;
#pragma unroll
        for (int s = 0; s < 4; ++s) { const bf16x8 bfr = *(const bf16x8*)(gp + 16 * s);
            acc[0] = __builtin_amdgcn_mfma_f32_32x32x16_bf16(af[0][s], bfr, acc[0], 0, 0, 0);
            acc[1] = __builtin_amdgcn_mfma_f32_32x32x16_bf16(af[1][s], bfr, acc[1], 0, 0, 0); }
        float sm = 0.f;
#pragma unroll
        for (int r = 0; r < 16; ++r) sm += acc[0][r] + acc[1][r];
        sm += __shfl_xor(sm, 32);
        const float mean = sm * (1.f / 64);
        float sq = 0.f;
#pragma unroll
        for (int r = 0; r < 16; ++r) { const float d0 = acc[0][r] - mean, d1 = acc[1][r] - mean; sq += d0 * d0 + d1 * d1; }
        sq += __shfl_xor(sq, 32);
        const float rstd = rsqrtf(sq * (1.f / 64) + GN_EPS);
        const int m = m_base + t;
        const bf16_t* bon = (const bf16_t*)(urec + U_BON) + t * 64;
        const bf16_t* zb = (const bf16_t*)(P.ws + WS_PROJ0) + (size_t)m * N0P + C_ZB + 64 * h;
        bf16_t* cat = (bf16_t*)(P.ws + WS_CAT) + (size_t)m * D + 512 + 64 * h;
#pragma unroll
        for (int tvb = 0; tvb < 2; ++tvb)
#pragma unroll
            for (int g = 0; g < 4; ++g) {
                const int vb = 32 * tvb + 8 * g + 4 * hi;
                const u32x2 bo = *(const u32x2*)(bon + vb), zz = *(const u32x2*)(zb + vb);
                const f32x4 gg = *(const f32x4*)(lng + vb), bb = *(const f32x4*)(lnb + vb);
                float y[4];
                y[0] = ((acc[tvb][4 * g] - mean) * rstd * gg[0] + bb[0] + bflo(bo.x)) * silu(bflo(zz.x));
                y[1] = ((acc[tvb][4 * g + 1] - mean) * rstd * gg[1] + bb[1] + bfhi(bo.x)) * silu(bfhi(zz.x));
                y[2] = ((acc[tvb][4 * g + 2] - mean) * rstd * gg[2] + bb[2] + bflo(bo.y)) * silu(bflo(zz.y));
                y[3] = ((acc[tvb][4 * g + 3] - mean) * rstd * gg[3] + bb[3] + bfhi(bo.y)) * silu(bfhi(zz.y));
                u32x2 pk; pk.x = cvtpk(y[0], y[1]); pk.y = cvtpk(y[2], y[3]);
                *(u32x2*)(cat + vb) = pk;
            }
    }
}
#undef RLAS
}
#define LAS __attribute__((address_space(3)))
#define XB_TMO      128
#define XB_XCNT(j)  (256  + 64 * (j))
#define XB_XSUB(j)  (1280 + 64 * (j))
#define XB_XGEN(j)  (2304 + 64 * (j))
#define XB_TOP      3328
#define XB_TOPGEN   3392
#define XCD_BAR_WORDS 3456
#define XB_SPIN_CAP (1u << 18)

__device__ __forceinline__ unsigned xb_ld(unsigned* p)              { return __hip_atomic_load(p, __ATOMIC_RELAXED, __HIP_MEMORY_SCOPE_AGENT); }
__device__ __forceinline__ unsigned xb_add(unsigned* p, unsigned v) { return __hip_atomic_fetch_add(p, v, __ATOMIC_RELAXED, __HIP_MEMORY_SCOPE_AGENT); }
__device__ __forceinline__ unsigned xb_xcc_id() { return (unsigned)__builtin_amdgcn_s_getreg((3 << 11) | 20) & 0xFu; }
#define XB_SPIN(cond, bar) do { unsigned _sp = 0; while (cond) { __builtin_amdgcn_s_sleep(1); \
    if ((++_sp & 255u) == 0u) { if (xb_ld(&(bar)[XB_TMO])) break; if (_sp > XB_SPIN_CAP) { atomicAdd(&(bar)[XB_TMO], 1u); break; } } } } while (0)

struct XcdBarrier {
    unsigned* bar; unsigned x;
    volatile LAS unsigned* st;
};

__device__ __forceinline__ XcdBarrier xcd_barrier_post(unsigned* bar, volatile LAS unsigned* st) {
    XcdBarrier b; b.bar = bar; b.x = xb_xcc_id(); b.st = st;
    if (threadIdx.x == 0) (void)xb_add(&bar[XB_XCNT(b.x)], 1u);
    return b;
}
__device__ __forceinline__ void xcd_barrier_complete(unsigned* bar, unsigned x, unsigned& nloc, unsigned& nx) {
    const unsigned G = gridDim.x * gridDim.y * gridDim.z;
    unsigned sum, cnt, mine, sp = 0u;
    for (;;) {
        sum = 0u; cnt = 0u; mine = 0u;
#pragma unroll
        for (unsigned j = 0; j < 16; ++j) { const unsigned c = xb_ld(&bar[XB_XCNT(j)]); sum += c; cnt += (c > 0u) ? 1u : 0u; mine = (j == x) ? c : mine; }
        if (sum == G) break;
        __builtin_amdgcn_s_sleep(1);
        if ((++sp & 255u) == 0u) { if (xb_ld(&bar[XB_TMO])) break; if (sp > XB_SPIN_CAP) { atomicAdd(&bar[XB_TMO], 1u); break; } }
    }
    nloc = mine > 0u ? mine : 1u; nx = cnt > 0u ? cnt : 1u;
}

__device__ __forceinline__ void xcd_barrier(const XcdBarrier& b) {
    asm volatile("s_waitcnt vmcnt(0)" ::: "memory");
    __syncthreads();
    if (threadIdx.x == 0) {
        unsigned* bar = b.bar;
        __builtin_amdgcn_s_waitcnt(0);
        unsigned nloc = b.st[0], nx = b.st[1];
        if (nloc == 0u) { xcd_barrier_complete(bar, b.x, nloc, nx); b.st[0] = nloc; b.st[1] = nx; }
        const unsigned old = xb_add(&bar[XB_XSUB(b.x)], 1u);
        const unsigned gen = old / nloc;
        if (old + 1u == (gen + 1u) * nloc) {
            __builtin_amdgcn_fence(__ATOMIC_RELEASE, "agent");
            asm volatile("s_waitcnt vmcnt(0)" ::: "memory");
            const unsigned og = xb_add(&bar[XB_TOP], 1u);
            const unsigned tg = og / nx;
            if (og + 1u == (tg + 1u) * nx) xb_add(&bar[XB_TOPGEN], 1u);
            else XB_SPIN(xb_ld(&bar[XB_TOPGEN]) == tg, bar);
            __builtin_amdgcn_fence(__ATOMIC_ACQUIRE, "agent");
            xb_add(&bar[XB_XGEN(b.x)], 1u);
            asm volatile("s_waitcnt vmcnt(0)" ::: "memory");
        } else {
            XB_SPIN(xb_ld(&bar[XB_XGEN(b.x)]) == gen, bar);
            __builtin_amdgcn_fence(__ATOMIC_ACQUIRE, "agent");
            asm volatile("s_waitcnt vmcnt(0)" ::: "memory");
        }
    }
    __syncthreads();
}


#ifndef FAST_ATTN0
#define FAST_ATTN0 1
#endif
#ifndef SCAN_IN_MIX
#define SCAN_IN_MIX 1
#endif
#ifndef FAST_RW
#define FAST_RW 1
#endif
#ifndef FAST_ATTN1
#define FAST_ATTN1 1
#endif
#include <hip/hip_cooperative_groups.h>
namespace cg = cooperative_groups;
constexpr int NWAVES = 8, NTHREADS = 512;
constexpr int LDS_BYTES = 147456;
enum Phase { PH_PRO = 0, PH_GEMM1 = 1, PH_TOK = 2, PH_SCAN = 3, PH_MIX = 4, PH_RWC = 5, PH_GEMM2 = 6, PH_GEMM3 = 7, PH_ATTN1 = 8, PH_GEMM4 = 9, PH_END = 10 };
struct Args { Ptrs p; int ph_lo, ph_hi; int pad0, pad1; };

__global__ void __launch_bounds__(NTHREADS, 2) mk_fwd(Args a) {
    extern __shared__ __attribute__((aligned(16))) unsigned char lds[];
    const Ptrs& P = a.p;
    unsigned char* ws = P.ws;
    const int lo = a.ph_lo, hi = a.ph_hi;
    const int tid = threadIdx.x, lane = tid & 63, wave = tid >> 6;
    const int G = gridDim.x, gw = blockIdx.x * NWAVES + wave, NGW = G * NWAVES;
    float* wscr = (float*)lds + wave * 256;
    volatile LAS unsigned* bst = (volatile LAS unsigned*)((LAS unsigned char*)lds + LDS_BYTES - 64);
    if (tid < 2) bst[tid] = 0u;
    __syncthreads();
    XcdBarrier bar = xcd_barrier_post((unsigned*)(ws + WS_CTL) + 4096, bst);
#define IN(k) (lo <= (k) && (k) < hi)
#define SEAM(k) do { if (IN(k) && IN((k) + 1)) xcd_barrier(bar); } while (0)
    if (IN(PH_PRO)) {
        const size_t gt = (size_t)blockIdx.x * NTHREADS + tid, NT = (size_t)G * NTHREADS;
        for (size_t i = gt; i < (size_t)N0P * D; i += NT) nv::d_transpose_w(P.in[10], D, N0, N0P, (bf16_t*)(ws + WS_WT0), nullptr, i);
        for (size_t i = gt; i < (size_t)D * D; i += NT) nv::d_transpose_w(P.in[11], D, D, D, (bf16_t*)(ws + WS_WO0T), nullptr, i);
        for (size_t i = gt; i < (size_t)N1 * D; i += NT) nv::d_transpose_w(P.in[30], D, N1, N1, (bf16_t*)(ws + WS_WT1), P.in[29], i);
        for (size_t i = gt; i < (size_t)D * D; i += NT) nv::d_transpose_w(P.in[31], D, D, D, (bf16_t*)(ws + WS_WO1T), nullptr, i);
        if (blockIdx.x == 0 && tid < 256) nv::d_tables(P, tid);
        for (size_t i = gt; i < 512 * 64; i += NT) { const int c = (int)(i >> 6), l = (int)(i & 63); bf16_t* LT = (bf16_t*)(ws + WS_LORA);
            LT[i] = f2bf(P.in[21][l * 512 + c]); LT[32768 + i] = f2bf(P.in[23][l * 512 + c]); }
        for (int m = gw; m < M; m += NGW) nv::d_rmsnorm_x(P, m, lane);
    }
    SEAM(PH_PRO);
    if (IN(PH_GEMM1)) {
        pg8::Gemm g{(const bf16_t*)(ws + WS_XN0), (const bf16_t*)(ws + WS_WT0), M, N0P, D}; pg8::StaticOrder S; S.init(M, N0P, G, (int)blockIdx.x);
        pg8::EpiProj0F E{(bf16_t*)(ws + WS_PROJ0)};
        pg8::gemm_phase<pg8::EpiProj0F, pg8::StaticOrder, true, true>((LAS unsigned char*)lds, g, S, E);
    }
    SEAM(PH_GEMM1);
    if (IN(PH_TOK)) {
        for (int m = gw; m < M; m += NGW) nv::d_tok0(P, m, lane);
        __syncthreads();
#if FAST_RW
        for (int u = blockIdx.x; u < rw::NUNIT; u += G) rw::unit_a(P, u, (LAS unsigned char*)lds, tid);
#else
        for (int m = blockIdx.x; m < M; m += G) { nv::d_rw_prep(P, m, tid, (float*)lds, (float*)lds + 64); __syncthreads(); }
#endif
    }
    SEAM(PH_TOK);
#if !SCAN_IN_MIX
    if (IN(PH_SCAN)) {
#if FAST_RW
        if (blockIdx.x < 8) rw::scan_prompt_wg(P, (int)blockIdx.x, (LAS unsigned char*)lds, tid);
        else for (int i = gw - 64; i < 512; i += NGW - 64) rw::scan_sample(P, i >> 4, (i >> 1) & 7, i & 1, lane);
#else
        if (gw < 33 * 8) nv::d_rw_scan(P, gw >> 3, gw & 7, lane);
#endif
    }
    SEAM(PH_SCAN);
#endif
    if (IN(PH_MIX)) {
#if SCAN_IN_MIX
        if (blockIdx.x < 8) rw::scan_prompt_wg(P, (int)blockIdx.x, (LAS unsigned char*)lds, tid);
        else for (int i = gw - 64; i < 512; i += NGW - 64) rw::scan_sample(P, i >> 4, (i >> 1) & 7, i & 1, lane);
#endif
#if FAST_ATTN0
        __syncthreads();
        da::phase(P, (LAS unsigned char*)lds, (unsigned*)(ws + WS_CTL), bst + 4, tid);
#else
        for (int i = gw; i < M * 4; i += NGW) nv::d_attn0(P, i >> 2, i & 3, lane, wscr, wscr + 128);
#endif
    }
    SEAM(PH_MIX);
#if FAST_RW
    if (IN(PH_RWC)) { for (int u = gw; u < rw::NUNIT; u += NGW) rw::unit_c(P, u, lane); }
#endif
    SEAM(PH_RWC);
    if (IN(PH_GEMM2)) {
        pg8::Gemm g{(const bf16_t*)(ws + WS_CAT), (const bf16_t*)(ws + WS_WO0T), M, D, D}; pg8::StaticOrder S; S.init(M, D, G, (int)blockIdx.x);
        pg8::EpiY0F E{P};
        pg8::gemm_phase<pg8::EpiY0F, pg8::StaticOrder, true, true>((LAS unsigned char*)lds, g, S, E);
    }
    SEAM(PH_GEMM2);
    if (IN(PH_GEMM3)) {
        pg8::Gemm g{(const bf16_t*)(ws + WS_Y0B), (const bf16_t*)(ws + WS_WT1), M, N1, D}; pg8::StaticOrder S; S.init(M, N1, G, (int)blockIdx.x);
        pg8::EpiL1F E{P};
        pg8::gemm_phase<pg8::EpiL1F, pg8::StaticOrder, true, true>((LAS unsigned char*)lds, g, S, E);
    }
    SEAM(PH_GEMM3);
    if (IN(PH_ATTN1)) {
#if FAST_ATTN1
        sb::phase(P, gw, NGW, lane);
#else
        for (int i = gw; i < M * 16; i += NGW) nv::d_attn1(P, i >> 4, i & 15, lane, wscr, wscr + 64);
#endif
    }
    SEAM(PH_ATTN1);
    if (IN(PH_GEMM4)) {
        pg8::Gemm g{(const bf16_t*)(ws + WS_O1B), (const bf16_t*)(ws + WS_WO1T), M, D, D}; pg8::StaticOrder S; S.init(M, D, G, (int)blockIdx.x);
        pg8::EpiOutF E{P};
        pg8::gemm_phase<pg8::EpiOutF, pg8::StaticOrder, true, true>((LAS unsigned char*)lds, g, S, E);
    }
#undef IN
#undef SEAM
}
extern "C" void kernel_launch(void* const* d_in, const int* in_sizes, int n_in, void* d_out, int out_size, void* d_ws, size_t ws_size, hipStream_t stream) {
    static int grid = 0;
    if (n_in != 32 || (size_t)out_size != O_TOTAL || ws_size < WS_END) { fprintf(stderr, "kernel_launch: unexpected shapes n_in=%d out=%d ws=%zu\n", n_in, out_size, ws_size); return; }
    if (grid == 0) {
        int dev = 0, cus = 0, per_cu = 0;
        (void)hipGetDevice(&dev); (void)hipDeviceGetAttribute(&cus, hipDeviceAttributeMultiprocessorCount, dev);
        (void)hipFuncSetAttribute((const void*)mk_fwd, hipFuncAttributeMaxDynamicSharedMemorySize, LDS_BYTES);
        (void)hipOccupancyMaxActiveBlocksPerMultiprocessor(&per_cu, (const void*)mk_fwd, NTHREADS, LDS_BYTES);
        if (per_cu < 1) { fprintf(stderr, "kernel_launch: occupancy query says %d blocks/CU\n", per_cu); per_cu = 1; }
        grid = (cus > 0 ? cus : 256);
    }
    Args a{};
    for (int i = 0; i < 32; ++i) a.p.in[i] = (const float*)d_in[i];
    a.p.out = (float*)d_out; a.p.ws = (unsigned char*)d_ws; a.ph_lo = 0; a.ph_hi = PH_END;
    (void)hipMemsetAsync((char*)d_ws + WS_CTL, 0, 256 * 1024, stream);
    void* args[] = {&a};
#ifdef REP_PHASE
    a.ph_hi = REP_PHASE + 1;
    (void)hipLaunchCooperativeKernel((const void*)mk_fwd, dim3(grid), dim3(NTHREADS), args, LDS_BYTES, stream);
    (void)hipMemsetAsync((char*)d_ws + WS_CTL, 0, 256 * 1024, stream);
    a.ph_lo = REP_PHASE; a.ph_hi = PH_END;
#endif
    hipError_t e = hipLaunchCooperativeKernel((const void*)mk_fwd, dim3(grid), dim3(NTHREADS), args, LDS_BYTES, stream);
    if (e != hipSuccess) fprintf(stderr, "cooperative launch failed: %s (grid %d)\n", hipGetErrorString(e), grid);
}
```

```cpp
#include <hip/hip_runtime.h>
#include <stdint.h>
#include <cstdio>

typedef unsigned short bf16_t;
__device__ __forceinline__ float bf2f(bf16_t b) { return __uint_as_float(((unsigned)b) << 16); }
__device__ __forceinline__ bf16_t f2bf(float f) { unsigned u = __float_as_uint(f); return (bf16_t)((u + 0x7fffu + ((u >> 16) & 1u)) >> 16); }

constexpr int D = 1024, TP = 16384, NSEQ = 32, TS = 32, MS = NSEQ * TS, M = TP + MS, PAST = 1024;
constexpr int N0 = 4224, N0P = 4352, N1 = 4096;
constexpr int C_Q = 0, C_K = 512, C_V = 1024, C_ZA = 1536, C_PRW = 2048, C_ZB = 3712;
constexpr int RWS = 1664;
constexpr float EPS = 1e-6f, GN_EPS = 64e-5f;
constexpr float LOG2E = 1.4426950408889634f;
constexpr float LAMBDA_INIT = 0.2f;
constexpr float QSCALE = 0.125f * LOG2E;

constexpr size_t O_Y = 0;
constexpr size_t O_L0K_P = (size_t)M * D;
constexpr size_t O_L0V_P = O_L0K_P + (size_t)TP * 512;
constexpr size_t O_L0SH_P = O_L0V_P + (size_t)TP * 512;
constexpr size_t O_L0WKV_P = O_L0SH_P + RWS;
constexpr size_t O_L1K_P = O_L0WKV_P + 8 * 64 * 64;
constexpr size_t O_L1V_P = O_L1K_P + (size_t)TP * 1024;
constexpr size_t O_L0K_S = O_L1V_P + (size_t)TP * 1024;
constexpr size_t O_L0V_S = O_L0K_S + (size_t)MS * 512;
constexpr size_t O_L0SH_S = O_L0V_S + (size_t)MS * 512;
constexpr size_t O_L0WKV_S = O_L0SH_S + (size_t)NSEQ * RWS;
constexpr size_t O_L1K_S = O_L0WKV_S + (size_t)NSEQ * 8 * 64 * 64;
constexpr size_t O_L1V_S = O_L1K_S + (size_t)MS * 1024;
constexpr size_t O_TOTAL = O_L1V_S + (size_t)MS * 1024;
static_assert(O_TOTAL == 72439424, "output size");

__host__ __device__ __forceinline__ size_t off_l0k(int m) { return m < TP ? O_L0K_P + (size_t)m * 512 : O_L0K_S + (size_t)(m - TP) * 512; }
__host__ __device__ __forceinline__ size_t off_l0v(int m) { return m < TP ? O_L0V_P + (size_t)m * 512 : O_L0V_S + (size_t)(m - TP) * 512; }
__host__ __device__ __forceinline__ size_t off_l1k(int m) { return m < TP ? O_L1K_P + (size_t)m * 1024 : O_L1K_S + (size_t)(m - TP) * 1024; }
__host__ __device__ __forceinline__ size_t off_l1v(int m) { return m < TP ? O_L1V_P + (size_t)m * 1024 : O_L1V_S + (size_t)(m - TP) * 1024; }

constexpr size_t MiB = 1u << 20;
constexpr size_t WS_CTL = 0;
constexpr size_t WS_TAB = 512 * 1024;
constexpr size_t WS_WT0 = 1 * MiB, WS_WO0T = 10 * MiB, WS_WT1 = 12 * MiB, WS_WO1T = 20 * MiB, WS_LORA = 22 * MiB;
constexpr size_t WS_CAT = 24 * MiB, WS_XN0 = WS_CAT;
constexpr size_t WS_PROJ0 = 58 * MiB;
constexpr size_t WS_Q0 = 203 * MiB, WS_K0 = 220 * MiB;
constexpr size_t WS_RW = 237 * MiB;
constexpr size_t WS_SST = 407 * MiB;
constexpr size_t WS_END = 441 * MiB;
constexpr size_t WS_Y0 = WS_PROJ0, WS_Y0B = 126 * MiB, WS_SSQ = 160 * MiB;
constexpr size_t WS_O1B = WS_Q0;
constexpr size_t WS_Q1 = 237 * MiB, WS_K1 = 271 * MiB, WS_V1T = 305 * MiB, WS_Z1 = 339 * MiB;
static_assert(WS_PROJ0 + (size_t)M * N0P * 2 <= WS_Q0, "proj0");
static_assert(WS_WT0 + (size_t)N0P * D * 2 <= WS_WO0T, "wt0");

struct Tab {
    float lam;
    float m0;
    float pad[2];
    float bias[4][256];
    float biasfar[4];
};

struct Ptrs {
    const float* in[32];
    float* out;
    unsigned char* ws;
};

__device__ __forceinline__ const float* xrow(const Ptrs& P, int m) { return m < TP ? P.in[0] + (size_t)m * D : P.in[1] + (size_t)(m - TP) * D; }

__device__ __forceinline__ float wave_sum(float v) {
#pragma unroll
    for (int o = 1; o < 64; o <<= 1) v += __shfl_xor(v, o);
    return v;
}
__device__ __forceinline__ float wave_max(float v) {
#pragma unroll
    for (int o = 1; o < 64; o <<= 1) v = fmaxf(v, __shfl_xor(v, o));
    return v;
}
__device__ __forceinline__ float silu(float x) { return x / (1.f + __expf(-x)); }

__device__ __forceinline__ int t5_bucket(int rel) {
    int n = rel < 0 ? -rel : rel;
    int b;
    if (n < 8) b = n;
    else { unsigned n2 = (unsigned)n * (unsigned)n; int lg = 31 - __clz((int)n2); b = 8 + (lg - 6); if (b > 15) b = 15; }
    return (rel > 0 ? 16 : 0) + b;
}
namespace nv {

__device__ __forceinline__ void d_transpose_w(const float* W, int K, int N, int NP, bf16_t* WT, const float* g, size_t i) {
    int n = (int)(i / K), k = (int)(i % K);
    float v = 0.f;
    if (n < N) { v = W[(size_t)k * N + n]; if (g) v *= g[k]; }
    WT[i] = f2bf(v);
}
__global__ void k_transpose_w(const float* W, int K, int N, int NP, bf16_t* WT, const float* g) {
    size_t i = (size_t)blockIdx.x * blockDim.x + threadIdx.x; if (i < (size_t)NP * K) d_transpose_w(W, K, N, NP, WT, g, i); }
__global__ void k_lora_t(const float* w_up, const float* a_up, float* LT) {
    int i = blockIdx.x * blockDim.x + threadIdx.x;
    if (i >= 512 * 64) return;
    int c = i / 64, l = i % 64;
    LT[i] = w_up[l * 512 + c];
    LT[512 * 64 + i] = a_up[l * 512 + c];
}
__device__ __forceinline__ void d_tables(const Ptrs& P, int tid) {
    Tab* T = (Tab*)(P.ws + WS_TAB);
    if (tid < 64) {
        float a = P.in[14][tid] * P.in[15][tid], b = P.in[16][tid] * P.in[17][tid];
        a = wave_sum(a); b = wave_sum(b);
        float gq = fabsf(P.in[12][tid]), gk = fabsf(P.in[13][tid]);
        gq = wave_max(gq); gk = wave_max(gk);
        if (tid == 0) { T->lam = __expf(a) - __expf(b) + LAMBDA_INIT; T->m0 = 8.f * gq * gk * LOG2E * 1.0001f + 0.01f; }
    }
    if (tid < 255) { int rel = tid - 191; int b = t5_bucket(rel); for (int h = 0; h < 4; ++h) T->bias[h][tid] = P.in[8][b * 4 + h]; }
    if (tid == 255) for (int h = 0; h < 4; ++h) { T->bias[h][255] = 0.f; T->biasfar[h] = P.in[8][15 * 4 + h]; }
}
__global__ void k_tables(Ptrs P) { d_tables(P, threadIdx.x); }
__device__ __forceinline__ void d_rmsnorm_x(const Ptrs& P, int w, int lane) {
    typedef float f4 __attribute__((ext_vector_type(4)));
    const f4* x = (const f4*)xrow(P, w) + lane; const f4* g = (const f4*)P.in[9] + lane;
    unsigned long long* o = (unsigned long long*)((bf16_t*)(P.ws + WS_XN0) + (size_t)w * D) + lane;
    f4 v[4]; float s = 0.f;
#pragma unroll
    for (int j = 0; j < 4; ++j) { v[j] = x[64 * j]; s += (v[j][0] * v[j][0] + v[j][1] * v[j][1]) + (v[j][2] * v[j][2] + v[j][3] * v[j][3]); }
    s = wave_sum(s);
    const float r = rsqrtf(s * (1.f / D) + EPS);
#pragma unroll
    for (int j = 0; j < 4; ++j) { const f4 gg = g[64 * j];
        const unsigned lo = (unsigned)f2bf(v[j][0] * r * gg[0]) | ((unsigned)f2bf(v[j][1] * r * gg[1]) << 16), hi = (unsigned)f2bf(v[j][2] * r * gg[2]) | ((unsigned)f2bf(v[j][3] * r * gg[3]) << 16);
        o[64 * j] = (unsigned long long)lo | ((unsigned long long)hi << 32); }
}
__global__ void k_rmsnorm_x(Ptrs P) { int w = (blockIdx.x * blockDim.x + threadIdx.x) >> 6; if (w < M) d_rmsnorm_x(P, w, threadIdx.x & 63); }

template <class Epi>
__global__ void __launch_bounds__(256) k_gemm(const bf16_t* A, const bf16_t* Bt, int K, Epi epi) {
    __shared__ float As[16][65], Bs[16][65];
    const int tx = threadIdx.x & 15, ty = threadIdx.x >> 4;
    const int m0 = blockIdx.y * 64, n0 = blockIdx.x * 64;
    float acc[4][4];
#pragma unroll
    for (int i = 0; i < 4; ++i)
#pragma unroll
        for (int j = 0; j < 4; ++j) acc[i][j] = 0.f;
    for (int k0 = 0; k0 < K; k0 += 16) {
#pragma unroll
        for (int i = 0; i < 4; ++i) {
            int e = threadIdx.x + 256 * i, r = e >> 4, c = e & 15;
            As[c][r] = bf2f(A[(size_t)(m0 + r) * K + k0 + c]);
            Bs[c][r] = bf2f(Bt[(size_t)(n0 + r) * K + k0 + c]);
        }
        __syncthreads();
#pragma unroll
        for (int kk = 0; kk < 16; ++kk) {
            float a[4], b[4];
#pragma unroll
            for (int i = 0; i < 4; ++i) { a[i] = As[kk][ty * 4 + i]; b[i] = Bs[kk][tx * 4 + i]; }
#pragma unroll
            for (int i = 0; i < 4; ++i)
#pragma unroll
                for (int j = 0; j < 4; ++j) acc[i][j] += a[i] * b[j];
        }
        __syncthreads();
    }
#pragma unroll
    for (int i = 0; i < 4; ++i)
#pragma unroll
        for (int j = 0; j < 4; ++j) epi(m0 + ty * 4 + i, n0 + tx * 4 + j, acc[i][j]);
}
struct EpiProj0 { bf16_t* O; __device__ void operator()(int m, int n, float v) const { O[(size_t)m * N0P + n] = f2bf(v); } };
struct EpiY0 {
    Ptrs P;
    __device__ void operator()(int m, int n, float v) const {
        float y = v + xrow(P, m)[n];
        ((float*)(P.ws + WS_Y0))[(size_t)m * D + n] = y;
        ((bf16_t*)(P.ws + WS_Y0B))[(size_t)m * D + n] = f2bf(y);
    }
};
struct EpiL1 {
    Ptrs P;
    __device__ void operator()(int m, int n, float v) const {
        const float* ss = (const float*)(P.ws + WS_SSQ) + (size_t)m * 16;
        float t = 0.f; for (int j = 0; j < 16; ++j) t += ss[j];
        float r = rsqrtf(t * (1.f / D) + EPS);
        float val = v * r;
        int c = n & 1023;
        if (n < 1024) ((bf16_t*)(P.ws + WS_Q1))[(size_t)m * D + c] = f2bf(val * QSCALE);
        else if (n < 2048) { ((bf16_t*)(P.ws + WS_K1))[(size_t)m * D + c] = f2bf(val); P.out[off_l1k(m) + c] = val; }
        else if (n < 3072) { ((bf16_t*)(P.ws + WS_V1T))[(size_t)c * M + m] = f2bf(val); P.out[off_l1v(m) + c] = val; }
        else ((bf16_t*)(P.ws + WS_Z1))[(size_t)m * D + c] = f2bf(val);
    }
};
struct EpiOut { Ptrs P; __device__ void operator()(int m, int n, float v) const { P.out[O_Y + (size_t)m * D + n] = v + ((const float*)(P.ws + WS_Y0))[(size_t)m * D + n]; } };

__device__ __forceinline__ void d_ssq(const Ptrs& P, int w, int lane) {
    const float* y = (const float*)(P.ws + WS_Y0) + (size_t)w * D;
    float* ss = (float*)(P.ws + WS_SSQ) + (size_t)w * 16;
    for (int j = 0; j < 16; ++j) { float v = y[64 * j + lane]; float s = wave_sum(v * v); if (lane == 0) ss[j] = s; }
}
__global__ void k_ssq(Ptrs P) { int w = (blockIdx.x * blockDim.x + threadIdx.x) >> 6; if (w < M) d_ssq(P, w, threadIdx.x & 63); }

__device__ __forceinline__ void d_tok0(const Ptrs& P, int m, int lane) {
    const bf16_t* pr = (const bf16_t*)(P.ws + WS_PROJ0) + (size_t)m * N0P;
    bf16_t* q0 = (bf16_t*)(P.ws + WS_Q0) + (size_t)m * 512;
    bf16_t* k0 = (bf16_t*)(P.ws + WS_K0) + (size_t)m * 512;
    const float gq = P.in[12][lane], gk = P.in[13][lane];
#pragma unroll 1
    for (int g = 0; g < 8; ++g) {
        float q = bf2f(pr[C_Q + 64 * g + lane]), k = bf2f(pr[C_K + 64 * g + lane]);
        float sq = wave_sum(q * q), sk = wave_sum(k * k);
        float qn = q * rsqrtf(sq * (1.f / 64) + EPS) * gq, kn = k * rsqrtf(sk * (1.f / 64) + EPS) * gk;
        q0[64 * g + lane] = f2bf(qn * QSCALE);
        k0[64 * g + lane] = f2bf(kn);
        P.out[off_l0k(m) + 64 * g + lane] = kn;
        P.out[off_l0v(m) + 64 * g + lane] = bf2f(pr[C_V + 64 * g + lane]);
    }
    int last = -1; size_t so = 0;
    if (m == TP - 1) { last = 1; so = O_L0SH_P; }
    else if (m >= TP && ((m - TP) & 31) == 31) { last = 1; so = O_L0SH_S + (size_t)((m - TP) >> 5) * RWS; }
    if (last > 0) for (int c = lane; c < RWS; c += 64) P.out[so + c] = bf2f(pr[C_PRW + c]);
}
__global__ void k_tok0(Ptrs P) { int m = (blockIdx.x * blockDim.x + threadIdx.x) >> 6; if (m < M) d_tok0(P, m, threadIdx.x & 63); }

template <class SP> __device__ __forceinline__ void d_attn0(const Ptrs& P, int m, int h, int lane, SP sqw, SP spw) {
    const Tab* T = (const Tab*)(P.ws + WS_TAB);
    const bf16_t* Q0 = (const bf16_t*)(P.ws + WS_Q0); const bf16_t* K0 = (const bf16_t*)(P.ws + WS_K0);
    const bf16_t* PR = (const bf16_t*)(P.ws + WS_PROJ0);
    int qpos, nk, b = 0; bool samp = m >= TP;
    if (!samp) { qpos = m; nk = ((m >> 6) + 1) * 64; } else { b = (m - TP) >> 5; qpos = PAST + ((m - TP) & 31); nk = PAST + TS; }
    sqw[lane] = bf2f(Q0[(size_t)m * 512 + 128 * h + lane]);
    sqw[64 + lane] = bf2f(Q0[(size_t)m * 512 + 128 * h + 64 + lane]);
    float m1 = -1e30f, m2 = -1e30f, l1 = 0.f, l2 = 0.f, o1[2] = {0.f, 0.f}, o2[2] = {0.f, 0.f};
    for (int j0 = 0; j0 < nk; j0 += 64) {
        int j = j0 + lane;
        bool valid = j < nk && ((j >> 6) <= (qpos >> 6));
        float s1 = 0.f, s2 = 0.f;
        if (valid) {
            if (samp && j < PAST) {
                const float* kr = P.in[2] + (((size_t)b * PAST + j) * 4 + h) * 128;
                for (int d = 0; d < 64; ++d) { s1 += sqw[d] * bf2f(f2bf(kr[d])); s2 += sqw[64 + d] * bf2f(f2bf(kr[64 + d])); }
            } else {
                int km = samp ? TP + 32 * b + (j - PAST) : j;
                const bf16_t* kr = K0 + (size_t)km * 512 + 128 * h;
                for (int d = 0; d < 64; ++d) { s1 += sqw[d] * bf2f(kr[d]); s2 += sqw[64 + d] * bf2f(kr[64 + d]); }
            }
            int rel = j - qpos; float bias = rel <= -128 ? T->biasfar[h] : T->bias[h][rel + 191];
            s1 += bias * LOG2E; s2 += bias * LOG2E;
        } else { s1 = -1e30f; s2 = -1e30f; }
        float bm1 = wave_max(s1), bm2 = wave_max(s2);
        float n1 = fmaxf(m1, bm1), n2 = fmaxf(m2, bm2);
        float f1 = exp2f(m1 - n1), f2 = exp2f(m2 - n2);
        float p1 = valid ? exp2f(s1 - n1) : 0.f, p2 = valid ? exp2f(s2 - n2) : 0.f;
        l1 = l1 * f1 + wave_sum(p1); l2 = l2 * f2 + wave_sum(p2);
        o1[0] *= f1; o1[1] *= f1; o2[0] *= f2; o2[1] *= f2; m1 = n1; m2 = n2;
        spw[lane] = p1; spw[64 + lane] = p2;
        __builtin_amdgcn_s_waitcnt(0);
        int jn = min(64, nk - j0);
        for (int jj = 0; jj < jn; ++jj) {
            int jp = j0 + jj; float a1 = spw[jj], a2 = spw[64 + jj];
            float v0, v1;
            if (samp && jp < PAST) { const float* vr = P.in[3] + (((size_t)b * PAST + jp) * 4 + h) * 128; v0 = bf2f(f2bf(vr[lane])); v1 = bf2f(f2bf(vr[64 + lane])); }
            else { int km = samp ? TP + 32 * b + (jp - PAST) : jp; const bf16_t* vr = PR + (size_t)km * N0P + C_V + 128 * h; v0 = bf2f(vr[lane]); v1 = bf2f(vr[64 + lane]); }
            o1[0] += a1 * v0; o1[1] += a1 * v1; o2[0] += a2 * v0; o2[1] += a2 * v1;
        }
    }
    const float lam = T->lam;
    float a0 = o1[0] / l1 - lam * o2[0] / l2, a1 = o1[1] / l1 - lam * o2[1] / l2;
    float ss = wave_sum(a0 * a0 + a1 * a1);
    float r = rsqrtf(ss * (1.f / 128) + EPS) * (1.f - LAMBDA_INIT);
    const float* sg = P.in[18];
    const bf16_t* za = PR + (size_t)m * N0P + C_ZA + 128 * h;
    bf16_t* cat = (bf16_t*)(P.ws + WS_CAT) + (size_t)m * D + 128 * h;
    cat[lane] = f2bf(a0 * r * sg[lane] * silu(bf2f(za[lane])));
    cat[64 + lane] = f2bf(a1 * r * sg[64 + lane] * silu(bf2f(za[64 + lane])));
}
__global__ void __launch_bounds__(256) k_attn0(Ptrs P) {
    __shared__ float sq[4][128], sp[4][128];
    const int wid = threadIdx.x >> 6, lane = threadIdx.x & 63, gw = blockIdx.x * 4 + wid;
    if ((gw >> 2) < M) d_attn0(P, gw >> 2, gw & 3, lane, &sq[wid][0], &sp[wid][0]);
}

constexpr size_t RWN = (size_t)M * 512;
__device__ __forceinline__ float prw_prev(const Ptrs& P, int m, int c) {
    if (m < TP) return m == 0 ? 0.f : bf2f(((const bf16_t*)(P.ws + WS_PROJ0))[(size_t)(m - 1) * N0P + C_PRW + c]);
    int i = (m - TP) & 31, b = (m - TP) >> 5;
    if (i == 0) return P.in[4][(size_t)b * RWS + c];
    return bf2f(((const bf16_t*)(P.ws + WS_PROJ0))[(size_t)(m - 1) * N0P + C_PRW + c]);
}
template <class SP> __device__ __forceinline__ void d_rw_prep(const Ptrs& P, int m, int c, SP swl, SP sal) {
    const bf16_t* pr = (const bf16_t*)(P.ws + WS_PROJ0) + (size_t)m * N0P + C_PRW;
    const float* mu = P.in[19];
#define NV_MIX(col) (bf2f(pr[col]) + (prw_prev(P, m, (col)) - bf2f(pr[col])) * mu[col])
    float r = NV_MIX(c), kr = NV_MIX(512 + c), vr = NV_MIX(1024 + c);
    if (c < 64) swl[c] = tanhf(NV_MIX(1536 + c)); else if (c < 128) sal[c - 64] = NV_MIX(1600 + c - 64);
#undef NV_MIX
    __syncthreads();
    float wa = P.in[20][c], aa = P.in[22][c];
    const float* wup = P.in[21]; const float* aup = P.in[23];
#pragma unroll 4
    for (int l = 0; l < 64; ++l) { wa += swl[l] * wup[l * 512 + c]; aa += sal[l] * aup[l * 512 + c]; }
    float spl = (-wa > 20.f) ? -wa : log1pf(__expf(-wa));
    float w = -spl - 0.5f;
    float dec = __expf(-__expf(w));
    float a = 1.f / (1.f + __expf(-aa));
    float kk = kr * P.in[24][c];
    float n2 = wave_sum(kk * kk);
    kk = kk / fmaxf(sqrtf(n2), 1e-12f);
    float km = kr * (1.f + (a - 1.f) * P.in[25][c]);
    float* R = (float*)(P.ws + WS_RW);
    size_t o = (size_t)m * 512 + c;
    R[o] = r; R[RWN + o] = dec; R[2 * RWN + o] = kk; R[3 * RWN + o] = kk * a; R[4 * RWN + o] = km; R[5 * RWN + o] = vr;
}
__global__ void __launch_bounds__(512) k_rw_prep(Ptrs P) { __shared__ float swl[64], sal[64]; d_rw_prep(P, blockIdx.x, threadIdx.x, &swl[0], &sal[0]); }
__device__ __forceinline__ void d_rw_scan(const Ptrs& P, int seq, int h, int lane) {
    const int m0 = seq == 0 ? 0 : TP + 32 * (seq - 1), T = seq == 0 ? TP : TS;
    float S[64];
    const float* s0 = P.in[5] + (((size_t)(seq > 0 ? seq - 1 : 0) * 8 + h) * 64 + lane) * 64;
#pragma unroll
    for (int k = 0; k < 64; ++k) S[k] = seq == 0 ? 0.f : s0[k];
    const float* R = (const float*)(P.ws + WS_RW);
    const float rk = P.in[26][h * 64 + lane], lg = P.in[27][h * 64 + lane], lb = P.in[28][h * 64 + lane];
    for (int t = 0; t < T; ++t) {
        size_t o = (size_t)(m0 + t) * 512 + h * 64 + lane;
        float r = R[o], dec = R[RWN + o], kk = R[2 * RWN + o], kka = R[3 * RWN + o], km = R[4 * RWN + o], v = R[5 * RWN + o];
        float sa = 0.f;
#pragma unroll
        for (int k = 0; k < 64; ++k) sa += S[k] * __shfl(kk, k);
        float ov = 0.f;
#pragma unroll
        for (int k = 0; k < 64; ++k) { S[k] = S[k] * __shfl(dec, k) - sa * __shfl(kka, k) + v * __shfl(km, k); ov += S[k] * __shfl(r, k); }
        float mu = wave_sum(ov) * (1.f / 64);
        float dv = ov - mu;
        float var = wave_sum(dv * dv) * (1.f / 64);
        float y = dv * rsqrtf(var + GN_EPS) * lg + lb;
        float bonus = wave_sum(r * km * rk) * v;
        int mm = m0 + t;
        float zb = bf2f(((const bf16_t*)(P.ws + WS_PROJ0))[(size_t)mm * N0P + C_ZB + h * 64 + lane]);
        ((bf16_t*)(P.ws + WS_CAT))[(size_t)mm * D + 512 + h * 64 + lane] = f2bf((y + bonus) * silu(zb));
    }
    float* so = P.out + (seq == 0 ? O_L0WKV_P + ((size_t)h * 64 + lane) * 64 : O_L0WKV_S + ((((size_t)(seq - 1)) * 8 + h) * 64 + lane) * 64);
#pragma unroll
    for (int k = 0; k < 64; ++k) so[k] = S[k];
}
__global__ void __launch_bounds__(64) k_rw_scan(Ptrs P) { d_rw_scan(P, blockIdx.x >> 3, blockIdx.x & 7, threadIdx.x); }

template <class SP> __device__ __forceinline__ void d_attn1(const Ptrs& P, int m, int h, int lane, SP sqw, SP saw) {
    const bf16_t* Q1 = (const bf16_t*)(P.ws + WS_Q1); const bf16_t* K1 = (const bf16_t*)(P.ws + WS_K1);
    const bf16_t* V1T = (const bf16_t*)(P.ws + WS_V1T);
    bool samp = m >= TP; int b = 0, qpos;
    if (!samp) qpos = m; else { b = (m - TP) >> 5; qpos = PAST + ((m - TP) & 31); }
    sqw[lane] = bf2f(Q1[(size_t)m * D + 64 * h + lane]);
    float run = 0.f, o = 0.f;
    for (int s0 = qpos - 1; s0 >= 0; s0 -= 64) {
        int s = s0 - lane;
        bool valid = s >= 0;
        float z = 0.f;
        if (valid) {
            if (samp && s < PAST) { const float* kr = P.in[6] + (((size_t)b * PAST + s) * 16 + h) * 64; for (int d = 0; d < 64; ++d) z += sqw[d] * bf2f(f2bf(kr[d])); }
            else { int km = samp ? TP + 32 * b + (s - PAST) : s; const bf16_t* kr = K1 + (size_t)km * D + 64 * h; for (int d = 0; d < 64; ++d) z += sqw[d] * bf2f(kr[d]); }
        }
        float spl = valid ? log2f(1.f + exp2f(z)) : 0.f;
        float inc = spl;
#pragma unroll
        for (int off = 1; off < 64; off <<= 1) { float t = __shfl_up(inc, off); if (lane >= off) inc += t; }
        float a = valid ? exp2f(z - inc - run) : 0.f;
        saw[lane] = a;
        run += __shfl(inc, 63);
        __builtin_amdgcn_s_waitcnt(0);
        int jn = min(64, s0 + 1);
        for (int jj = 0; jj < jn; ++jj) {
            int sp_ = s0 - jj; float v;
            if (samp && sp_ < PAST) v = bf2f(f2bf(P.in[7][(((size_t)b * PAST + sp_) * 16 + h) * 64 + lane]));
            else { int km = samp ? TP + 32 * b + (sp_ - PAST) : sp_; v = bf2f(V1T[(size_t)(64 * h + lane) * M + km]); }
            o += saw[jj] * v;
        }
        if (run > 200.f) break;
    }
    float z1 = bf2f(((const bf16_t*)(P.ws + WS_Z1))[(size_t)m * D + 64 * h + lane]);
    ((bf16_t*)(P.ws + WS_O1B))[(size_t)m * D + 64 * h + lane] = f2bf(o * silu(z1));
}
__global__ void __launch_bounds__(256) k_attn1(Ptrs P) {
    __shared__ float sq[4][64], sa[4][64];
    const int wid = threadIdx.x >> 6, lane = threadIdx.x & 63, gw = blockIdx.x * 4 + wid;
    if ((gw >> 4) < M) d_attn1(P, gw >> 4, gw & 15, lane, &sq[wid][0], &sa[wid][0]);
}

}
namespace pg8 {
#define PG8_LAS __attribute__((address_space(3)))
typedef unsigned short bf16_t;
typedef short bf16x8 __attribute__((ext_vector_type(8)));
typedef float f32x4 __attribute__((ext_vector_type(4)));
typedef unsigned u32x4 __attribute__((ext_vector_type(4)));
constexpr int BM = 256, BK = 64, HALF = 128, HTB = HALF * BK * 2  , STAGE_BYTES = 8 * HTB, NXCD = 8, WGM = 8;

__host__ __device__ __forceinline__ int lds_byte(int r, int c) { const int st = (r >> 4) * 2 + (c >> 5), rr = r & 15, cc = c & 31, ob = rr * 64 + cc * 2; return st * 1024 + (ob ^ (((ob >> 9) & 1) << 5)); }
__host__ __device__ __forceinline__ void stage_rc(int b, int& R, int& C) { const int st = b / 1024, sb = b % 1024, swz = sb ^ (((sb >> 9) & 1) << 5); R = (st >> 1) * 16 + swz / 64; C = (st & 1) * 32 + (swz % 64) / 2; }
__host__ __device__ __forceinline__ int perm32(int rho) { const int n = rho >> 4, i = rho & 15; return 8 * (i >> 2) + 4 * n + (i & 3); }

struct Unit { int pm, pn; };
struct Gemm { const bf16_t* A; const bf16_t* Bt; int M, N, K; };

struct StaticOrder {
    int nM, nN, nwg, G, c;
    __host__ __device__ void init(int M, int N, int G_, int c_) { nM = M / BM; nN = N / BM; nwg = nM * nN; G = G_; c = c_; }
    __host__ __device__ bool next(int i, Unit& u) const {
        const long L = (long)i * G + c; if (L >= nwg) return false;
        int wgid = (int)L; { const int q = nwg / NXCD, r = nwg % NXCD, xcd = wgid % NXCD, off = wgid / NXCD; wgid = (xcd < r ? xcd * (q + 1) : r * (q + 1) + (xcd - r) * q) + off; }
        const int nig = WGM * nN, gid = wgid / nig, fm = gid * WGM, gsz = (nM - fm) < WGM ? (nM - fm) : WGM;
        u.pm = fm + ((wgid % nig) % gsz); u.pn = (wgid % nig) / gsz; return true;
    }
    __device__ __forceinline__ void a_ready(const Unit&) const {}
    __device__ __forceinline__ void done(const Unit&) const {}
};


__device__ __forceinline__ unsigned cvt_pk_bf16(float lo, float hi) { unsigned r; asm volatile("v_cvt_pk_bf16_f32 %0, %1, %2" : "=v"(r) : "v"(lo), "v"(hi)); return r; }
__device__ __forceinline__ u32x4 pack8(const f32x4& v0, const f32x4& v1) { u32x4 w; w.x = cvt_pk_bf16(v0[0], v0[1]); w.y = cvt_pk_bf16(v0[2], v0[3]); w.z = cvt_pk_bf16(v1[0], v1[1]); w.w = cvt_pk_bf16(v1[2], v1[3]); return w; }

struct EpiProj0F {
    static constexpr bool PERM = true, AFTER_DRAIN = false;
    bf16_t* O;
    __device__ __forceinline__ void operator()(const f32x4 (&acc)[2][2][4][2], const Unit& u, int wr, int wc, int fr, int fq) const {
        const int row0 = u.pm * BM + wr * 64 + fr, col0 = u.pn * BM + wc * 32 + 8 * fq;
#pragma unroll
        for (int ai = 0; ai < 2; ++ai)
#pragma unroll
            for (int m = 0; m < 4; ++m) { bf16_t* rowp = O + (size_t)(row0 + ai * HALF + m * 16) * N0P + col0;
#pragma unroll
                for (int bj = 0; bj < 2; ++bj) *(u32x4*)(rowp + bj * HALF) = pack8(acc[ai][bj][m][0], acc[ai][bj][m][1]); }
    }
};
struct EpiY0F {
    static constexpr bool PERM = true, AFTER_DRAIN = false;
    Ptrs P;
    __device__ __forceinline__ void operator()(const f32x4 (&acc)[2][2][4][2], const Unit& u, int wr, int wc, int fr, int fq) const {
        const int row0 = u.pm * BM + wr * 64 + fr, col0 = u.pn * BM + wc * 32 + 8 * fq;
        float* Y0 = (float*)(P.ws + WS_Y0); bf16_t* YB = (bf16_t*)(P.ws + WS_Y0B); float* SSQ = (float*)(P.ws + WS_SSQ);
#pragma unroll
        for (int ai = 0; ai < 2; ++ai)
#pragma unroll
            for (int m = 0; m < 4; ++m) { const int row = row0 + ai * HALF + m * 16; const float* xr = xrow(P, row) + col0; float ss = 0.f;
#pragma unroll
                for (int bj = 0; bj < 2; ++bj) {
                    const f32x4 y0 = acc[ai][bj][m][0] + *(const f32x4*)(xr + bj * HALF), y1 = acc[ai][bj][m][1] + *(const f32x4*)(xr + bj * HALF + 4);
                    *(f32x4*)(Y0 + (size_t)row * D + col0 + bj * HALF) = y0; *(f32x4*)(Y0 + (size_t)row * D + col0 + bj * HALF + 4) = y1;
                    *(u32x4*)(YB + (size_t)row * D + col0 + bj * HALF) = pack8(y0, y1);
                    ss += (y0[0] * y0[0] + y0[1] * y0[1]) + (y0[2] * y0[2] + y0[3] * y0[3]) + (y1[0] * y1[0] + y1[1] * y1[1]) + (y1[2] * y1[2] + y1[3] * y1[3]); }
                ss += __shfl_xor(ss, 16); ss += __shfl_xor(ss, 32);
                if (fq == 0) SSQ[(size_t)row * 16 + u.pn * 4 + wc] = ss; }
    }
};
struct EpiL1F {
    static constexpr bool PERM = true, AFTER_DRAIN = false;
    Ptrs P;
    __device__ __forceinline__ void operator()(const f32x4 (&acc)[2][2][4][2], const Unit& u, int wr, int wc, int fr, int fq) const {
        const int row0 = u.pm * BM + wr * 64 + fr, colt = u.pn * BM, reg = colt >> 10, c0 = (colt & 1023) + wc * 32 + 8 * fq;
        const float* SSQ = (const float*)(P.ws + WS_SSQ);
#pragma unroll
        for (int ai = 0; ai < 2; ++ai)
#pragma unroll
            for (int m = 0; m < 4; ++m) { const int row = row0 + ai * HALF + m * 16;
                const f32x4* sp = (const f32x4*)(SSQ + (size_t)row * 16); const f32x4 s0 = sp[0], s1 = sp[1], s2 = sp[2], s3 = sp[3];
                const f32x4 st = (s0 + s1) + (s2 + s3); const float rs = rsqrtf(((st[0] + st[1]) + (st[2] + st[3])) * (1.f / D) + EPS);
#pragma unroll
                for (int bj = 0; bj < 2; ++bj) { const int c = c0 + bj * HALF; f32x4 v0 = acc[ai][bj][m][0] * rs, v1 = acc[ai][bj][m][1] * rs;
                    if (reg == 0) { *(u32x4*)((bf16_t*)(P.ws + WS_Q1) + (size_t)row * D + c) = pack8(v0 * QSCALE, v1 * QSCALE); }
                    else if (reg == 1) { *(u32x4*)((bf16_t*)(P.ws + WS_K1) + (size_t)row * D + c) = pack8(v0, v1); float* o = P.out + off_l1k(row) + c; *(f32x4*)o = v0; *(f32x4*)(o + 4) = v1; }
                    else if (reg == 2) { bf16_t* vt = (bf16_t*)(P.ws + WS_V1T) + (size_t)c * M + row;
#pragma unroll
                        for (int j = 0; j < 4; ++j) { vt[(size_t)j * M] = f2bf(v0[j]); vt[(size_t)(4 + j) * M] = f2bf(v1[j]); }
                        float* o = P.out + off_l1v(row) + c; *(f32x4*)o = v0; *(f32x4*)(o + 4) = v1; }
                    else { *(u32x4*)((bf16_t*)(P.ws + WS_Z1) + (size_t)row * D + c) = pack8(v0, v1); } } }
    }
};
struct EpiOutF {
    static constexpr bool PERM = true, AFTER_DRAIN = false;
    Ptrs P;
    __device__ __forceinline__ void operator()(const f32x4 (&acc)[2][2][4][2], const Unit& u, int wr, int wc, int fr, int fq) const {
        const int row0 = u.pm * BM + wr * 64 + fr, col0 = u.pn * BM + wc * 32 + 8 * fq;
        const float* Y0 = (const float*)(P.ws + WS_Y0);
#pragma unroll
        for (int ai = 0; ai < 2; ++ai)
#pragma unroll
            for (int m = 0; m < 4; ++m) { const size_t ro = (size_t)(row0 + ai * HALF + m * 16) * D + col0;
#pragma unroll
                for (int bj = 0; bj < 2; ++bj) {
                    *(f32x4*)(P.out + O_Y + ro + bj * HALF) = acc[ai][bj][m][0] + *(const f32x4*)(Y0 + ro + bj * HALF);
                    *(f32x4*)(P.out + O_Y + ro + bj * HALF + 4) = acc[ai][bj][m][1] + *(const f32x4*)(Y0 + ro + bj * HALF + 4); } }
    }
};
template <class Epi, class Sched, bool ALIGN_EPI = false, bool SP2 = false>
__device__ __forceinline__ void gemm_phase(PG8_LAS unsigned char* lds, const Gemm g, const Sched& S, const Epi& E) {
    const int tid = threadIdx.x, wid = __builtin_amdgcn_readfirstlane(tid >> 6), lane = tid & 63, wr = wid >> 2, wc = wid & 3, fr = lane & 15, fq = lane >> 4;
    const int K = g.K, nt = K / BK;
    unsigned voffA[2], voffB[2];
#pragma unroll
    for (int i = 0; i < 2; ++i) { int R, C; stage_rc(tid * 16 + i * 8192, R, C); const int Rb = Epi::PERM ? ((R & ~31) + perm32(R & 31)) : R;
        voffA[i] = (unsigned)(R * K + C) * 2u; voffB[i] = (unsigned)(Rb * K + C) * 2u; }
    const size_t kstep = (size_t)(BK * 2);
    const size_t hstep = (size_t)HALF * K * 2;
    const size_t tstep = 2 * hstep;
    const unsigned ldsw = (unsigned)wid * 1024u;
    const int aoff = lds_byte(wr * 64 + fr, fq * 8), boff = lds_byte(wc * 32 + fr, fq * 8);
#define PG8_SA(b, h) (((b) * 2 + (h)) * HTB)
#define PG8_SB(b, h) ((4 + (b) * 2 + (h)) * HTB)
#define PG8_STAGE(bufoff, gbase, voff) do { _Pragma("unroll") for (int _i = 0; _i < 2; ++_i) \
        __builtin_amdgcn_global_load_lds((const unsigned*)((const char*)(gbase) + (voff)[_i]), (PG8_LAS unsigned*)(lds + (bufoff) + ldsw + _i * 8192), 16, 0, 0); } while (0)
#define PG8_LDA(dst, b, h) do { _Pragma("unroll") for (int m = 0; m < 4; ++m) _Pragma("unroll") for (int k = 0; k < 2; ++k) dst[m][k] = *(const PG8_LAS bf16x8*)(lds + PG8_SA(b, h) + aoff + m * 2048 + k * 1024); } while (0)
#define PG8_LDB(dst, b, h) do { _Pragma("unroll") for (int n = 0; n < 2; ++n) _Pragma("unroll") for (int k = 0; k < 2; ++k) dst[n][k] = *(const PG8_LAS bf16x8*)(lds + PG8_SB(b, h) + boff + n * 2048 + k * 1024); } while (0)
#define PG8_MMA(ai, bj, At, Bt) do { __builtin_amdgcn_s_setprio(1); _Pragma("unroll") for (int m = 0; m < 4; ++m) _Pragma("unroll") for (int n = 0; n < 2; ++n) _Pragma("unroll") for (int k = 0; k < 2; ++k) \
        acc[ai][bj][m][n] = __builtin_amdgcn_mfma_f32_16x16x32_bf16(Bt[n][k], At[m][k], acc[ai][bj][m][n], 0, 0, 0); __builtin_amdgcn_s_setprio(0); } while (0)
#define PG8_WAIT_V(n) asm volatile("s_waitcnt vmcnt(" #n ")" ::: "memory")
#define PG8_WAIT_L(n) asm volatile("s_waitcnt lgkmcnt(" #n ")" ::: "memory")
#define PG8_BAR __builtin_amdgcn_s_barrier()
#define PG8_SCHED __builtin_amdgcn_sched_barrier(0)
    Unit cur, nxt; int ui = 0;
    if (!S.next(0, cur)) return;
    f32x4 acc[2][2][4][2];
#pragma unroll
    for (int a = 0; a < 2; ++a)
#pragma unroll
        for (int b = 0; b < 2; ++b)
#pragma unroll
            for (int m = 0; m < 4; ++m)
#pragma unroll
                for (int n = 0; n < 2; ++n) acc[a][b][m][n] = (f32x4){0.f, 0.f, 0.f, 0.f};
    bf16x8 At[4][2], B0[2][2], B1[2][2];
    const char* cA = (const char*)g.A + (size_t)cur.pm * tstep; const char* cB = (const char*)g.Bt + (size_t)cur.pn * tstep;
    S.a_ready(cur);
    if constexpr (SP2) {
        PG8_STAGE(PG8_SB(0, 0), cB, voffB); PG8_STAGE(PG8_SB(0, 1), cB + hstep, voffB); PG8_STAGE(PG8_SA(0, 0), cA, voffA); PG8_STAGE(PG8_SA(0, 1), cA + hstep, voffA);
        if (wr == 1) PG8_BAR;
        PG8_WAIT_V(2); PG8_BAR;
        PG8_STAGE(PG8_SB(1, 0), cB + kstep, voffB); PG8_STAGE(PG8_SA(1, 0), cA + kstep, voffA); PG8_STAGE(PG8_SB(1, 1), cB + hstep + kstep, voffB);
        PG8_WAIT_V(6); PG8_BAR;
    } else {
        PG8_STAGE(PG8_SB(0, 0), cB, voffB); PG8_STAGE(PG8_SA(0, 0), cA, voffA); PG8_STAGE(PG8_SB(0, 1), cB + hstep, voffB); PG8_STAGE(PG8_SA(0, 1), cA + hstep, voffA);
        if (wr == 1) PG8_BAR;
        PG8_WAIT_V(4); PG8_BAR;
        PG8_STAGE(PG8_SB(1, 0), cB + kstep, voffB); PG8_STAGE(PG8_SA(1, 0), cA + kstep, voffA); PG8_STAGE(PG8_SB(1, 1), cB + hstep + kstep, voffB);
        PG8_WAIT_V(6); PG8_BAR;
    }
    for (;;) {
        const bool has_next = S.next(ui + 1, nxt);
        const char* nA = has_next ? (const char*)g.A + (size_t)nxt.pm * tstep : cA; const char* nB = has_next ? (const char*)g.Bt + (size_t)nxt.pn * tstep : cB;
        for (int t = 0; t < nt; t += 2) {
            const bool last = (t == nt - 2);
            const char* a1 = cA + (size_t)(t + 1) * kstep;
            const char* a2 = last ? nA : cA + (size_t)(t + 2) * kstep; const char* b2 = last ? nB : cB + (size_t)(t + 2) * kstep;
            const char* a3 = a2 + kstep; const char* b3 = b2 + kstep;
            if (last && has_next) S.a_ready(nxt);
            if constexpr (SP2) {
            PG8_LDB(B0, 0, 0); PG8_LDB(B1, 0, 1); PG8_SCHED; PG8_LDA(At, 0, 0); PG8_STAGE(PG8_SA(1, 1), a1 + hstep, voffA);
            PG8_WAIT_V(8); PG8_WAIT_L(0); PG8_BAR; PG8_MMA(0, 0, At, B0); PG8_MMA(0, 1, At, B1); PG8_BAR; PG8_SCHED;
            PG8_LDA(At, 0, 1); PG8_STAGE(PG8_SB(0, 0), b2, voffB); PG8_STAGE(PG8_SB(0, 1), b2 + hstep, voffB); PG8_STAGE(PG8_SA(0, 0), a2, voffA);
            PG8_WAIT_V(8); PG8_WAIT_L(0); PG8_BAR; PG8_MMA(1, 0, At, B0); PG8_MMA(1, 1, At, B1); PG8_BAR; PG8_SCHED;
            PG8_LDB(B0, 1, 0); PG8_LDB(B1, 1, 1); PG8_SCHED; PG8_LDA(At, 1, 0); PG8_STAGE(PG8_SA(0, 1), a2 + hstep, voffA);
            PG8_WAIT_V(8); PG8_WAIT_L(0); PG8_BAR; PG8_MMA(0, 0, At, B0); PG8_MMA(0, 1, At, B1); PG8_BAR; PG8_SCHED;
            PG8_LDA(At, 1, 1); PG8_STAGE(PG8_SB(1, 0), b3, voffB); PG8_STAGE(PG8_SB(1, 1), b3 + hstep, voffB); PG8_STAGE(PG8_SA(1, 0), a3, voffA);
            PG8_WAIT_V(8); PG8_WAIT_L(0); PG8_BAR; PG8_MMA(1, 0, At, B0); PG8_MMA(1, 1, At, B1); PG8_BAR; PG8_SCHED;
            } else {
            PG8_LDB(B0, 0, 0); PG8_SCHED; PG8_LDA(At, 0, 0); PG8_STAGE(PG8_SA(1, 1), a1 + hstep, voffA);
            PG8_WAIT_L(8); PG8_BAR; PG8_WAIT_L(0); PG8_MMA(0, 0, At, B0); PG8_BAR; PG8_SCHED;
            PG8_LDB(B1, 0, 1); PG8_STAGE(PG8_SB(0, 0), b2, voffB);
            PG8_BAR; PG8_WAIT_L(0); PG8_MMA(0, 1, At, B1); PG8_BAR;
            PG8_LDA(At, 0, 1); PG8_STAGE(PG8_SA(0, 0), a2, voffA);
            PG8_BAR; PG8_WAIT_L(0); PG8_MMA(1, 0, At, B0); PG8_BAR; PG8_SCHED;
            PG8_STAGE(PG8_SB(0, 1), b2 + hstep, voffB);
            PG8_WAIT_V(6); PG8_BAR; PG8_MMA(1, 1, At, B1); PG8_BAR;
            PG8_LDB(B0, 1, 0); PG8_SCHED; PG8_LDA(At, 1, 0); PG8_STAGE(PG8_SA(0, 1), a2 + hstep, voffA);
            PG8_WAIT_L(8); PG8_BAR; PG8_WAIT_L(0); PG8_MMA(0, 0, At, B0); PG8_BAR; PG8_SCHED;
            PG8_LDB(B1, 1, 1); PG8_STAGE(PG8_SB(1, 0), b3, voffB);
            PG8_BAR; PG8_WAIT_L(0); PG8_MMA(0, 1, At, B1); PG8_BAR;
            PG8_LDA(At, 1, 1); PG8_STAGE(PG8_SA(1, 0), a3, voffA);
            PG8_BAR; PG8_WAIT_L(0); PG8_MMA(1, 0, At, B0); PG8_BAR; PG8_SCHED;
            PG8_STAGE(PG8_SB(1, 1), b3 + hstep, voffB);
            PG8_WAIT_V(6); PG8_BAR; PG8_MMA(1, 1, At, B1); PG8_BAR;
            }
        }
        if constexpr (ALIGN_EPI) { if (wr == 0) PG8_BAR; }
        if constexpr (!Epi::AFTER_DRAIN) { E(acc, cur, wr, wc, fr, fq); S.done(cur); }
        if (!has_next) break;
#pragma unroll
        for (int a = 0; a < 2; ++a)
#pragma unroll
            for (int b = 0; b < 2; ++b)
#pragma unroll
                for (int m = 0; m < 4; ++m)
#pragma unroll
                    for (int n = 0; n < 2; ++n) acc[a][b][m][n] = (f32x4){0.f, 0.f, 0.f, 0.f};
        cur = nxt; cA = nA; cB = nB; ++ui;
        if constexpr (ALIGN_EPI) { if (wr == 1) PG8_BAR; }
    }
    PG8_WAIT_V(0);
    if constexpr (!ALIGN_EPI) { if (wr == 0) PG8_BAR; }
    PG8_BAR;
    if constexpr (Epi::AFTER_DRAIN) { E.fused(acc, cur, wr, wc, fr, fq, lds, wid, lane); S.done(cur); }
#undef PG8_SA
#undef PG8_SB
#undef PG8_STAGE
#undef PG8_LDA
#undef PG8_LDB
#undef PG8_MMA
#undef PG8_WAIT_V
#undef PG8_WAIT_L
#undef PG8_BAR
#undef PG8_SCHED
}
}
namespace da {
#define DLAS __attribute__((address_space(3)))
typedef short bf16x8 __attribute__((ext_vector_type(8)));
typedef short s16x4 __attribute__((ext_vector_type(4)));
typedef float f32x16 __attribute__((ext_vector_type(16)));
typedef float f32x4 __attribute__((ext_vector_type(4)));
typedef unsigned u32x4 __attribute__((ext_vector_type(4)));

constexpr int KROW = 272, KBUF = 64 * KROW, VBUF = 16384;
constexpr int OFF_K = 0, OFF_V = 2 * KBUF;
constexpr int OFF_STAGE = 0;
constexpr int OFF_LST = 131072;
constexpr int OFF_BIAS = OFF_LST + 1024;
constexpr int DA_LDS_END = OFF_BIAS + 1024;

struct Unit { int kind, h, idx; };

__device__ __forceinline__ unsigned cvtpk(float lo, float hi) { unsigned r; asm volatile("v_cvt_pk_bf16_f32 %0, %1, %2" : "=v"(r) : "v"(lo), "v"(hi)); return r; }
__device__ __forceinline__ u32x4 pack8(const f32x4& a, const f32x4& b) { u32x4 w; w.x = cvtpk(a[0], a[1]); w.y = cvtpk(a[2], a[3]); w.z = cvtpk(b[0], b[1]); w.w = cvtpk(b[2], b[3]); return w; }

struct Stage { f32x4 kA0, kA1, vA0, vA1, kB0, kB1, vB0, vB1; };
template <int KIND> __device__ __forceinline__ void chunk_issue(const Ptrs& P, const Unit& u, int t, int c, f32x4& k0, f32x4& k1, f32x4& v0, f32x4& v1) {
    const int row = c >> 4, ch = c & 15;
    if (KIND == 0 || t == 16) {
        const int m = (KIND == 0) ? 64 * t + row : TP + 32 * u.idx + (row & 31);
        const bf16_t* kp = (const bf16_t*)(P.ws + WS_K0) + (size_t)m * 512 + 128 * u.h + ch * 8;
        const bf16_t* vp = (const bf16_t*)(P.ws + WS_PROJ0) + (size_t)m * N0P + C_V + 128 * u.h + ch * 8;
        f32x4 kv = *(const f32x4*)kp, vv = *(const f32x4*)vp;
        if (KIND != 0 && row >= 32) { kv = (f32x4){0.f, 0.f, 0.f, 0.f}; vv = kv; }
        k0 = kv; v0 = vv;
    } else {
        const size_t ro = (((size_t)u.idx * PAST + 64 * t + row) * 4 + u.h) * 128 + ch * 8;
        const float* kp = P.in[2] + ro; const float* vp = P.in[3] + ro;
        k0 = *(const f32x4*)kp; k1 = *(const f32x4*)(kp + 4); v0 = *(const f32x4*)vp; v1 = *(const f32x4*)(vp + 4);
    }
}
template <int KIND> __device__ __forceinline__ void chunk_write(int t, int c, DLAS unsigned char* lds, int buf, const f32x4& k0, const f32x4& k1, const f32x4& v0, const f32x4& v1) {
    const int row = c >> 4, ch = c & 15;
    DLAS unsigned char* kd = lds + OFF_K + buf * KBUF + row * KROW + ch * 16;
    DLAS unsigned char* vd = lds + OFF_V + buf * VBUF + (ch >> 2) * 4096 + row * 64 + (ch & 3) * 16;
    if (KIND == 0 || t == 16) { *(DLAS f32x4*)kd = k0; *(DLAS f32x4*)vd = v0; }
    else { *(DLAS u32x4*)kd = pack8(k0, k1); *(DLAS u32x4*)vd = pack8(v0, v1); }
}
#define TILE_ISSUE(t_) do { chunk_issue<KIND>(P, u, (t_), tid, S.kA0, S.kA1, S.vA0, S.vA1); chunk_issue<KIND>(P, u, (t_), tid + 512, S.kB0, S.kB1, S.vB0, S.vB1); } while (0)
#define TILE_WRITE(t_, buf_) do { chunk_write<KIND>((t_), tid, lds, (buf_), S.kA0, S.kA1, S.vA0, S.vA1); chunk_write<KIND>((t_), tid + 512, lds, (buf_), S.kB0, S.kB1, S.vB0, S.vB1); } while (0)

template <int KIND> __device__ __forceinline__ void unit_run(const Ptrs& P, const Unit& u0, DLAS unsigned char* lds, int tid) {
    const Unit u{KIND, u0.h, u0.idx};
    asm volatile("" : "+v"(tid));
    const int lane = tid & 63, wave = __builtin_amdgcn_readfirstlane(tid >> 6), r32 = lane & 31, hi = lane >> 5, mp = wave >> 2, w4 = wave & 3;
    constexpr bool is_s = KIND != 0;
    int m0row, qpos0, NT, cq;
    if (!is_s) { m0row = 128 * u.idx + 32 * w4; qpos0 = m0row; NT = 2 * u.idx + 2; cq = m0row >> 6; }
    else { m0row = TP + 32 * u.idx; qpos0 = PAST; NT = 17; cq = 16; }
    const Tab* T = (const Tab*)(P.ws + WS_TAB);
    DLAS float* lst = (DLAS float*)(lds + OFF_LST);
    DLAS float* bl = (DLAS float*)(lds + OFF_BIAS);
    if (tid < 256) { bl[tid] = (T->bias[u.h][tid] - T->biasfar[u.h]) * LOG2E; lst[tid] = 0.f; }
    bf16x8 qf[4];
    { const bf16_t* qp = (const bf16_t*)(P.ws + WS_Q0) + (size_t)(m0row + r32) * 512 + 128 * u.h + 64 * mp + 8 * hi;
#pragma unroll
      for (int s = 0; s < 4; ++s) qf[s] = *(const bf16x8*)(qp + 16 * s); }
    f32x16 o[4];
#pragma unroll
    for (int d = 0; d < 4; ++d)
#pragma unroll
        for (int r = 0; r < 16; ++r) o[d][r] = 0.f;
    float lsum = 0.f;
    Stage S;
    { const f32x4 z = (f32x4){0.f, 0.f, 0.f, 0.f}; S.kA0 = z; S.kA1 = z; S.vA0 = z; S.vA1 = z; S.kB0 = z; S.kB1 = z; S.vB0 = z; S.vB1 = z; }
    TILE_ISSUE(0);
    TILE_WRITE(0, 0);
    __syncthreads();
    const int vaddr = (4 * hi + ((lane & 15) >> 2)) * 64 + (16 * ((lane >> 4) & 1) + 4 * (lane & 3)) * 2;
    for (int t = 0; t < NT; ++t) {
        const int buf = t & 1;
        const bool has_next = t + 1 < NT;
        if (has_next) TILE_ISSUE(t + 1);
        const bool active = is_s ? ((t & 3) == w4) : (t <= cq);
        if (active) {
            const DLAS unsigned char* kb = lds + OFF_K + buf * KBUF + r32 * KROW + mp * 128 + hi * 16;
            f32x16 p0, p1;
#pragma unroll
            for (int r = 0; r < 16; ++r) { p0[r] = 0.f; p1[r] = 0.f; }
#pragma unroll
            for (int s = 0; s < 4; ++s) {
                const bf16x8 a0 = *(const DLAS bf16x8*)(kb + s * 32), a1 = *(const DLAS bf16x8*)(kb + 32 * KROW + s * 32);
                p0 = __builtin_amdgcn_mfma_f32_32x32x16_bf16(a0, qf[s], p0, 0, 0, 0);
                p1 = __builtin_amdgcn_mfma_f32_32x32x16_bf16(a1, qf[s], p1, 0, 0, 0);
            }
            if (t >= cq - 2) {
                const int rb = 64 * t - qpos0 - r32 + 191 + 4 * hi;
#pragma unroll
                for (int r = 0; r < 16; ++r) { const int kk = (r & 3) + 8 * (r >> 2); p0[r] += bl[rb + kk]; p1[r] += bl[rb + 32 + kk]; }
            }
#pragma unroll
            for (int r = 0; r < 16; ++r) { p0[r] = __builtin_amdgcn_exp2f(p0[r]); p1[r] = __builtin_amdgcn_exp2f(p1[r]); }
            if (is_s && t == 16) {
#pragma unroll
                for (int r = 0; r < 16; ++r) p1[r] = 0.f;
            }
            float sa = 0.f, sb = 0.f;
#pragma unroll
            for (int r = 0; r < 16; ++r) { sa += p0[r]; sb += p1[r]; }
            lsum += sa + sb;
            bf16x8 pa[4];
            pa[0] = __builtin_bit_cast(bf16x8, pack8((f32x4){p0[0], p0[1], p0[2], p0[3]}, (f32x4){p0[4], p0[5], p0[6], p0[7]}));
            pa[1] = __builtin_bit_cast(bf16x8, pack8((f32x4){p0[8], p0[9], p0[10], p0[11]}, (f32x4){p0[12], p0[13], p0[14], p0[15]}));
            pa[2] = __builtin_bit_cast(bf16x8, pack8((f32x4){p1[0], p1[1], p1[2], p1[3]}, (f32x4){p1[4], p1[5], p1[6], p1[7]}));
            pa[3] = __builtin_bit_cast(bf16x8, pack8((f32x4){p1[8], p1[9], p1[10], p1[11]}, (f32x4){p1[12], p1[13], p1[14], p1[15]}));
            const DLAS unsigned char* vb = lds + OFF_V + buf * VBUF + vaddr;
#pragma unroll
            for (int d = 0; d < 4; ++d)
#pragma unroll
                for (int k = 0; k < 4; ++k) {
                    const s16x4 lo = __builtin_bit_cast(s16x4, __builtin_amdgcn_ds_read_tr16_b64_v4i16((DLAS s16x4*)(vb + d * 4096 + k * 1024)));
                    const s16x4 hh = __builtin_bit_cast(s16x4, __builtin_amdgcn_ds_read_tr16_b64_v4i16((DLAS s16x4*)(vb + d * 4096 + k * 1024 + 512)));
                    const bf16x8 bf = (bf16x8){lo[0], lo[1], lo[2], lo[3], hh[0], hh[1], hh[2], hh[3]};
                    o[d] = __builtin_amdgcn_mfma_f32_32x32x16_bf16(pa[k], bf, o[d], 0, 0, 0);
                    if (k == 3) __builtin_amdgcn_sched_barrier(0);
                }
        }
        if (has_next) TILE_WRITE(t + 1, buf ^ 1);
        __syncthreads();
    }
    lsum += __shfl_xor(lsum, 32);
    DLAS float* stage = (DLAS float*)(lds + OFF_STAGE);
    {
        const int rowb = is_s ? 0 : 32 * w4;
        DLAS float* st0 = stage + (mp * 128 + rowb + 4 * hi) * 128 + r32;
#pragma unroll 1
        for (int round = 0; round < (is_s ? 4 : 1); ++round) {
            if (!is_s || round == w4) {
                const bool first = !is_s || round == 0;
#pragma unroll
                for (int d = 0; d < 4; ++d)
#pragma unroll
                    for (int r = 0; r < 16; ++r) {
                        DLAS float* st = st0 + ((r & 3) + 8 * (r >> 2)) * 128 + d * 32;
                        *st = first ? o[d][r] : *st + o[d][r];
                    }
                if (hi == 0) { DLAS float* lp = &lst[mp * 128 + rowb + r32]; *lp = first ? lsum : *lp + lsum; }
            }
            __syncthreads();
        }
    }
    {
        const int nrow = is_s ? 4 : 16;
        const float lam = T->lam;
        const float* sg = P.in[18];
        for (int i = 0; i < nrow; ++i) {
            const int row = wave * nrow + i;
            const float l1 = lst[row], l2 = lst[128 + row];
            const float il1 = 1.f / l1, il2 = lam / l2;
            const float a0 = stage[row * 128 + lane] * il1 - stage[(128 + row) * 128 + lane] * il2;
            const float a1 = stage[row * 128 + 64 + lane] * il1 - stage[(128 + row) * 128 + 64 + lane] * il2;
            const float ss = wave_sum(a0 * a0 + a1 * a1);
            const float rr = rsqrtf(ss * (1.f / 128) + EPS) * (1.f - LAMBDA_INIT);
            const int m = is_s ? TP + 32 * u.idx + row : 128 * u.idx + row;
            const bf16_t* za = (const bf16_t*)(P.ws + WS_PROJ0) + (size_t)m * N0P + C_ZA + 128 * u.h;
            bf16_t* cat = (bf16_t*)(P.ws + WS_CAT) + (size_t)m * D + 128 * u.h;
            cat[lane] = f2bf(a0 * rr * sg[lane] * silu(bf2f(za[lane])));
            cat[64 + lane] = f2bf(a1 * rr * sg[64 + lane] * silu(bf2f(za[64 + lane])));
        }
    }
    __syncthreads();
}

__device__ __forceinline__ void phase(const Ptrs& P, DLAS unsigned char* lds, unsigned* qhead, volatile DLAS unsigned* slot, int tid) {
#pragma unroll 1
    for (;;) {
        if (tid == 0) *slot = __hip_atomic_fetch_add(qhead, 1u, __ATOMIC_RELAXED, __HIP_MEMORY_SCOPE_AGENT);
        __syncthreads();
        const int i = (int)*slot;
        __syncthreads();
        if (i >= 640) break;
        if (i < 512) unit_run<0>(P, Unit{0, i & 3, 127 - (i >> 2)}, lds, tid);
        else unit_run<1>(P, Unit{1, (i - 512) & 3, (i - 512) >> 2}, lds, tid);
    }
}
#undef DLAS
}
namespace sb {
typedef short bf16x8 __attribute__((ext_vector_type(8)));
typedef short s16x4 __attribute__((ext_vector_type(4)));
typedef float f32x16 __attribute__((ext_vector_type(16)));
typedef float f32x4 __attribute__((ext_vector_type(4)));
typedef unsigned u32x4 __attribute__((ext_vector_type(4)));
typedef unsigned u32x2 __attribute__((ext_vector_type(2)));

__device__ __forceinline__ unsigned cvtpk(float lo, float hi) { unsigned r; asm volatile("v_cvt_pk_bf16_f32 %0, %1, %2" : "=v"(r) : "v"(lo), "v"(hi)); return r; }
constexpr float RUN_EXIT = 160.f;

template <int SAMPLE> __device__ __forceinline__ void unit_run(const Ptrs& P, int b, int h, int qt, int lane) {
    const int r32 = lane & 31, hi = lane >> 5;
    const bf16_t* Q1 = (const bf16_t*)(P.ws + WS_Q1); const bf16_t* K1 = (const bf16_t*)(P.ws + WS_K1); const bf16_t* V1T = (const bf16_t*)(P.ws + WS_V1T);
    const int m0 = SAMPLE ? TP + 32 * b : 32 * qt;
    const int q0 = SAMPLE ? PAST : 32 * qt;
    bf16x8 qf[4];
    { const bf16_t* qp = Q1 + (size_t)(m0 + r32) * D + 64 * h + 8 * hi;
#pragma unroll
      for (int s = 0; s < 4; ++s) qf[s] = *(const bf16x8*)(qp + 16 * s); }
    f32x16 o0, o1;
#pragma unroll
    for (int r = 0; r < 16; ++r) { o0[r] = 0.f; o1[r] = 0.f; }
    float run = 0.f;
#pragma unroll 1
    for (int k0 = q0; k0 >= 0; k0 -= 32) {
        const bool diag = (k0 == q0);
        const bool cache = SAMPLE && !diag;
        f32x16 p;
#pragma unroll
        for (int r = 0; r < 16; ++r) p[r] = 0.f;
        if (!cache) {
            const int mk = SAMPLE ? TP + 32 * b : k0;
            const bf16_t* kp = K1 + (size_t)(mk + r32) * D + 64 * h + 8 * hi;
#pragma unroll
            for (int s = 0; s < 4; ++s) { const bf16x8 a = *(const bf16x8*)(kp + 16 * s); p = __builtin_amdgcn_mfma_f32_32x32x16_bf16(a, qf[s], p, 0, 0, 0); }
        } else {
            const float* kp = P.in[6] + (((size_t)b * PAST + k0 + r32) * 16 + h) * 64 + 8 * hi;
#pragma unroll
            for (int s = 0; s < 4; ++s) { const f32x4 x0 = *(const f32x4*)(kp + 16 * s), x1 = *(const f32x4*)(kp + 16 * s + 4);
                u32x4 w; w.x = cvtpk(x0[0], x0[1]); w.y = cvtpk(x0[2], x0[3]); w.z = cvtpk(x1[0], x1[1]); w.w = cvtpk(x1[2], x1[3]);
                p = __builtin_amdgcn_mfma_f32_32x32x16_bf16(__builtin_bit_cast(bf16x8, w), qf[s], p, 0, 0, 0); }
        }
        float sp[16];
#pragma unroll
        for (int r = 0; r < 16; ++r) {
            const int kk = (r & 3) + 8 * (r >> 2) + 4 * hi;
            const float e = __builtin_amdgcn_exp2f(p[r]);
            float s = __builtin_amdgcn_logf(1.f + e);
            if (diag && !(kk < r32)) s = 0.f;
            sp[r] = s;
        }
        float a[4], bsum[4];
#pragma unroll
        for (int g = 0; g < 4; ++g) { a[g] = (sp[4 * g] + sp[4 * g + 1]) + (sp[4 * g + 2] + sp[4 * g + 3]); bsum[g] = __shfl_xor(a[g], 32); }
        float Tg[4];
        { float accA = 0.f, accB = 0.f;
#pragma unroll
          for (int g = 3; g >= 0; --g) {
              const float pb = hi ? accB : accB + bsum[g];
              Tg[g] = accA + pb;
              accA += a[g]; accB += bsum[g];
          }
          const float tot = accA + accB;
#pragma unroll
          for (int g = 0; g < 4; ++g) {
              float c = Tg[g] + run;
#pragma unroll
              for (int i = 3; i >= 0; --i) {
                  const int r = 4 * g + i, kk = i + 8 * g + 4 * hi;
                  c += sp[r];
                  float w = __builtin_amdgcn_exp2f(p[r] - c);
                  if (diag && !(kk < r32)) w = 0.f;
                  p[r] = w;
              }
          }
          run += tot;
        }
        u32x4 w0, w1;
        w0.x = cvtpk(p[0], p[1]); w0.y = cvtpk(p[2], p[3]); w0.z = cvtpk(p[4], p[5]); w0.w = cvtpk(p[6], p[7]);
        w1.x = cvtpk(p[8], p[9]); w1.y = cvtpk(p[10], p[11]); w1.z = cvtpk(p[12], p[13]); w1.w = cvtpk(p[14], p[15]);
        const bf16x8 pa0 = __builtin_bit_cast(bf16x8, w0), pa1 = __builtin_bit_cast(bf16x8, w1);
        if (!cache) {
            const int mk = SAMPLE ? TP + 32 * b : k0;
            const bf16_t* vp = V1T + (size_t)(64 * h + r32) * M + mk + 4 * hi;
#pragma unroll
            for (int d = 0; d < 2; ++d)
#pragma unroll
                for (int s = 0; s < 2; ++s) {
                    const u32x2 lo = *(const u32x2*)(vp + (size_t)(32 * d) * M + 16 * s), hh = *(const u32x2*)(vp + (size_t)(32 * d) * M + 16 * s + 8);
                    const u32x4 w = (u32x4){lo.x, lo.y, hh.x, hh.y};
                    if (d == 0) o0 = __builtin_amdgcn_mfma_f32_32x32x16_bf16(s == 0 ? pa0 : pa1, __builtin_bit_cast(bf16x8, w), o0, 0, 0, 0);
                    else o1 = __builtin_amdgcn_mfma_f32_32x32x16_bf16(s == 0 ? pa0 : pa1, __builtin_bit_cast(bf16x8, w), o1, 0, 0, 0);
                }
        } else {
            const float* vp = P.in[7] + (((size_t)b * PAST + k0 + 4 * hi) * 16 + h) * 64 + r32;
#pragma unroll
            for (int d = 0; d < 2; ++d)
#pragma unroll
                for (int s = 0; s < 2; ++s) {
                    float x[8];
#pragma unroll
                    for (int j = 0; j < 8; ++j) x[j] = vp[(size_t)(16 * s + 8 * (j >> 2) + (j & 3)) * 1024 + 32 * d];
                    u32x4 w; w.x = cvtpk(x[0], x[1]); w.y = cvtpk(x[2], x[3]); w.z = cvtpk(x[4], x[5]); w.w = cvtpk(x[6], x[7]);
                    if (d == 0) o0 = __builtin_amdgcn_mfma_f32_32x32x16_bf16(s == 0 ? pa0 : pa1, __builtin_bit_cast(bf16x8, w), o0, 0, 0, 0);
                    else o1 = __builtin_amdgcn_mfma_f32_32x32x16_bf16(s == 0 ? pa0 : pa1, __builtin_bit_cast(bf16x8, w), o1, 0, 0, 0);
                }
        }
        if (__all(run >= RUN_EXIT)) break;
    }
    const bf16_t* Z1 = (const bf16_t*)(P.ws + WS_Z1); bf16_t* O1 = (bf16_t*)(P.ws + WS_O1B);
#pragma unroll
    for (int r = 0; r < 16; ++r) {
        const int q = (r & 3) + 8 * (r >> 2) + 4 * hi;
        const size_t off = (size_t)(m0 + q) * D + 64 * h + r32;
        O1[off] = f2bf(o0[r] * silu(bf2f(Z1[off])));
        O1[off + 32] = f2bf(o1[r] * silu(bf2f(Z1[off + 32])));
    }
}

#define SLAS __attribute__((address_space(3)))
#ifndef SB_FORCE_GLOBAL
#define SB_FORCE_GLOBAL 0
#endif
#ifndef SB_LDS_K
#define SB_LDS_K 1
#endif
#ifndef SB_LDS_V
#define SB_LDS_V 1
#endif
constexpr int KS = 144, VS = 1032, L_K = 0, L_V = 512 * KS, SB_LDS_END = L_V + 64 * VS;
static_assert(SB_LDS_END <= 147456 - 64, "sb lds");
__device__ __forceinline__ void unit_prompt_wg(const Ptrs& P, int h, int qb, SLAS unsigned char* lds, int tid) {
    asm volatile("" : "+v"(tid));
    const int lane = tid & 63, wave = __builtin_amdgcn_readfirstlane(tid >> 6), r32 = lane & 31, hi = lane >> 5;
    const bf16_t* Q1 = (const bf16_t*)(P.ws + WS_Q1); const bf16_t* K1 = (const bf16_t*)(P.ws + WS_K1); const bf16_t* V1T = (const bf16_t*)(P.ws + WS_V1T);
    const int q0b = 256 * qb, wlo = q0b - 256;
    {
        f32x4 kreg[8]; u32x4 vreg[8];
#pragma unroll
        for (int i = 0; i < 8; ++i) { const int c = tid + 512 * i, row = c >> 3, ch = c & 7; const int pos = wlo + row;
            kreg[i] = pos >= 0 ? *(const f32x4*)(K1 + (size_t)pos * D + 64 * h + 8 * ch) : (f32x4){0.f, 0.f, 0.f, 0.f}; }
#pragma unroll
        for (int i = 0; i < 8; ++i) { const int c = tid + 512 * i, d = c >> 6, ch = c & 63; const int pos = wlo + 8 * ch;
            vreg[i] = pos >= 0 ? *(const u32x4*)(V1T + (size_t)(64 * h + d) * M + pos) : (u32x4){0u, 0u, 0u, 0u}; }
#pragma unroll
        for (int i = 0; i < 8; ++i) { const int c = tid + 512 * i, row = c >> 3, ch = c & 7; *(SLAS f32x4*)(lds + L_K + row * KS + ch * 16) = kreg[i]; }
#pragma unroll
        for (int i = 0; i < 8; ++i) { const int c = tid + 512 * i, d = c >> 6, ch = c & 63; SLAS unsigned char* p = lds + L_V + d * VS + ch * 16;
            *(SLAS u32x2*)p = (u32x2){vreg[i].x, vreg[i].y};
            *(SLAS u32x2*)(p + 8) = (u32x2){vreg[i].z, vreg[i].w}; }
    }
    const int q0 = q0b + 32 * wave, m0 = q0;
    bf16x8 qf[4];
    { const bf16_t* qp = Q1 + (size_t)(m0 + r32) * D + 64 * h + 8 * hi;
#pragma unroll
      for (int s = 0; s < 4; ++s) qf[s] = *(const bf16x8*)(qp + 16 * s); }
    __syncthreads();
    f32x16 o0, o1;
#pragma unroll
    for (int r = 0; r < 16; ++r) { o0[r] = 0.f; o1[r] = 0.f; }
    float run = 0.f;
#pragma unroll 1
    for (int k0 = q0; k0 >= 0; k0 -= 32) {
        const bool diag = (k0 == q0);
        const bool inwin = (k0 >= wlo) && !SB_FORCE_GLOBAL;
        f32x16 p;
#pragma unroll
        for (int r = 0; r < 16; ++r) p[r] = 0.f;
        if (inwin && SB_LDS_K) {
            const SLAS unsigned char* kp = lds + L_K + (k0 - wlo + r32) * KS + hi * 16;
#pragma unroll
            for (int s = 0; s < 4; ++s) p = __builtin_amdgcn_mfma_f32_32x32x16_bf16(*(const SLAS bf16x8*)(kp + 32 * s), qf[s], p, 0, 0, 0);
        } else {
            const bf16_t* kp = K1 + (size_t)(k0 + r32) * D + 64 * h + 8 * hi;
#pragma unroll
            for (int s = 0; s < 4; ++s) p = __builtin_amdgcn_mfma_f32_32x32x16_bf16(*(const bf16x8*)(kp + 16 * s), qf[s], p, 0, 0, 0);
        }
        float sp[16];
#pragma unroll
        for (int r = 0; r < 16; ++r) {
            const int kk = (r & 3) + 8 * (r >> 2) + 4 * hi;
            float sv = __builtin_amdgcn_logf(1.f + __builtin_amdgcn_exp2f(p[r]));
            if (diag && !(kk < r32)) sv = 0.f;
            sp[r] = sv;
        }
        float a[4], bsum[4], Tg[4];
#pragma unroll
        for (int g = 0; g < 4; ++g) { a[g] = (sp[4 * g] + sp[4 * g + 1]) + (sp[4 * g + 2] + sp[4 * g + 3]); bsum[g] = __shfl_xor(a[g], 32); }
        float accA = 0.f, accB = 0.f;
#pragma unroll
        for (int g = 3; g >= 0; --g) { const float pb = hi ? accB : accB + bsum[g]; Tg[g] = accA + pb; accA += a[g]; accB += bsum[g]; }
#pragma unroll
        for (int g = 0; g < 4; ++g) {
            float c = Tg[g] + run;
#pragma unroll
            for (int i = 3; i >= 0; --i) { const int r = 4 * g + i, kk = i + 8 * g + 4 * hi; c += sp[r]; float w = __builtin_amdgcn_exp2f(p[r] - c); if (diag && !(kk < r32)) w = 0.f; p[r] = w; }
        }
        run += accA + accB;
        u32x4 w0, w1;
        w0.x = cvtpk(p[0], p[1]); w0.y = cvtpk(p[2], p[3]); w0.z = cvtpk(p[4], p[5]); w0.w = cvtpk(p[6], p[7]);
        w1.x = cvtpk(p[8], p[9]); w1.y = cvtpk(p[10], p[11]); w1.z = cvtpk(p[12], p[13]); w1.w = cvtpk(p[14], p[15]);
        const bf16x8 pa0 = __builtin_bit_cast(bf16x8, w0), pa1 = __builtin_bit_cast(bf16x8, w1);
        if (inwin && SB_LDS_V) {
            const SLAS unsigned char* vp = lds + L_V + r32 * VS + (k0 - wlo + 4 * hi) * 2;
#pragma unroll
            for (int d = 0; d < 2; ++d)
#pragma unroll
                for (int s = 0; s < 2; ++s) {
                    const u32x2 lo = *(const SLAS u32x2*)(vp + d * 32 * VS + 32 * s), hh = *(const SLAS u32x2*)(vp + d * 32 * VS + 32 * s + 16);
                    const u32x4 w = (u32x4){lo.x, lo.y, hh.x, hh.y};
                    if (d == 0) o0 = __builtin_amdgcn_mfma_f32_32x32x16_bf16(s == 0 ? pa0 : pa1, __builtin_bit_cast(bf16x8, w), o0, 0, 0, 0);
                    else o1 = __builtin_amdgcn_mfma_f32_32x32x16_bf16(s == 0 ? pa0 : pa1, __builtin_bit_cast(bf16x8, w), o1, 0, 0, 0);
                }
        } else {
            const bf16_t* vp = V1T + (size_t)(64 * h + r32) * M + k0 + 4 * hi;
#pragma unroll
            for (int d = 0; d < 2; ++d)
#pragma unroll
                for (int s = 0; s < 2; ++s) {
                    const u32x2 lo = *(const u32x2*)(vp + (size_t)(32 * d) * M + 16 * s), hh = *(const u32x2*)(vp + (size_t)(32 * d) * M + 16 * s + 8);
                    const u32x4 w = (u32x4){lo.x, lo.y, hh.x, hh.y};
                    if (d == 0) o0 = __builtin_amdgcn_mfma_f32_32x32x16_bf16(s == 0 ? pa0 : pa1, __builtin_bit_cast(bf16x8, w), o0, 0, 0, 0);
                    else o1 = __builtin_amdgcn_mfma_f32_32x32x16_bf16(s == 0 ? pa0 : pa1, __builtin_bit_cast(bf16x8, w), o1, 0, 0, 0);
                }
        }
        if (__all(run >= RUN_EXIT)) break;
    }
    const bf16_t* Z1 = (const bf16_t*)(P.ws + WS_Z1); bf16_t* O1 = (bf16_t*)(P.ws + WS_O1B);
#pragma unroll
    for (int r = 0; r < 16; ++r) {
        const int q = (r & 3) + 8 * (r >> 2) + 4 * hi;
        const size_t off = (size_t)(m0 + q) * D + 64 * h + r32;
        O1[off] = f2bf(o0[r] * silu(bf2f(Z1[off])));
        O1[off + 32] = f2bf(o1[r] * silu(bf2f(Z1[off + 32])));
    }
    __syncthreads();
}
#undef SLAS

__device__ __forceinline__ void phase(const Ptrs& P, __attribute__((address_space(3))) unsigned char* lds, int wg, int nwg, int tid) {
#pragma unroll 1
    for (int i = wg; i < 16 * 64; i += nwg) unit_prompt_wg(P, i & 15, i >> 4, lds, tid);
    const int gw = wg * 8 + (tid >> 6), ngw = nwg * 8;
#pragma unroll 1
    for (int i = gw; i < 16 * 32; i += ngw) unit_run<1>(P, i >> 4, i & 15, 0, tid & 63);
}
}
namespace rw {
#define RLAS __attribute__((address_space(3)))
typedef short bf16x8 __attribute__((ext_vector_type(8)));
typedef float f32x16 __attribute__((ext_vector_type(16)));
typedef float f32x4 __attribute__((ext_vector_type(4)));
typedef unsigned u32x4 __attribute__((ext_vector_type(4)));
typedef unsigned u32x2 __attribute__((ext_vector_type(2)));

constexpr int NUNIT = 2048 + 256;
constexpr size_t U_MFRAG = 0;
constexpr size_t U_NRAW = 16384;
constexpr size_t U_HRAW = 32768;
constexpr size_t U_G = 49152;
constexpr size_t U_BON = 57344;
constexpr size_t U_BYTES = 65536;
static_assert(WS_RW + (size_t)NUNIT * U_BYTES <= WS_SST, "rw region");

constexpr int SB = 144, SF = 272;
constexpr int BSZ = 64 * SB, FSZ = 64 * SF;
constexpr int L_S0 = 0, L_S1 = BSZ, L_S2 = 2 * BSZ, L_S3 = 3 * BSZ, L_S4 = 4 * BSZ, L_S5 = 5 * BSZ, L_S6 = 6 * BSZ, L_S7 = 7 * BSZ, L_S8 = 8 * BSZ, L_S9 = 9 * BSZ;
constexpr int L_F0 = 10 * BSZ, L_F1 = L_F0 + FSZ, L_F2 = L_F1 + FSZ;
constexpr int L_PC = L_F2 + FSZ;
constexpr int L_TOT = L_PC + 256;
constexpr int RW_LDS_END = L_TOT + 2048;
static_assert(RW_LDS_END <= 147456, "rw lds");

__device__ __forceinline__ unsigned cvtpk(float lo, float hi) { unsigned r; asm volatile("v_cvt_pk_bf16_f32 %0, %1, %2" : "=v"(r) : "v"(lo), "v"(hi)); return r; }
__device__ __forceinline__ float bflo(unsigned w) { return __uint_as_float(w << 16); }
__device__ __forceinline__ float bfhi(unsigned w) { return __uint_as_float(w & 0xffff0000u); }

__device__ __forceinline__ f32x16 mm_tile(f32x16 acc, const RLAS unsigned char* A, int arow0, const RLAS unsigned char* B, int brow0, int r32, int hi) {
    const RLAS unsigned char* ap = A + (arow0 + r32) * SB + hi * 16;
    const RLAS unsigned char* bp = B + (brow0 + r32) * SB + hi * 16;
#pragma unroll
    for (int s = 0; s < 4; ++s) acc = __builtin_amdgcn_mfma_f32_32x32x16_bf16(*(const RLAS bf16x8*)(ap + 32 * s), *(const RLAS bf16x8*)(bp + 32 * s), acc, 0, 0, 0);
    return acc;
}
__device__ __forceinline__ f32x16 zero16() { f32x16 z;
#pragma unroll
    for (int r = 0; r < 16; ++r) z[r] = 0.f; return z; }

template <int J> struct SolveStep {
    static __device__ __forceinline__ void run(float (&R)[16], const RLAS unsigned char* ap  ) {
        constexpr int jq = J & 3, jg = J >> 2;
        const float xj = __builtin_bit_cast(float, __builtin_amdgcn_update_dpp(0, __builtin_bit_cast(int, R[jg]), jq | (jq << 2) | (jq << 4) | (jq << 6), 0xf, 0xf, false));
#pragma unroll
        for (int gq = jg >> 2; gq < 4; ++gq) {
            const f32x4 a = *(const RLAS f32x4*)(ap + J * SF + 16 * gq);
#pragma unroll
            for (int i = 0; i < 4; ++i) { if (4 * gq + i >= jg) R[4 * gq + i] -= a[i] * xj; }
        }
        SolveStep<J + 1>::run(R, ap);
    }
};
template <> struct SolveStep<63> { static __device__ __forceinline__ void run(float (&)[16], const RLAS unsigned char*) {} };

__device__ __forceinline__ void unit_a(const Ptrs& P, int unit, RLAS unsigned char* lds, int tid) {
    asm volatile("" : "+v"(tid));
    const int lane = tid & 63, wave = __builtin_amdgcn_readfirstlane(tid >> 6), r32 = lane & 31, hi = lane >> 5;
    const bool samp = unit >= 2048;
    const int h = unit & 7, cb = samp ? (unit - 2048) >> 3 : unit >> 3;
    const int m_base = samp ? TP + 32 * cb : 64 * cb;
    const int nvalid = samp ? 32 : 64;
    const bf16_t* PR = (const bf16_t*)(P.ws + WS_PROJ0);
    unsigned char* urec = P.ws + WS_RW + (size_t)unit * U_BYTES;
    const float* mu = P.in[19];
    const int ch = 64 * h + lane;
    float rr[8], kr[8], vr[8];
    {
        const float mu_r = mu[ch], mu_k = mu[512 + ch], mu_v = mu[1024 + ch], mu_w = mu[1536 + lane], mu_a = mu[1600 + lane];
        const int t0 = 8 * wave;
        float x_r[9], x_k[9], x_v[9], x_w[9], x_a[9];
        const int mprev = m_base + t0 - 1;
        const bool prev_state = samp && t0 == 0, prev_zero = (!samp && mprev < 0) || t0 >= nvalid;
        {
            const int mp = (prev_state || prev_zero) ? m_base : mprev;
            const bf16_t* p = PR + (size_t)mp * N0P + C_PRW;
            x_r[0] = bf2f(p[ch]); x_k[0] = bf2f(p[512 + ch]); x_v[0] = bf2f(p[1024 + ch]); x_w[0] = bf2f(p[1536 + lane]); x_a[0] = bf2f(p[1600 + lane]);
        }
#pragma unroll
        for (int i = 0; i < 8; ++i) {
            const int t = t0 + i, tc = t < nvalid ? t : nvalid - 1;
            const bf16_t* p = PR + (size_t)(m_base + tc) * N0P + C_PRW;
            x_r[i + 1] = bf2f(p[ch]); x_k[i + 1] = bf2f(p[512 + ch]); x_v[i + 1] = bf2f(p[1024 + ch]); x_w[i + 1] = bf2f(p[1536 + lane]); x_a[i + 1] = bf2f(p[1600 + lane]);
        }
        if (prev_state) { const float* sh = P.in[4] + (size_t)cb * RWS; x_r[0] = sh[ch]; x_k[0] = sh[512 + ch]; x_v[0] = sh[1024 + ch]; x_w[0] = sh[1536 + lane]; x_a[0] = sh[1600 + lane]; }
        if (prev_zero) { x_r[0] = 0.f; x_k[0] = 0.f; x_v[0] = 0.f; x_w[0] = 0.f; x_a[0] = 0.f; }
#pragma unroll
        for (int i = 0; i < 8; ++i) {
            const int t = t0 + i;
            if (t >= nvalid) { x_r[i + 1] = 0.f; x_k[i + 1] = 0.f; x_v[i + 1] = 0.f; x_w[i + 1] = 0.f; x_a[i + 1] = 0.f; }
            rr[i] = x_r[i + 1] + (x_r[i] - x_r[i + 1]) * mu_r; kr[i] = x_k[i + 1] + (x_k[i] - x_k[i + 1]) * mu_k; vr[i] = x_v[i + 1] + (x_v[i] - x_v[i + 1]) * mu_v;
            const float wl = x_w[i + 1] + (x_w[i] - x_w[i + 1]) * mu_w, al = x_a[i + 1] + (x_a[i] - x_a[i + 1]) * mu_a;
            const float th = 1.f - 2.f * __builtin_amdgcn_rcpf(__builtin_amdgcn_exp2f(wl * (2.f * LOG2E)) + 1.f);
            *(RLAS bf16_t*)(lds + L_S0 + t * SB + lane * 2) = f2bf(th);
            *(RLAS bf16_t*)(lds + L_S1 + t * SB + lane * 2) = f2bf(al);
        }
    }
    __syncthreads();
    {
        const int which = wave >> 2, tile = wave & 3, ti = tile >> 1, tj = tile & 1;
        const bf16_t* WT = (const bf16_t*)(P.ws + WS_LORA) + (size_t)which * 512 * 64 + (size_t)(64 * h + 32 * tj + r32) * 64 + 8 * hi;
        const RLAS unsigned char* ap = lds + (which ? L_S1 : L_S0) + (32 * ti + r32) * SB + hi * 16;
        f32x16 acc = zero16();
#pragma unroll
        for (int s = 0; s < 4; ++s) acc = __builtin_amdgcn_mfma_f32_32x32x16_bf16(*(const RLAS bf16x8*)(ap + 32 * s), *(const bf16x8*)(WT + 16 * s), acc, 0, 0, 0);
        RLAS unsigned char* o = lds + (which ? L_F1 : L_F0) + (32 * tj + r32) * 4;
#pragma unroll
        for (int r = 0; r < 16; ++r) *(RLAS float*)(o + (32 * ti + (r & 3) + 8 * (r >> 2) + 4 * hi) * SF) = acc[r];
    }
    __syncthreads();
    {
        const float w0 = P.in[20][ch], a0 = P.in[22][ch], k_k = P.in[24][ch], k_a = P.in[25][ch], r_k = P.in[26][ch];
        const int t0 = 8 * wave;
        float kk[8], kka[8], km[8], ld[8];
        float run = 0.f;
#pragma unroll
        for (int i = 0; i < 8; ++i) {
            const int t = t0 + i;
            const float wa = w0 + *(const RLAS float*)(lds + L_F0 + t * SF + lane * 4), aa = a0 + *(const RLAS float*)(lds + L_F1 + t * SF + lane * 4);
            const float nw = -wa;
            const float spl = fmaxf(nw, 0.f) + __builtin_amdgcn_logf(1.f + __builtin_amdgcn_exp2f(-fabsf(nw) * LOG2E)) * 0.6931471805599453f;
            const float w = -spl - 0.5f;
            float logd = -__builtin_amdgcn_exp2f(w * LOG2E);
            const float a = __builtin_amdgcn_rcpf(1.f + __builtin_amdgcn_exp2f(-aa * LOG2E));
            float kx = kr[i] * k_k;
            const float n2 = wave_sum(kx * kx);
            kx = kx * __builtin_amdgcn_rcpf(fmaxf(__builtin_amdgcn_sqrtf(n2), 1e-12f));
            float kmod = kr[i] * (1.f + (a - 1.f) * k_a);
            if (t >= nvalid) { kx = 0.f; kmod = 0.f; logd = 0.f; rr[i] = 0.f; vr[i] = 0.f; }
            kk[i] = kx; kka[i] = kx * a; km[i] = kmod;
            const float scal = wave_sum(rr[i] * kmod * r_k);
            ((bf16_t*)(urec + U_BON))[t * 64 + lane] = f2bf(scal * vr[i]);
            run += logd; ld[i] = run;
        }
        *(RLAS float*)(lds + L_TOT + (wave * 64 + lane) * 4) = run;
        __syncthreads();
        float base = 0.f, lc = 0.f;
#pragma unroll
        for (int w = 0; w < 8; ++w) { const float tw = *(const RLAS float*)(lds + L_TOT + (w * 64 + lane) * 4); if (w < wave) base += tw; lc += tw; }
        if (wave == 0) *(RLAS float*)(lds + L_PC + lane * 4) = __builtin_amdgcn_exp2f(lc * LOG2E);
        float kbt[8], kdt[8], kkt[8];
#pragma unroll
        for (int i = 0; i < 8; ++i) {
            const int t = t0 + i;
            const float L = base + ld[i], Lm1 = L - (i == 0 ? ld[0] : ld[i] - ld[i - 1]);
            const float eL = __builtin_amdgcn_exp2f(L * LOG2E), eLm1 = __builtin_amdgcn_exp2f(Lm1 * LOG2E), enL = __builtin_amdgcn_exp2f(-L * LOG2E), eCL = __builtin_amdgcn_exp2f((lc - L) * LOG2E);
            kkt[i] = kk[i] * eLm1;
            *(RLAS bf16_t*)(lds + L_S2 + t * SB + lane * 2) = f2bf(kkt[i]);
            *(RLAS bf16_t*)(lds + L_S5 + t * SB + lane * 2) = f2bf(rr[i] * eL);
            *(RLAS bf16_t*)(lds + L_S3 + t * SB + lane * 2) = f2bf(kka[i] * enL);
            *(RLAS bf16_t*)(lds + L_S4 + t * SB + lane * 2) = f2bf(km[i] * enL);
            kbt[i] = kka[i] * eCL; kdt[i] = km[i] * eCL;
        }
        u32x4 w;
        w.x = cvtpk(kbt[0], kbt[1]); w.y = cvtpk(kbt[2], kbt[3]); w.z = cvtpk(kbt[4], kbt[5]); w.w = cvtpk(kbt[6], kbt[7]);
        *(RLAS u32x4*)(lds + L_S6 + lane * SB + t0 * 2) = w;
        w.x = cvtpk(kdt[0], kdt[1]); w.y = cvtpk(kdt[2], kdt[3]); w.z = cvtpk(kdt[4], kdt[5]); w.w = cvtpk(kdt[6], kdt[7]);
        *(RLAS u32x4*)(lds + L_S7 + lane * SB + t0 * 2) = w;
        w.x = cvtpk(vr[0], vr[1]); w.y = cvtpk(vr[2], vr[3]); w.z = cvtpk(vr[4], vr[5]); w.w = cvtpk(vr[6], vr[7]);
        *(RLAS u32x4*)(lds + L_S8 + lane * SB + t0 * 2) = w;
        *(RLAS f32x4*)(lds + L_F2 + lane * SF + t0 * 4) = (f32x4){kkt[0], kkt[1], kkt[2], kkt[3]};
        *(RLAS f32x4*)(lds + L_F2 + lane * SF + t0 * 4 + 16) = (f32x4){kkt[4], kkt[5], kkt[6], kkt[7]};
    }
    __syncthreads();
    {
        const int q = wave >> 1;
#pragma unroll
        for (int tl = 0; tl < 2; ++tl) {
            const int tile = 2 * (wave & 1) + tl, ti = tile >> 1, tj = tile & 1;
            f32x16 acc = zero16();
            if (q == 0) {
                if (!(ti == 0 && tj == 1)) acc = mm_tile(acc, lds + L_S2, 32 * ti, lds + L_S3, 32 * tj, r32, hi);
                const int j = 32 * tj + r32;
#pragma unroll
                for (int g = 0; g < 4; ++g) { const int tb = 32 * ti + 8 * g + 4 * hi;
#pragma unroll
                    for (int i = 0; i < 4; ++i) *(RLAS float*)(lds + L_F0 + j * SF + (i * 16 + (tb >> 2)) * 4) = (j < tb + i) ? acc[4 * g + i] : 0.f; }
            } else {
                const RLAS unsigned char* Am = lds + ((q == 2) ? L_S3 : L_S4);
                const RLAS unsigned char* Bm = lds + ((q == 1) ? L_S2 : L_S5);
                if (!(ti == 1 && tj == 0)) acc = mm_tile(acc, Am, 32 * ti, Bm, 32 * tj, r32, hi);
                const int t = 32 * tj + r32;
                RLAS unsigned char* O = lds + (q == 1 ? L_S0 : q == 2 ? L_S1 : L_S9);
#pragma unroll
                for (int g = 0; g < 4; ++g) { const int jb = 32 * ti + 8 * g + 4 * hi; float v[4];
#pragma unroll
                    for (int i = 0; i < 4; ++i) { const int j = jb + i; const bool keep = (q == 1) ? (j < t) : (j <= t); v[i] = keep ? acc[4 * g + i] : 0.f; }
                    u32x2 pk; pk.x = cvtpk(v[0], v[1]); pk.y = cvtpk(v[2], v[3]);
                    *(RLAS u32x2*)(O + t * SB + jb * 2) = pk; }
            }
        }
    }
    __syncthreads();
    if (wave < 4) {
        const int ti = wave >> 1, tj = wave & 1;
        f32x16 acc = mm_tile(zero16(), lds + L_S0, 32 * ti, lds + L_S8, 32 * tj, r32, hi);
        const int v = 32 * tj + r32;
#pragma unroll
        for (int g = 0; g < 4; ++g) { const int tb = 32 * ti + 8 * g + 4 * hi; *(RLAS f32x4*)(lds + L_F1 + v * SF + tb * 4) = (f32x4){acc[4 * g], acc[4 * g + 1], acc[4 * g + 2], acc[4 * g + 3]}; }
    }
    __syncthreads();
    {
        const int q = lane & 3, col = 16 * wave + (lane >> 2);
        const RLAS unsigned char* rhs = lds + (col < 64 ? L_F2 + col * SF : L_F1 + (col - 64) * SF);
        float R[16];
#pragma unroll
        for (int g = 0; g < 16; ++g) { const f32x4 v = *(const RLAS f32x4*)(rhs + 16 * g); R[g] = q == 0 ? v[0] : q == 1 ? v[1] : q == 2 ? v[2] : v[3]; }
        SolveStep<0>::run(R, lds + L_F0 + q * 64);
        RLAS unsigned char* O = lds + (col < 64 ? L_S2 + col * SB : L_S3 + (col - 64) * SB) + q * 2;
#pragma unroll
        for (int g = 0; g < 16; ++g) *(RLAS bf16_t*)(O + 8 * g) = f2bf(-R[g]);
    }
    __syncthreads();
    {
        const int which = wave >> 1;
#pragma unroll
        for (int tl = 0; tl < 2; ++tl) {
            const int tile = 2 * (wave & 1) + tl, ti = tile >> 1, tj = tile & 1;
            if (which == 0) {
                f32x16 acc = mm_tile(zero16(), lds + L_S2, 32 * ti, lds + L_S6, 32 * tj, r32, hi);
                if (ti == tj) { const float pc = *(const RLAS float*)(lds + L_PC + (32 * tj + r32) * 4);
#pragma unroll
                    for (int r = 0; r < 16; ++r) if (((r & 3) + 8 * (r >> 2) + 4 * hi) == r32) acc[r] += pc; }
#pragma unroll
                for (int sp = 0; sp < 2; ++sp) {
                    u32x4 wh, wl; float lo[8];
                    wh.x = cvtpk(acc[8 * sp], acc[8 * sp + 1]); wh.y = cvtpk(acc[8 * sp + 2], acc[8 * sp + 3]); wh.z = cvtpk(acc[8 * sp + 4], acc[8 * sp + 5]); wh.w = cvtpk(acc[8 * sp + 6], acc[8 * sp + 7]);
                    lo[0] = acc[8 * sp] - bflo(wh.x); lo[1] = acc[8 * sp + 1] - bfhi(wh.x); lo[2] = acc[8 * sp + 2] - bflo(wh.y); lo[3] = acc[8 * sp + 3] - bfhi(wh.y);
                    lo[4] = acc[8 * sp + 4] - bflo(wh.z); lo[5] = acc[8 * sp + 5] - bfhi(wh.z); lo[6] = acc[8 * sp + 6] - bflo(wh.w); lo[7] = acc[8 * sp + 7] - bfhi(wh.w);
                    wl.x = cvtpk(lo[0], lo[1]); wl.y = cvtpk(lo[2], lo[3]); wl.z = cvtpk(lo[4], lo[5]); wl.w = cvtpk(lo[6], lo[7]);
                    unsigned char* f = urec + U_MFRAG + (size_t)(((tj * 4 + (2 * ti + sp)) * 2) * 64 + lane) * 16;
                    *(u32x4*)f = wh; *(u32x4*)(f + 1024) = wl;
                }
            } else if (which == 1) {
                f32x16 acc = mm_tile(zero16(), lds + L_S7, 32 * ti, lds + L_S8, 32 * tj, r32, hi);
                acc = mm_tile(acc, lds + L_S6, 32 * ti, lds + L_S3, 32 * tj, r32, hi);
                float* o = (float*)(urec + U_NRAW) + (size_t)(ti * 2 + tj) * 1024 + lane;
#pragma unroll
                for (int r = 0; r < 16; ++r) o[r * 64] = acc[r];
            } else if (which == 2) {
                f32x16 acc = mm_tile(zero16(), lds + L_S2, 32 * ti, lds + L_S1, 32 * tj, r32, hi);
                const int t = 32 * tj + r32;
#pragma unroll
                for (int g = 0; g < 4; ++g) { const int kb = 32 * ti + 8 * g + 4 * hi;
                    const u32x2 rt = *(const RLAS u32x2*)(lds + L_S5 + t * SB + kb * 2);
                    u32x2 pk; pk.x = cvtpk(acc[4 * g] + bflo(rt.x), acc[4 * g + 1] + bfhi(rt.x)); pk.y = cvtpk(acc[4 * g + 2] + bflo(rt.y), acc[4 * g + 3] + bfhi(rt.y));
                    *(u32x2*)(urec + U_G + (size_t)(t * 64 + kb) * 2) = pk; }
            } else {
                f32x16 acc = mm_tile(zero16(), lds + L_S8, 32 * ti, lds + L_S9, 32 * tj, r32, hi);
                acc = mm_tile(acc, lds + L_S3, 32 * ti, lds + L_S1, 32 * tj, r32, hi);
                float* o = (float*)(urec + U_HRAW) + (size_t)(ti * 2 + tj) * 1024 + lane;
#pragma unroll
                for (int r = 0; r < 16; ++r) o[r * 64] = acc[r];
            }
        }
    }
    __syncthreads();
}

__device__ __forceinline__ void split8(const f32x16& x, int sp, bf16x8& bh, bf16x8& bl) {
    u32x4 wh, wl; float lo[8];
    wh.x = cvtpk(x[8 * sp], x[8 * sp + 1]); wh.y = cvtpk(x[8 * sp + 2], x[8 * sp + 3]); wh.z = cvtpk(x[8 * sp + 4], x[8 * sp + 5]); wh.w = cvtpk(x[8 * sp + 6], x[8 * sp + 7]);
    lo[0] = x[8 * sp] - bflo(wh.x); lo[1] = x[8 * sp + 1] - bfhi(wh.x); lo[2] = x[8 * sp + 2] - bflo(wh.y); lo[3] = x[8 * sp + 3] - bfhi(wh.y);
    lo[4] = x[8 * sp + 4] - bflo(wh.z); lo[5] = x[8 * sp + 5] - bfhi(wh.z); lo[6] = x[8 * sp + 6] - bflo(wh.w); lo[7] = x[8 * sp + 7] - bfhi(wh.w);
    wl.x = cvtpk(lo[0], lo[1]); wl.y = cvtpk(lo[2], lo[3]); wl.z = cvtpk(lo[4], lo[5]); wl.w = cvtpk(lo[6], lo[7]);
    bh = __builtin_bit_cast(bf16x8, wh); bl = __builtin_bit_cast(bf16x8, wl);
}
__device__ __forceinline__ void store_state(float* dst  , const f32x16& s0, const f32x16& s1, int v, int hi) {
#pragma unroll
    for (int g = 0; g < 4; ++g) {
        *(f32x4*)(dst + v * 64 + 8 * g + 4 * hi) = (f32x4){s0[4 * g], s0[4 * g + 1], s0[4 * g + 2], s0[4 * g + 3]};
        *(f32x4*)(dst + v * 64 + 32 + 8 * g + 4 * hi) = (f32x4){s1[4 * g], s1[4 * g + 1], s1[4 * g + 2], s1[4 * g + 3]};
    }
}
struct StepOps { bf16x8 a0h[4], a0l[4], a1h[4], a1l[4]; f32x16 n0, n1; };
__device__ __forceinline__ void scan_load(const unsigned char* urec, int tv, int lane, StepOps& F) {
    const float* nr = (const float*)(urec + U_NRAW) + lane;
#pragma unroll
    for (int r = 0; r < 16; ++r) { F.n0[r] = nr[(size_t)(0 * 2 + tv) * 1024 + r * 64]; F.n1[r] = nr[(size_t)(1 * 2 + tv) * 1024 + r * 64]; }
#pragma unroll
    for (int s = 0; s < 4; ++s) {
        const unsigned char* f0 = urec + U_MFRAG + (size_t)(((0 * 4 + s) * 2) * 64 + lane) * 16;
        const unsigned char* f1 = urec + U_MFRAG + (size_t)(((1 * 4 + s) * 2) * 64 + lane) * 16;
        F.a0h[s] = *(const bf16x8*)f0; F.a0l[s] = *(const bf16x8*)(f0 + 1024); F.a1h[s] = *(const bf16x8*)f1; F.a1l[s] = *(const bf16x8*)(f1 + 1024);
    }
}
__device__ __forceinline__ void scan_compute(StepOps& F, f32x16& s0, f32x16& s1) {
    bf16x8 bh[4], bl[4];
    split8(s0, 0, bh[0], bl[0]); split8(s0, 1, bh[1], bl[1]); split8(s1, 0, bh[2], bl[2]); split8(s1, 1, bh[3], bl[3]);
#pragma unroll
    for (int s = 0; s < 4; ++s) {
        F.n0 = __builtin_amdgcn_mfma_f32_32x32x16_bf16(F.a0h[s], bh[s], F.n0, 0, 0, 0);
        F.n1 = __builtin_amdgcn_mfma_f32_32x32x16_bf16(F.a1h[s], bh[s], F.n1, 0, 0, 0);
        F.n0 = __builtin_amdgcn_mfma_f32_32x32x16_bf16(F.a0h[s], bl[s], F.n0, 0, 0, 0);
        F.n1 = __builtin_amdgcn_mfma_f32_32x32x16_bf16(F.a1h[s], bl[s], F.n1, 0, 0, 0);
        F.n0 = __builtin_amdgcn_mfma_f32_32x32x16_bf16(F.a0l[s], bh[s], F.n0, 0, 0, 0);
        F.n1 = __builtin_amdgcn_mfma_f32_32x32x16_bf16(F.a1l[s], bh[s], F.n1, 0, 0, 0);
    }
    s0 = F.n0; s1 = F.n1;
}
__device__ __forceinline__ void scan_sample(const Ptrs& P, int b, int h, int tv, int lane) {
    const int r32 = lane & 31, hi = lane >> 5, v = 32 * tv + r32;
    f32x16 s0, s1;
    const float* src = P.in[5] + ((size_t)b * 8 + h) * 4096;
#pragma unroll
    for (int g = 0; g < 4; ++g) {
        const f32x4 x0 = *(const f32x4*)(src + v * 64 + 8 * g + 4 * hi), x1 = *(const f32x4*)(src + v * 64 + 32 + 8 * g + 4 * hi);
#pragma unroll
        for (int i = 0; i < 4; ++i) { s0[4 * g + i] = x0[i]; s1[4 * g + i] = x1[i]; }
    }
    StepOps fa;
    scan_load(P.ws + WS_RW + (size_t)(2048 + b * 8 + h) * U_BYTES, tv, lane, fa);
    scan_compute(fa, s0, s1);
    store_state(P.out + O_L0WKV_S + ((size_t)b * 8 + h) * 4096, s0, s1, v, hi);
}
__device__ __forceinline__ void scan_prompt_wg(const Ptrs& P, int h, RLAS unsigned char* lds, int tid) {
    const int lane = tid & 63, wave = __builtin_amdgcn_readfirstlane(tid >> 6), r32 = lane & 31, hi = lane >> 5;
    constexpr int SLOT = 32768;
    const unsigned char* rec0 = P.ws + WS_RW + (size_t)h * U_BYTES;
    const size_t rstep = (size_t)8 * U_BYTES;
    for (int i = tid; i < 2 * 2048; i += 512) { const int st = i >> 11, j = i & 2047; *(RLAS f32x4*)(lds + st * SLOT + j * 16) = *(const f32x4*)(rec0 + st * rstep + (size_t)j * 16); }
    const int hl = (wave - 2) * 64 + lane;
    f32x4 hr[6];
#pragma unroll
    for (int i = 0; i < 6; ++i) hr[i] = (f32x4){0.f, 0.f, 0.f, 0.f};
    if (wave >= 2) {
#pragma unroll
        for (int i = 0; i < 6; ++i) { const int j = hl + 384 * i; if (j < 2048) hr[i] = *(const f32x4*)(rec0 + 2 * rstep + (size_t)j * 16); }
    }
    __syncthreads();
    const int tv = wave & 1, v = 32 * tv + r32;
    f32x16 s0 = zero16(), s1 = zero16();
    float* sst = (float*)(P.ws + WS_SST);
#pragma unroll 1
    for (int c = 0; c < 256; ++c) {
        if (wave >= 2) {
            if (c + 2 < 256) {
                RLAS unsigned char* dst = lds + ((c + 2) & 3) * SLOT;
#pragma unroll
                for (int i = 0; i < 6; ++i) { const int j = hl + 384 * i; if (j < 2048) *(RLAS f32x4*)(dst + j * 16) = hr[i]; }
            }
            if (c + 3 < 256) {
                const unsigned char* src = rec0 + (size_t)(c + 3) * rstep;
#pragma unroll
                for (int i = 0; i < 6; ++i) { const int j = hl + 384 * i; if (j < 2048) hr[i] = *(const f32x4*)(src + (size_t)j * 16); }
            }
        } else {
            store_state(sst + ((size_t)c * 8 + h) * 4096, s0, s1, v, hi);
            const RLAS unsigned char* sl = lds + (c & 3) * SLOT;
            bf16x8 bh[4], bl[4];
            split8(s0, 0, bh[0], bl[0]); split8(s0, 1, bh[1], bl[1]); split8(s1, 0, bh[2], bl[2]); split8(s1, 1, bh[3], bl[3]);
            f32x16 n0, n1;
            { const RLAS float* nr = (const RLAS float*)(sl + 16384) + lane;
#pragma unroll
              for (int r = 0; r < 16; ++r) { n0[r] = nr[(0 * 2 + tv) * 1024 + r * 64]; n1[r] = nr[(1 * 2 + tv) * 1024 + r * 64]; } }
#pragma unroll
            for (int s = 0; s < 4; ++s) {
                const RLAS unsigned char* f0 = sl + (((0 * 4 + s) * 2) * 64 + lane) * 16;
                const RLAS unsigned char* f1 = sl + (((1 * 4 + s) * 2) * 64 + lane) * 16;
                const bf16x8 a0h = *(const RLAS bf16x8*)f0, a0l = *(const RLAS bf16x8*)(f0 + 1024), a1h = *(const RLAS bf16x8*)f1, a1l = *(const RLAS bf16x8*)(f1 + 1024);
                n0 = __builtin_amdgcn_mfma_f32_32x32x16_bf16(a0h, bh[s], n0, 0, 0, 0);
                n1 = __builtin_amdgcn_mfma_f32_32x32x16_bf16(a1h, bh[s], n1, 0, 0, 0);
                n0 = __builtin_amdgcn_mfma_f32_32x32x16_bf16(a0h, bl[s], n0, 0, 0, 0);
                n1 = __builtin_amdgcn_mfma_f32_32x32x16_bf16(a1h, bl[s], n1, 0, 0, 0);
                n0 = __builtin_amdgcn_mfma_f32_32x32x16_bf16(a0l, bh[s], n0, 0, 0, 0);
                n1 = __builtin_amdgcn_mfma_f32_32x32x16_bf16(a1l, bh[s], n1, 0, 0, 0);
            }
            s0 = n0; s1 = n1;
        }
        __syncthreads();
    }
    if (wave < 2) store_state(P.out + O_L0WKV_P + (size_t)h * 4096, s0, s1, v, hi);
    __syncthreads();
}

__device__ __forceinline__ void unit_c(const Ptrs& P, int unit, int lane) {
    const int r32 = lane & 31, hi = lane >> 5;
    const bool samp = unit >= 2048;
    const int h = unit & 7, cb = samp ? (unit - 2048) >> 3 : unit >> 3;
    const int m_base = samp ? TP + 32 * cb : 64 * cb;
    const unsigned char* urec = P.ws + WS_RW + (size_t)unit * U_BYTES;
    const float* S0 = samp ? P.in[5] + ((size_t)cb * 8 + h) * 4096 : (const float*)(P.ws + WS_SST) + ((size_t)cb * 8 + h) * 4096;
    bf16x8 af[2][4];
#pragma unroll
    for (int tvb = 0; tvb < 2; ++tvb)
#pragma unroll
        for (int s = 0; s < 4; ++s) { const float* p = S0 + (32 * tvb + r32) * 64 + 16 * s + 8 * hi; const f32x4 x0 = *(const f32x4*)p, x1 = *(const f32x4*)(p + 4);
            u32x4 w; w.x = cvtpk(x0[0], x0[1]); w.y = cvtpk(x0[2], x0[3]); w.z = cvtpk(x1[0], x1[1]); w.w = cvtpk(x1[2], x1[3]); af[tvb][s] = __builtin_bit_cast(bf16x8, w); }
    const float* lng = P.in[27] + 64 * h; const float* lnb = P.in[28] + 64 * h;
#pragma unroll 1
    for (int tt = 0; tt < (samp ? 1 : 2); ++tt) {
        const int t = 32 * tt + r32;
        f32x16 acc[2];
#pragma unroll
        for (int tvb = 0; tvb < 2; ++tvb) { const float* hr = (const float*)(urec + U_HRAW) + (size_t)(tvb * 2 + tt) * 1024 + lane;
#pragma unroll
            for (int r = 0; r < 16; ++r) acc[tvb][r] = hr[r * 64]; }
        const bf16_t* gp = (const bf16_t*)(urec + U_G) + t * 64 + 8 * hi;
#pragma unroll
        for (int s = 0; s < 4; ++s) { const bf16x8 bfr = *(const bf16x8*)(gp + 16 * s);
            acc[0] = __builtin_amdgcn_mfma_f32_32x32x16_bf16(af[0][s], bfr, acc[0], 0, 0, 0);
            acc[1] = __builtin_amdgcn_mfma_f32_32x32x16_bf16(af[1][s], bfr, acc[1], 0, 0, 0); }
        float sm = 0.f;
#pragma unroll
        for (int r = 0; r < 16; ++r) sm += acc[0][r] + acc[1][r];
        sm += __shfl_xor(sm, 32);
        const float mean = sm * (1.f / 64);
        float sq = 0.f;
#pragma unroll
        for (int r = 0; r < 16; ++r) { const float d0 = acc[0][r] - mean, d1 = acc[1][r] - mean; sq += d0 * d0 + d1 * d1; }
        sq += __shfl_xor(sq, 32);
        const float rstd = rsqrtf(sq * (1.f / 64) + GN_EPS);
        const int m = m_base + t;
        const bf16_t* bon = (const bf16_t*)(urec + U_BON) + t * 64;
        const bf16_t* zb = (const bf16_t*)(P.ws + WS_PROJ0) + (size_t)m * N0P + C_ZB + 64 * h;
        bf16_t* cat = (bf16_t*)(P.ws + WS_CAT) + (size_t)m * D + 512 + 64 * h;
#pragma unroll
        for (int tvb = 0; tvb < 2; ++tvb)
#pragma unroll
            for (int g = 0; g < 4; ++g) {
                const int vb = 32 * tvb + 8 * g + 4 * hi;
                const u32x2 bo = *(const u32x2*)(bon + vb), zz = *(const u32x2*)(zb + vb);
                const f32x4 gg = *(const f32x4*)(lng + vb), bb = *(const f32x4*)(lnb + vb);
                float y[4];
                y[0] = ((acc[tvb][4 * g] - mean) * rstd * gg[0] + bb[0] + bflo(bo.x)) * silu(bflo(zz.x));
                y[1] = ((acc[tvb][4 * g + 1] - mean) * rstd * gg[1] + bb[1] + bfhi(bo.x)) * silu(bfhi(zz.x));
                y[2] = ((acc[tvb][4 * g + 2] - mean) * rstd * gg[2] + bb[2] + bflo(bo.y)) * silu(bflo(zz.y));
                y[3] = ((acc[tvb][4 * g + 3] - mean) * rstd * gg[3] + bb[3] + bfhi(bo.y)) * silu(bfhi(zz.y));
                u32x2 pk; pk.x = cvtpk(y[0], y[1]); pk.y = cvtpk(y[2], y[3]);
                *(u32x2*)(cat + vb) = pk;
            }
    }
}
#undef RLAS
}
#define LAS __attribute__((address_space(3)))
#define XB_TMO      128
#define XB_XCNT(j)  (256  + 64 * (j))
#define XB_XSUB(j)  (1280 + 64 * (j))
#define XB_XGEN(j)  (2304 + 64 * (j))
#define XB_TOP      3328
#define XB_TOPGEN   3392
#define XCD_BAR_WORDS 3456
#define XB_SPIN_CAP (1u << 18)

__device__ __forceinline__ unsigned xb_ld(unsigned* p)              { return __hip_atomic_load(p, __ATOMIC_RELAXED, __HIP_MEMORY_SCOPE_AGENT); }
__device__ __forceinline__ unsigned xb_add(unsigned* p, unsigned v) { return __hip_atomic_fetch_add(p, v, __ATOMIC_RELAXED, __HIP_MEMORY_SCOPE_AGENT); }
__device__ __forceinline__ unsigned xb_xcc_id() { return (unsigned)__builtin_amdgcn_s_getreg((3 << 11) | 20) & 0xFu; }
#define XB_SPIN(cond, bar) do { unsigned _sp = 0; while (cond) { __builtin_amdgcn_s_sleep(1); \
    if ((++_sp & 255u) == 0u) { if (xb_ld(&(bar)[XB_TMO])) break; if (_sp > XB_SPIN_CAP) { atomicAdd(&(bar)[XB_TMO], 1u); break; } } } } while (0)

struct XcdBarrier {
    unsigned* bar; unsigned x;
    volatile LAS unsigned* st;
};

__device__ __forceinline__ XcdBarrier xcd_barrier_post(unsigned* bar, volatile LAS unsigned* st) {
    XcdBarrier b; b.bar = bar; b.x = xb_xcc_id(); b.st = st;
    if (threadIdx.x == 0) (void)xb_add(&bar[XB_XCNT(b.x)], 1u);
    return b;
}
__device__ __forceinline__ void xcd_barrier_complete(unsigned* bar, unsigned x, unsigned& nloc, unsigned& nx) {
    const unsigned G = gridDim.x * gridDim.y * gridDim.z;
    unsigned sum, cnt, mine, sp = 0u;
    for (;;) {
        sum = 0u; cnt = 0u; mine = 0u;
#pragma unroll
        for (unsigned j = 0; j < 16; ++j) { const unsigned c = xb_ld(&bar[XB_XCNT(j)]); sum += c; cnt += (c > 0u) ? 1u : 0u; mine = (j == x) ? c : mine; }
        if (sum == G) break;
        __builtin_amdgcn_s_sleep(1);
        if ((++sp & 255u) == 0u) { if (xb_ld(&bar[XB_TMO])) break; if (sp > XB_SPIN_CAP) { atomicAdd(&bar[XB_TMO], 1u); break; } }
    }
    nloc = mine > 0u ? mine : 1u; nx = cnt > 0u ? cnt : 1u;
}

__device__ __forceinline__ void xcd_barrier(const XcdBarrier& b) {
    asm volatile("s_waitcnt vmcnt(0)" ::: "memory");
    __syncthreads();
    if (threadIdx.x == 0) {
        unsigned* bar = b.bar;
        __builtin_amdgcn_s_waitcnt(0);
        unsigned nloc = b.st[0], nx = b.st[1];
        if (nloc == 0u) { xcd_barrier_complete(bar, b.x, nloc, nx); b.st[0] = nloc; b.st[1] = nx; }
        const unsigned old = xb_add(&bar[XB_XSUB(b.x)], 1u);
        const unsigned gen = old / nloc;
        if (old + 1u == (gen + 1u) * nloc) {
            __builtin_amdgcn_fence(__ATOMIC_RELEASE, "agent");
            asm volatile("s_waitcnt vmcnt(0)" ::: "memory");
            const unsigned og = xb_add(&bar[XB_TOP], 1u);
            const unsigned tg = og / nx;
            if (og + 1u == (tg + 1u) * nx) xb_add(&bar[XB_TOPGEN], 1u);
            else XB_SPIN(xb_ld(&bar[XB_TOPGEN]) == tg, bar);
            __builtin_amdgcn_fence(__ATOMIC_ACQUIRE, "agent");
            xb_add(&bar[XB_XGEN(b.x)], 1u);
            asm volatile("s_waitcnt vmcnt(0)" ::: "memory");
        } else {
            XB_SPIN(xb_ld(&bar[XB_XGEN(b.x)]) == gen, bar);
            __builtin_amdgcn_fence(__ATOMIC_ACQUIRE, "agent");
            asm volatile("s_waitcnt vmcnt(0)" ::: "memory");
        }
    }
    __syncthreads();
}


#ifndef FAST_ATTN0
#define FAST_ATTN0 1
#endif
#ifndef SCAN_IN_MIX
#define SCAN_IN_MIX 1
#endif
#ifndef FAST_RW
#define FAST_RW 1
#endif
#ifndef FAST_ATTN1
#define FAST_ATTN1 1
#endif
#include <hip/hip_cooperative_groups.h>
namespace cg = cooperative_groups;
constexpr int NWAVES = 8, NTHREADS = 512;
constexpr int LDS_BYTES = 147456;
enum Phase { PH_PRO = 0, PH_GEMM1 = 1, PH_TOK = 2, PH_SCAN = 3, PH_MIX = 4, PH_RWC = 5, PH_GEMM2 = 6, PH_GEMM3 = 7, PH_ATTN1 = 8, PH_GEMM4 = 9, PH_END = 10 };
typedef float f32x4_t __attribute__((ext_vector_type(4)));
struct Args { Ptrs p; int ph_lo, ph_hi; int pad0, pad1; };


__device__ __forceinline__ unsigned pk2(float lo, float hi) { return (unsigned)f2bf(lo) | ((unsigned)f2bf(hi) << 16); }
__device__ __forceinline__ void p0_transpose_item(const float* W, int K, int N, bf16_t* WT, const float* g, LAS float* scr, int item, int lane) {
    typedef unsigned v4u __attribute__((ext_vector_type(4)));
    const int nblk = N / 32, kb = item / nblk, nb = item % nblk, k0 = 64 * kb, n0 = 32 * nb;
#pragma unroll 8
    for (int i = 0; i < 32; ++i) { const int kk = 2 * i + (lane >> 5); float v = W[(size_t)(k0 + kk) * N + n0 + (lane & 31)]; if (g) v *= g[k0 + kk]; scr[kk * 33 + (lane & 31)] = v; }
    asm volatile("s_waitcnt lgkmcnt(0)" ::: "memory");
    const int c = lane & 7;
#pragma unroll
    for (int j = 0; j < 4; ++j) { const int n = (lane >> 3) + 8 * j; const LAS float* s = scr + (8 * c) * 33 + n;
        v4u o; o.x = pk2(s[0 * 33], s[1 * 33]); o.y = pk2(s[2 * 33], s[3 * 33]); o.z = pk2(s[4 * 33], s[5 * 33]); o.w = pk2(s[6 * 33], s[7 * 33]);
        *(v4u*)(WT + (size_t)(n0 + n) * K + k0 + 8 * c) = o; }
    asm volatile("s_waitcnt lgkmcnt(0)" ::: "memory");
}

__global__ void __launch_bounds__(NTHREADS, 2) mk_fwd(Args a) {
    extern __shared__ __attribute__((aligned(16))) unsigned char lds[];
    const Ptrs& P = a.p;
    unsigned char* ws = P.ws;
    const int lo = a.ph_lo, hi = a.ph_hi;
    const int tid = threadIdx.x, lane = tid & 63, wave = tid >> 6;
    const int G = gridDim.x, gw = blockIdx.x * NWAVES + wave, NGW = G * NWAVES;
    float* wscr = (float*)lds + wave * 256;
    volatile LAS unsigned* bst = (volatile LAS unsigned*)((LAS unsigned char*)lds + LDS_BYTES - 64);
    if (tid < 2) bst[tid] = 0u;
    __syncthreads();
    XcdBarrier bar = xcd_barrier_post((unsigned*)(ws + WS_CTL) + 4096, bst);
#define IN(k) (lo <= (k) && (k) < hi)
#define SEAM(k) do { if (IN(k) && IN((k) + 1)) xcd_barrier(bar); } while (0)
    if (IN(PH_PRO)) {
        const size_t gt = (size_t)blockIdx.x * NTHREADS + tid, NT = (size_t)G * NTHREADS;
        {
            LAS float* scr = (LAS float*)((LAS unsigned char*)lds + wave * 16384);
            constexpr int I0 = (D / 64) * (N0 / 32), I1 = (D / 64) * (D / 32), I2 = (D / 64) * (N1 / 32), NIT = I0 + I1 + I2 + I1;
            for (int it = gw; it < NIT; it += NGW) {
                int r = it;
                if (r < I0) { p0_transpose_item(P.in[10], D, N0, (bf16_t*)(ws + WS_WT0), nullptr, scr, r, lane); continue; } r -= I0;
                if (r < I1) { p0_transpose_item(P.in[11], D, D, (bf16_t*)(ws + WS_WO0T), nullptr, scr, r, lane); continue; } r -= I1;
                if (r < I2) { p0_transpose_item(P.in[30], D, N1, (bf16_t*)(ws + WS_WT1), P.in[29], scr, r, lane); continue; } r -= I2;
                p0_transpose_item(P.in[31], D, D, (bf16_t*)(ws + WS_WO1T), nullptr, scr, r, lane);
            }
            for (size_t i = gt; i < (size_t)(N0P - N0) * D / 8; i += NT) ((f32x4_t*)((bf16_t*)(ws + WS_WT0) + (size_t)N0 * D))[i] = (f32x4_t){0.f, 0.f, 0.f, 0.f};
        }
        if (blockIdx.x == 0 && tid < 256) nv::d_tables(P, tid);
        for (size_t i = gt; i < 512 * 64; i += NT) { const int c = (int)(i >> 6), l = (int)(i & 63); bf16_t* LT = (bf16_t*)(ws + WS_LORA);
            LT[i] = f2bf(P.in[21][l * 512 + c]); LT[32768 + i] = f2bf(P.in[23][l * 512 + c]); }
        for (int m = gw; m < M; m += NGW) nv::d_rmsnorm_x(P, m, lane);
    }
    SEAM(PH_PRO);
    if (IN(PH_GEMM1)) {
        pg8::Gemm g{(const bf16_t*)(ws + WS_XN0), (const bf16_t*)(ws + WS_WT0), M, N0P, D}; pg8::StaticOrder S; S.init(M, N0P, G, (int)blockIdx.x);
        pg8::EpiProj0F E{(bf16_t*)(ws + WS_PROJ0)};
        pg8::gemm_phase<pg8::EpiProj0F, pg8::StaticOrder, true, true>((LAS unsigned char*)lds, g, S, E);
    }
    SEAM(PH_GEMM1);
    if (IN(PH_TOK)) {
        for (int m = gw; m < M; m += NGW) nv::d_tok0(P, m, lane);
        __syncthreads();
#if FAST_RW
        for (int u = blockIdx.x; u < rw::NUNIT; u += G) rw::unit_a(P, u, (LAS unsigned char*)lds, tid);
#else
        for (int m = blockIdx.x; m < M; m += G) { nv::d_rw_prep(P, m, tid, (float*)lds, (float*)lds + 64); __syncthreads(); }
#endif
    }
    SEAM(PH_TOK);
#if !SCAN_IN_MIX
    if (IN(PH_SCAN)) {
#if FAST_RW
        if (blockIdx.x < 8) rw::scan_prompt_wg(P, (int)blockIdx.x, (LAS unsigned char*)lds, tid);
        else for (int i = gw - 64; i < 512; i += NGW - 64) rw::scan_sample(P, i >> 4, (i >> 1) & 7, i & 1, lane);
#else
        if (gw < 33 * 8) nv::d_rw_scan(P, gw >> 3, gw & 7, lane);
#endif
    }
    SEAM(PH_SCAN);
#endif
    if (IN(PH_MIX)) {
#if SCAN_IN_MIX
        if (blockIdx.x < 8) rw::scan_prompt_wg(P, (int)blockIdx.x, (LAS unsigned char*)lds, tid);
        else for (int i = gw - 64; i < 512; i += NGW - 64) rw::scan_sample(P, i >> 4, (i >> 1) & 7, i & 1, lane);
#endif
#if FAST_ATTN0
        __syncthreads();
        da::phase(P, (LAS unsigned char*)lds, (unsigned*)(ws + WS_CTL), bst + 4, tid);
#else
        for (int i = gw; i < M * 4; i += NGW) nv::d_attn0(P, i >> 2, i & 3, lane, wscr, wscr + 128);
#endif
    }
    SEAM(PH_MIX);
#if FAST_RW
    if (IN(PH_RWC)) { for (int u = gw; u < rw::NUNIT; u += NGW) rw::unit_c(P, u, lane); }
#endif
    SEAM(PH_RWC);
    if (IN(PH_GEMM2)) {
        pg8::Gemm g{(const bf16_t*)(ws + WS_CAT), (const bf16_t*)(ws + WS_WO0T), M, D, D}; pg8::StaticOrder S; S.init(M, D, G, (int)blockIdx.x);
        pg8::EpiY0F E{P};
        pg8::gemm_phase<pg8::EpiY0F, pg8::StaticOrder, true, true>((LAS unsigned char*)lds, g, S, E);
    }
    SEAM(PH_GEMM2);
    if (IN(PH_GEMM3)) {
        pg8::Gemm g{(const bf16_t*)(ws + WS_Y0B), (const bf16_t*)(ws + WS_WT1), M, N1, D}; pg8::StaticOrder S; S.init(M, N1, G, (int)blockIdx.x);
        pg8::EpiL1F E{P};
        pg8::gemm_phase<pg8::EpiL1F, pg8::StaticOrder, true, true>((LAS unsigned char*)lds, g, S, E);
    }
    SEAM(PH_GEMM3);
    if (IN(PH_ATTN1)) {
#if FAST_ATTN1
        sb::phase(P, (LAS unsigned char*)lds, (int)blockIdx.x, G, tid);
#else
        for (int i = gw; i < M * 16; i += NGW) nv::d_attn1(P, i >> 4, i & 15, lane, wscr, wscr + 64);
#endif
    }
    SEAM(PH_ATTN1);
    if (IN(PH_GEMM4)) {
        pg8::Gemm g{(const bf16_t*)(ws + WS_O1B), (const bf16_t*)(ws + WS_WO1T), M, D, D}; pg8::StaticOrder S; S.init(M, D, G, (int)blockIdx.x);
        pg8::EpiOutF E{P};
        pg8::gemm_phase<pg8::EpiOutF, pg8::StaticOrder, true, true>((LAS unsigned char*)lds, g, S, E);
    }
#undef IN
#undef SEAM
}
extern "C" void kernel_launch(void* const* d_in, const int* in_sizes, int n_in, void* d_out, int out_size, void* d_ws, size_t ws_size, hipStream_t stream) {
    static int grid = 0;
    if (n_in != 32 || (size_t)out_size != O_TOTAL || ws_size < WS_END) { fprintf(stderr, "kernel_launch: unexpected shapes n_in=%d out=%d ws=%zu\n", n_in, out_size, ws_size); return; }
    if (grid == 0) {
        int dev = 0, cus = 0, per_cu = 0;
        (void)hipGetDevice(&dev); (void)hipDeviceGetAttribute(&cus, hipDeviceAttributeMultiprocessorCount, dev);
        (void)hipFuncSetAttribute((const void*)mk_fwd, hipFuncAttributeMaxDynamicSharedMemorySize, LDS_BYTES);
        (void)hipOccupancyMaxActiveBlocksPerMultiprocessor(&per_cu, (const void*)mk_fwd, NTHREADS, LDS_BYTES);
        if (per_cu < 1) { fprintf(stderr, "kernel_launch: occupancy query says %d blocks/CU\n", per_cu); per_cu = 1; }
        grid = (cus > 0 ? cus : 256);
    }
    Args a{};
    for (int i = 0; i < 32; ++i) a.p.in[i] = (const float*)d_in[i];
    a.p.out = (float*)d_out; a.p.ws = (unsigned char*)d_ws; a.ph_lo = 0; a.ph_hi = PH_END;
    (void)hipMemsetAsync((char*)d_ws + WS_CTL, 0, 256 * 1024, stream);
    void* args[] = {&a};
#ifdef REP_PHASE
    a.ph_hi = REP_PHASE + 1;
    (void)hipLaunchCooperativeKernel((const void*)mk_fwd, dim3(grid), dim3(NTHREADS), args, LDS_BYTES, stream);
    (void)hipMemsetAsync((char*)d_ws + WS_CTL, 0, 256 * 1024, stream);
    a.ph_lo = REP_PHASE; a.ph_hi = PH_END;
#endif
    hipError_t e = hipLaunchCooperativeKernel((const void*)mk_fwd, dim3(grid), dim3(NTHREADS), args, LDS_BYTES, stream);
    if (e != hipSuccess) fprintf(stderr, "cooperative launch failed: %s (grid %d)\n", hipGetErrorString(e), grid);
}
```

```cpp
#include <hip/hip_runtime.h>
#include <stdint.h>
#include <cstdio>

typedef unsigned short bf16_t;
__device__ __forceinline__ float bf2f(bf16_t b) { return __uint_as_float(((unsigned)b) << 16); }
__device__ __forceinline__ bf16_t f2bf(float f) { unsigned u = __float_as_uint(f); return (bf16_t)((u + 0x7fffu + ((u >> 16) & 1u)) >> 16); }

constexpr int D = 1024, TP = 16384, NSEQ = 32, TS = 32, MS = NSEQ * TS, M = TP + MS, PAST = 1024;
constexpr int N0 = 4224, N0P = 4352, N1 = 4096;
constexpr int C_Q = 0, C_K = 512, C_V = 1024, C_ZA = 1536, C_PRW = 2048, C_ZB = 3712;
constexpr int RWS = 1664;
constexpr float EPS = 1e-6f, GN_EPS = 64e-5f;
constexpr float LOG2E = 1.4426950408889634f;
constexpr float LAMBDA_INIT = 0.2f;
constexpr float QSCALE = 0.125f * LOG2E;

constexpr size_t O_Y = 0;
constexpr size_t O_L0K_P = (size_t)M * D;
constexpr size_t O_L0V_P = O_L0K_P + (size_t)TP * 512;
constexpr size_t O_L0SH_P = O_L0V_P + (size_t)TP * 512;
constexpr size_t O_L0WKV_P = O_L0SH_P + RWS;
constexpr size_t O_L1K_P = O_L0WKV_P + 8 * 64 * 64;
constexpr size_t O_L1V_P = O_L1K_P + (size_t)TP * 1024;
constexpr size_t O_L0K_S = O_L1V_P + (size_t)TP * 1024;
constexpr size_t O_L0V_S = O_L0K_S + (size_t)MS * 512;
constexpr size_t O_L0SH_S = O_L0V_S + (size_t)MS * 512;
constexpr size_t O_L0WKV_S = O_L0SH_S + (size_t)NSEQ * RWS;
constexpr size_t O_L1K_S = O_L0WKV_S + (size_t)NSEQ * 8 * 64 * 64;
constexpr size_t O_L1V_S = O_L1K_S + (size_t)MS * 1024;
constexpr size_t O_TOTAL = O_L1V_S + (size_t)MS * 1024;
static_assert(O_TOTAL == 72439424, "output size");

__host__ __device__ __forceinline__ size_t off_l0k(int m) { return m < TP ? O_L0K_P + (size_t)m * 512 : O_L0K_S + (size_t)(m - TP) * 512; }
__host__ __device__ __forceinline__ size_t off_l0v(int m) { return m < TP ? O_L0V_P + (size_t)m * 512 : O_L0V_S + (size_t)(m - TP) * 512; }
__host__ __device__ __forceinline__ size_t off_l1k(int m) { return m < TP ? O_L1K_P + (size_t)m * 1024 : O_L1K_S + (size_t)(m - TP) * 1024; }
__host__ __device__ __forceinline__ size_t off_l1v(int m) { return m < TP ? O_L1V_P + (size_t)m * 1024 : O_L1V_S + (size_t)(m - TP) * 1024; }

constexpr size_t MiB = 1u << 20;
constexpr size_t WS_CTL = 0;
constexpr size_t WS_TAB = 512 * 1024;
constexpr size_t WS_WT0 = 1 * MiB, WS_WO0T = 10 * MiB, WS_WT1 = 12 * MiB, WS_WO1T = 20 * MiB, WS_LORA = 22 * MiB;
constexpr size_t WS_CAT = 24 * MiB, WS_XN0 = WS_CAT;
constexpr size_t WS_PROJ0 = 58 * MiB;
constexpr size_t WS_Q0 = 203 * MiB, WS_K0 = 220 * MiB;
constexpr size_t WS_RW = 237 * MiB;
constexpr size_t WS_SST = 407 * MiB;
constexpr size_t WS_END = 441 * MiB;
constexpr size_t WS_Y0 = WS_PROJ0, WS_Y0B = 126 * MiB, WS_SSQ = 160 * MiB;
constexpr size_t WS_O1B = WS_Q0;
constexpr size_t WS_Q1 = 237 * MiB, WS_K1 = 271 * MiB, WS_V1T = 305 * MiB, WS_Z1 = 339 * MiB;
static_assert(WS_PROJ0 + (size_t)M * N0P * 2 <= WS_Q0, "proj0");
static_assert(WS_WT0 + (size_t)N0P * D * 2 <= WS_WO0T, "wt0");

struct Tab {
    float lam;
    float m0;
    float pad[2];
    float bias[4][256];
    float biasfar[4];
};

struct Ptrs {
    const float* in[32];
    float* out;
    unsigned char* ws;
};

__device__ __forceinline__ const float* xrow(const Ptrs& P, int m) { return m < TP ? P.in[0] + (size_t)m * D : P.in[1] + (size_t)(m - TP) * D; }

__device__ __forceinline__ float wave_sum(float v) {
#pragma unroll
    for (int o = 1; o < 64; o <<= 1) v += __shfl_xor(v, o);
    return v;
}
__device__ __forceinline__ float wave_max(float v) {
#pragma unroll
    for (int o = 1; o < 64; o <<= 1) v = fmaxf(v, __shfl_xor(v, o));
    return v;
}
__device__ __forceinline__ float silu(float x) { return x / (1.f + __expf(-x)); }

__device__ __forceinline__ int t5_bucket(int rel) {
    int n = rel < 0 ? -rel : rel;
    int b;
    if (n < 8) b = n;
    else { unsigned n2 = (unsigned)n * (unsigned)n; int lg = 31 - __clz((int)n2); b = 8 + (lg - 6); if (b > 15) b = 15; }
    return (rel > 0 ? 16 : 0) + b;
}
namespace nv {

__device__ __forceinline__ void d_transpose_w(const float* W, int K, int N, int NP, bf16_t* WT, const float* g, size_t i) {
    int n = (int)(i / K), k = (int)(i % K);
    float v = 0.f;
    if (n < N) { v = W[(size_t)k * N + n]; if (g) v *= g[k]; }
    WT[i] = f2bf(v);
}
__global__ void k_transpose_w(const float* W, int K, int N, int NP, bf16_t* WT, const float* g) {
    size_t i = (size_t)blockIdx.x * blockDim.x + threadIdx.x; if (i < (size_t)NP * K) d_transpose_w(W, K, N, NP, WT, g, i); }
__global__ void k_lora_t(const float* w_up, const float* a_up, float* LT) {
    int i = blockIdx.x * blockDim.x + threadIdx.x;
    if (i >= 512 * 64) return;
    int c = i / 64, l = i % 64;
    LT[i] = w_up[l * 512 + c];
    LT[512 * 64 + i] = a_up[l * 512 + c];
}
__device__ __forceinline__ void d_tables(const Ptrs& P, int tid) {
    Tab* T = (Tab*)(P.ws + WS_TAB);
    if (tid < 64) {
        float a = P.in[14][tid] * P.in[15][tid], b = P.in[16][tid] * P.in[17][tid];
        a = wave_sum(a); b = wave_sum(b);
        float gq = fabsf(P.in[12][tid]), gk = fabsf(P.in[13][tid]);
        gq = wave_max(gq); gk = wave_max(gk);
        if (tid == 0) { T->lam = __expf(a) - __expf(b) + LAMBDA_INIT; T->m0 = 8.f * gq * gk * LOG2E * 1.0001f + 0.01f; }
    }
    if (tid < 255) { int rel = tid - 191; int b = t5_bucket(rel); for (int h = 0; h < 4; ++h) T->bias[h][tid] = P.in[8][b * 4 + h]; }
    if (tid == 255) for (int h = 0; h < 4; ++h) { T->bias[h][255] = 0.f; T->biasfar[h] = P.in[8][15 * 4 + h]; }
}
__global__ void k_tables(Ptrs P) { d_tables(P, threadIdx.x); }
__device__ __forceinline__ void d_rmsnorm_x(const Ptrs& P, int w, int lane) {
    typedef float f4 __attribute__((ext_vector_type(4)));
    const f4* x = (const f4*)xrow(P, w) + lane; const f4* g = (const f4*)P.in[9] + lane;
    unsigned long long* o = (unsigned long long*)((bf16_t*)(P.ws + WS_XN0) + (size_t)w * D) + lane;
    f4 v[4]; float s = 0.f;
#pragma unroll
    for (int j = 0; j < 4; ++j) { v[j] = x[64 * j]; s += (v[j][0] * v[j][0] + v[j][1] * v[j][1]) + (v[j][2] * v[j][2] + v[j][3] * v[j][3]); }
    s = wave_sum(s);
    const float r = rsqrtf(s * (1.f / D) + EPS);
#pragma unroll
    for (int j = 0; j < 4; ++j) { const f4 gg = g[64 * j];
        const unsigned lo = (unsigned)f2bf(v[j][0] * r * gg[0]) | ((unsigned)f2bf(v[j][1] * r * gg[1]) << 16), hi = (unsigned)f2bf(v[j][2] * r * gg[2]) | ((unsigned)f2bf(v[j][3] * r * gg[3]) << 16);
        o[64 * j] = (unsigned long long)lo | ((unsigned long long)hi << 32); }
}
__global__ void k_rmsnorm_x(Ptrs P) { int w = (blockIdx.x * blockDim.x + threadIdx.x) >> 6; if (w < M) d_rmsnorm_x(P, w, threadIdx.x & 63); }

template <class Epi>
__global__ void __launch_bounds__(256) k_gemm(const bf16_t* A, const bf16_t* Bt, int K, Epi epi) {
    __shared__ float As[16][65], Bs[16][65];
    const int tx = threadIdx.x & 15, ty = threadIdx.x >> 4;
    const int m0 = blockIdx.y * 64, n0 = blockIdx.x * 64;
    float acc[4][4];
#pragma unroll
    for (int i = 0; i < 4; ++i)
#pragma unroll
        for (int j = 0; j < 4; ++j) acc[i][j] = 0.f;
    for (int k0 = 0; k0 < K; k0 += 16) {
#pragma unroll
        for (int i = 0; i < 4; ++i) {
            int e = threadIdx.x + 256 * i, r = e >> 4, c = e & 15;
            As[c][r] = bf2f(A[(size_t)(m0 + r) * K + k0 + c]);
            Bs[c][r] = bf2f(Bt[(size_t)(n0 + r) * K + k0 + c]);
        }
        __syncthreads();
#pragma unroll
        for (int kk = 0; kk < 16; ++kk) {
            float a[4], b[4];
#pragma unroll
            for (int i = 0; i < 4; ++i) { a[i] = As[kk][ty * 4 + i]; b[i] = Bs[kk][tx * 4 + i]; }
#pragma unroll
            for (int i = 0; i < 4; ++i)
#pragma unroll
                for (int j = 0; j < 4; ++j) acc[i][j] += a[i] * b[j];
        }
        __syncthreads();
    }
#pragma unroll
    for (int i = 0; i < 4; ++i)
#pragma unroll
        for (int j = 0; j < 4; ++j) epi(m0 + ty * 4 + i, n0 + tx * 4 + j, acc[i][j]);
}
struct EpiProj0 { bf16_t* O; __device__ void operator()(int m, int n, float v) const { O[(size_t)m * N0P + n] = f2bf(v); } };
struct EpiY0 {
    Ptrs P;
    __device__ void operator()(int m, int n, float v) const {
        float y = v + xrow(P, m)[n];
        ((float*)(P.ws + WS_Y0))[(size_t)m * D + n] = y;
        ((bf16_t*)(P.ws + WS_Y0B))[(size_t)m * D + n] = f2bf(y);
    }
};
struct EpiL1 {
    Ptrs P;
    __device__ void operator()(int m, int n, float v) const {
        const float* ss = (const float*)(P.ws + WS_SSQ) + (size_t)m * 16;
        float t = 0.f; for (int j = 0; j < 16; ++j) t += ss[j];
        float r = rsqrtf(t * (1.f / D) + EPS);
        float val = v * r;
        int c = n & 1023;
        if (n < 1024) ((bf16_t*)(P.ws + WS_Q1))[(size_t)m * D + c] = f2bf(val * QSCALE);
        else if (n < 2048) { ((bf16_t*)(P.ws + WS_K1))[(size_t)m * D + c] = f2bf(val); P.out[off_l1k(m) + c] = val; }
        else if (n < 3072) { ((bf16_t*)(P.ws + WS_V1T))[(size_t)c * M + m] = f2bf(val); P.out[off_l1v(m) + c] = val; }
        else ((bf16_t*)(P.ws + WS_Z1))[(size_t)m * D + c] = f2bf(val);
    }
};
struct EpiOut { Ptrs P; __device__ void operator()(int m, int n, float v) const { P.out[O_Y + (size_t)m * D + n] = v + ((const float*)(P.ws + WS_Y0))[(size_t)m * D + n]; } };

__device__ __forceinline__ void d_ssq(const Ptrs& P, int w, int lane) {
    const float* y = (const float*)(P.ws + WS_Y0) + (size_t)w * D;
    float* ss = (float*)(P.ws + WS_SSQ) + (size_t)w * 16;
    for (int j = 0; j < 16; ++j) { float v = y[64 * j + lane]; float s = wave_sum(v * v); if (lane == 0) ss[j] = s; }
}
__global__ void k_ssq(Ptrs P) { int w = (blockIdx.x * blockDim.x + threadIdx.x) >> 6; if (w < M) d_ssq(P, w, threadIdx.x & 63); }

__device__ __forceinline__ void d_tok0(const Ptrs& P, int m, int lane) {
    const bf16_t* pr = (const bf16_t*)(P.ws + WS_PROJ0) + (size_t)m * N0P;
    bf16_t* q0 = (bf16_t*)(P.ws + WS_Q0) + (size_t)m * 512;
    bf16_t* k0 = (bf16_t*)(P.ws + WS_K0) + (size_t)m * 512;
    const float gq = P.in[12][lane], gk = P.in[13][lane];
#pragma unroll 1
    for (int g = 0; g < 8; ++g) {
        float q = bf2f(pr[C_Q + 64 * g + lane]), k = bf2f(pr[C_K + 64 * g + lane]);
        float sq = wave_sum(q * q), sk = wave_sum(k * k);
        float qn = q * rsqrtf(sq * (1.f / 64) + EPS) * gq, kn = k * rsqrtf(sk * (1.f / 64) + EPS) * gk;
        q0[64 * g + lane] = f2bf(qn * QSCALE);
        k0[64 * g + lane] = f2bf(kn);
        P.out[off_l0k(m) + 64 * g + lane] = kn;
        P.out[off_l0v(m) + 64 * g + lane] = bf2f(pr[C_V + 64 * g + lane]);
    }
    int last = -1; size_t so = 0;
    if (m == TP - 1) { last = 1; so = O_L0SH_P; }
    else if (m >= TP && ((m - TP) & 31) == 31) { last = 1; so = O_L0SH_S + (size_t)((m - TP) >> 5) * RWS; }
    if (last > 0) for (int c = lane; c < RWS; c += 64) P.out[so + c] = bf2f(pr[C_PRW + c]);
}
__global__ void k_tok0(Ptrs P) { int m = (blockIdx.x * blockDim.x + threadIdx.x) >> 6; if (m < M) d_tok0(P, m, threadIdx.x & 63); }

template <class SP> __device__ __forceinline__ void d_attn0(const Ptrs& P, int m, int h, int lane, SP sqw, SP spw) {
    const Tab* T = (const Tab*)(P.ws + WS_TAB);
    const bf16_t* Q0 = (const bf16_t*)(P.ws + WS_Q0); const bf16_t* K0 = (const bf16_t*)(P.ws + WS_K0);
    const bf16_t* PR = (const bf16_t*)(P.ws + WS_PROJ0);
    int qpos, nk, b = 0; bool samp = m >= TP;
    if (!samp) { qpos = m; nk = ((m >> 6) + 1) * 64; } else { b = (m - TP) >> 5; qpos = PAST + ((m - TP) & 31); nk = PAST + TS; }
    sqw[lane] = bf2f(Q0[(size_t)m * 512 + 128 * h + lane]);
    sqw[64 + lane] = bf2f(Q0[(size_t)m * 512 + 128 * h + 64 + lane]);
    float m1 = -1e30f, m2 = -1e30f, l1 = 0.f, l2 = 0.f, o1[2] = {0.f, 0.f}, o2[2] = {0.f, 0.f};
    for (int j0 = 0; j0 < nk; j0 += 64) {
        int j = j0 + lane;
        bool valid = j < nk && ((j >> 6) <= (qpos >> 6));
        float s1 = 0.f, s2 = 0.f;
        if (valid) {
            if (samp && j < PAST) {
                const float* kr = P.in[2] + (((size_t)b * PAST + j) * 4 + h) * 128;
                for (int d = 0; d < 64; ++d) { s1 += sqw[d] * bf2f(f2bf(kr[d])); s2 += sqw[64 + d] * bf2f(f2bf(kr[64 + d])); }
            } else {
                int km = samp ? TP + 32 * b + (j - PAST) : j;
                const bf16_t* kr = K0 + (size_t)km * 512 + 128 * h;
                for (int d = 0; d < 64; ++d) { s1 += sqw[d] * bf2f(kr[d]); s2 += sqw[64 + d] * bf2f(kr[64 + d]); }
            }
            int rel = j - qpos; float bias = rel <= -128 ? T->biasfar[h] : T->bias[h][rel + 191];
            s1 += bias * LOG2E; s2 += bias * LOG2E;
        } else { s1 = -1e30f; s2 = -1e30f; }
        float bm1 = wave_max(s1), bm2 = wave_max(s2);
        float n1 = fmaxf(m1, bm1), n2 = fmaxf(m2, bm2);
        float f1 = exp2f(m1 - n1), f2 = exp2f(m2 - n2);
        float p1 = valid ? exp2f(s1 - n1) : 0.f, p2 = valid ? exp2f(s2 - n2) : 0.f;
        l1 = l1 * f1 + wave_sum(p1); l2 = l2 * f2 + wave_sum(p2);
        o1[0] *= f1; o1[1] *= f1; o2[0] *= f2; o2[1] *= f2; m1 = n1; m2 = n2;
        spw[lane] = p1; spw[64 + lane] = p2;
        __builtin_amdgcn_s_waitcnt(0);
        int jn = min(64, nk - j0);
        for (int jj = 0; jj < jn; ++jj) {
            int jp = j0 + jj; float a1 = spw[jj], a2 = spw[64 + jj];
            float v0, v1;
            if (samp && jp < PAST) { const float* vr = P.in[3] + (((size_t)b * PAST + jp) * 4 + h) * 128; v0 = bf2f(f2bf(vr[lane])); v1 = bf2f(f2bf(vr[64 + lane])); }
            else { int km = samp ? TP + 32 * b + (jp - PAST) : jp; const bf16_t* vr = PR + (size_t)km * N0P + C_V + 128 * h; v0 = bf2f(vr[lane]); v1 = bf2f(vr[64 + lane]); }
            o1[0] += a1 * v0; o1[1] += a1 * v1; o2[0] += a2 * v0; o2[1] += a2 * v1;
        }
    }
    const float lam = T->lam;
    float a0 = o1[0] / l1 - lam * o2[0] / l2, a1 = o1[1] / l1 - lam * o2[1] / l2;
    float ss = wave_sum(a0 * a0 + a1 * a1);
    float r = rsqrtf(ss * (1.f / 128) + EPS) * (1.f - LAMBDA_INIT);
    const float* sg = P.in[18];
    const bf16_t* za = PR + (size_t)m * N0P + C_ZA + 128 * h;
    bf16_t* cat = (bf16_t*)(P.ws + WS_CAT) + (size_t)m * D + 128 * h;
    cat[lane] = f2bf(a0 * r * sg[lane] * silu(bf2f(za[lane])));
    cat[64 + lane] = f2bf(a1 * r * sg[64 + lane] * silu(bf2f(za[64 + lane])));
}
__global__ void __launch_bounds__(256) k_attn0(Ptrs P) {
    __shared__ float sq[4][128], sp[4][128];
    const int wid = threadIdx.x >> 6, lane = threadIdx.x & 63, gw = blockIdx.x * 4 + wid;
    if ((gw >> 2) < M) d_attn0(P, gw >> 2, gw & 3, lane, &sq[wid][0], &sp[wid][0]);
}

constexpr size_t RWN = (size_t)M * 512;
__device__ __forceinline__ float prw_prev(const Ptrs& P, int m, int c) {
    if (m < TP) return m == 0 ? 0.f : bf2f(((const bf16_t*)(P.ws + WS_PROJ0))[(size_t)(m - 1) * N0P + C_PRW + c]);
    int i = (m - TP) & 31, b = (m - TP) >> 5;
    if (i == 0) return P.in[4][(size_t)b * RWS + c];
    return bf2f(((const bf16_t*)(P.ws + WS_PROJ0))[(size_t)(m - 1) * N0P + C_PRW + c]);
}
template <class SP> __device__ __forceinline__ void d_rw_prep(const Ptrs& P, int m, int c, SP swl, SP sal) {
    const bf16_t* pr = (const bf16_t*)(P.ws + WS_PROJ0) + (size_t)m * N0P + C_PRW;
    const float* mu = P.in[19];
#define NV_MIX(col) (bf2f(pr[col]) + (prw_prev(P, m, (col)) - bf2f(pr[col])) * mu[col])
    float r = NV_MIX(c), kr = NV_MIX(512 + c), vr = NV_MIX(1024 + c);
    if (c < 64) swl[c] = tanhf(NV_MIX(1536 + c)); else if (c < 128) sal[c - 64] = NV_MIX(1600 + c - 64);
#undef NV_MIX
    __syncthreads();
    float wa = P.in[20][c], aa = P.in[22][c];
    const float* wup = P.in[21]; const float* aup = P.in[23];
#pragma unroll 4
    for (int l = 0; l < 64; ++l) { wa += swl[l] * wup[l * 512 + c]; aa += sal[l] * aup[l * 512 + c]; }
    float spl = (-wa > 20.f) ? -wa : log1pf(__expf(-wa));
    float w = -spl - 0.5f;
    float dec = __expf(-__expf(w));
    float a = 1.f / (1.f + __expf(-aa));
    float kk = kr * P.in[24][c];
    float n2 = wave_sum(kk * kk);
    kk = kk / fmaxf(sqrtf(n2), 1e-12f);
    float km = kr * (1.f + (a - 1.f) * P.in[25][c]);
    float* R = (float*)(P.ws + WS_RW);
    size_t o = (size_t)m * 512 + c;
    R[o] = r; R[RWN + o] = dec; R[2 * RWN + o] = kk; R[3 * RWN + o] = kk * a; R[4 * RWN + o] = km; R[5 * RWN + o] = vr;
}
__global__ void __launch_bounds__(512) k_rw_prep(Ptrs P) { __shared__ float swl[64], sal[64]; d_rw_prep(P, blockIdx.x, threadIdx.x, &swl[0], &sal[0]); }
__device__ __forceinline__ void d_rw_scan(const Ptrs& P, int seq, int h, int lane) {
    const int m0 = seq == 0 ? 0 : TP + 32 * (seq - 1), T = seq == 0 ? TP : TS;
    float S[64];
    const float* s0 = P.in[5] + (((size_t)(seq > 0 ? seq - 1 : 0) * 8 + h) * 64 + lane) * 64;
#pragma unroll
    for (int k = 0; k < 64; ++k) S[k] = seq == 0 ? 0.f : s0[k];
    const float* R = (const float*)(P.ws + WS_RW);
    const float rk = P.in[26][h * 64 + lane], lg = P.in[27][h * 64 + lane], lb = P.in[28][h * 64 + lane];
    for (int t = 0; t < T; ++t) {
        size_t o = (size_t)(m0 + t) * 512 + h * 64 + lane;
        float r = R[o], dec = R[RWN + o], kk = R[2 * RWN + o], kka = R[3 * RWN + o], km = R[4 * RWN + o], v = R[5 * RWN + o];
        float sa = 0.f;
#pragma unroll
        for (int k = 0; k < 64; ++k) sa += S[k] * __shfl(kk, k);
        float ov = 0.f;
#pragma unroll
        for (int k = 0; k < 64; ++k) { S[k] = S[k] * __shfl(dec, k) - sa * __shfl(kka, k) + v * __shfl(km, k); ov += S[k] * __shfl(r, k); }
        float mu = wave_sum(ov) * (1.f / 64);
        float dv = ov - mu;
        float var = wave_sum(dv * dv) * (1.f / 64);
        float y = dv * rsqrtf(var + GN_EPS) * lg + lb;
        float bonus = wave_sum(r * km * rk) * v;
        int mm = m0 + t;
        float zb = bf2f(((const bf16_t*)(P.ws + WS_PROJ0))[(size_t)mm * N0P + C_ZB + h * 64 + lane]);
        ((bf16_t*)(P.ws + WS_CAT))[(size_t)mm * D + 512 + h * 64 + lane] = f2bf((y + bonus) * silu(zb));
    }
    float* so = P.out + (seq == 0 ? O_L0WKV_P + ((size_t)h * 64 + lane) * 64 : O_L0WKV_S + ((((size_t)(seq - 1)) * 8 + h) * 64 + lane) * 64);
#pragma unroll
    for (int k = 0; k < 64; ++k) so[k] = S[k];
}
__global__ void __launch_bounds__(64) k_rw_scan(Ptrs P) { d_rw_scan(P, blockIdx.x >> 3, blockIdx.x & 7, threadIdx.x); }

template <class SP> __device__ __forceinline__ void d_attn1(const Ptrs& P, int m, int h, int lane, SP sqw, SP saw) {
    const bf16_t* Q1 = (const bf16_t*)(P.ws + WS_Q1); const bf16_t* K1 = (const bf16_t*)(P.ws + WS_K1);
    const bf16_t* V1T = (const bf16_t*)(P.ws + WS_V1T);
    bool samp = m >= TP; int b = 0, qpos;
    if (!samp) qpos = m; else { b = (m - TP) >> 5; qpos = PAST + ((m - TP) & 31); }
    sqw[lane] = bf2f(Q1[(size_t)m * D + 64 * h + lane]);
    float run = 0.f, o = 0.f;
    for (int s0 = qpos - 1; s0 >= 0; s0 -= 64) {
        int s = s0 - lane;
        bool valid = s >= 0;
        float z = 0.f;
        if (valid) {
            if (samp && s < PAST) { const float* kr = P.in[6] + (((size_t)b * PAST + s) * 16 + h) * 64; for (int d = 0; d < 64; ++d) z += sqw[d] * bf2f(f2bf(kr[d])); }
            else { int km = samp ? TP + 32 * b + (s - PAST) : s; const bf16_t* kr = K1 + (size_t)km * D + 64 * h; for (int d = 0; d < 64; ++d) z += sqw[d] * bf2f(kr[d]); }
        }
        float spl = valid ? log2f(1.f + exp2f(z)) : 0.f;
        float inc = spl;
#pragma unroll
        for (int off = 1; off < 64; off <<= 1) { float t = __shfl_up(inc, off); if (lane >= off) inc += t; }
        float a = valid ? exp2f(z - inc - run) : 0.f;
        saw[lane] = a;
        run += __shfl(inc, 63);
        __builtin_amdgcn_s_waitcnt(0);
        int jn = min(64, s0 + 1);
        for (int jj = 0; jj < jn; ++jj) {
            int sp_ = s0 - jj; float v;
            if (samp && sp_ < PAST) v = bf2f(f2bf(P.in[7][(((size_t)b * PAST + sp_) * 16 + h) * 64 + lane]));
            else { int km = samp ? TP + 32 * b + (sp_ - PAST) : sp_; v = bf2f(V1T[(size_t)(64 * h + lane) * M + km]); }
            o += saw[jj] * v;
        }
        if (run > 200.f) break;
    }
    float z1 = bf2f(((const bf16_t*)(P.ws + WS_Z1))[(size_t)m * D + 64 * h + lane]);
    ((bf16_t*)(P.ws + WS_O1B))[(size_t)m * D + 64 * h + lane] = f2bf(o * silu(z1));
}
__global__ void __launch_bounds__(256) k_attn1(Ptrs P) {
    __shared__ float sq[4][64], sa[4][64];
    const int wid = threadIdx.x >> 6, lane = threadIdx.x & 63, gw = blockIdx.x * 4 + wid;
    if ((gw >> 4) < M) d_attn1(P, gw >> 4, gw & 15, lane, &sq[wid][0], &sa[wid][0]);
}

}
namespace pg8 {
#define PG8_LAS __attribute__((address_space(3)))
typedef unsigned short bf16_t;
typedef short bf16x8 __attribute__((ext_vector_type(8)));
typedef float f32x4 __attribute__((ext_vector_type(4)));
typedef unsigned u32x4 __attribute__((ext_vector_type(4)));
constexpr int BM = 256, BK = 64, HALF = 128, HTB = HALF * BK * 2  , STAGE_BYTES = 8 * HTB, NXCD = 8, WGM = 8;

__host__ __device__ __forceinline__ int lds_byte(int r, int c) { const int st = (r >> 4) * 2 + (c >> 5), rr = r & 15, cc = c & 31, ob = rr * 64 + cc * 2; return st * 1024 + (ob ^ (((ob >> 9) & 1) << 5)); }
__host__ __device__ __forceinline__ void stage_rc(int b, int& R, int& C) { const int st = b / 1024, sb = b % 1024, swz = sb ^ (((sb >> 9) & 1) << 5); R = (st >> 1) * 16 + swz / 64; C = (st & 1) * 32 + (swz % 64) / 2; }
__host__ __device__ __forceinline__ int perm32(int rho) { const int n = rho >> 4, i = rho & 15; return 8 * (i >> 2) + 4 * n + (i & 3); }

struct Unit { int pm, pn; };
struct Gemm { const bf16_t* A; const bf16_t* Bt; int M, N, K; };

struct StaticOrder {
    int nM, nN, nwg, G, c;
    __host__ __device__ void init(int M, int N, int G_, int c_) { nM = M / BM; nN = N / BM; nwg = nM * nN; G = G_; c = c_; }
    __host__ __device__ bool next(int i, Unit& u) const {
        const long L = (long)i * G + c; if (L >= nwg) return false;
        int wgid = (int)L; { const int q = nwg / NXCD, r = nwg % NXCD, xcd = wgid % NXCD, off = wgid / NXCD; wgid = (xcd < r ? xcd * (q + 1) : r * (q + 1) + (xcd - r) * q) + off; }
        const int nig = WGM * nN, gid = wgid / nig, fm = gid * WGM, gsz = (nM - fm) < WGM ? (nM - fm) : WGM;
        u.pm = fm + ((wgid % nig) % gsz); u.pn = (wgid % nig) / gsz; return true;
    }
    __device__ __forceinline__ void a_ready(const Unit&) const {}
    __device__ __forceinline__ void done(const Unit&) const {}
};


__device__ __forceinline__ unsigned cvt_pk_bf16(float lo, float hi) { unsigned r; asm volatile("v_cvt_pk_bf16_f32 %0, %1, %2" : "=v"(r) : "v"(lo), "v"(hi)); return r; }
__device__ __forceinline__ u32x4 pack8(const f32x4& v0, const f32x4& v1) { u32x4 w; w.x = cvt_pk_bf16(v0[0], v0[1]); w.y = cvt_pk_bf16(v0[2], v0[3]); w.z = cvt_pk_bf16(v1[0], v1[1]); w.w = cvt_pk_bf16(v1[2], v1[3]); return w; }

struct EpiProj0F {
    static constexpr bool PERM = true, AFTER_DRAIN = false;
    bf16_t* O;
    __device__ __forceinline__ void operator()(const f32x4 (&acc)[2][2][4][2], const Unit& u, int wr, int wc, int fr, int fq) const {
        const int row0 = u.pm * BM + wr * 64 + fr, col0 = u.pn * BM + wc * 32 + 8 * fq;
#pragma unroll
        for (int ai = 0; ai < 2; ++ai)
#pragma unroll
            for (int m = 0; m < 4; ++m) { bf16_t* rowp = O + (size_t)(row0 + ai * HALF + m * 16) * N0P + col0;
#pragma unroll
                for (int bj = 0; bj < 2; ++bj) *(u32x4*)(rowp + bj * HALF) = pack8(acc[ai][bj][m][0], acc[ai][bj][m][1]); }
    }
};
struct EpiY0F {
    static constexpr bool PERM = true, AFTER_DRAIN = false;
    Ptrs P;
    __device__ __forceinline__ void operator()(const f32x4 (&acc)[2][2][4][2], const Unit& u, int wr, int wc, int fr, int fq) const {
        const int row0 = u.pm * BM + wr * 64 + fr, col0 = u.pn * BM + wc * 32 + 8 * fq;
        float* Y0 = (float*)(P.ws + WS_Y0); bf16_t* YB = (bf16_t*)(P.ws + WS_Y0B); float* SSQ = (float*)(P.ws + WS_SSQ);
#pragma unroll
        for (int ai = 0; ai < 2; ++ai)
#pragma unroll
            for (int m = 0; m < 4; ++m) { const int row = row0 + ai * HALF + m * 16; const float* xr = xrow(P, row) + col0; float ss = 0.f;
#pragma unroll
                for (int bj = 0; bj < 2; ++bj) {
                    const f32x4 y0 = acc[ai][bj][m][0] + *(const f32x4*)(xr + bj * HALF), y1 = acc[ai][bj][m][1] + *(const f32x4*)(xr + bj * HALF + 4);
                    *(f32x4*)(Y0 + (size_t)row * D + col0 + bj * HALF) = y0; *(f32x4*)(Y0 + (size_t)row * D + col0 + bj * HALF + 4) = y1;
                    *(u32x4*)(YB + (size_t)row * D + col0 + bj * HALF) = pack8(y0, y1);
                    ss += (y0[0] * y0[0] + y0[1] * y0[1]) + (y0[2] * y0[2] + y0[3] * y0[3]) + (y1[0] * y1[0] + y1[1] * y1[1]) + (y1[2] * y1[2] + y1[3] * y1[3]); }
                ss += __shfl_xor(ss, 16); ss += __shfl_xor(ss, 32);
                if (fq == 0) SSQ[(size_t)row * 16 + u.pn * 4 + wc] = ss; }
    }
};
struct EpiL1F {
    static constexpr bool PERM = true, AFTER_DRAIN = false;
    Ptrs P;
    __device__ __forceinline__ void operator()(const f32x4 (&acc)[2][2][4][2], const Unit& u, int wr, int wc, int fr, int fq) const {
        const int row0 = u.pm * BM + wr * 64 + fr, colt = u.pn * BM, reg = colt >> 10, c0 = (colt & 1023) + wc * 32 + 8 * fq;
        const float* SSQ = (const float*)(P.ws + WS_SSQ);
#pragma unroll
        for (int ai = 0; ai < 2; ++ai)
#pragma unroll
            for (int m = 0; m < 4; ++m) { const int row = row0 + ai * HALF + m * 16;
                const f32x4* sp = (const f32x4*)(SSQ + (size_t)row * 16); const f32x4 s0 = sp[0], s1 = sp[1], s2 = sp[2], s3 = sp[3];
                const f32x4 st = (s0 + s1) + (s2 + s3); const float rs = rsqrtf(((st[0] + st[1]) + (st[2] + st[3])) * (1.f / D) + EPS);
#pragma unroll
                for (int bj = 0; bj < 2; ++bj) { const int c = c0 + bj * HALF; f32x4 v0 = acc[ai][bj][m][0] * rs, v1 = acc[ai][bj][m][1] * rs;
                    if (reg == 0) { *(u32x4*)((bf16_t*)(P.ws + WS_Q1) + (size_t)row * D + c) = pack8(v0 * QSCALE, v1 * QSCALE); }
                    else if (reg == 1) { *(u32x4*)((bf16_t*)(P.ws + WS_K1) + (size_t)row * D + c) = pack8(v0, v1); float* o = P.out + off_l1k(row) + c; *(f32x4*)o = v0; *(f32x4*)(o + 4) = v1; }
                    else if (reg == 2) { bf16_t* vt = (bf16_t*)(P.ws + WS_V1T) + (size_t)c * M + row;
#pragma unroll
                        for (int j = 0; j < 4; ++j) { vt[(size_t)j * M] = f2bf(v0[j]); vt[(size_t)(4 + j) * M] = f2bf(v1[j]); }
                        float* o = P.out + off_l1v(row) + c; *(f32x4*)o = v0; *(f32x4*)(o + 4) = v1; }
                    else { *(u32x4*)((bf16_t*)(P.ws + WS_Z1) + (size_t)row * D + c) = pack8(v0, v1); } } }
    }
};
struct EpiOutF {
    static constexpr bool PERM = true, AFTER_DRAIN = false;
    Ptrs P;
    __device__ __forceinline__ void operator()(const f32x4 (&acc)[2][2][4][2], const Unit& u, int wr, int wc, int fr, int fq) const {
        const int row0 = u.pm * BM + wr * 64 + fr, col0 = u.pn * BM + wc * 32 + 8 * fq;
        const float* Y0 = (const float*)(P.ws + WS_Y0);
#pragma unroll
        for (int ai = 0; ai < 2; ++ai)
#pragma unroll
            for (int m = 0; m < 4; ++m) { const size_t ro = (size_t)(row0 + ai * HALF + m * 16) * D + col0;
#pragma unroll
                for (int bj = 0; bj < 2; ++bj) {
                    *(f32x4*)(P.out + O_Y + ro + bj * HALF) = acc[ai][bj][m][0] + *(const f32x4*)(Y0 + ro + bj * HALF);
                    *(f32x4*)(P.out + O_Y + ro + bj * HALF + 4) = acc[ai][bj][m][1] + *(const f32x4*)(Y0 + ro + bj * HALF + 4); } }
    }
};
template <class Epi, class Sched, bool ALIGN_EPI = false, bool SP2 = false>
__device__ __forceinline__ void gemm_phase(PG8_LAS unsigned char* lds, const Gemm g, const Sched& S, const Epi& E) {
    const int tid = threadIdx.x, wid = __builtin_amdgcn_readfirstlane(tid >> 6), lane = tid & 63, wr = wid >> 2, wc = wid & 3, fr = lane & 15, fq = lane >> 4;
    const int K = g.K, nt = K / BK;
    unsigned voffA[2], voffB[2];
#pragma unroll
    for (int i = 0; i < 2; ++i) { int R, C; stage_rc(tid * 16 + i * 8192, R, C); const int Rb = Epi::PERM ? ((R & ~31) + perm32(R & 31)) : R;
        voffA[i] = (unsigned)(R * K + C) * 2u; voffB[i] = (unsigned)(Rb * K + C) * 2u; }
    const size_t kstep = (size_t)(BK * 2);
    const size_t hstep = (size_t)HALF * K * 2;
    const size_t tstep = 2 * hstep;
    const unsigned ldsw = (unsigned)wid * 1024u;
    const int aoff = lds_byte(wr * 64 + fr, fq * 8), boff = lds_byte(wc * 32 + fr, fq * 8);
#define PG8_SA(b, h) (((b) * 2 + (h)) * HTB)
#define PG8_SB(b, h) ((4 + (b) * 2 + (h)) * HTB)
#define PG8_STAGE(bufoff, gbase, voff) do { _Pragma("unroll") for (int _i = 0; _i < 2; ++_i) \
        __builtin_amdgcn_global_load_lds((const unsigned*)((const char*)(gbase) + (voff)[_i]), (PG8_LAS unsigned*)(lds + (bufoff) + ldsw + _i * 8192), 16, 0, 0); } while (0)
#define PG8_LDA(dst, b, h) do { _Pragma("unroll") for (int m = 0; m < 4; ++m) _Pragma("unroll") for (int k = 0; k < 2; ++k) dst[m][k] = *(const PG8_LAS bf16x8*)(lds + PG8_SA(b, h) + aoff + m * 2048 + k * 1024); } while (0)
#define PG8_LDB(dst, b, h) do { _Pragma("unroll") for (int n = 0; n < 2; ++n) _Pragma("unroll") for (int k = 0; k < 2; ++k) dst[n][k] = *(const PG8_LAS bf16x8*)(lds + PG8_SB(b, h) + boff + n * 2048 + k * 1024); } while (0)
#define PG8_MMA(ai, bj, At, Bt) do { __builtin_amdgcn_s_setprio(1); _Pragma("unroll") for (int m = 0; m < 4; ++m) _Pragma("unroll") for (int n = 0; n < 2; ++n) _Pragma("unroll") for (int k = 0; k < 2; ++k) \
        acc[ai][bj][m][n] = __builtin_amdgcn_mfma_f32_16x16x32_bf16(Bt[n][k], At[m][k], acc[ai][bj][m][n], 0, 0, 0); __builtin_amdgcn_s_setprio(0); } while (0)
#define PG8_WAIT_V(n) asm volatile("s_waitcnt vmcnt(" #n ")" ::: "memory")
#define PG8_WAIT_L(n) asm volatile("s_waitcnt lgkmcnt(" #n ")" ::: "memory")
#define PG8_BAR __builtin_amdgcn_s_barrier()
#define PG8_SCHED __builtin_amdgcn_sched_barrier(0)
    Unit cur, nxt; int ui = 0;
    if (!S.next(0, cur)) return;
    f32x4 acc[2][2][4][2];
#pragma unroll
    for (int a = 0; a < 2; ++a)
#pragma unroll
        for (int b = 0; b < 2; ++b)
#pragma unroll
            for (int m = 0; m < 4; ++m)
#pragma unroll
                for (int n = 0; n < 2; ++n) acc[a][b][m][n] = (f32x4){0.f, 0.f, 0.f, 0.f};
    bf16x8 At[4][2], B0[2][2], B1[2][2];
    const char* cA = (const char*)g.A + (size_t)cur.pm * tstep; const char* cB = (const char*)g.Bt + (size_t)cur.pn * tstep;
    S.a_ready(cur);
    if constexpr (SP2) {
        PG8_STAGE(PG8_SB(0, 0), cB, voffB); PG8_STAGE(PG8_SB(0, 1), cB + hstep, voffB); PG8_STAGE(PG8_SA(0, 0), cA, voffA); PG8_STAGE(PG8_SA(0, 1), cA + hstep, voffA);
        if (wr == 1) PG8_BAR;
        PG8_WAIT_V(2); PG8_BAR;
        PG8_STAGE(PG8_SB(1, 0), cB + kstep, voffB); PG8_STAGE(PG8_SA(1, 0), cA + kstep, voffA); PG8_STAGE(PG8_SB(1, 1), cB + hstep + kstep, voffB);
        PG8_WAIT_V(6); PG8_BAR;
    } else {
        PG8_STAGE(PG8_SB(0, 0), cB, voffB); PG8_STAGE(PG8_SA(0, 0), cA, voffA); PG8_STAGE(PG8_SB(0, 1), cB + hstep, voffB); PG8_STAGE(PG8_SA(0, 1), cA + hstep, voffA);
        if (wr == 1) PG8_BAR;
        PG8_WAIT_V(4); PG8_BAR;
        PG8_STAGE(PG8_SB(1, 0), cB + kstep, voffB); PG8_STAGE(PG8_SA(1, 0), cA + kstep, voffA); PG8_STAGE(PG8_SB(1, 1), cB + hstep + kstep, voffB);
        PG8_WAIT_V(6); PG8_BAR;
    }
    for (;;) {
        const bool has_next = S.next(ui + 1, nxt);
        const char* nA = has_next ? (const char*)g.A + (size_t)nxt.pm * tstep : cA; const char* nB = has_next ? (const char*)g.Bt + (size_t)nxt.pn * tstep : cB;
        for (int t = 0; t < nt; t += 2) {
            const bool last = (t == nt - 2);
            const char* a1 = cA + (size_t)(t + 1) * kstep;
            const char* a2 = last ? nA : cA + (size_t)(t + 2) * kstep; const char* b2 = last ? nB : cB + (size_t)(t + 2) * kstep;
            const char* a3 = a2 + kstep; const char* b3 = b2 + kstep;
            if (last && has_next) S.a_ready(nxt);
            if constexpr (SP2) {
            PG8_LDB(B0, 0, 0); PG8_LDB(B1, 0, 1); PG8_SCHED; PG8_LDA(At, 0, 0); PG8_STAGE(PG8_SA(1, 1), a1 + hstep, voffA);
            PG8_WAIT_V(8); PG8_WAIT_L(0); PG8_BAR; PG8_MMA(0, 0, At, B0); PG8_MMA(0, 1, At, B1); PG8_BAR; PG8_SCHED;
            PG8_LDA(At, 0, 1); PG8_STAGE(PG8_SB(0, 0), b2, voffB); PG8_STAGE(PG8_SB(0, 1), b2 + hstep, voffB); PG8_STAGE(PG8_SA(0, 0), a2, voffA);
            PG8_WAIT_V(8); PG8_WAIT_L(0); PG8_BAR; PG8_MMA(1, 0, At, B0); PG8_MMA(1, 1, At, B1); PG8_BAR; PG8_SCHED;
            PG8_LDB(B0, 1, 0); PG8_LDB(B1, 1, 1); PG8_SCHED; PG8_LDA(At, 1, 0); PG8_STAGE(PG8_SA(0, 1), a2 + hstep, voffA);
            PG8_WAIT_V(8); PG8_WAIT_L(0); PG8_BAR; PG8_MMA(0, 0, At, B0); PG8_MMA(0, 1, At, B1); PG8_BAR; PG8_SCHED;
            PG8_LDA(At, 1, 1); PG8_STAGE(PG8_SB(1, 0), b3, voffB); PG8_STAGE(PG8_SB(1, 1), b3 + hstep, voffB); PG8_STAGE(PG8_SA(1, 0), a3, voffA);
            PG8_WAIT_V(8); PG8_WAIT_L(0); PG8_BAR; PG8_MMA(1, 0, At, B0); PG8_MMA(1, 1, At, B1); PG8_BAR; PG8_SCHED;
            } else {
            PG8_LDB(B0, 0, 0); PG8_SCHED; PG8_LDA(At, 0, 0); PG8_STAGE(PG8_SA(1, 1), a1 + hstep, voffA);
            PG8_WAIT_L(8); PG8_BAR; PG8_WAIT_L(0); PG8_MMA(0, 0, At, B0); PG8_BAR; PG8_SCHED;
            PG8_LDB(B1, 0, 1); PG8_STAGE(PG8_SB(0, 0), b2, voffB);
            PG8_BAR; PG8_WAIT_L(0); PG8_MMA(0, 1, At, B1); PG8_BAR;
            PG8_LDA(At, 0, 1); PG8_STAGE(PG8_SA(0, 0), a2, voffA);
            PG8_BAR; PG8_WAIT_L(0); PG8_MMA(1, 0, At, B0); PG8_BAR; PG8_SCHED;
            PG8_STAGE(PG8_SB(0, 1), b2 + hstep, voffB);
            PG8_WAIT_V(6); PG8_BAR; PG8_MMA(1, 1, At, B1); PG8_BAR;
            PG8_LDB(B0, 1, 0); PG8_SCHED; PG8_LDA(At, 1, 0); PG8_STAGE(PG8_SA(0, 1), a2 + hstep, voffA);
            PG8_WAIT_L(8); PG8_BAR; PG8_WAIT_L(0); PG8_MMA(0, 0, At, B0); PG8_BAR; PG8_SCHED;
            PG8_LDB(B1, 1, 1); PG8_STAGE(PG8_SB(1, 0), b3, voffB);
            PG8_BAR; PG8_WAIT_L(0); PG8_MMA(0, 1, At, B1); PG8_BAR;
            PG8_LDA(At, 1, 1); PG8_STAGE(PG8_SA(1, 0), a3, voffA);
            PG8_BAR; PG8_WAIT_L(0); PG8_MMA(1, 0, At, B0); PG8_BAR; PG8_SCHED;
            PG8_STAGE(PG8_SB(1, 1), b3 + hstep, voffB);
            PG8_WAIT_V(6); PG8_BAR; PG8_MMA(1, 1, At, B1); PG8_BAR;
            }
        }
        if constexpr (ALIGN_EPI) { if (wr == 0) PG8_BAR; }
        if constexpr (!Epi::AFTER_DRAIN) { E(acc, cur, wr, wc, fr, fq); S.done(cur); }
        if (!has_next) break;
#pragma unroll
        for (int a = 0; a < 2; ++a)
#pragma unroll
            for (int b = 0; b < 2; ++b)
#pragma unroll
                for (int m = 0; m < 4; ++m)
#pragma unroll
                    for (int n = 0; n < 2; ++n) acc[a][b][m][n] = (f32x4){0.f, 0.f, 0.f, 0.f};
        cur = nxt; cA = nA; cB = nB; ++ui;
        if constexpr (ALIGN_EPI) { if (wr == 1) PG8_BAR; }
    }
    PG8_WAIT_V(0);
    if constexpr (!ALIGN_EPI) { if (wr == 0) PG8_BAR; }
    PG8_BAR;
    if constexpr (Epi::AFTER_DRAIN) { E.fused(acc, cur, wr, wc, fr, fq, lds, wid, lane); S.done(cur); }
#undef PG8_SA
#undef PG8_SB
#undef PG8_STAGE
#undef PG8_LDA
#undef PG8_LDB
#undef PG8_MMA
#undef PG8_WAIT_V
#undef PG8_WAIT_L
#undef PG8_BAR
#undef PG8_SCHED
}
}
namespace da {
#define DLAS __attribute__((address_space(3)))
typedef short bf16x8 __attribute__((ext_vector_type(8)));
typedef short s16x4 __attribute__((ext_vector_type(4)));
typedef float f32x16 __attribute__((ext_vector_type(16)));
typedef float f32x4 __attribute__((ext_vector_type(4)));
typedef unsigned u32x4 __attribute__((ext_vector_type(4)));

constexpr int KROW = 272, KBUF = 64 * KROW, VBUF = 16384;
constexpr int OFF_K = 0, OFF_V = 2 * KBUF;
constexpr int OFF_STAGE = 0;
constexpr int OFF_LST = 131072;
constexpr int OFF_BIAS = OFF_LST + 1024;
constexpr int DA_LDS_END = OFF_BIAS + 1024;

struct Unit { int kind, h, idx; };

__device__ __forceinline__ unsigned cvtpk(float lo, float hi) { unsigned r; asm volatile("v_cvt_pk_bf16_f32 %0, %1, %2" : "=v"(r) : "v"(lo), "v"(hi)); return r; }
__device__ __forceinline__ u32x4 pack8(const f32x4& a, const f32x4& b) { u32x4 w; w.x = cvtpk(a[0], a[1]); w.y = cvtpk(a[2], a[3]); w.z = cvtpk(b[0], b[1]); w.w = cvtpk(b[2], b[3]); return w; }

struct Stage { f32x4 kA0, kA1, vA0, vA1, kB0, kB1, vB0, vB1; };
template <int KIND> __device__ __forceinline__ void chunk_issue(const Ptrs& P, const Unit& u, int t, int c, f32x4& k0, f32x4& k1, f32x4& v0, f32x4& v1) {
    const int row = c >> 4, ch = c & 15;
    if (KIND == 0 || t == 16) {
        const int m = (KIND == 0) ? 64 * t + row : TP + 32 * u.idx + (row & 31);
        const bf16_t* kp = (const bf16_t*)(P.ws + WS_K0) + (size_t)m * 512 + 128 * u.h + ch * 8;
        const bf16_t* vp = (const bf16_t*)(P.ws + WS_PROJ0) + (size_t)m * N0P + C_V + 128 * u.h + ch * 8;
        f32x4 kv = *(const f32x4*)kp, vv = *(const f32x4*)vp;
        if (KIND != 0 && row >= 32) { kv = (f32x4){0.f, 0.f, 0.f, 0.f}; vv = kv; }
        k0 = kv; v0 = vv;
    } else {
        const size_t ro = (((size_t)u.idx * PAST + 64 * t + row) * 4 + u.h) * 128 + ch * 8;
        const float* kp = P.in[2] + ro; const float* vp = P.in[3] + ro;
        k0 = *(const f32x4*)kp; k1 = *(const f32x4*)(kp + 4); v0 = *(const f32x4*)vp; v1 = *(const f32x4*)(vp + 4);
    }
}
template <int KIND> __device__ __forceinline__ void chunk_write(int t, int c, DLAS unsigned char* lds, int kbuf, int vbuf, const f32x4& k0, const f32x4& k1, const f32x4& v0, const f32x4& v1) {
    const int row = c >> 4, ch = c & 15;
    DLAS unsigned char* kd = lds + OFF_K + kbuf * KBUF + row * KROW + ch * 16;
    DLAS unsigned char* vd = lds + OFF_V + vbuf * VBUF + (ch >> 2) * 4096 + row * 64 + (ch & 3) * 16;
    if (KIND == 0 || t == 16) { *(DLAS f32x4*)kd = k0; *(DLAS f32x4*)vd = v0; }
    else { *(DLAS u32x4*)kd = pack8(k0, k1); *(DLAS u32x4*)vd = pack8(v0, v1); }
}
#define TILE_ISSUE(t_) do { chunk_issue<KIND>(P, u, (t_), tid, S.kA0, S.kA1, S.vA0, S.vA1); chunk_issue<KIND>(P, u, (t_), tid + 512, S.kB0, S.kB1, S.vB0, S.vB1); } while (0)
#define TILE_WRITE(t_) do { chunk_write<KIND>((t_), tid, lds, (t_) & 1, (t_) % 3, S.kA0, S.kA1, S.vA0, S.vA1); chunk_write<KIND>((t_), tid + 512, lds, (t_) & 1, (t_) % 3, S.kB0, S.kB1, S.vB0, S.vB1); } while (0)

template <int KIND> __device__ __forceinline__ void unit_run(const Ptrs& P, const Unit& u0, DLAS unsigned char* lds, int tid) {
    const Unit u{KIND, u0.h, u0.idx};
    asm volatile("" : "+v"(tid));
    const int lane = tid & 63, wave = __builtin_amdgcn_readfirstlane(tid >> 6), r32 = lane & 31, hi = lane >> 5, mp = wave >> 2, w4 = wave & 3;
    constexpr bool is_s = KIND != 0;
    int m0row, qpos0, NT, cq;
    if (!is_s) { m0row = 128 * u.idx + 32 * w4; qpos0 = m0row; NT = 2 * u.idx + 2; cq = m0row >> 6; }
    else { m0row = TP + 32 * u.idx; qpos0 = PAST; NT = 17; cq = 16; }
    const Tab* T = (const Tab*)(P.ws + WS_TAB);
    DLAS float* lst = (DLAS float*)(lds + OFF_LST);
    DLAS float* bl = (DLAS float*)(lds + OFF_BIAS);
    if (tid < 256) { bl[tid] = (T->bias[u.h][tid] - T->biasfar[u.h]) * LOG2E; lst[tid] = 0.f; }
    bf16x8 qf[4];
    { const bf16_t* qp = (const bf16_t*)(P.ws + WS_Q0) + (size_t)(m0row + r32) * 512 + 128 * u.h + 64 * mp + 8 * hi;
#pragma unroll
      for (int s = 0; s < 4; ++s) qf[s] = *(const bf16x8*)(qp + 16 * s); }
    f32x16 o[4];
#pragma unroll
    for (int d = 0; d < 4; ++d)
#pragma unroll
        for (int r = 0; r < 16; ++r) o[d][r] = 0.f;
    float lsum = 0.f;
    Stage S;
    { const f32x4 z = (f32x4){0.f, 0.f, 0.f, 0.f}; S.kA0 = z; S.kA1 = z; S.vA0 = z; S.vA1 = z; S.kB0 = z; S.kB1 = z; S.vB0 = z; S.vB1 = z; }
    TILE_ISSUE(0);
    TILE_WRITE(0);
    __syncthreads();
    const int vaddr = (4 * hi + ((lane & 15) >> 2)) * 64 + (16 * ((lane >> 4) & 1) + 4 * (lane & 3)) * 2;
    int t_start = 0;
    if (!is_s && u.idx >= 2) {
        const int TF = 2 * u.idx - 2;
        typedef float f32x2 __attribute__((ext_vector_type(2))); typedef __bf16 bf16x2 __attribute__((ext_vector_type(2)));
#define CVT2(lo_, hi_) __builtin_bit_cast(unsigned, __builtin_convertvector((f32x2){(lo_), (hi_)}, bf16x2))
        f32x16 pe0, pe1;
        {
            TILE_ISSUE(1);
            const DLAS unsigned char* kb = lds + OFF_K + r32 * KROW + mp * 128 + hi * 16;
            f32x16 p0, p1;
#pragma unroll
            for (int r = 0; r < 16; ++r) { p0[r] = 0.f; p1[r] = 0.f; }
#pragma unroll
            for (int s = 0; s < 4; ++s) { p0 = __builtin_amdgcn_mfma_f32_32x32x16_bf16(*(const DLAS bf16x8*)(kb + s * 32), qf[s], p0, 0, 0, 0); p1 = __builtin_amdgcn_mfma_f32_32x32x16_bf16(*(const DLAS bf16x8*)(kb + 32 * KROW + s * 32), qf[s], p1, 0, 0, 0); }
#pragma unroll
            for (int r = 0; r < 16; ++r) { pe0[r] = __builtin_amdgcn_exp2f(p0[r]); pe1[r] = __builtin_amdgcn_exp2f(p1[r]); }
            TILE_WRITE(1);
            __syncthreads();
        }
#pragma unroll 1
        for (int t = 1; t < TF; ++t) {
            TILE_ISSUE(t + 1);
            unsigned kba = (unsigned)(uintptr_t)(lds + OFF_K + (t & 1) * KBUF + r32 * KROW + mp * 128 + hi * 16), vba = (unsigned)(uintptr_t)(lds + OFF_V + ((t - 1) % 3) * VBUF + vaddr);
            asm volatile("" : "+v"(kba), "+v"(vba));
            const DLAS unsigned char* kb = (const DLAS unsigned char*)(uintptr_t)kba;
            const DLAS unsigned char* vb = (const DLAS unsigned char*)(uintptr_t)vba;
            __builtin_amdgcn_sched_barrier(0);
            bf16x8 ka[4], kc[4];
#pragma unroll
            for (int s = 0; s < 4; ++s) { ka[s] = *(const DLAS bf16x8*)(kb + s * 32); kc[s] = *(const DLAS bf16x8*)(kb + 32 * KROW + s * 32); }
            f32x16 p0, p1;
#pragma unroll
            for (int r = 0; r < 16; ++r) { p0[r] = 0.f; p1[r] = 0.f; }
#pragma unroll
            for (int s = 0; s < 4; ++s) { p0 = __builtin_amdgcn_mfma_f32_32x32x16_bf16(ka[s], qf[s], p0, 0, 0, 0); p1 = __builtin_amdgcn_mfma_f32_32x32x16_bf16(kc[s], qf[s], p1, 0, 0, 0); }
            float sa = (pe0[0] + pe0[1]) + (pe0[2] + pe0[3]), sb = (pe1[0] + pe1[1]) + (pe1[2] + pe1[3]);
#pragma unroll
            for (int r = 4; r < 16; r += 4) { sa += (pe0[r] + pe0[r + 1]) + (pe0[r + 2] + pe0[r + 3]); sb += (pe1[r] + pe1[r + 1]) + (pe1[r + 2] + pe1[r + 3]); }
            lsum += sa + sb;
            u32x4 w0, w1, w2, w3;
            w0.x = CVT2(pe0[0], pe0[1]); w0.y = CVT2(pe0[2], pe0[3]); w0.z = CVT2(pe0[4], pe0[5]); w0.w = CVT2(pe0[6], pe0[7]);
            w1.x = CVT2(pe0[8], pe0[9]); w1.y = CVT2(pe0[10], pe0[11]); w1.z = CVT2(pe0[12], pe0[13]); w1.w = CVT2(pe0[14], pe0[15]);
            w2.x = CVT2(pe1[0], pe1[1]); w2.y = CVT2(pe1[2], pe1[3]); w2.z = CVT2(pe1[4], pe1[5]); w2.w = CVT2(pe1[6], pe1[7]);
            w3.x = CVT2(pe1[8], pe1[9]); w3.y = CVT2(pe1[10], pe1[11]); w3.z = CVT2(pe1[12], pe1[13]); w3.w = CVT2(pe1[14], pe1[15]);
            bf16x8 pa[4] = {__builtin_bit_cast(bf16x8, w0), __builtin_bit_cast(bf16x8, w1), __builtin_bit_cast(bf16x8, w2), __builtin_bit_cast(bf16x8, w3)};
            __builtin_amdgcn_sched_group_barrier(0x100, 4, 0);
#pragma unroll
            for (int i = 0; i < 8; ++i) { __builtin_amdgcn_sched_group_barrier(0x008, 1, 0); if (i < 4) __builtin_amdgcn_sched_group_barrier(0x100, 1, 0); __builtin_amdgcn_sched_group_barrier(0x002, 6, 0); }
            __builtin_amdgcn_sched_barrier(0);
#pragma unroll
            for (int d = 0; d < 4; ++d)
#pragma unroll
                for (int k = 0; k < 4; ++k) {
                    const s16x4 lo = __builtin_bit_cast(s16x4, __builtin_amdgcn_ds_read_tr16_b64_v4i16((DLAS s16x4*)(vb + d * 4096 + k * 1024)));
                    const s16x4 hh = __builtin_bit_cast(s16x4, __builtin_amdgcn_ds_read_tr16_b64_v4i16((DLAS s16x4*)(vb + d * 4096 + k * 1024 + 512)));
                    const bf16x8 bf = (bf16x8){lo[0], lo[1], lo[2], lo[3], hh[0], hh[1], hh[2], hh[3]};
                    o[d] = __builtin_amdgcn_mfma_f32_32x32x16_bf16(pa[k], bf, o[d], 0, 0, 0);
                }
#pragma unroll
            for (int r = 0; r < 16; ++r) { pe0[r] = __builtin_amdgcn_exp2f(p0[r]); pe1[r] = __builtin_amdgcn_exp2f(p1[r]); }
            __builtin_amdgcn_sched_group_barrier(0x100, 4, 0);
#pragma unroll
            for (int i = 0; i < 16; ++i) { __builtin_amdgcn_sched_group_barrier(0x100, 2, 0); __builtin_amdgcn_sched_group_barrier(0x008, 1, 0); __builtin_amdgcn_sched_group_barrier(0x400, 2, 0); }
            __builtin_amdgcn_sched_barrier(0);
            TILE_WRITE(t + 1);
            __syncthreads();
        }
        {
            float sa = 0.f, sb = 0.f;
#pragma unroll
            for (int r = 0; r < 16; ++r) { sa += pe0[r]; sb += pe1[r]; }
            lsum += sa + sb;
            bf16x8 pa[4];
            pa[0] = __builtin_bit_cast(bf16x8, pack8((f32x4){pe0[0], pe0[1], pe0[2], pe0[3]}, (f32x4){pe0[4], pe0[5], pe0[6], pe0[7]}));
            pa[1] = __builtin_bit_cast(bf16x8, pack8((f32x4){pe0[8], pe0[9], pe0[10], pe0[11]}, (f32x4){pe0[12], pe0[13], pe0[14], pe0[15]}));
            pa[2] = __builtin_bit_cast(bf16x8, pack8((f32x4){pe1[0], pe1[1], pe1[2], pe1[3]}, (f32x4){pe1[4], pe1[5], pe1[6], pe1[7]}));
            pa[3] = __builtin_bit_cast(bf16x8, pack8((f32x4){pe1[8], pe1[9], pe1[10], pe1[11]}, (f32x4){pe1[12], pe1[13], pe1[14], pe1[15]}));
            const DLAS unsigned char* vb = lds + OFF_V + ((TF - 1) % 3) * VBUF + vaddr;
#pragma unroll
            for (int d = 0; d < 4; ++d)
#pragma unroll
                for (int k = 0; k < 4; ++k) {
                    const s16x4 lo = __builtin_bit_cast(s16x4, __builtin_amdgcn_ds_read_tr16_b64_v4i16((DLAS s16x4*)(vb + d * 4096 + k * 1024)));
                    const s16x4 hh = __builtin_bit_cast(s16x4, __builtin_amdgcn_ds_read_tr16_b64_v4i16((DLAS s16x4*)(vb + d * 4096 + k * 1024 + 512)));
                    const bf16x8 bf = (bf16x8){lo[0], lo[1], lo[2], lo[3], hh[0], hh[1], hh[2], hh[3]};
                    o[d] = __builtin_amdgcn_mfma_f32_32x32x16_bf16(pa[k], bf, o[d], 0, 0, 0);
                }
        }
#undef CVT2
        t_start = TF;
    }
    for (int t = t_start; t < NT; ++t) {
        const int buf = t & 1;
        const bool has_next = t + 1 < NT;
        if (has_next) TILE_ISSUE(t + 1);
        const bool active = is_s ? ((t & 3) == w4) : (t <= cq);
        if (active) {
            unsigned kba = (unsigned)(uintptr_t)(lds + OFF_K + buf * KBUF + r32 * KROW + mp * 128 + hi * 16), vba = (unsigned)(uintptr_t)(lds + OFF_V + (t % 3) * VBUF + vaddr);
            asm volatile("" : "+v"(kba), "+v"(vba));
            const DLAS unsigned char* kb = (const DLAS unsigned char*)(uintptr_t)kba;
            f32x16 p0, p1;
#pragma unroll
            for (int r = 0; r < 16; ++r) { p0[r] = 0.f; p1[r] = 0.f; }
#pragma unroll
            for (int s = 0; s < 4; ++s) {
                const bf16x8 a0 = *(const DLAS bf16x8*)(kb + s * 32), a1 = *(const DLAS bf16x8*)(kb + 32 * KROW + s * 32);
                p0 = __builtin_amdgcn_mfma_f32_32x32x16_bf16(a0, qf[s], p0, 0, 0, 0);
                p1 = __builtin_amdgcn_mfma_f32_32x32x16_bf16(a1, qf[s], p1, 0, 0, 0);
            }
            if (t >= cq - 2) {
                const int rb = 64 * t - qpos0 - r32 + 191 + 4 * hi;
#pragma unroll
                for (int r = 0; r < 16; ++r) { const int kk = (r & 3) + 8 * (r >> 2); p0[r] += bl[rb + kk]; p1[r] += bl[rb + 32 + kk]; }
            }
#pragma unroll
            for (int r = 0; r < 16; ++r) { p0[r] = __builtin_amdgcn_exp2f(p0[r]); p1[r] = __builtin_amdgcn_exp2f(p1[r]); }
            if (is_s && t == 16) {
#pragma unroll
                for (int r = 0; r < 16; ++r) p1[r] = 0.f;
            }
            float sa = 0.f, sb = 0.f;
#pragma unroll
            for (int r = 0; r < 16; ++r) { sa += p0[r]; sb += p1[r]; }
            lsum += sa + sb;
            bf16x8 pa[4];
            pa[0] = __builtin_bit_cast(bf16x8, pack8((f32x4){p0[0], p0[1], p0[2], p0[3]}, (f32x4){p0[4], p0[5], p0[6], p0[7]}));
            pa[1] = __builtin_bit_cast(bf16x8, pack8((f32x4){p0[8], p0[9], p0[10], p0[11]}, (f32x4){p0[12], p0[13], p0[14], p0[15]}));
            pa[2] = __builtin_bit_cast(bf16x8, pack8((f32x4){p1[0], p1[1], p1[2], p1[3]}, (f32x4){p1[4], p1[5], p1[6], p1[7]}));
            pa[3] = __builtin_bit_cast(bf16x8, pack8((f32x4){p1[8], p1[9], p1[10], p1[11]}, (f32x4){p1[12], p1[13], p1[14], p1[15]}));
            const DLAS unsigned char* vb = (const DLAS unsigned char*)(uintptr_t)vba;
#pragma unroll
            for (int d = 0; d < 4; ++d)
#pragma unroll
                for (int k = 0; k < 4; ++k) {
                    const s16x4 lo = __builtin_bit_cast(s16x4, __builtin_amdgcn_ds_read_tr16_b64_v4i16((DLAS s16x4*)(vb + d * 4096 + k * 1024)));
                    const s16x4 hh = __builtin_bit_cast(s16x4, __builtin_amdgcn_ds_read_tr16_b64_v4i16((DLAS s16x4*)(vb + d * 4096 + k * 1024 + 512)));
                    const bf16x8 bf = (bf16x8){lo[0], lo[1], lo[2], lo[3], hh[0], hh[1], hh[2], hh[3]};
                    o[d] = __builtin_amdgcn_mfma_f32_32x32x16_bf16(pa[k], bf, o[d], 0, 0, 0);
                    if (k == 3) __builtin_amdgcn_sched_barrier(0);
                }
        }
        if (has_next) TILE_WRITE(t + 1);
        __syncthreads();
    }
    lsum += __shfl_xor(lsum, 32);
    DLAS float* stage = (DLAS float*)(lds + OFF_STAGE);
    {
        const int rowb = is_s ? 0 : 32 * w4;
        DLAS float* st0 = stage + (mp * 128 + rowb + 4 * hi) * 128 + r32;
#pragma unroll 1
        for (int round = 0; round < (is_s ? 4 : 1); ++round) {
            if (!is_s || round == w4) {
                const bool first = !is_s || round == 0;
#pragma unroll
                for (int d = 0; d < 4; ++d)
#pragma unroll
                    for (int r = 0; r < 16; ++r) {
                        DLAS float* st = st0 + ((r & 3) + 8 * (r >> 2)) * 128 + d * 32;
                        *st = first ? o[d][r] : *st + o[d][r];
                    }
                if (hi == 0) { DLAS float* lp = &lst[mp * 128 + rowb + r32]; *lp = first ? lsum : *lp + lsum; }
            }
            __syncthreads();
        }
    }
    {
        const int nrow = is_s ? 4 : 16;
        const float lam = T->lam;
        const float* sg = P.in[18];
        for (int i = 0; i < nrow; ++i) {
            const int row = wave * nrow + i;
            const float l1 = lst[row], l2 = lst[128 + row];
            const float il1 = 1.f / l1, il2 = lam / l2;
            const float a0 = stage[row * 128 + lane] * il1 - stage[(128 + row) * 128 + lane] * il2;
            const float a1 = stage[row * 128 + 64 + lane] * il1 - stage[(128 + row) * 128 + 64 + lane] * il2;
            const float ss = wave_sum(a0 * a0 + a1 * a1);
            const float rr = rsqrtf(ss * (1.f / 128) + EPS) * (1.f - LAMBDA_INIT);
            const int m = is_s ? TP + 32 * u.idx + row : 128 * u.idx + row;
            const bf16_t* za = (const bf16_t*)(P.ws + WS_PROJ0) + (size_t)m * N0P + C_ZA + 128 * u.h;
            bf16_t* cat = (bf16_t*)(P.ws + WS_CAT) + (size_t)m * D + 128 * u.h;
            cat[lane] = f2bf(a0 * rr * sg[lane] * silu(bf2f(za[lane])));
            cat[64 + lane] = f2bf(a1 * rr * sg[64 + lane] * silu(bf2f(za[64 + lane])));
        }
    }
    __syncthreads();
}

__device__ __forceinline__ void phase(const Ptrs& P, DLAS unsigned char* lds, unsigned* qhead, volatile DLAS unsigned* slot, int tid) {
#pragma unroll 1
    for (;;) {
        if (tid == 0) *slot = __hip_atomic_fetch_add(qhead, 1u, __ATOMIC_RELAXED, __HIP_MEMORY_SCOPE_AGENT);
        __syncthreads();
        const int i = (int)*slot;
        __syncthreads();
        if (i >= 640) break;
        if (i < 512) unit_run<0>(P, Unit{0, i & 3, 127 - (i >> 2)}, lds, tid);
        else unit_run<1>(P, Unit{1, (i - 512) & 3, (i - 512) >> 2}, lds, tid);
    }
}
#undef DLAS
}
namespace sb {
typedef short bf16x8 __attribute__((ext_vector_type(8)));
typedef short s16x4 __attribute__((ext_vector_type(4)));
typedef float f32x16 __attribute__((ext_vector_type(16)));
typedef float f32x4 __attribute__((ext_vector_type(4)));
typedef unsigned u32x4 __attribute__((ext_vector_type(4)));
typedef unsigned u32x2 __attribute__((ext_vector_type(2)));

__device__ __forceinline__ unsigned cvtpk(float lo, float hi) { unsigned r; asm volatile("v_cvt_pk_bf16_f32 %0, %1, %2" : "=v"(r) : "v"(lo), "v"(hi)); return r; }
constexpr float RUN_EXIT = 160.f;

template <int SAMPLE> __device__ __forceinline__ void unit_run(const Ptrs& P, int b, int h, int qt, int lane) {
    const int r32 = lane & 31, hi = lane >> 5;
    const bf16_t* Q1 = (const bf16_t*)(P.ws + WS_Q1); const bf16_t* K1 = (const bf16_t*)(P.ws + WS_K1); const bf16_t* V1T = (const bf16_t*)(P.ws + WS_V1T);
    const int m0 = SAMPLE ? TP + 32 * b : 32 * qt;
    const int q0 = SAMPLE ? PAST : 32 * qt;
    bf16x8 qf[4];
    { const bf16_t* qp = Q1 + (size_t)(m0 + r32) * D + 64 * h + 8 * hi;
#pragma unroll
      for (int s = 0; s < 4; ++s) qf[s] = *(const bf16x8*)(qp + 16 * s); }
    f32x16 o0, o1;
#pragma unroll
    for (int r = 0; r < 16; ++r) { o0[r] = 0.f; o1[r] = 0.f; }
    float run = 0.f;
#pragma unroll 1
    for (int k0 = q0; k0 >= 0; k0 -= 32) {
        const bool diag = (k0 == q0);
        const bool cache = SAMPLE && !diag;
        f32x16 p;
#pragma unroll
        for (int r = 0; r < 16; ++r) p[r] = 0.f;
        if (!cache) {
            const int mk = SAMPLE ? TP + 32 * b : k0;
            const bf16_t* kp = K1 + (size_t)(mk + r32) * D + 64 * h + 8 * hi;
#pragma unroll
            for (int s = 0; s < 4; ++s) { const bf16x8 a = *(const bf16x8*)(kp + 16 * s); p = __builtin_amdgcn_mfma_f32_32x32x16_bf16(a, qf[s], p, 0, 0, 0); }
        } else {
            const float* kp = P.in[6] + (((size_t)b * PAST + k0 + r32) * 16 + h) * 64 + 8 * hi;
#pragma unroll
            for (int s = 0; s < 4; ++s) { const f32x4 x0 = *(const f32x4*)(kp + 16 * s), x1 = *(const f32x4*)(kp + 16 * s + 4);
                u32x4 w; w.x = cvtpk(x0[0], x0[1]); w.y = cvtpk(x0[2], x0[3]); w.z = cvtpk(x1[0], x1[1]); w.w = cvtpk(x1[2], x1[3]);
                p = __builtin_amdgcn_mfma_f32_32x32x16_bf16(__builtin_bit_cast(bf16x8, w), qf[s], p, 0, 0, 0); }
        }
        float sp[16];
#pragma unroll
        for (int r = 0; r < 16; ++r) {
            const int kk = (r & 3) + 8 * (r >> 2) + 4 * hi;
            const float e = __builtin_amdgcn_exp2f(p[r]);
            float s = __builtin_amdgcn_logf(1.f + e);
            if (diag && !(kk < r32)) s = 0.f;
            sp[r] = s;
        }
        float a[4], bsum[4];
#pragma unroll
        for (int g = 0; g < 4; ++g) { a[g] = (sp[4 * g] + sp[4 * g + 1]) + (sp[4 * g + 2] + sp[4 * g + 3]); bsum[g] = __shfl_xor(a[g], 32); }
        float Tg[4];
        { float accA = 0.f, accB = 0.f;
#pragma unroll
          for (int g = 3; g >= 0; --g) {
              const float pb = hi ? accB : accB + bsum[g];
              Tg[g] = accA + pb;
              accA += a[g]; accB += bsum[g];
          }
          const float tot = accA + accB;
#pragma unroll
          for (int g = 0; g < 4; ++g) {
              float c = Tg[g] + run;
#pragma unroll
              for (int i = 3; i >= 0; --i) {
                  const int r = 4 * g + i, kk = i + 8 * g + 4 * hi;
                  c += sp[r];
                  float w = __builtin_amdgcn_exp2f(p[r] - c);
                  if (diag && !(kk < r32)) w = 0.f;
                  p[r] = w;
              }
          }
          run += tot;
        }
        u32x4 w0, w1;
        w0.x = cvtpk(p[0], p[1]); w0.y = cvtpk(p[2], p[3]); w0.z = cvtpk(p[4], p[5]); w0.w = cvtpk(p[6], p[7]);
        w1.x = cvtpk(p[8], p[9]); w1.y = cvtpk(p[10], p[11]); w1.z = cvtpk(p[12], p[13]); w1.w = cvtpk(p[14], p[15]);
        const bf16x8 pa0 = __builtin_bit_cast(bf16x8, w0), pa1 = __builtin_bit_cast(bf16x8, w1);
        if (!cache) {
            const int mk = SAMPLE ? TP + 32 * b : k0;
            const bf16_t* vp = V1T + (size_t)(64 * h + r32) * M + mk + 4 * hi;
#pragma unroll
            for (int d = 0; d < 2; ++d)
#pragma unroll
                for (int s = 0; s < 2; ++s) {
                    const u32x2 lo = *(const u32x2*)(vp + (size_t)(32 * d) * M + 16 * s), hh = *(const u32x2*)(vp + (size_t)(32 * d) * M + 16 * s + 8);
                    const u32x4 w = (u32x4){lo.x, lo.y, hh.x, hh.y};
                    if (d == 0) o0 = __builtin_amdgcn_mfma_f32_32x32x16_bf16(s == 0 ? pa0 : pa1, __builtin_bit_cast(bf16x8, w), o0, 0, 0, 0);
                    else o1 = __builtin_amdgcn_mfma_f32_32x32x16_bf16(s == 0 ? pa0 : pa1, __builtin_bit_cast(bf16x8, w), o1, 0, 0, 0);
                }
        } else {
            const float* vp = P.in[7] + (((size_t)b * PAST + k0 + 4 * hi) * 16 + h) * 64 + r32;
#pragma unroll
            for (int d = 0; d < 2; ++d)
#pragma unroll
                for (int s = 0; s < 2; ++s) {
                    float x[8];
#pragma unroll
                    for (int j = 0; j < 8; ++j) x[j] = vp[(size_t)(16 * s + 8 * (j >> 2) + (j & 3)) * 1024 + 32 * d];
                    u32x4 w; w.x = cvtpk(x[0], x[1]); w.y = cvtpk(x[2], x[3]); w.z = cvtpk(x[4], x[5]); w.w = cvtpk(x[6], x[7]);
                    if (d == 0) o0 = __builtin_amdgcn_mfma_f32_32x32x16_bf16(s == 0 ? pa0 : pa1, __builtin_bit_cast(bf16x8, w), o0, 0, 0, 0);
                    else o1 = __builtin_amdgcn_mfma_f32_32x32x16_bf16(s == 0 ? pa0 : pa1, __builtin_bit_cast(bf16x8, w), o1, 0, 0, 0);
                }
        }
        if (__all(run >= RUN_EXIT)) break;
    }
    const bf16_t* Z1 = (const bf16_t*)(P.ws + WS_Z1); bf16_t* O1 = (bf16_t*)(P.ws + WS_O1B);
#pragma unroll
    for (int r = 0; r < 16; ++r) {
        const int q = (r & 3) + 8 * (r >> 2) + 4 * hi;
        const size_t off = (size_t)(m0 + q) * D + 64 * h + r32;
        O1[off] = f2bf(o0[r] * silu(bf2f(Z1[off])));
        O1[off + 32] = f2bf(o1[r] * silu(bf2f(Z1[off + 32])));
    }
}

#define SLAS __attribute__((address_space(3)))
#ifndef SB_FORCE_GLOBAL
#define SB_FORCE_GLOBAL 0
#endif
#ifndef SB_LDS_K
#define SB_LDS_K 1
#endif
#ifndef SB_LDS_V
#define SB_LDS_V 1
#endif
constexpr int KS = 144, VS = 1032, L_K = 0, L_V = 512 * KS, SB_LDS_END = L_V + 64 * VS;
static_assert(SB_LDS_END <= 147456 - 64, "sb lds");
__device__ __forceinline__ void unit_prompt_wg(const Ptrs& P, int h, int qb, SLAS unsigned char* lds, int tid) {
    asm volatile("" : "+v"(tid));
    const int lane = tid & 63, wave = __builtin_amdgcn_readfirstlane(tid >> 6), r32 = lane & 31, hi = lane >> 5;
    const bf16_t* Q1 = (const bf16_t*)(P.ws + WS_Q1); const bf16_t* K1 = (const bf16_t*)(P.ws + WS_K1); const bf16_t* V1T = (const bf16_t*)(P.ws + WS_V1T);
    const int q0b = 256 * qb, wlo = q0b - 256;
    {
        f32x4 kreg[8]; u32x4 vreg[8];
#pragma unroll
        for (int i = 0; i < 8; ++i) { const int c = tid + 512 * i, row = c >> 3, ch = c & 7; const int pos = wlo + row;
            kreg[i] = pos >= 0 ? *(const f32x4*)(K1 + (size_t)pos * D + 64 * h + 8 * ch) : (f32x4){0.f, 0.f, 0.f, 0.f}; }
#pragma unroll
        for (int i = 0; i < 8; ++i) { const int c = tid + 512 * i, d = c >> 6, ch = c & 63; const int pos = wlo + 8 * ch;
            vreg[i] = pos >= 0 ? *(const u32x4*)(V1T + (size_t)(64 * h + d) * M + pos) : (u32x4){0u, 0u, 0u, 0u}; }
#pragma unroll
        for (int i = 0; i < 8; ++i) { const int c = tid + 512 * i, row = c >> 3, ch = c & 7; *(SLAS f32x4*)(lds + L_K + row * KS + ch * 16) = kreg[i]; }
#pragma unroll
        for (int i = 0; i < 8; ++i) { const int c = tid + 512 * i, d = c >> 6, ch = c & 63; SLAS unsigned char* p = lds + L_V + d * VS + ch * 16;
            *(SLAS u32x2*)p = (u32x2){vreg[i].x, vreg[i].y};
            *(SLAS u32x2*)(p + 8) = (u32x2){vreg[i].z, vreg[i].w}; }
    }
    const int q0 = q0b + 32 * wave, m0 = q0;
    bf16x8 qf[4];
    { const bf16_t* qp = Q1 + (size_t)(m0 + r32) * D + 64 * h + 8 * hi;
#pragma unroll
      for (int s = 0; s < 4; ++s) qf[s] = *(const bf16x8*)(qp + 16 * s); }
    __syncthreads();
    f32x16 o0, o1;
#pragma unroll
    for (int r = 0; r < 16; ++r) { o0[r] = 0.f; o1[r] = 0.f; }
    float run = 0.f;
#pragma unroll 1
    for (int k0 = q0; k0 >= 0; k0 -= 32) {
        const bool diag = (k0 == q0);
        const bool inwin = (k0 >= wlo) && !SB_FORCE_GLOBAL;
        f32x16 p;
#pragma unroll
        for (int r = 0; r < 16; ++r) p[r] = 0.f;
        if (inwin && SB_LDS_K) {
            const SLAS unsigned char* kp = lds + L_K + (k0 - wlo + r32) * KS + hi * 16;
#pragma unroll
            for (int s = 0; s < 4; ++s) p = __builtin_amdgcn_mfma_f32_32x32x16_bf16(*(const SLAS bf16x8*)(kp + 32 * s), qf[s], p, 0, 0, 0);
        } else {
            const bf16_t* kp = K1 + (size_t)(k0 + r32) * D + 64 * h + 8 * hi;
#pragma unroll
            for (int s = 0; s < 4; ++s) p = __builtin_amdgcn_mfma_f32_32x32x16_bf16(*(const bf16x8*)(kp + 16 * s), qf[s], p, 0, 0, 0);
        }
        float sp[16];
#pragma unroll
        for (int r = 0; r < 16; ++r) {
            const int kk = (r & 3) + 8 * (r >> 2) + 4 * hi;
            float sv = __builtin_amdgcn_logf(1.f + __builtin_amdgcn_exp2f(p[r]));
            if (diag && !(kk < r32)) sv = 0.f;
            sp[r] = sv;
        }
        float a[4], bsum[4], Tg[4];
#pragma unroll
        for (int g = 0; g < 4; ++g) { a[g] = (sp[4 * g] + sp[4 * g + 1]) + (sp[4 * g + 2] + sp[4 * g + 3]); bsum[g] = __shfl_xor(a[g], 32); }
        float accA = 0.f, accB = 0.f;
#pragma unroll
        for (int g = 3; g >= 0; --g) { const float pb = hi ? accB : accB + bsum[g]; Tg[g] = accA + pb; accA += a[g]; accB += bsum[g]; }
#pragma unroll
        for (int g = 0; g < 4; ++g) {
            float c = Tg[g] + run;
#pragma unroll
            for (int i = 3; i >= 0; --i) { const int r = 4 * g + i, kk = i + 8 * g + 4 * hi; c += sp[r]; float w = __builtin_amdgcn_exp2f(p[r] - c); if (diag && !(kk < r32)) w = 0.f; p[r] = w; }
        }
        run += accA + accB;
        u32x4 w0, w1;
        w0.x = cvtpk(p[0], p[1]); w0.y = cvtpk(p[2], p[3]); w0.z = cvtpk(p[4], p[5]); w0.w = cvtpk(p[6], p[7]);
        w1.x = cvtpk(p[8], p[9]); w1.y = cvtpk(p[10], p[11]); w1.z = cvtpk(p[12], p[13]); w1.w = cvtpk(p[14], p[15]);
        const bf16x8 pa0 = __builtin_bit_cast(bf16x8, w0), pa1 = __builtin_bit_cast(bf16x8, w1);
        if (inwin && SB_LDS_V) {
            const SLAS unsigned char* vp = lds + L_V + r32 * VS + (k0 - wlo + 4 * hi) * 2;
#pragma unroll
            for (int d = 0; d < 2; ++d)
#pragma unroll
                for (int s = 0; s < 2; ++s) {
                    const u32x2 lo = *(const SLAS u32x2*)(vp + d * 32 * VS + 32 * s), hh = *(const SLAS u32x2*)(vp + d * 32 * VS + 32 * s + 16);
                    const u32x4 w = (u32x4){lo.x, lo.y, hh.x, hh.y};
                    if (d == 0) o0 = __builtin_amdgcn_mfma_f32_32x32x16_bf16(s == 0 ? pa0 : pa1, __builtin_bit_cast(bf16x8, w), o0, 0, 0, 0);
                    else o1 = __builtin_amdgcn_mfma_f32_32x32x16_bf16(s == 0 ? pa0 : pa1, __builtin_bit_cast(bf16x8, w), o1, 0, 0, 0);
                }
        } else {
            const bf16_t* vp = V1T + (size_t)(64 * h + r32) * M + k0 + 4 * hi;
#pragma unroll
            for (int d = 0; d < 2; ++d)
#pragma unroll
                for (int s = 0; s < 2; ++s) {
                    const u32x2 lo = *(const u32x2*)(vp + (size_t)(32 * d) * M + 16 * s), hh = *(const u32x2*)(vp + (size_t)(32 * d) * M + 16 * s + 8);
                    const u32x4 w = (u32x4){lo.x, lo.y, hh.x, hh.y};
                    if (d == 0) o0 = __builtin_amdgcn_mfma_f32_32x32x16_bf16(s == 0 ? pa0 : pa1, __builtin_bit_cast(bf16x8, w), o0, 0, 0, 0);
                    else o1 = __builtin_amdgcn_mfma_f32_32x32x16_bf16(s == 0 ? pa0 : pa1, __builtin_bit_cast(bf16x8, w), o1, 0, 0, 0);
                }
        }
        if (__all(run >= RUN_EXIT)) break;
    }
    const bf16_t* Z1 = (const bf16_t*)(P.ws + WS_Z1); bf16_t* O1 = (bf16_t*)(P.ws + WS_O1B);
#pragma unroll
    for (int r = 0; r < 16; ++r) {
        const int q = (r & 3) + 8 * (r >> 2) + 4 * hi;
        const size_t off = (size_t)(m0 + q) * D + 64 * h + r32;
        O1[off] = f2bf(o0[r] * silu(bf2f(Z1[off])));
        O1[off + 32] = f2bf(o1[r] * silu(bf2f(Z1[off + 32])));
    }
    __syncthreads();
}
#undef SLAS

__device__ __forceinline__ void phase(const Ptrs& P, __attribute__((address_space(3))) unsigned char* lds, int wg, int nwg, int tid) {
#pragma unroll 1
    for (int i = wg; i < 16 * 64; i += nwg) unit_prompt_wg(P, i & 15, i >> 4, lds, tid);
    const int gw = wg * 8 + (tid >> 6), ngw = nwg * 8;
#pragma unroll 1
    for (int i = gw; i < 16 * 32; i += ngw) unit_run<1>(P, i >> 4, i & 15, 0, tid & 63);
}
}
namespace rw {
#define RLAS __attribute__((address_space(3)))
typedef short bf16x8 __attribute__((ext_vector_type(8)));
typedef float f32x16 __attribute__((ext_vector_type(16)));
typedef float f32x4 __attribute__((ext_vector_type(4)));
typedef unsigned u32x4 __attribute__((ext_vector_type(4)));
typedef unsigned u32x2 __attribute__((ext_vector_type(2)));

constexpr int NUNIT = 2048 + 256;
constexpr size_t U_MFRAG = 0;
constexpr size_t U_NRAW = 16384;
constexpr size_t U_HRAW = 32768;
constexpr size_t U_G = 49152;
constexpr size_t U_BON = 57344;
constexpr size_t U_BYTES = 65536;
static_assert(WS_RW + (size_t)NUNIT * U_BYTES <= WS_SST, "rw region");

constexpr int SB = 144, SF = 272;
constexpr int BSZ = 64 * SB, FSZ = 64 * SF;
constexpr int L_S0 = 0, L_S1 = BSZ, L_S2 = 2 * BSZ, L_S3 = 3 * BSZ, L_S4 = 4 * BSZ, L_S5 = 5 * BSZ, L_S6 = 6 * BSZ, L_S7 = 7 * BSZ, L_S8 = 8 * BSZ, L_S9 = 9 * BSZ;
constexpr int L_F0 = 10 * BSZ, L_F1 = L_F0 + FSZ, L_F2 = L_F1 + FSZ;
constexpr int L_PC = L_F2 + FSZ;
constexpr int L_TOT = L_PC + 256;
constexpr int RW_LDS_END = L_TOT + 2048;
static_assert(RW_LDS_END <= 147456, "rw lds");

__device__ __forceinline__ unsigned cvtpk(float lo, float hi) { unsigned r; asm volatile("v_cvt_pk_bf16_f32 %0, %1, %2" : "=v"(r) : "v"(lo), "v"(hi)); return r; }
__device__ __forceinline__ float bflo(unsigned w) { return __uint_as_float(w << 16); }
__device__ __forceinline__ float bfhi(unsigned w) { return __uint_as_float(w & 0xffff0000u); }

__device__ __forceinline__ f32x16 mm_tile(f32x16 acc, const RLAS unsigned char* A, int arow0, const RLAS unsigned char* B, int brow0, int r32, int hi) {
    const RLAS unsigned char* ap = A + (arow0 + r32) * SB + hi * 16;
    const RLAS unsigned char* bp = B + (brow0 + r32) * SB + hi * 16;
#pragma unroll
    for (int s = 0; s < 4; ++s) acc = __builtin_amdgcn_mfma_f32_32x32x16_bf16(*(const RLAS bf16x8*)(ap + 32 * s), *(const RLAS bf16x8*)(bp + 32 * s), acc, 0, 0, 0);
    return acc;
}
__device__ __forceinline__ f32x16 zero16() { f32x16 z;
#pragma unroll
    for (int r = 0; r < 16; ++r) z[r] = 0.f; return z; }

template <int J> struct SolveStep {
    static __device__ __forceinline__ void run(float (&R)[16], const RLAS unsigned char* ap  ) {
        constexpr int jq = J & 3, jg = J >> 2;
        const float xj = __builtin_bit_cast(float, __builtin_amdgcn_update_dpp(0, __builtin_bit_cast(int, R[jg]), jq | (jq << 2) | (jq << 4) | (jq << 6), 0xf, 0xf, false));
#pragma unroll
        for (int gq = jg >> 2; gq < 4; ++gq) {
            const f32x4 a = *(const RLAS f32x4*)(ap + J * SF + 16 * gq);
#pragma unroll
            for (int i = 0; i < 4; ++i) { if (4 * gq + i >= jg) R[4 * gq + i] -= a[i] * xj; }
        }
        SolveStep<J + 1>::run(R, ap);
    }
};
template <> struct SolveStep<63> { static __device__ __forceinline__ void run(float (&)[16], const RLAS unsigned char*) {} };

__device__ __forceinline__ void unit_a(const Ptrs& P, int unit, RLAS unsigned char* lds, int tid) {
    asm volatile("" : "+v"(tid));
    const int lane = tid & 63, wave = __builtin_amdgcn_readfirstlane(tid >> 6), r32 = lane & 31, hi = lane >> 5;
    const bool samp = unit >= 2048;
    const int h = unit & 7, cb = samp ? (unit - 2048) >> 3 : unit >> 3;
    const int m_base = samp ? TP + 32 * cb : 64 * cb;
    const int nvalid = samp ? 32 : 64;
    const bf16_t* PR = (const bf16_t*)(P.ws + WS_PROJ0);
    unsigned char* urec = P.ws + WS_RW + (size_t)unit * U_BYTES;
    const float* mu = P.in[19];
    const int ch = 64 * h + lane;
    float rr[8], kr[8], vr[8];
    {
        const float mu_r = mu[ch], mu_k = mu[512 + ch], mu_v = mu[1024 + ch], mu_w = mu[1536 + lane], mu_a = mu[1600 + lane];
        const int t0 = 8 * wave;
        float x_r[9], x_k[9], x_v[9], x_w[9], x_a[9];
        const int mprev = m_base + t0 - 1;
        const bool prev_state = samp && t0 == 0, prev_zero = (!samp && mprev < 0) || t0 >= nvalid;
        {
            const int mp = (prev_state || prev_zero) ? m_base : mprev;
            const bf16_t* p = PR + (size_t)mp * N0P + C_PRW;
            x_r[0] = bf2f(p[ch]); x_k[0] = bf2f(p[512 + ch]); x_v[0] = bf2f(p[1024 + ch]); x_w[0] = bf2f(p[1536 + lane]); x_a[0] = bf2f(p[1600 + lane]);
        }
#pragma unroll
        for (int i = 0; i < 8; ++i) {
            const int t = t0 + i, tc = t < nvalid ? t : nvalid - 1;
            const bf16_t* p = PR + (size_t)(m_base + tc) * N0P + C_PRW;
            x_r[i + 1] = bf2f(p[ch]); x_k[i + 1] = bf2f(p[512 + ch]); x_v[i + 1] = bf2f(p[1024 + ch]); x_w[i + 1] = bf2f(p[1536 + lane]); x_a[i + 1] = bf2f(p[1600 + lane]);
        }
        if (prev_state) { const float* sh = P.in[4] + (size_t)cb * RWS; x_r[0] = sh[ch]; x_k[0] = sh[512 + ch]; x_v[0] = sh[1024 + ch]; x_w[0] = sh[1536 + lane]; x_a[0] = sh[1600 + lane]; }
        if (prev_zero) { x_r[0] = 0.f; x_k[0] = 0.f; x_v[0] = 0.f; x_w[0] = 0.f; x_a[0] = 0.f; }
#pragma unroll
        for (int i = 0; i < 8; ++i) {
            const int t = t0 + i;
            if (t >= nvalid) { x_r[i + 1] = 0.f; x_k[i + 1] = 0.f; x_v[i + 1] = 0.f; x_w[i + 1] = 0.f; x_a[i + 1] = 0.f; }
            rr[i] = x_r[i + 1] + (x_r[i] - x_r[i + 1]) * mu_r; kr[i] = x_k[i + 1] + (x_k[i] - x_k[i + 1]) * mu_k; vr[i] = x_v[i + 1] + (x_v[i] - x_v[i + 1]) * mu_v;
            const float wl = x_w[i + 1] + (x_w[i] - x_w[i + 1]) * mu_w, al = x_a[i + 1] + (x_a[i] - x_a[i + 1]) * mu_a;
            const float th = 1.f - 2.f * __builtin_amdgcn_rcpf(__builtin_amdgcn_exp2f(wl * (2.f * LOG2E)) + 1.f);
            *(RLAS bf16_t*)(lds + L_S0 + t * SB + lane * 2) = f2bf(th);
            *(RLAS bf16_t*)(lds + L_S1 + t * SB + lane * 2) = f2bf(al);
        }
    }
    __syncthreads();
    {
        const int which = wave >> 2, tile = wave & 3, ti = tile >> 1, tj = tile & 1;
        const bf16_t* WT = (const bf16_t*)(P.ws + WS_LORA) + (size_t)which * 512 * 64 + (size_t)(64 * h + 32 * tj + r32) * 64 + 8 * hi;
        const RLAS unsigned char* ap = lds + (which ? L_S1 : L_S0) + (32 * ti + r32) * SB + hi * 16;
        f32x16 acc = zero16();
#pragma unroll
        for (int s = 0; s < 4; ++s) acc = __builtin_amdgcn_mfma_f32_32x32x16_bf16(*(const RLAS bf16x8*)(ap + 32 * s), *(const bf16x8*)(WT + 16 * s), acc, 0, 0, 0);
        RLAS unsigned char* o = lds + (which ? L_F1 : L_F0) + (32 * tj + r32) * 4;
#pragma unroll
        for (int r = 0; r < 16; ++r) *(RLAS float*)(o + (32 * ti + (r & 3) + 8 * (r >> 2) + 4 * hi) * SF) = acc[r];
    }
    __syncthreads();
    {
        const float w0 = P.in[20][ch], a0 = P.in[22][ch], k_k = P.in[24][ch], k_a = P.in[25][ch], r_k = P.in[26][ch];
        const int t0 = 8 * wave;
        float kk[8], kka[8], km[8], ld[8];
        float run = 0.f;
#pragma unroll
        for (int i = 0; i < 8; ++i) {
            const int t = t0 + i;
            const float wa = w0 + *(const RLAS float*)(lds + L_F0 + t * SF + lane * 4), aa = a0 + *(const RLAS float*)(lds + L_F1 + t * SF + lane * 4);
            const float nw = -wa;
            const float spl = fmaxf(nw, 0.f) + __builtin_amdgcn_logf(1.f + __builtin_amdgcn_exp2f(-fabsf(nw) * LOG2E)) * 0.6931471805599453f;
            const float w = -spl - 0.5f;
            float logd = -__builtin_amdgcn_exp2f(w * LOG2E);
            const float a = __builtin_amdgcn_rcpf(1.f + __builtin_amdgcn_exp2f(-aa * LOG2E));
            float kx = kr[i] * k_k;
            const float n2 = wave_sum(kx * kx);
            kx = kx * __builtin_amdgcn_rcpf(fmaxf(__builtin_amdgcn_sqrtf(n2), 1e-12f));
            float kmod = kr[i] * (1.f + (a - 1.f) * k_a);
            if (t >= nvalid) { kx = 0.f; kmod = 0.f; logd = 0.f; rr[i] = 0.f; vr[i] = 0.f; }
            kk[i] = kx; kka[i] = kx * a; km[i] = kmod;
            const float scal = wave_sum(rr[i] * kmod * r_k);
            ((bf16_t*)(urec + U_BON))[t * 64 + lane] = f2bf(scal * vr[i]);
            run += logd; ld[i] = run;
        }
        *(RLAS float*)(lds + L_TOT + (wave * 64 + lane) * 4) = run;
        __syncthreads();
        float base = 0.f, lc = 0.f;
#pragma unroll
        for (int w = 0; w < 8; ++w) { const float tw = *(const RLAS float*)(lds + L_TOT + (w * 64 + lane) * 4); if (w < wave) base += tw; lc += tw; }
        if (wave == 0) *(RLAS float*)(lds + L_PC + lane * 4) = __builtin_amdgcn_exp2f(lc * LOG2E);
        float kbt[8], kdt[8], kkt[8];
#pragma unroll
        for (int i = 0; i < 8; ++i) {
            const int t = t0 + i;
            const float L = base + ld[i], Lm1 = L - (i == 0 ? ld[0] : ld[i] - ld[i - 1]);
            const float eL = __builtin_amdgcn_exp2f(L * LOG2E), eLm1 = __builtin_amdgcn_exp2f(Lm1 * LOG2E), enL = __builtin_amdgcn_exp2f(-L * LOG2E), eCL = __builtin_amdgcn_exp2f((lc - L) * LOG2E);
            kkt[i] = kk[i] * eLm1;
            *(RLAS bf16_t*)(lds + L_S2 + t * SB + lane * 2) = f2bf(kkt[i]);
            *(RLAS bf16_t*)(lds + L_S5 + t * SB + lane * 2) = f2bf(rr[i] * eL);
            *(RLAS bf16_t*)(lds + L_S3 + t * SB + lane * 2) = f2bf(kka[i] * enL);
            *(RLAS bf16_t*)(lds + L_S4 + t * SB + lane * 2) = f2bf(km[i] * enL);
            kbt[i] = kka[i] * eCL; kdt[i] = km[i] * eCL;
        }
        u32x4 w;
        w.x = cvtpk(kbt[0], kbt[1]); w.y = cvtpk(kbt[2], kbt[3]); w.z = cvtpk(kbt[4], kbt[5]); w.w = cvtpk(kbt[6], kbt[7]);
        *(RLAS u32x4*)(lds + L_S6 + lane * SB + t0 * 2) = w;
        w.x = cvtpk(kdt[0], kdt[1]); w.y = cvtpk(kdt[2], kdt[3]); w.z = cvtpk(kdt[4], kdt[5]); w.w = cvtpk(kdt[6], kdt[7]);
        *(RLAS u32x4*)(lds + L_S7 + lane * SB + t0 * 2) = w;
        w.x = cvtpk(vr[0], vr[1]); w.y = cvtpk(vr[2], vr[3]); w.z = cvtpk(vr[4], vr[5]); w.w = cvtpk(vr[6], vr[7]);
        *(RLAS u32x4*)(lds + L_S8 + lane * SB + t0 * 2) = w;
        *(RLAS f32x4*)(lds + L_F2 + lane * SF + t0 * 4) = (f32x4){kkt[0], kkt[1], kkt[2], kkt[3]};
        *(RLAS f32x4*)(lds + L_F2 + lane * SF + t0 * 4 + 16) = (f32x4){kkt[4], kkt[5], kkt[6], kkt[7]};
    }
    __syncthreads();
    {
        const int q = wave >> 1;
#pragma unroll
        for (int tl = 0; tl < 2; ++tl) {
            const int tile = 2 * (wave & 1) + tl, ti = tile >> 1, tj = tile & 1;
            f32x16 acc = zero16();
            if (q == 0) {
                if (!(ti == 0 && tj == 1)) acc = mm_tile(acc, lds + L_S2, 32 * ti, lds + L_S3, 32 * tj, r32, hi);
                const int j = 32 * tj + r32;
#pragma unroll
                for (int g = 0; g < 4; ++g) { const int tb = 32 * ti + 8 * g + 4 * hi;
#pragma unroll
                    for (int i = 0; i < 4; ++i) *(RLAS float*)(lds + L_F0 + j * SF + (i * 16 + (tb >> 2)) * 4) = (j < tb + i) ? acc[4 * g + i] : 0.f; }
            } else {
                const RLAS unsigned char* Am = lds + ((q == 2) ? L_S3 : L_S4);
                const RLAS unsigned char* Bm = lds + ((q == 1) ? L_S2 : L_S5);
                if (!(ti == 1 && tj == 0)) acc = mm_tile(acc, Am, 32 * ti, Bm, 32 * tj, r32, hi);
                const int t = 32 * tj + r32;
                RLAS unsigned char* O = lds + (q == 1 ? L_S0 : q == 2 ? L_S1 : L_S9);
#pragma unroll
                for (int g = 0; g < 4; ++g) { const int jb = 32 * ti + 8 * g + 4 * hi; float v[4];
#pragma unroll
                    for (int i = 0; i < 4; ++i) { const int j = jb + i; const bool keep = (q == 1) ? (j < t) : (j <= t); v[i] = keep ? acc[4 * g + i] : 0.f; }
                    u32x2 pk; pk.x = cvtpk(v[0], v[1]); pk.y = cvtpk(v[2], v[3]);
                    *(RLAS u32x2*)(O + t * SB + jb * 2) = pk; }
            }
        }
    }
    __syncthreads();
    if (wave < 4) {
        const int ti = wave >> 1, tj = wave & 1;
        f32x16 acc = mm_tile(zero16(), lds + L_S0, 32 * ti, lds + L_S8, 32 * tj, r32, hi);
        const int v = 32 * tj + r32;
#pragma unroll
        for (int g = 0; g < 4; ++g) { const int tb = 32 * ti + 8 * g + 4 * hi; *(RLAS f32x4*)(lds + L_F1 + v * SF + tb * 4) = (f32x4){acc[4 * g], acc[4 * g + 1], acc[4 * g + 2], acc[4 * g + 3]}; }
    }
    __syncthreads();
    {
        const int q = lane & 3, col = 16 * wave + (lane >> 2);
        const RLAS unsigned char* rhs = lds + (col < 64 ? L_F2 + col * SF : L_F1 + (col - 64) * SF);
        float R[16];
#pragma unroll
        for (int g = 0; g < 16; ++g) { const f32x4 v = *(const RLAS f32x4*)(rhs + 16 * g); R[g] = q == 0 ? v[0] : q == 1 ? v[1] : q == 2 ? v[2] : v[3]; }
        SolveStep<0>::run(R, lds + L_F0 + q * 64);
        RLAS unsigned char* O = lds + (col < 64 ? L_S2 + col * SB : L_S3 + (col - 64) * SB) + q * 2;
#pragma unroll
        for (int g = 0; g < 16; ++g) *(RLAS bf16_t*)(O + 8 * g) = f2bf(-R[g]);
    }
    __syncthreads();
    {
        const int which = wave >> 1;
#pragma unroll
        for (int tl = 0; tl < 2; ++tl) {
            const int tile = 2 * (wave & 1) + tl, ti = tile >> 1, tj = tile & 1;
            if (which == 0) {
                f32x16 acc = mm_tile(zero16(), lds + L_S2, 32 * ti, lds + L_S6, 32 * tj, r32, hi);
                if (ti == tj) { const float pc = *(const RLAS float*)(lds + L_PC + (32 * tj + r32) * 4);
#pragma unroll
                    for (int r = 0; r < 16; ++r) if (((r & 3) + 8 * (r >> 2) + 4 * hi) == r32) acc[r] += pc; }
#pragma unroll
                for (int sp = 0; sp < 2; ++sp) {
                    u32x4 wh, wl; float lo[8];
                    wh.x = cvtpk(acc[8 * sp], acc[8 * sp + 1]); wh.y = cvtpk(acc[8 * sp + 2], acc[8 * sp + 3]); wh.z = cvtpk(acc[8 * sp + 4], acc[8 * sp + 5]); wh.w = cvtpk(acc[8 * sp + 6], acc[8 * sp + 7]);
                    lo[0] = acc[8 * sp] - bflo(wh.x); lo[1] = acc[8 * sp + 1] - bfhi(wh.x); lo[2] = acc[8 * sp + 2] - bflo(wh.y); lo[3] = acc[8 * sp + 3] - bfhi(wh.y);
                    lo[4] = acc[8 * sp + 4] - bflo(wh.z); lo[5] = acc[8 * sp + 5] - bfhi(wh.z); lo[6] = acc[8 * sp + 6] - bflo(wh.w); lo[7] = acc[8 * sp + 7] - bfhi(wh.w);
                    wl.x = cvtpk(lo[0], lo[1]); wl.y = cvtpk(lo[2], lo[3]); wl.z = cvtpk(lo[4], lo[5]); wl.w = cvtpk(lo[6], lo[7]);
                    unsigned char* f = urec + U_MFRAG + (size_t)(((tj * 4 + (2 * ti + sp)) * 2) * 64 + lane) * 16;
                    *(u32x4*)f = wh; *(u32x4*)(f + 1024) = wl;
                }
            } else if (which == 1) {
                f32x16 acc = mm_tile(zero16(), lds + L_S7, 32 * ti, lds + L_S8, 32 * tj, r32, hi);
                acc = mm_tile(acc, lds + L_S6, 32 * ti, lds + L_S3, 32 * tj, r32, hi);
                float* o = (float*)(urec + U_NRAW) + (size_t)(ti * 2 + tj) * 1024 + lane;
#pragma unroll
                for (int r = 0; r < 16; ++r) o[r * 64] = acc[r];
            } else if (which == 2) {
                f32x16 acc = mm_tile(zero16(), lds + L_S2, 32 * ti, lds + L_S1, 32 * tj, r32, hi);
                const int t = 32 * tj + r32;
#pragma unroll
                for (int g = 0; g < 4; ++g) { const int kb = 32 * ti + 8 * g + 4 * hi;
                    const u32x2 rt = *(const RLAS u32x2*)(lds + L_S5 + t * SB + kb * 2);
                    u32x2 pk; pk.x = cvtpk(acc[4 * g] + bflo(rt.x), acc[4 * g + 1] + bfhi(rt.x)); pk.y = cvtpk(acc[4 * g + 2] + bflo(rt.y), acc[4 * g + 3] + bfhi(rt.y));
                    *(u32x2*)(urec + U_G + (size_t)(t * 64 + kb) * 2) = pk; }
            } else {
                f32x16 acc = mm_tile(zero16(), lds + L_S8, 32 * ti, lds + L_S9, 32 * tj, r32, hi);
                acc = mm_tile(acc, lds + L_S3, 32 * ti, lds + L_S1, 32 * tj, r32, hi);
                float* o = (float*)(urec + U_HRAW) + (size_t)(ti * 2 + tj) * 1024 + lane;
#pragma unroll
                for (int r = 0; r < 16; ++r) o[r * 64] = acc[r];
            }
        }
    }
    __syncthreads();
}

__device__ __forceinline__ void split8(const f32x16& x, int sp, bf16x8& bh, bf16x8& bl) {
    u32x4 wh, wl; float lo[8];
    wh.x = cvtpk(x[8 * sp], x[8 * sp + 1]); wh.y = cvtpk(x[8 * sp + 2], x[8 * sp + 3]); wh.z = cvtpk(x[8 * sp + 4], x[8 * sp + 5]); wh.w = cvtpk(x[8 * sp + 6], x[8 * sp + 7]);
    lo[0] = x[8 * sp] - bflo(wh.x); lo[1] = x[8 * sp + 1] - bfhi(wh.x); lo[2] = x[8 * sp + 2] - bflo(wh.y); lo[3] = x[8 * sp + 3] - bfhi(wh.y);
    lo[4] = x[8 * sp + 4] - bflo(wh.z); lo[5] = x[8 * sp + 5] - bfhi(wh.z); lo[6] = x[8 * sp + 6] - bflo(wh.w); lo[7] = x[8 * sp + 7] - bfhi(wh.w);
    wl.x = cvtpk(lo[0], lo[1]); wl.y = cvtpk(lo[2], lo[3]); wl.z = cvtpk(lo[4], lo[5]); wl.w = cvtpk(lo[6], lo[7]);
    bh = __builtin_bit_cast(bf16x8, wh); bl = __builtin_bit_cast(bf16x8, wl);
}
__device__ __forceinline__ void store_state(float* dst  , const f32x16& s0, const f32x16& s1, int v, int hi) {
#pragma unroll
    for (int g = 0; g < 4; ++g) {
        *(f32x4*)(dst + v * 64 + 8 * g + 4 * hi) = (f32x4){s0[4 * g], s0[4 * g + 1], s0[4 * g + 2], s0[4 * g + 3]};
        *(f32x4*)(dst + v * 64 + 32 + 8 * g + 4 * hi) = (f32x4){s1[4 * g], s1[4 * g + 1], s1[4 * g + 2], s1[4 * g + 3]};
    }
}
struct StepOps { bf16x8 a0h[4], a0l[4], a1h[4], a1l[4]; f32x16 n0, n1; };
__device__ __forceinline__ void scan_load(const unsigned char* urec, int tv, int lane, StepOps& F) {
    const float* nr = (const float*)(urec + U_NRAW) + lane;
#pragma unroll
    for (int r = 0; r < 16; ++r) { F.n0[r] = nr[(size_t)(0 * 2 + tv) * 1024 + r * 64]; F.n1[r] = nr[(size_t)(1 * 2 + tv) * 1024 + r * 64]; }
#pragma unroll
    for (int s = 0; s < 4; ++s) {
        const unsigned char* f0 = urec + U_MFRAG + (size_t)(((0 * 4 + s) * 2) * 64 + lane) * 16;
        const unsigned char* f1 = urec + U_MFRAG + (size_t)(((1 * 4 + s) * 2) * 64 + lane) * 16;
        F.a0h[s] = *(const bf16x8*)f0; F.a0l[s] = *(const bf16x8*)(f0 + 1024); F.a1h[s] = *(const bf16x8*)f1; F.a1l[s] = *(const bf16x8*)(f1 + 1024);
    }
}
__device__ __forceinline__ void scan_compute(StepOps& F, f32x16& s0, f32x16& s1) {
    bf16x8 bh[4], bl[4];
    split8(s0, 0, bh[0], bl[0]); split8(s0, 1, bh[1], bl[1]); split8(s1, 0, bh[2], bl[2]); split8(s1, 1, bh[3], bl[3]);
#pragma unroll
    for (int s = 0; s < 4; ++s) {
        F.n0 = __builtin_amdgcn_mfma_f32_32x32x16_bf16(F.a0h[s], bh[s], F.n0, 0, 0, 0);
        F.n1 = __builtin_amdgcn_mfma_f32_32x32x16_bf16(F.a1h[s], bh[s], F.n1, 0, 0, 0);
        F.n0 = __builtin_amdgcn_mfma_f32_32x32x16_bf16(F.a0h[s], bl[s], F.n0, 0, 0, 0);
        F.n1 = __builtin_amdgcn_mfma_f32_32x32x16_bf16(F.a1h[s], bl[s], F.n1, 0, 0, 0);
        F.n0 = __builtin_amdgcn_mfma_f32_32x32x16_bf16(F.a0l[s], bh[s], F.n0, 0, 0, 0);
        F.n1 = __builtin_amdgcn_mfma_f32_32x32x16_bf16(F.a1l[s], bh[s], F.n1, 0, 0, 0);
    }
    s0 = F.n0; s1 = F.n1;
}
__device__ __forceinline__ void scan_sample(const Ptrs& P, int b, int h, int tv, int lane) {
    const int r32 = lane & 31, hi = lane >> 5, v = 32 * tv + r32;
    f32x16 s0, s1;
    const float* src = P.in[5] + ((size_t)b * 8 + h) * 4096;
#pragma unroll
    for (int g = 0; g < 4; ++g) {
        const f32x4 x0 = *(const f32x4*)(src + v * 64 + 8 * g + 4 * hi), x1 = *(const f32x4*)(src + v * 64 + 32 + 8 * g + 4 * hi);
#pragma unroll
        for (int i = 0; i < 4; ++i) { s0[4 * g + i] = x0[i]; s1[4 * g + i] = x1[i]; }
    }
    StepOps fa;
    scan_load(P.ws + WS_RW + (size_t)(2048 + b * 8 + h) * U_BYTES, tv, lane, fa);
    scan_compute(fa, s0, s1);
    store_state(P.out + O_L0WKV_S + ((size_t)b * 8 + h) * 4096, s0, s1, v, hi);
}
__device__ __forceinline__ void scan_prompt_wg(const Ptrs& P, int h, RLAS unsigned char* lds, int tid) {
    const int lane = tid & 63, wave = __builtin_amdgcn_readfirstlane(tid >> 6), r32 = lane & 31, hi = lane >> 5;
    constexpr int SLOT = 32768;
    const unsigned char* rec0 = P.ws + WS_RW + (size_t)h * U_BYTES;
    const size_t rstep = (size_t)8 * U_BYTES;
    for (int i = tid; i < 2 * 2048; i += 512) { const int st = i >> 11, j = i & 2047; *(RLAS f32x4*)(lds + st * SLOT + j * 16) = *(const f32x4*)(rec0 + st * rstep + (size_t)j * 16); }
    const int hl = (wave - 2) * 64 + lane;
    f32x4 hr[6];
#pragma unroll
    for (int i = 0; i < 6; ++i) hr[i] = (f32x4){0.f, 0.f, 0.f, 0.f};
    if (wave >= 2) {
#pragma unroll
        for (int i = 0; i < 6; ++i) { const int j = hl + 384 * i; if (j < 2048) hr[i] = *(const f32x4*)(rec0 + 2 * rstep + (size_t)j * 16); }
    }
    __syncthreads();
    const int tv = wave & 1, v = 32 * tv + r32;
    f32x16 s0 = zero16(), s1 = zero16();
    float* sst = (float*)(P.ws + WS_SST);
#pragma unroll 1
    for (int c = 0; c < 256; ++c) {
        if (wave >= 2) {
            if (c + 2 < 256) {
                RLAS unsigned char* dst = lds + ((c + 2) & 3) * SLOT;
#pragma unroll
                for (int i = 0; i < 6; ++i) { const int j = hl + 384 * i; if (j < 2048) *(RLAS f32x4*)(dst + j * 16) = hr[i]; }
            }
            if (c + 3 < 256) {
                const unsigned char* src = rec0 + (size_t)(c + 3) * rstep;
#pragma unroll
                for (int i = 0; i < 6; ++i) { const int j = hl + 384 * i; if (j < 2048) hr[i] = *(const f32x4*)(src + (size_t)j * 16); }
            }
        } else {
            store_state(sst + ((size_t)c * 8 + h) * 4096, s0, s1, v, hi);
            const RLAS unsigned char* sl = lds + (c & 3) * SLOT;
            bf16x8 bh[4], bl[4];
            split8(s0, 0, bh[0], bl[0]); split8(s0, 1, bh[1], bl[1]); split8(s1, 0, bh[2], bl[2]); split8(s1, 1, bh[3], bl[3]);
            f32x16 n0, n1;
            { const RLAS float* nr = (const RLAS float*)(sl + 16384) + lane;
#pragma unroll
              for (int r = 0; r < 16; ++r) { n0[r] = nr[(0 * 2 + tv) * 1024 + r * 64]; n1[r] = nr[(1 * 2 + tv) * 1024 + r * 64]; } }
#pragma unroll
            for (int s = 0; s < 4; ++s) {
                const RLAS unsigned char* f0 = sl + (((0 * 4 + s) * 2) * 64 + lane) * 16;
                const RLAS unsigned char* f1 = sl + (((1 * 4 + s) * 2) * 64 + lane) * 16;
                const bf16x8 a0h = *(const RLAS bf16x8*)f0, a0l = *(const RLAS bf16x8*)(f0 + 1024), a1h = *(const RLAS bf16x8*)f1, a1l = *(const RLAS bf16x8*)(f1 + 1024);
                n0 = __builtin_amdgcn_mfma_f32_32x32x16_bf16(a0h, bh[s], n0, 0, 0, 0);
                n1 = __builtin_amdgcn_mfma_f32_32x32x16_bf16(a1h, bh[s], n1, 0, 0, 0);
                n0 = __builtin_amdgcn_mfma_f32_32x32x16_bf16(a0h, bl[s], n0, 0, 0, 0);
                n1 = __builtin_amdgcn_mfma_f32_32x32x16_bf16(a1h, bl[s], n1, 0, 0, 0);
                n0 = __builtin_amdgcn_mfma_f32_32x32x16_bf16(a0l, bh[s], n0, 0, 0, 0);
                n1 = __builtin_amdgcn_mfma_f32_32x32x16_bf16(a1l, bh[s], n1, 0, 0, 0);
            }
            s0 = n0; s1 = n1;
        }
        __syncthreads();
    }
    if (wave < 2) store_state(P.out + O_L0WKV_P + (size_t)h * 4096, s0, s1, v, hi);
    __syncthreads();
}

__device__ __forceinline__ void unit_c(const Ptrs& P, int unit, int lane) {
    const int r32 = lane & 31, hi = lane >> 5;
    const bool samp = unit >= 2048;
    const int h = unit & 7, cb = samp ? (unit - 2048) >> 3 : unit >> 3;
    const int m_base = samp ? TP + 32 * cb : 64 * cb;
    const unsigned char* urec = P.ws + WS_RW + (size_t)unit * U_BYTES;
    const float* S0 = samp ? P.in[5] + ((size_t)cb * 8 + h) * 4096 : (const float*)(P.ws + WS_SST) + ((size_t)cb * 8 + h) * 4096;
    bf16x8 af[2][4];
#pragma unroll
    for (int tvb = 0; tvb < 2; ++tvb)
#pragma unroll
        for (int s = 0; s < 4; ++s) { const float* p = S0 + (32 * tvb + r32) * 64 + 16 * s + 8 * hi; const f32x4 x0 = *(const f32x4*)p, x1 = *(const f32x4*)(p + 4);
            u32x4 w; w.x = cvtpk(x0[0], x0[1]); w.y = cvtpk(x0[2], x0[3]); w.z = cvtpk(x1[0], x1[1]); w.w = cvtpk(x1[2], x1[3]); af[tvb][s] = __builtin_bit_cast(bf16x8, w); }
    const float* lng = P.in[27] + 64 * h; const float* lnb = P.in[28] + 64 * h;
#pragma unroll 1
    for (int tt = 0; tt < (samp ? 1 : 2); ++tt) {
        const int t = 32 * tt + r32;
        f32x16 acc[2];
#pragma unroll
        for (int tvb = 0; tvb < 2; ++tvb) { const float* hr = (const float*)(urec + U_HRAW) + (size_t)(tvb * 2 + tt) * 1024 + lane;
#pragma unroll
            for (int r = 0; r < 16; ++r) acc[tvb][r] = hr[r * 64]; }
        const bf16_t* gp = (const bf16_t*)(urec + U_G) + t * 64 + 8 * hi;
#pragma unroll
        for (int s = 0; s < 4; ++s) { const bf16x8 bfr = *(const bf16x8*)(gp + 16 * s);
            acc[0] = __builtin_amdgcn_mfma_f32_32x32x16_bf16(af[0][s], bfr, acc[0], 0, 0, 0);
            acc[1] = __builtin_amdgcn_mfma_f32_32x32x16_bf16(af[1][s], bfr, acc[1], 0, 0, 0); }
        float sm = 0.f;
#pragma unroll
        for (int r = 0; r < 16; ++r) sm += acc[0][r] + acc[1][r];
        sm += __shfl_xor(sm, 32);
        const float mean = sm * (1.f / 64);
        float sq = 0.f;
#pragma unroll
        for (int r = 0; r < 16; ++r) { const float d0 = acc[0][r] - mean, d1 = acc[1][r] - mean; sq += d0 * d0 + d1 * d1; }
        sq += __shfl_xor(sq, 32);
        const float rstd = rsqrtf(sq * (1.f / 64) + GN_EPS);
        const int m = m_base + t;
        const bf16_t* bon = (const bf16_t*)(urec + U_BON) + t * 64;
        const bf16_t* zb = (const bf16_t*)(P.ws + WS_PROJ0) + (size_t)m * N0P + C_ZB + 64 * h;
        bf16_t* cat = (bf16_t*)(P.ws + WS_CAT) + (size_t)m * D + 512 + 64 * h;
#pragma unroll
        for (int tvb = 0; tvb < 2; ++tvb)
#pragma unroll
            for (int g = 0; g < 4; ++g) {
                const int vb = 32 * tvb + 8 * g + 4 * hi;
                const u32x2 bo = *(const u32x2*)(bon + vb), zz = *(const u32x2*)(zb + vb);
                const f32x4 gg = *(const f32x4*)(lng + vb), bb = *(const f32x4*)(lnb + vb);
                float y[4];
                y[0] = ((acc[tvb][4 * g] - mean) * rstd * gg[0] + bb[0] + bflo(bo.x)) * silu(bflo(zz.x));
                y[1] = ((acc[tvb][4 * g + 1] - mean) * rstd * gg[1] + bb[1] + bfhi(bo.x)) * silu(bfhi(zz.x));
                y[2] = ((acc[tvb][4 * g + 2] - mean) * rstd * gg[2] + bb[2] + bflo(bo.y)) * silu(bflo(zz.y));
                y[3] = ((acc[tvb][4 * g + 3] - mean) * rstd * gg[3] + bb[3] + bfhi(bo.y)) * silu(bfhi(zz.y));
                u32x2 pk; pk.x = cvtpk(y[0], y[1]); pk.y = cvtpk(y[2], y[3]);
                *(u32x2*)(cat + vb) = pk;
            }
    }
}
#undef RLAS
}
#define LAS __attribute__((address_space(3)))
#define XB_TMO      128
#define XB_XCNT(j)  (256  + 64 * (j))
#define XB_XSUB(j)  (1280 + 64 * (j))
#define XB_XGEN(j)  (2304 + 64 * (j))
#define XB_TOP      3328
#define XB_TOPGEN   3392
#define XCD_BAR_WORDS 3456
#define XB_SPIN_CAP (1u << 18)

__device__ __forceinline__ unsigned xb_ld(unsigned* p)              { return __hip_atomic_load(p, __ATOMIC_RELAXED, __HIP_MEMORY_SCOPE_AGENT); }
__device__ __forceinline__ unsigned xb_add(unsigned* p, unsigned v) { return __hip_atomic_fetch_add(p, v, __ATOMIC_RELAXED, __HIP_MEMORY_SCOPE_AGENT); }
__device__ __forceinline__ unsigned xb_xcc_id() { return (unsigned)__builtin_amdgcn_s_getreg((3 << 11) | 20) & 0xFu; }
#define XB_SPIN(cond, bar) do { unsigned _sp = 0; while (cond) { __builtin_amdgcn_s_sleep(1); \
    if ((++_sp & 255u) == 0u) { if (xb_ld(&(bar)[XB_TMO])) break; if (_sp > XB_SPIN_CAP) { atomicAdd(&(bar)[XB_TMO], 1u); break; } } } } while (0)

struct XcdBarrier {
    unsigned* bar; unsigned x;
    volatile LAS unsigned* st;
};

__device__ __forceinline__ XcdBarrier xcd_barrier_post(unsigned* bar, volatile LAS unsigned* st) {
    XcdBarrier b; b.bar = bar; b.x = xb_xcc_id(); b.st = st;
    if (threadIdx.x == 0) (void)xb_add(&bar[XB_XCNT(b.x)], 1u);
    return b;
}
__device__ __forceinline__ void xcd_barrier_complete(unsigned* bar, unsigned x, unsigned& nloc, unsigned& nx) {
    const unsigned G = gridDim.x * gridDim.y * gridDim.z;
    unsigned sum, cnt, mine, sp = 0u;
    for (;;) {
        sum = 0u; cnt = 0u; mine = 0u;
#pragma unroll
        for (unsigned j = 0; j < 16; ++j) { const unsigned c = xb_ld(&bar[XB_XCNT(j)]); sum += c; cnt += (c > 0u) ? 1u : 0u; mine = (j == x) ? c : mine; }
        if (sum == G) break;
        __builtin_amdgcn_s_sleep(1);
        if ((++sp & 255u) == 0u) { if (xb_ld(&bar[XB_TMO])) break; if (sp > XB_SPIN_CAP) { atomicAdd(&bar[XB_TMO], 1u); break; } }
    }
    nloc = mine > 0u ? mine : 1u; nx = cnt > 0u ? cnt : 1u;
}

__device__ __forceinline__ void xcd_barrier(const XcdBarrier& b) {
    asm volatile("s_waitcnt vmcnt(0)" ::: "memory");
    __syncthreads();
    if (threadIdx.x == 0) {
        unsigned* bar = b.bar;
        __builtin_amdgcn_s_waitcnt(0);
        unsigned nloc = b.st[0], nx = b.st[1];
        if (nloc == 0u) { xcd_barrier_complete(bar, b.x, nloc, nx); b.st[0] = nloc; b.st[1] = nx; }
        const unsigned old = xb_add(&bar[XB_XSUB(b.x)], 1u);
        const unsigned gen = old / nloc;
        if (old + 1u == (gen + 1u) * nloc) {
            __builtin_amdgcn_fence(__ATOMIC_RELEASE, "agent");
            asm volatile("s_waitcnt vmcnt(0)" ::: "memory");
            const unsigned og = xb_add(&bar[XB_TOP], 1u);
            const unsigned tg = og / nx;
            if (og + 1u == (tg + 1u) * nx) xb_add(&bar[XB_TOPGEN], 1u);
            else XB_SPIN(xb_ld(&bar[XB_TOPGEN]) == tg, bar);
            __builtin_amdgcn_fence(__ATOMIC_ACQUIRE, "agent");
            xb_add(&bar[XB_XGEN(b.x)], 1u);
            asm volatile("s_waitcnt vmcnt(0)" ::: "memory");
        } else {
            XB_SPIN(xb_ld(&bar[XB_XGEN(b.x)]) == gen, bar);
            __builtin_amdgcn_fence(__ATOMIC_ACQUIRE, "agent");
            asm volatile("s_waitcnt vmcnt(0)" ::: "memory");
        }
    }
    __syncthreads();
}


#ifndef FAST_ATTN0
#define FAST_ATTN0 1
#endif
#ifndef SCAN_IN_MIX
#define SCAN_IN_MIX 1
#endif
#ifndef FAST_RW
#define FAST_RW 1
#endif
#ifndef FAST_ATTN1
#define FAST_ATTN1 1
#endif
#include <hip/hip_cooperative_groups.h>
namespace cg = cooperative_groups;
constexpr int NWAVES = 8, NTHREADS = 512;
constexpr int LDS_BYTES = 147456;
enum Phase { PH_PRO = 0, PH_GEMM1 = 1, PH_TOK = 2, PH_SCAN = 3, PH_MIX = 4, PH_RWC = 5, PH_GEMM2 = 6, PH_GEMM3 = 7, PH_ATTN1 = 8, PH_GEMM4 = 9, PH_END = 10 };
typedef float f32x4_t __attribute__((ext_vector_type(4)));
struct Args { Ptrs p; int ph_lo, ph_hi; int pad0, pad1; };


__device__ __forceinline__ unsigned pk2(float lo, float hi) { return (unsigned)f2bf(lo) | ((unsigned)f2bf(hi) << 16); }
__device__ __forceinline__ void p0_transpose_item(const float* W, int K, int N, bf16_t* WT, const float* g, LAS float* scr, int item, int lane) {
    typedef unsigned v4u __attribute__((ext_vector_type(4)));
    const int nblk = N / 32, kb = item / nblk, nb = item % nblk, k0 = 64 * kb, n0 = 32 * nb;
#pragma unroll 8
    for (int i = 0; i < 32; ++i) { const int kk = 2 * i + (lane >> 5); float v = W[(size_t)(k0 + kk) * N + n0 + (lane & 31)]; if (g) v *= g[k0 + kk]; scr[kk * 33 + (lane & 31)] = v; }
    asm volatile("s_waitcnt lgkmcnt(0)" ::: "memory");
    const int c = lane & 7;
#pragma unroll
    for (int j = 0; j < 4; ++j) { const int n = (lane >> 3) + 8 * j; const LAS float* s = scr + (8 * c) * 33 + n;
        v4u o; o.x = pk2(s[0 * 33], s[1 * 33]); o.y = pk2(s[2 * 33], s[3 * 33]); o.z = pk2(s[4 * 33], s[5 * 33]); o.w = pk2(s[6 * 33], s[7 * 33]);
        *(v4u*)(WT + (size_t)(n0 + n) * K + k0 + 8 * c) = o; }
    asm volatile("s_waitcnt lgkmcnt(0)" ::: "memory");
}

__global__ void __launch_bounds__(NTHREADS, 2) mk_fwd(Args a) {
    extern __shared__ __attribute__((aligned(16))) unsigned char lds[];
    const Ptrs& P = a.p;
    unsigned char* ws = P.ws;
    const int lo = a.ph_lo, hi = a.ph_hi;
    const int tid = threadIdx.x, lane = tid & 63, wave = tid >> 6;
    const int G = gridDim.x, gw = blockIdx.x * NWAVES + wave, NGW = G * NWAVES;
    float* wscr = (float*)lds + wave * 256;
    volatile LAS unsigned* bst = (volatile LAS unsigned*)((LAS unsigned char*)lds + LDS_BYTES - 64);
    if (tid < 2) bst[tid] = 0u;
    __syncthreads();
    XcdBarrier bar = xcd_barrier_post((unsigned*)(ws + WS_CTL) + 4096, bst);
#define IN(k) (lo <= (k) && (k) < hi)
#define SEAM(k) do { if (IN(k) && IN((k) + 1)) xcd_barrier(bar); } while (0)
    if (IN(PH_PRO)) {
        const size_t gt = (size_t)blockIdx.x * NTHREADS + tid, NT = (size_t)G * NTHREADS;
        {
            LAS float* scr = (LAS float*)((LAS unsigned char*)lds + wave * 16384);
            constexpr int I0 = (D / 64) * (N0 / 32), I1 = (D / 64) * (D / 32), I2 = (D / 64) * (N1 / 32), NIT = I0 + I1 + I2 + I1;
            for (int it = gw; it < NIT; it += NGW) {
                int r = it;
                if (r < I0) { p0_transpose_item(P.in[10], D, N0, (bf16_t*)(ws + WS_WT0), nullptr, scr, r, lane); continue; } r -= I0;
                if (r < I1) { p0_transpose_item(P.in[11], D, D, (bf16_t*)(ws + WS_WO0T), nullptr, scr, r, lane); continue; } r -= I1;
                if (r < I2) { p0_transpose_item(P.in[30], D, N1, (bf16_t*)(ws + WS_WT1), P.in[29], scr, r, lane); continue; } r -= I2;
                p0_transpose_item(P.in[31], D, D, (bf16_t*)(ws + WS_WO1T), nullptr, scr, r, lane);
            }
            for (size_t i = gt; i < (size_t)(N0P - N0) * D / 8; i += NT) ((f32x4_t*)((bf16_t*)(ws + WS_WT0) + (size_t)N0 * D))[i] = (f32x4_t){0.f, 0.f, 0.f, 0.f};
        }
        if (blockIdx.x == 0 && tid < 256) nv::d_tables(P, tid);
        for (size_t i = gt; i < 512 * 64; i += NT) { const int c = (int)(i >> 6), l = (int)(i & 63); bf16_t* LT = (bf16_t*)(ws + WS_LORA);
            LT[i] = f2bf(P.in[21][l * 512 + c]); LT[32768 + i] = f2bf(P.in[23][l * 512 + c]); }
        for (int m = gw; m < M; m += NGW) nv::d_rmsnorm_x(P, m, lane);
    }
    SEAM(PH_PRO);
    if (IN(PH_GEMM1)) {
        pg8::Gemm g{(const bf16_t*)(ws + WS_XN0), (const bf16_t*)(ws + WS_WT0), M, N0P, D}; pg8::StaticOrder S; S.init(M, N0P, G, (int)blockIdx.x);
        pg8::EpiProj0F E{(bf16_t*)(ws + WS_PROJ0)};
        pg8::gemm_phase<pg8::EpiProj0F, pg8::StaticOrder, true, true>((LAS unsigned char*)lds, g, S, E);
    }
    SEAM(PH_GEMM1);
    if (IN(PH_TOK)) {
        for (int m = gw; m < M; m += NGW) nv::d_tok0(P, m, lane);
        __syncthreads();
#if FAST_RW
        for (int u = blockIdx.x; u < rw::NUNIT; u += G) rw::unit_a(P, u, (LAS unsigned char*)lds, tid);
#else
        for (int m = blockIdx.x; m < M; m += G) { nv::d_rw_prep(P, m, tid, (float*)lds, (float*)lds + 64); __syncthreads(); }
#endif
    }
    SEAM(PH_TOK);
#if !SCAN_IN_MIX
    if (IN(PH_SCAN)) {
#if FAST_RW
        if (blockIdx.x < 8) rw::scan_prompt_wg(P, (int)blockIdx.x, (LAS unsigned char*)lds, tid);
        else for (int i = gw - 64; i < 512; i += NGW - 64) rw::scan_sample(P, i >> 4, (i >> 1) & 7, i & 1, lane);
#else
        if (gw < 33 * 8) nv::d_rw_scan(P, gw >> 3, gw & 7, lane);
#endif
    }
    SEAM(PH_SCAN);
#endif
    if (IN(PH_MIX)) {
#if SCAN_IN_MIX
        if (blockIdx.x < 8) rw::scan_prompt_wg(P, (int)blockIdx.x, (LAS unsigned char*)lds, tid);
        else for (int i = gw - 64; i < 512; i += NGW - 64) rw::scan_sample(P, i >> 4, (i >> 1) & 7, i & 1, lane);
#endif
#if FAST_ATTN0
        __syncthreads();
        da::phase(P, (LAS unsigned char*)lds, (unsigned*)(ws + WS_CTL), bst + 4, tid);
#else
        for (int i = gw; i < M * 4; i += NGW) nv::d_attn0(P, i >> 2, i & 3, lane, wscr, wscr + 128);
#endif
    }
    SEAM(PH_MIX);
#if FAST_RW
    if (IN(PH_RWC)) { for (int u = gw; u < rw::NUNIT; u += NGW) rw::unit_c(P, u, lane); }
#endif
    SEAM(PH_RWC);
    if (IN(PH_GEMM2)) {
        pg8::Gemm g{(const bf16_t*)(ws + WS_CAT), (const bf16_t*)(ws + WS_WO0T), M, D, D}; pg8::StaticOrder S; S.init(M, D, G, (int)blockIdx.x);
        pg8::EpiY0F E{P};
        pg8::gemm_phase<pg8::EpiY0F, pg8::StaticOrder, true, true>((LAS unsigned char*)lds, g, S, E);
    }
    SEAM(PH_GEMM2);
    if (IN(PH_GEMM3)) {
        pg8::Gemm g{(const bf16_t*)(ws + WS_Y0B), (const bf16_t*)(ws + WS_WT1), M, N1, D}; pg8::StaticOrder S; S.init(M, N1, G, (int)blockIdx.x);
        pg8::EpiL1F E{P};
        pg8::gemm_phase<pg8::EpiL1F, pg8::StaticOrder, true, true>((LAS unsigned char*)lds, g, S, E);
    }
    SEAM(PH_GEMM3);
    if (IN(PH_ATTN1)) {
#if FAST_ATTN1
        sb::phase(P, (LAS unsigned char*)lds, (int)blockIdx.x, G, tid);
#else
        for (int i = gw; i < M * 16; i += NGW) nv::d_attn1(P, i >> 4, i & 15, lane, wscr, wscr + 64);
#endif
    }
    SEAM(PH_ATTN1);
    if (IN(PH_GEMM4)) {
        pg8::Gemm g{(const bf16_t*)(ws + WS_O1B), (const bf16_t*)(ws + WS_WO1T), M, D, D}; pg8::StaticOrder S; S.init(M, D, G, (int)blockIdx.x);
        pg8::EpiOutF E{P};
        pg8::gemm_phase<pg8::EpiOutF, pg8::StaticOrder, true, true>((LAS unsigned char*)lds, g, S, E);
    }
#undef IN
#undef SEAM
}
extern "C" void kernel_launch(void* const* d_in, const int* in_sizes, int n_in, void* d_out, int out_size, void* d_ws, size_t ws_size, hipStream_t stream) {
    static int grid = 0;
    if (n_in != 32 || (size_t)out_size != O_TOTAL || ws_size < WS_END) { fprintf(stderr, "kernel_launch: unexpected shapes n_in=%d out=%d ws=%zu\n", n_in, out_size, ws_size); return; }
    if (grid == 0) {
        int dev = 0, cus = 0, per_cu = 0;
        (void)hipGetDevice(&dev); (void)hipDeviceGetAttribute(&cus, hipDeviceAttributeMultiprocessorCount, dev);
        (void)hipFuncSetAttribute((const void*)mk_fwd, hipFuncAttributeMaxDynamicSharedMemorySize, LDS_BYTES);
        (void)hipOccupancyMaxActiveBlocksPerMultiprocessor(&per_cu, (const void*)mk_fwd, NTHREADS, LDS_BYTES);
        if (per_cu < 1) { fprintf(stderr, "kernel_launch: occupancy query says %d blocks/CU\n", per_cu); per_cu = 1; }
        grid = (cus > 0 ? cus : 256);
    }
    Args a{};
    for (int i = 0; i < 32; ++i) a.p.in[i] = (const float*)d_in[i];
    a.p.out = (float*)d_out; a.p.ws = (unsigned char*)d_ws; a.ph_lo = 0; a.ph_hi = PH_END;
    (void)hipMemsetAsync((char*)d_ws + WS_CTL, 0, 256 * 1024, stream);
    void* args[] = {&a};
#ifdef REP_PHASE
    a.ph_hi = REP_PHASE + 1;
    (void)hipLaunchCooperativeKernel((const void*)mk_fwd, dim3(grid), dim3(NTHREADS), args, LDS_BYTES, stream);
    (void)hipMemsetAsync((char*)d_ws + WS_CTL, 0, 256 * 1024, stream);
    a.ph_lo = REP_PHASE; a.ph_hi = PH_END;
#endif
    hipError_t e = hipLaunchCooperativeKernel((const void*)mk_fwd, dim3(grid), dim3(NTHREADS), args, LDS_BYTES, stream);
    if (e != hipSuccess) fprintf(stderr, "cooperative launch failed: %s (grid %d)\n", hipGetErrorString(e), grid);
}
```
